# Optimizing an MI355X kernel written in HIP

```python
import math
import jax, jax.numpy as jnp
from jax import lax
import numpy as np

D_MODEL = 1024
BATCH = 16
SEQ = 2048
DEPTH = 4
DEC_BATCH = 8
DEC_SEQ = 4096
PAST_LEN = 128

GRID_W = 64
N_MIXERS = 2
N_HYENA = (DEPTH + 1) // 2
N_ATTN = DEPTH // 2
HY_WIDTH = D_MODEL
HY_ORDER = 2
SHORT_CONV = 3
POS_EMB_DIM = 33
POS_BANDS = (POS_EMB_DIM - 1) // 2
FILTER_WIDTH = 64
DECAY_TARGET = 1e-2
FAST_DECAY_PCT = 0.3
SLOW_DECAY_PCT = 1.5
FILTER_EPS = 1e-6
HEAD_DIM = 128
N_Q_HEADS = D_MODEL // HEAD_DIM
N_KV_HEADS = 2
GROUP = N_Q_HEADS // N_KV_HEADS
ATTN_WIDTH = N_Q_HEADS * HEAD_DIM
KV_WIDTH = N_KV_HEADS * HEAD_DIM
AXIS_DIM = HEAD_DIM // 2
ROPE_THETA = 10000.0
Q_BLOCK = 128
RMS_EPS = 1e-6
LN_EPS = 1e-5
DEEPNORM_ALPHA = (2.0 * DEPTH) ** 0.25
DEEPNORM_BETA = (8.0 * DEPTH) ** -0.25

kernel_name = "hyena_axial_gqa_deepnorm_encoder"

F32 = jnp.float32


def layer_norm(x, g, b):
    xf = x.astype(F32)
    mu = jnp.mean(xf, axis=-1, keepdims=True)
    xc = xf - mu
    var = jnp.mean(xc * xc, axis=-1, keepdims=True)
    return (xc * lax.rsqrt(var + LN_EPS) * g.astype(F32) + b.astype(F32)).astype(x.dtype)


def short_conv(u, w, b):
    L = u.shape[1]
    up = jnp.pad(u, ((0, 0), (1, 1), (0, 0)))
    return up[:, :L] * w[0] + up[:, 1:L + 1] * w[1] + up[:, 2:] * w[2] + b


def hyena_filters(L, w1, b1, freq, w2, b2, w3, decay):
    t = jnp.linspace(0.0, 1.0, L, dtype=F32)[:, None]
    w = 2.0 * math.pi * jnp.arange(L, dtype=F32)[:, None] / L
    f = jnp.linspace(1e-4, POS_BANDS - 1, POS_BANDS, dtype=F32)[None]
    feats = jnp.concatenate([t, jnp.cos(f * w), -jnp.sin(f * w)], axis=-1)
    fr = freq.astype(F32)
    h = jnp.sin(fr * (feats @ w1.astype(F32) + b1.astype(F32)))
    h = jnp.sin(fr * (h @ w2.astype(F32) + b2.astype(F32)))
    h = h @ w3.astype(F32)
    h = h * jnp.exp(-t * jnp.abs(decay.astype(F32)))
    h = h.reshape(L, HY_ORDER, 2, HY_WIDTH)
    h = h * lax.rsqrt(jnp.sum(h * h, axis=(0, 2), keepdims=True) + FILTER_EPS)
    fwd = h[:, :, 0]
    bwd = h[:, :, 1]
    k = jnp.concatenate([fwd, jnp.zeros((1, HY_ORDER, HY_WIDTH), F32), bwd[:0:-1]], axis=0)
    return jnp.fft.rfft(k, axis=0)


def long_conv(z, kf):
    L = z.shape[1]
    zf = jnp.fft.rfft(z, n=2 * L, axis=1)
    return jnp.fft.irfft(zf * kf[None], n=2 * L, axis=1)[:, :L]


def hyena_mixer(x, w_in, b_in, conv_w, conv_b, f_w1, f_b1, f_freq, f_w2, f_b2, f_w3, decay, filt_bias, w_out, b_out):
    L = x.shape[1]
    u = x @ w_in + b_in
    proj = short_conv(u[..., :3 * HY_WIDTH], conv_w, conv_b)
    gate = u[..., 3 * HY_WIDTH:]
    v = proj[..., :HY_WIDTH]
    gates = (proj[..., HY_WIDTH:2 * HY_WIDTH], proj[..., 2 * HY_WIDTH:])
    kf = hyena_filters(L, f_w1, f_b1, f_freq, f_w2, f_b2, f_w3, decay)
    z = v.astype(F32)
    for o in range(HY_ORDER):
        z = gates[o].astype(F32) * (long_conv(z, kf[:, o]) + z * filt_bias[o].astype(F32))
    y = z.astype(x.dtype) * jax.nn.silu(gate)
    return y @ w_out + b_out


def axial_rope(L):
    rows = L // GRID_W
    row = jnp.repeat(jnp.arange(rows, dtype=F32), GRID_W)
    col = jnp.tile(jnp.arange(GRID_W, dtype=F32), rows)
    inv = ROPE_THETA ** (-jnp.arange(0, AXIS_DIM, 2, dtype=F32) / AXIS_DIM)
    ang = jnp.concatenate([row[:, None] * inv, col[:, None] * inv], axis=-1)
    return jnp.cos(ang), jnp.sin(ang)


def apply_rope(x, cos, sin):
    c = cos[None, :, None]
    s = sin[None, :, None]
    x1 = x[..., :AXIS_DIM]
    x2 = x[..., AXIS_DIM:]
    return jnp.concatenate([x1 * c - x2 * s, x2 * c + x1 * s], axis=-1)


def rms_heads(x, g):
    xf = x.astype(F32)
    return xf * lax.rsqrt(jnp.mean(xf * xf, axis=-1, keepdims=True) + RMS_EPS) * g.astype(F32)


def attention_mixer(x, w_in, b_in, q_norm, k_norm, w_out, b_out):
    B, L, _ = x.shape
    u = x @ w_in + b_in
    q = u[..., :ATTN_WIDTH].reshape(B, L, N_Q_HEADS, HEAD_DIM)
    k = u[..., ATTN_WIDTH:ATTN_WIDTH + KV_WIDTH].reshape(B, L, N_KV_HEADS, HEAD_DIM)
    v = u[..., ATTN_WIDTH + KV_WIDTH:ATTN_WIDTH + 2 * KV_WIDTH].reshape(B, L, N_KV_HEADS, HEAD_DIM)
    gate = u[..., ATTN_WIDTH + 2 * KV_WIDTH:]
    cos, sin = axial_rope(L)
    q = apply_rope(rms_heads(q, q_norm), cos, sin).astype(x.dtype)
    k = apply_rope(rms_heads(k, k_norm), cos, sin).astype(x.dtype)
    nb = L // Q_BLOCK
    qb = q.reshape(B, nb, Q_BLOCK, N_KV_HEADS, GROUP, HEAD_DIM).transpose(1, 0, 3, 4, 2, 5)
    kt = k.transpose(0, 2, 1, 3)
    vt = v.transpose(0, 2, 1, 3)
    scale = HEAD_DIM ** -0.5

    def block(qi):
        s = jnp.einsum("bkgqd,bksd->bkgqs", qi, kt).astype(F32) * scale
        p = jax.nn.softmax(s, axis=-1).astype(vt.dtype)
        return jnp.einsum("bkgqs,bksd->bkgqd", p, vt)

    o = lax.map(block, qb)
    o = o.transpose(1, 0, 4, 2, 3, 5).reshape(B, L, ATTN_WIDTH)
    y = o * jax.nn.silu(gate)
    return y @ w_out + b_out


def trunk(x, hy_w_in, hy_b_in, hy_conv_w, hy_conv_b, hy_f_w1, hy_f_b1, hy_f_freq, hy_f_w2, hy_f_b2, hy_f_w3,
          hy_decay, hy_filt_bias, hy_w_out, hy_b_out, at_w_in, at_b_in, at_q_norm, at_k_norm, at_w_out, at_b_out,
          ln_g, ln_b):
    for i in range(DEPTH):
        j = i // N_MIXERS
        if i % N_MIXERS == 0:
            s = hyena_mixer(x, hy_w_in[j], hy_b_in[j], hy_conv_w[j], hy_conv_b[j], hy_f_w1[j], hy_f_b1[j],
                            hy_f_freq[j], hy_f_w2[j], hy_f_b2[j], hy_f_w3[j], hy_decay[j], hy_filt_bias[j],
                            hy_w_out[j], hy_b_out[j])
        else:
            s = attention_mixer(x, at_w_in[j], at_b_in[j], at_q_norm[j], at_k_norm[j], at_w_out[j], at_b_out[j])
        x = layer_norm(DEEPNORM_ALPHA * x + s, ln_g[i], ln_b[i])
    return x


def setup_inputs(seed: int = 0) -> dict:
    key = jax.random.key(seed)
    ks = jax.random.split(key, 24)
    E = HY_WIDTH
    nrm = lambda k, shape, sc: jax.random.normal(k, shape, F32) * sc
    base_decay = jnp.linspace(abs(math.log(DECAY_TARGET)) / SLOW_DECAY_PCT,
                              abs(math.log(DECAY_TARGET)) / FAST_DECAY_PCT, E, dtype=F32)
    attn_in = ATTN_WIDTH + 2 * KV_WIDTH + ATTN_WIDTH
    return {
        "x_prompt": nrm(ks[0], (BATCH, SEQ, D_MODEL), 1.0),
        "x_sample": nrm(ks[1], (DEC_BATCH, DEC_SEQ, D_MODEL), 1.0),
        "hy_w_in": nrm(ks[2], (N_HYENA, D_MODEL, 4 * E), D_MODEL ** -0.5),
        "hy_b_in": nrm(ks[3], (N_HYENA, 4 * E), 0.01),
        "hy_conv_w": nrm(ks[4], (N_HYENA, SHORT_CONV, 3 * E), SHORT_CONV ** -0.5),
        "hy_conv_b": nrm(ks[5], (N_HYENA, 3 * E), 0.01),
        "hy_f_w1": nrm(ks[6], (N_HYENA, POS_EMB_DIM, FILTER_WIDTH), POS_EMB_DIM ** -0.5),
        "hy_f_b1": nrm(ks[7], (N_HYENA, FILTER_WIDTH), 0.01),
        "hy_f_freq": 1.0 + nrm(ks[8], (N_HYENA, FILTER_WIDTH), 0.01),
        "hy_f_w2": nrm(ks[9], (N_HYENA, FILTER_WIDTH, FILTER_WIDTH), FILTER_WIDTH ** -0.5),
        "hy_f_b2": nrm(ks[10], (N_HYENA, FILTER_WIDTH), 0.01),
        "hy_f_w3": nrm(ks[11], (N_HYENA, FILTER_WIDTH, 2 * HY_ORDER * E), FILTER_WIDTH ** -0.5),
        "hy_decay": jnp.tile(base_decay, 2 * HY_ORDER)[None] + nrm(ks[12], (N_HYENA, 2 * HY_ORDER * E), 0.1),
        "hy_filt_bias": nrm(ks[13], (N_HYENA, HY_ORDER, E), 1.0),
        "hy_w_out": nrm(ks[14], (N_HYENA, E, D_MODEL), DEEPNORM_BETA * E ** -0.5),
        "hy_b_out": nrm(ks[15], (N_HYENA, D_MODEL), 0.01),
        "at_w_in": nrm(ks[16], (N_ATTN, D_MODEL, attn_in), D_MODEL ** -0.5),
        "at_b_in": nrm(ks[17], (N_ATTN, attn_in), 0.01),
        "at_q_norm": 1.0 + nrm(ks[18], (N_ATTN, HEAD_DIM), 0.01),
        "at_k_norm": 1.0 + nrm(ks[19], (N_ATTN, HEAD_DIM), 0.01),
        "at_w_out": nrm(ks[20], (N_ATTN, ATTN_WIDTH, D_MODEL), DEEPNORM_BETA * ATTN_WIDTH ** -0.5),
        "at_b_out": nrm(ks[21], (N_ATTN, D_MODEL), 0.01),
        "ln_g": 1.0 + nrm(ks[22], (DEPTH, D_MODEL), 0.01),
        "ln_b": nrm(ks[23], (DEPTH, D_MODEL), 0.01),
    }


def reference(x_prompt, x_sample, hy_w_in, hy_b_in, hy_conv_w, hy_conv_b, hy_f_w1, hy_f_b1, hy_f_freq, hy_f_w2,
              hy_f_b2, hy_f_w3, hy_decay, hy_filt_bias, hy_w_out, hy_b_out, at_w_in, at_b_in, at_q_norm, at_k_norm,
              at_w_out, at_b_out, ln_g, ln_b):
    y_prompt = trunk(x_prompt, hy_w_in, hy_b_in, hy_conv_w, hy_conv_b, hy_f_w1, hy_f_b1, hy_f_freq, hy_f_w2,
                     hy_f_b2, hy_f_w3, hy_decay, hy_filt_bias, hy_w_out, hy_b_out, at_w_in, at_b_in, at_q_norm,
                     at_k_norm, at_w_out, at_b_out, ln_g, ln_b)
    y_sample = trunk(x_sample, hy_w_in, hy_b_in, hy_conv_w, hy_conv_b, hy_f_w1, hy_f_b1, hy_f_freq, hy_f_w2,
                     hy_f_b2, hy_f_w3, hy_decay, hy_filt_bias, hy_w_out, hy_b_out, at_w_in, at_b_in, at_q_norm,
                     at_k_norm, at_w_out, at_b_out, ln_g, ln_b)
    return (y_prompt, y_sample)
```

```cpp
#include <hip/hip_runtime.h>
#include <hip/hip_cooperative_groups.h>
#include <cstdio>
#include <cstdint>
namespace cg = cooperative_groups;

#ifndef MK_LAUNCHES
#define MK_LAUNCHES 1
#endif

__device__ __forceinline__ int tidx() { int t = threadIdx.x; asm volatile("" : "+v"(t)); return t; }

namespace pg8 {
#define PG8_LAS __attribute__((address_space(3)))
typedef unsigned short bf16_t;
typedef short bf16x8 __attribute__((ext_vector_type(8)));
typedef float f32x4 __attribute__((ext_vector_type(4)));
typedef unsigned u32x4 __attribute__((ext_vector_type(4)));
constexpr int BM = 256, BK = 64, HALF = 128, HTB = HALF * BK * 2  , STAGE_BYTES = 8 * HTB, NXCD = 8, WGM = 8;

__host__ __device__ __forceinline__ int lds_byte(int r, int c) { const int st = (r >> 4) * 2 + (c >> 5), rr = r & 15, cc = c & 31, ob = rr * 64 + cc * 2; return st * 1024 + (ob ^ (((ob >> 9) & 1) << 5)); }
__host__ __device__ __forceinline__ void stage_rc(int b, int& R, int& C) { const int st = b / 1024, sb = b % 1024, swz = sb ^ (((sb >> 9) & 1) << 5); R = (st >> 1) * 16 + swz / 64; C = (st & 1) * 32 + (swz % 64) / 2; }
__host__ __device__ __forceinline__ int perm32(int rho) { const int n = rho >> 4, i = rho & 15; return 8 * (i >> 2) + 4 * n + (i & 3); }

struct Unit { int pm, pn; };
struct Gemm { const bf16_t* A; const bf16_t* Bt; int M, N, K; };
struct StaticOrder {
    int nM, nN, nwg, G, c;
    __host__ __device__ void init(int M, int N, int G_, int c_) { nM = M / BM; nN = N / BM; nwg = nM * nN; G = G_; c = c_; }
    __host__ __device__ bool next(int i, Unit& u) const {
        const long L = (long)i * G + c; if (L >= nwg) return false;
        int wgid = (int)L; { const int q = nwg / NXCD, r = nwg % NXCD, xcd = wgid % NXCD, off = wgid / NXCD; wgid = (xcd < r ? xcd * (q + 1) : r * (q + 1) + (xcd - r) * q) + off; }
        const int nig = WGM * nN, gid = wgid / nig, fm = gid * WGM, gsz = (nM - fm) < WGM ? (nM - fm) : WGM;
        u.pm = fm + ((wgid % nig) % gsz); u.pn = (wgid % nig) / gsz; return true;
    }
    __device__ __forceinline__ void a_ready(const Unit&) const {}
    __device__ __forceinline__ void done(const Unit&) const {}
};
__device__ __forceinline__ unsigned cvt_pk_bf16(float lo, float hi) { unsigned r; asm volatile("v_cvt_pk_bf16_f32 %0, %1, %2" : "=v"(r) : "v"(lo), "v"(hi)); return r; }
template <class Epi, class Sched, bool STAMP = false>
__device__ __forceinline__ void gemm_phase(PG8_LAS unsigned char* lds, const Gemm g, const Sched& S, const Epi& E, unsigned long long* stamps) {
    const int tid = tidx(), wid = __builtin_amdgcn_readfirstlane(tid >> 6), lane = tid & 63, wr = wid >> 2, wc = wid & 3, fr = lane & 15, fq = lane >> 4;
    const int K = g.K, nt = K / BK;
    unsigned voffA[2], voffB[2];
#pragma unroll
    for (int i = 0; i < 2; ++i) { int R, C; stage_rc(tid * 16 + i * 8192, R, C); const int Rb = Epi::PERM ? ((R & ~31) + perm32(R & 31)) : R;
        voffA[i] = (unsigned)(R * K + C) * 2u; voffB[i] = (unsigned)(Rb * K + C) * 2u; }
    const size_t kstep = (size_t)(BK * 2);
    const size_t hstep = (size_t)HALF * K * 2;
    const size_t tstep = 2 * hstep;
    const unsigned ldsw = (unsigned)wid * 1024u;
    const int aoff = lds_byte(wr * 64 + fr, fq * 8), boff = lds_byte(wc * 32 + fr, fq * 8);
#define PG8_SA(b, h) (((b) * 2 + (h)) * HTB)
#define PG8_SB(b, h) ((4 + (b) * 2 + (h)) * HTB)
#define PG8_STAGE(bufoff, gbase, voff) do { _Pragma("unroll") for (int _i = 0; _i < 2; ++_i) \
        __builtin_amdgcn_global_load_lds((const unsigned*)((const char*)(gbase) + (voff)[_i]), (PG8_LAS unsigned*)(lds + (bufoff) + ldsw + _i * 8192), 16, 0, 0); } while (0)
#define PG8_LDA(dst, b, h) do { _Pragma("unroll") for (int m = 0; m < 4; ++m) _Pragma("unroll") for (int k = 0; k < 2; ++k) dst[m][k] = *(const PG8_LAS bf16x8*)(lds + PG8_SA(b, h) + aoff + m * 2048 + k * 1024); } while (0)
#define PG8_LDB(dst, b, h) do { _Pragma("unroll") for (int n = 0; n < 2; ++n) _Pragma("unroll") for (int k = 0; k < 2; ++k) dst[n][k] = *(const PG8_LAS bf16x8*)(lds + PG8_SB(b, h) + boff + n * 2048 + k * 1024); } while (0)
#define PG8_MMA(ai, bj, At, Bt) do { __builtin_amdgcn_s_setprio(1); _Pragma("unroll") for (int m = 0; m < 4; ++m) _Pragma("unroll") for (int n = 0; n < 2; ++n) _Pragma("unroll") for (int k = 0; k < 2; ++k) \
        acc[ai][bj][m][n] = __builtin_amdgcn_mfma_f32_16x16x32_bf16(Bt[n][k], At[m][k], acc[ai][bj][m][n], 0, 0, 0); __builtin_amdgcn_s_setprio(0); } while (0)
#define PG8_WAIT_V(n) asm volatile("s_waitcnt vmcnt(" #n ")" ::: "memory")
#define PG8_WAIT_L(n) asm volatile("s_waitcnt lgkmcnt(" #n ")" ::: "memory")
#define PG8_BAR __builtin_amdgcn_s_barrier()
#define PG8_SCHED __builtin_amdgcn_sched_barrier(0)
    Unit cur, nxt; int ui = 0;
    if (!S.next(0, cur)) return;
    f32x4 acc[2][2][4][2];
#pragma unroll
    for (int a = 0; a < 2; ++a)
#pragma unroll
        for (int b = 0; b < 2; ++b)
#pragma unroll
            for (int m = 0; m < 4; ++m)
#pragma unroll
                for (int n = 0; n < 2; ++n) acc[a][b][m][n] = (f32x4){0.f, 0.f, 0.f, 0.f};
    bf16x8 At[4][2], B0[2][2], B1[2][2];
    const char* cA = (const char*)g.A + (size_t)cur.pm * tstep; const char* cB = (const char*)g.Bt + (size_t)cur.pn * tstep;
    S.a_ready(cur);
    PG8_STAGE(PG8_SB(0, 0), cB, voffB); PG8_STAGE(PG8_SA(0, 0), cA, voffA); PG8_STAGE(PG8_SB(0, 1), cB + hstep, voffB); PG8_STAGE(PG8_SA(0, 1), cA + hstep, voffA);
    if (wr == 1) PG8_BAR;
    PG8_WAIT_V(4); PG8_BAR;
    PG8_STAGE(PG8_SB(1, 0), cB + kstep, voffB); PG8_STAGE(PG8_SA(1, 0), cA + kstep, voffA); PG8_STAGE(PG8_SB(1, 1), cB + hstep + kstep, voffB);
    PG8_WAIT_V(6); PG8_BAR;
    for (;;) {
        const bool has_next = S.next(ui + 1, nxt);
        const char* nA = has_next ? (const char*)g.A + (size_t)nxt.pm * tstep : cA; const char* nB = has_next ? (const char*)g.Bt + (size_t)nxt.pn * tstep : cB;
        for (int t = 0; t < nt; t += 2) {
            const bool last = (t == nt - 2);
            const char* a1 = cA + (size_t)(t + 1) * kstep;
            const char* a2 = last ? nA : cA + (size_t)(t + 2) * kstep; const char* b2 = last ? nB : cB + (size_t)(t + 2) * kstep;
            const char* a3 = a2 + kstep; const char* b3 = b2 + kstep;
            if (last && has_next) S.a_ready(nxt);
            PG8_LDB(B0, 0, 0); PG8_SCHED; PG8_LDA(At, 0, 0); PG8_STAGE(PG8_SA(1, 1), a1 + hstep, voffA);
            PG8_WAIT_L(8); PG8_BAR; PG8_WAIT_L(0); PG8_MMA(0, 0, At, B0); PG8_BAR; PG8_SCHED;
            PG8_LDB(B1, 0, 1); PG8_STAGE(PG8_SB(0, 0), b2, voffB);
            PG8_BAR; PG8_WAIT_L(0); PG8_MMA(0, 1, At, B1); PG8_BAR;
            PG8_LDA(At, 0, 1); PG8_STAGE(PG8_SA(0, 0), a2, voffA);
            PG8_BAR; PG8_WAIT_L(0); PG8_MMA(1, 0, At, B0); PG8_BAR; PG8_SCHED;
            PG8_STAGE(PG8_SB(0, 1), b2 + hstep, voffB);
            PG8_WAIT_V(6); PG8_BAR; PG8_MMA(1, 1, At, B1); PG8_BAR;
            PG8_LDB(B0, 1, 0); PG8_SCHED; PG8_LDA(At, 1, 0); PG8_STAGE(PG8_SA(0, 1), a2 + hstep, voffA);
            PG8_WAIT_L(8); PG8_BAR; PG8_WAIT_L(0); PG8_MMA(0, 0, At, B0); PG8_BAR; PG8_SCHED;
            PG8_LDB(B1, 1, 1); PG8_STAGE(PG8_SB(1, 0), b3, voffB);
            PG8_BAR; PG8_WAIT_L(0); PG8_MMA(0, 1, At, B1); PG8_BAR;
            PG8_LDA(At, 1, 1); PG8_STAGE(PG8_SA(1, 0), a3, voffA);
            PG8_BAR; PG8_WAIT_L(0); PG8_MMA(1, 0, At, B0); PG8_BAR; PG8_SCHED;
            PG8_STAGE(PG8_SB(1, 1), b3 + hstep, voffB);
            PG8_WAIT_V(6); PG8_BAR; PG8_MMA(1, 1, At, B1); PG8_BAR;
        }
        if constexpr (!Epi::AFTER_DRAIN) { E(acc, cur, wr, wc, fr, fq); S.done(cur); }
        if (!has_next) break;
#pragma unroll
        for (int a = 0; a < 2; ++a)
#pragma unroll
            for (int b = 0; b < 2; ++b)
#pragma unroll
                for (int m = 0; m < 4; ++m)
#pragma unroll
                    for (int n = 0; n < 2; ++n) acc[a][b][m][n] = (f32x4){0.f, 0.f, 0.f, 0.f};
        cur = nxt; cA = nA; cB = nB; ++ui;
    }
    PG8_WAIT_V(0);
    if (wr == 0) PG8_BAR;
    PG8_BAR;
    if constexpr (Epi::AFTER_DRAIN) { E.fused(acc, cur, wr, wc, fr, fq, lds, wid, lane); S.done(cur); }
#undef PG8_SA
#undef PG8_SB
#undef PG8_STAGE
#undef PG8_LDA
#undef PG8_LDB
#undef PG8_MMA
#undef PG8_WAIT_V
#undef PG8_WAIT_L
#undef PG8_BAR
#undef PG8_SCHED
}
}

using pg8::bf16_t; using pg8::bf16x8; using pg8::f32x4; using pg8::u32x4; using pg8::cvt_pk_bf16;
typedef short s16x4 __attribute__((ext_vector_type(4)));
typedef float f32x8 __attribute__((ext_vector_type(8)));
typedef float f32x16 __attribute__((ext_vector_type(16)));
typedef unsigned u32x2 __attribute__((ext_vector_type(2)));

constexpr int DM = 1024, TG = 32768;
constexpr size_t MiB = 1u << 20;
constexpr size_t WS_HWIN = 0, WS_HWOUT = 16 * MiB, WS_AWIN = 20 * MiB, WS_AWOUT = 30 * MiB, WS_H2 = 34 * MiB, WS_XB = 38 * MiB,
                 WS_UT = 102 * MiB, WS_GATE = 294 * MiB, WS_Y = 358 * MiB, WS_END = 422 * MiB;
constexpr int LDS_BYTES = 136 * 1024;
constexpr float ALPHA = 1.681792830507429f;
constexpr int NPHASE = 1 + 2 * 21;
#ifndef PHMASK
#define PHMASK 0xFFFF
#endif

struct Params { const float* in[24]; float* out; unsigned char* ws; int ph_lo, ph_hi; };
struct PV { const Params& q; int z; float* out; unsigned char* ws;
    __device__ __forceinline__ PV(const Params& q_, int z_) : q(q_), z(z_), out(q_.out + z_), ws(q_.ws + z_) {}
    __device__ __forceinline__ const float* in(int k) const { return q.in[k + z]; } };

__device__ __forceinline__ float bf2f(unsigned short x) { return __uint_as_float(((unsigned)x) << 16); }
__device__ __forceinline__ float bf2f_s(short x) { return __uint_as_float(((unsigned)(unsigned short)x) << 16); }
__device__ __forceinline__ unsigned short f2bf(float x) { return (unsigned short)(cvt_pk_bf16(x, 0.f) & 0xffffu); }
__device__ __forceinline__ float wave_sum(float v) {
#pragma unroll
    for (int o = 32; o >= 1; o >>= 1) v += __shfl_xor(v, o, 64);
    return v;
}
template <class T> __device__ __forceinline__ T* launder(T* q) {
    unsigned long long w = (unsigned long long)q; unsigned lo = (unsigned)w, hi = (unsigned)(w >> 32);
    asm volatile("" : "+v"(lo), "+v"(hi));
    lo = __builtin_amdgcn_readfirstlane(lo); hi = __builtin_amdgcn_readfirstlane(hi);
    return (T*)(((unsigned long long)hi << 32) | lo);
}
__device__ __forceinline__ int opaque_zero() { int z = 0; asm volatile("" : "+v"(z)); return __builtin_amdgcn_readfirstlane(z); }
__device__ __forceinline__ int opaque(int x) { asm volatile("" : "+v"(x)); return x; }
__device__ __forceinline__ float silu(float x) { return x / (1.f + __expf(-x)); }

struct EpiBf16B {
    static constexpr bool PERM = true, AFTER_DRAIN = false;
    bf16_t* O; int ldc; const float* bias;
    __device__ __forceinline__ void operator()(const f32x4 (&acc)[2][2][4][2], const pg8::Unit& u, int wr, int wc, int fr, int fq) const {
        const int row0 = u.pm * 256 + wr * 64 + fr, col0 = u.pn * 256 + wc * 32 + 8 * fq;
        f32x4 bv[2][2];
#pragma unroll
        for (int bj = 0; bj < 2; ++bj)
#pragma unroll
            for (int n = 0; n < 2; ++n) bv[bj][n] = *(const f32x4*)(bias + col0 + bj * 128 + 4 * n);
#pragma unroll
        for (int ai = 0; ai < 2; ++ai)
#pragma unroll
            for (int m = 0; m < 4; ++m) { bf16_t* rowp = O + (size_t)(row0 + ai * 128 + m * 16) * ldc + col0;
#pragma unroll
                for (int bj = 0; bj < 2; ++bj) { f32x4 v0 = acc[ai][bj][m][0] + bv[bj][0], v1 = acc[ai][bj][m][1] + bv[bj][1];
                    u32x4 w; w.x = cvt_pk_bf16(v0[0], v0[1]); w.y = cvt_pk_bf16(v0[2], v0[3]); w.z = cvt_pk_bf16(v1[0], v1[1]); w.w = cvt_pk_bf16(v1[2], v1[3]);
                    *(u32x4*)(rowp + bj * 128) = w; } }
    }
};
struct EpiUT {
    static constexpr bool PERM = true, AFTER_DRAIN = false;
    bf16_t* O; const float* bias; int L;
    __device__ __forceinline__ void operator()(const f32x4 (&acc)[2][2][4][2], const pg8::Unit& u, int wr, int wc, int fr, int fq) const {
        const int row0 = u.pm * 256 + wr * 64 + fr; const int tokt = u.pn * 256; const int b = tokt / L; const int t0 = tokt - b * L + wc * 32 + 8 * fq;
#pragma unroll
        for (int ai = 0; ai < 2; ++ai)
#pragma unroll
            for (int m = 0; m < 4; ++m) { const int ch = row0 + ai * 128 + m * 16; const float bs = bias[ch];
                bf16_t* rowp = O + ((size_t)b * 3072 + ch) * L + t0;
#pragma unroll
                for (int bj = 0; bj < 2; ++bj) { f32x4 v0 = acc[ai][bj][m][0] + bs, v1 = acc[ai][bj][m][1] + bs;
                    u32x4 w; w.x = cvt_pk_bf16(v0[0], v0[1]); w.y = cvt_pk_bf16(v0[2], v0[3]); w.z = cvt_pk_bf16(v1[0], v1[1]); w.w = cvt_pk_bf16(v1[2], v1[3]);
                    *(u32x4*)(rowp + bj * 128) = w; } }
    }
};
struct EpiRes {
    static constexpr bool PERM = false, AFTER_DRAIN = false;
    float* out; const float* xin; const float* bias;
    __device__ __forceinline__ void operator()(const f32x4 (&acc)[2][2][4][2], const pg8::Unit& u, int wr, int wc, int fr, int fq) const {
        const int row0 = u.pm * 256 + wr * 64 + fr, col0 = u.pn * 256 + wc * 32 + 4 * fq;
        f32x4 bv[2][2];
#pragma unroll
        for (int bj = 0; bj < 2; ++bj)
#pragma unroll
            for (int n = 0; n < 2; ++n) bv[bj][n] = *(const f32x4*)(bias + col0 + bj * 128 + n * 16);
#pragma unroll
        for (int ai = 0; ai < 2; ++ai)
#pragma unroll
            for (int m = 0; m < 4; ++m) { const size_t ro = (size_t)(row0 + ai * 128 + m * 16) * DM + col0;
#pragma unroll
                for (int bj = 0; bj < 2; ++bj)
#pragma unroll
                    for (int n = 0; n < 2; ++n) { const f32x4 xv = *(const f32x4*)(xin + ro + bj * 128 + n * 16);
                        *(f32x4*)(out + ro + bj * 128 + n * 16) = xv * ALPHA + acc[ai][bj][m][n] + bv[bj][n]; } }
    }
};

template <class Epi> __device__ __forceinline__ void run_gemm(unsigned char* lds, const bf16_t* A, const bf16_t* Bt, int M, int N, const Epi& E) {
    pg8::Gemm g; g.A = A; g.Bt = Bt; g.M = M; g.N = N; g.K = DM;
    pg8::StaticOrder S; S.init(M, N, (int)gridDim.x, (int)blockIdx.x);
    pg8::gemm_phase<Epi, pg8::StaticOrder, false>((PG8_LAS unsigned char*)lds, g, S, E, nullptr);
    __syncthreads();
}

__device__ __forceinline__ void transpose_tile(const float* __restrict__ W, bf16_t* __restrict__ WT, int K, int N, int tk, int tn, unsigned char* lds) {
    float* tile = (float*)lds;
    const int tid = tidx();
#pragma unroll
    for (int i = 0; i < 2; ++i) { const int q = tid + i * 512, k = q >> 4, n4 = (q & 15) * 4;
        const f32x4 v = *(const f32x4*)(W + (size_t)(tk * 64 + k) * N + tn * 64 + n4);
        tile[k * 65 + n4 + 0] = v[0]; tile[k * 65 + n4 + 1] = v[1]; tile[k * 65 + n4 + 2] = v[2]; tile[k * 65 + n4 + 3] = v[3]; }
    __syncthreads();
    { const int n = tid >> 3, k8 = (tid & 7) * 8; float v[8];
#pragma unroll
        for (int e = 0; e < 8; ++e) v[e] = tile[(k8 + e) * 65 + n];
        u32x4 w; w.x = cvt_pk_bf16(v[0], v[1]); w.y = cvt_pk_bf16(v[2], v[3]); w.z = cvt_pk_bf16(v[4], v[5]); w.w = cvt_pk_bf16(v[6], v[7]);
        *(u32x4*)(WT + (size_t)(tn * 64 + n) * K + tk * 64 + k8) = w; }
    __syncthreads();
}

__device__ __forceinline__ void prologue_phase(const PV& p, unsigned char* lds) {
    const int total = 2 * 2176;
    for (int it = blockIdx.x; it < total; it += gridDim.x) {
        const int j = it / 2176; int r = it - j * 2176; int kind;
        if (r < 1024) kind = 0; else if (r < 1280) { kind = 1; r -= 1024; } else if (r < 1920) { kind = 2; r -= 1280; } else { kind = 3; r -= 1920; }
        const int N = kind == 0 ? 4096 : (kind == 2 ? 2560 : 1024);
        const int nN = N / 64; const int tk = r / nN, tn = r % nN;
        const float* W = (kind == 0 ? p.in(2) : kind == 1 ? p.in(14) : kind == 2 ? p.in(16) : p.in(20)) + (size_t)j * 1024 * N;
        bf16_t* WT = (bf16_t*)(p.ws + (kind == 0 ? WS_HWIN : kind == 1 ? WS_HWOUT : kind == 2 ? WS_AWIN : WS_AWOUT)) + (size_t)j * 1024 * N;
        transpose_tile(W, WT, 1024, N, tk, tn, lds);
    }
    const int tid_ = tidx(); const int wid = __builtin_amdgcn_readfirstlane(tid_ >> 6), lane = tid_ & 63;
    for (int row = blockIdx.x * 8 + wid; row < 2 * 6144; row += gridDim.x * 8) {
        const int j = row / 6144; int t = row - j * 6144; const int sel = t >= 2048 ? 1 : 0; if (sel) t -= 2048; const int L = sel ? 4096 : 2048;
        const float* w1 = p.in(6) + j * 33 * 64; const float* b1 = p.in(7) + j * 64; const float* fq = p.in(8) + j * 64;
        const float* w2 = p.in(9) + j * 64 * 64; const float* b2 = p.in(10) + j * 64;
        float feat = 0.f;
        if (lane == 0) feat = (float)t / (float)(L - 1);
        else if (lane <= 32) { const int i = (lane - 1) & 15; const double f = 1e-4 + (double)i * ((15.0 - 1e-4) / 15.0);
            double ph = f * (double)t / (double)L; ph -= (double)(long long)ph;
            const float a = (float)(ph * 6.283185307179586);
            feat = lane <= 16 ? cosf(a) : -sinf(a); }
        float s = b1[lane];
        for (int i = 0; i < 33; ++i) s += __shfl(feat, i, 64) * w1[i * 64 + lane];
        const float fr = fq[lane];
        const float h1 = sinf(fr * s);
        float s2 = b2[lane];
        for (int i = 0; i < 64; ++i) s2 += __shfl(h1, i, 64) * w2[i * 64 + lane];
        const float h2 = sinf(fr * s2);
        ((float*)(p.ws + WS_H2))[((size_t)(j * 2 + sel) * 4096 + t) * 64 + lane] = h2;
    }
}

__device__ __forceinline__ void cvt_phase(const PV& p, int g) {
    const float* x = p.in(g); bf16_t* xb = (bf16_t*)(p.ws + WS_XB);
    const size_t n8 = (size_t)TG * DM / 8;
    for (size_t i = (size_t)blockIdx.x * 512 + tidx(); i < n8; i += (size_t)gridDim.x * 512) {
        const f32x4 a = *(const f32x4*)(x + i * 8), b = *(const f32x4*)(x + i * 8 + 4);
        u32x4 w; w.x = cvt_pk_bf16(a[0], a[1]); w.y = cvt_pk_bf16(a[2], a[3]); w.z = cvt_pk_bf16(b[0], b[1]); w.w = cvt_pk_bf16(b[2], b[3]);
        *(u32x4*)(xb + i * 8) = w;
    }
}

__device__ __forceinline__ void ln_phase(const PV& p, int g, int layer) {
    float* x = p.out + (size_t)g * TG * DM; bf16_t* xb = (bf16_t*)(p.ws + WS_XB);
    const float* gam = p.in(22) + layer * DM; const float* bet = p.in(23) + layer * DM;
    const int tid_ = tidx(); const int wid = __builtin_amdgcn_readfirstlane(tid_ >> 6), lane = tid_ & 63;
    f32x4 gv[4], bv[4];
#pragma unroll
    for (int k = 0; k < 4; ++k) { gv[k] = *(const f32x4*)(gam + k * 256 + lane * 4); bv[k] = *(const f32x4*)(bet + k * 256 + lane * 4); }
    for (int row = blockIdx.x * 8 + wid; row < TG; row += gridDim.x * 8) {
        float* xr = x + (size_t)row * DM; f32x4 v[4]; float s = 0.f;
#pragma unroll
        for (int k = 0; k < 4; ++k) { v[k] = *(const f32x4*)(xr + k * 256 + lane * 4); s += v[k][0] + v[k][1] + v[k][2] + v[k][3]; }
        const float mu = wave_sum(s) * (1.f / DM); float q = 0.f;
#pragma unroll
        for (int k = 0; k < 4; ++k) { v[k] = v[k] - mu; q += v[k][0] * v[k][0] + v[k][1] * v[k][1] + v[k][2] * v[k][2] + v[k][3] * v[k][3]; }
        const float rstd = rsqrtf(wave_sum(q) * (1.f / DM) + 1e-5f);
#pragma unroll
        for (int k = 0; k < 4; ++k) { const f32x4 y = v[k] * rstd * gv[k] + bv[k];
            *(f32x4*)(xr + k * 256 + lane * 4) = y;
            u32x2 w; w.x = cvt_pk_bf16(y[0], y[1]); w.y = cvt_pk_bf16(y[2], y[3]);
            *(u32x2*)(xb + (size_t)row * DM + k * 256 + lane * 4) = w; }
    }
}

__device__ __forceinline__ bf16x8 lds_a4(const unsigned char* lds, unsigned addr) {
    const unsigned* q = (const unsigned*)(lds + addr); u32x4 w; w.x = q[0]; w.y = q[1]; w.z = q[2]; w.w = q[3]; return *reinterpret_cast<bf16x8*>(&w);
}
template <int NB> struct ConvCfg {
    static constexpr int L = NB == 16 ? 2048 : 4096, ROWE = L + 8, SB = NB == 16 ? 0 : -2048, NT = NB == 16 ? 64 : 192;
    static constexpr int ZOFF = 0, FOFF = 66560, FCOPY = 2 * L * 2, W3OFF = FOFF + 4 * FCOPY, REDOFF = W3OFF + 1024;
};
template <int NB> __device__ __forceinline__ void conv_main(const unsigned char* lds, int o, f32x4 (&acc)[16]) {
    using C = ConvCfg<NB>;
    const int tid_ = tidx(); const int lane = tid_ & 63, wid = __builtin_amdgcn_readfirstlane(tid_ >> 6), r = lane & 15, gq = lane >> 4;
    const int b = NB == 16 ? r : (r & 7), h = NB == 16 ? 0 : (r >> 3);
    const int E0 = (C::L - 1) + C::SB - 256 * wid + 8 * gq - r;
    const int P = E0 & 1;
    unsigned aPtr = (unsigned)(C::FOFF + (o * 2 + P) * C::FCOPY + 2 * (E0 - P));
    const int bBase = C::ZOFF + b * C::ROWE * 2 + 2 * (C::SB + 2048 * h + 8 * gq);
    const int s_lane0 = C::SB + 2048 * h;
    bf16x8 A[16];
#pragma unroll
    for (int i = 0; i < 16; ++i) { A[i] = lds_a4(lds, aPtr - 32 * i); acc[i] = (f32x4){0.f, 0.f, 0.f, 0.f}; }
    auto ldb = [&](int j) -> bf16x8 {
        if (NB == 16) return *(const bf16x8*)(lds + bBase + 64 * j);
        const bool valid = (unsigned)(s_lane0 + 32 * j) < (unsigned)C::L;
        const bf16x8 t = *(const bf16x8*)(lds + (valid ? bBase + 64 * j : C::ZOFF));
        const bf16x8 z = {0, 0, 0, 0, 0, 0, 0, 0}; return valid ? t : z; };
    bf16x8 bnext = ldb(0);
    for (int jo = 0; jo < C::NT / 8; ++jo) {
#pragma unroll
        for (int jj = 0; jj < 8; ++jj) {
            const int j = jo * 8 + jj;
            const bf16x8 bf = bnext;
            bnext = ldb(j + 1 < C::NT ? j + 1 : j);
            acc[15] = __builtin_amdgcn_mfma_f32_16x16x32_bf16(A[(15 - 2 * jj) & 15], bf, acc[15], 0, 0, 0);
            acc[14] = __builtin_amdgcn_mfma_f32_16x16x32_bf16(A[(14 - 2 * jj) & 15], bf, acc[14], 0, 0, 0);
            A[(14 - 2 * jj) & 15] = lds_a4(lds, aPtr + 64 * (jj + 1));
            A[(15 - 2 * jj) & 15] = lds_a4(lds, aPtr + 64 * (jj + 1) - 32);
#pragma unroll
            for (int i = 13; i >= 0; --i) acc[i] = __builtin_amdgcn_mfma_f32_16x16x32_bf16(A[(i - 2 * jj) & 15], bf, acc[i], 0, 0, 0);
            __builtin_amdgcn_sched_barrier(0);
        }
        aPtr += 512;
    }
}
template <int NB> __device__ __forceinline__ void conv_epi(const unsigned char* lds, const f32x4 (&acc)[16], u32x2 (&zp)[16], const bf16_t* UT, int gch,
                                                          float gw0, float gw1, float gw2, float gcb, float fb, float nrm) {
    using C = ConvCfg<NB>;
    const int tid_ = tidx(); const int lane = tid_ & 63, wid = __builtin_amdgcn_readfirstlane(tid_ >> 6), r = lane & 15, gq = lane >> 4;
    const int b = NB == 16 ? r : (r & 7), h = NB == 16 ? 0 : (r >> 3);
    const bf16_t* grow = UT + ((size_t)b * 3072 + gch) * C::L;
#pragma unroll
    for (int i = 0; i < 16; ++i) {
        const int t = 256 * wid + 16 * i + 4 * gq + 2048 * h;
        const s16x4 gu = *(const s16x4*)(grow + t);
        const float gl = t > 0 ? bf2f(grow[t - 1]) : 0.f, gr = (t + 4 < C::L) ? bf2f(grow[t + 4]) : 0.f;
        const float u0 = bf2f_s(gu[0]), u1 = bf2f_s(gu[1]), u2 = bf2f_s(gu[2]), u3 = bf2f_s(gu[3]);
        const float g0 = gw0 * gl + gw1 * u0 + gw2 * u1 + gcb, g1 = gw0 * u0 + gw1 * u1 + gw2 * u2 + gcb;
        const float g2 = gw0 * u1 + gw1 * u2 + gw2 * u3 + gcb, g3 = gw0 * u2 + gw1 * u3 + gw2 * gr + gcb;
        const s16x4 vz = *(const s16x4*)(lds + C::ZOFF + (b * C::ROWE + t) * 2);
        const float z0 = g0 * (acc[i][0] * nrm + bf2f_s(vz[0]) * fb), z1 = g1 * (acc[i][1] * nrm + bf2f_s(vz[1]) * fb);
        const float z2 = g2 * (acc[i][2] * nrm + bf2f_s(vz[2]) * fb), z3 = g3 * (acc[i][3] * nrm + bf2f_s(vz[3]) * fb);
        zp[i].x = cvt_pk_bf16(z0, z1); zp[i].y = cvt_pk_bf16(z2, z3);
    }
}
template <int NB> __device__ __forceinline__ void conv_store_z(unsigned char* lds, const u32x2 (&zp)[16]) {
    using C = ConvCfg<NB>;
    const int tid_ = tidx(); const int lane = tid_ & 63, wid = __builtin_amdgcn_readfirstlane(tid_ >> 6), r = lane & 15, gq = lane >> 4;
    const int b = NB == 16 ? r : (r & 7), h = NB == 16 ? 0 : (r >> 3);
#pragma unroll
    for (int i = 0; i < 16; ++i) { const int t = 256 * wid + 16 * i + 4 * gq + 2048 * h; *(u32x2*)(lds + C::ZOFF + (b * C::ROWE + t) * 2) = zp[i]; }
}

template <int NB> __device__ __forceinline__ void conv_phase(const PV& p, int hj, unsigned char* lds) {
    using C = ConvCfg<NB>;
    constexpr int L = C::L;
    const int tid = tidx(), wid = __builtin_amdgcn_readfirstlane(tid >> 6), lane = tid & 63;
    bf16_t* UT = (bf16_t*)(p.ws + WS_UT);
    const float* h2 = (const float*)(p.ws + WS_H2) + (size_t)(hj * 2 + (NB == 16 ? 0 : 1)) * 4096 * 64;
    const float* w3 = p.in(11) + (size_t)hj * 64 * 4096; const float* decay = p.in(12) + hj * 4096;
    const float* fbias = p.in(13) + hj * 2048; const float* cw = p.in(4) + hj * 3 * 3072; const float* cb = p.in(5) + hj * 3072;
    float* w3s = (float*)(lds + C::W3OFF); float* red = (float*)(lds + C::REDOFF);
    for (int c = blockIdx.x; c < 1024; c += gridDim.x) {
        if (tid < 256) { const int od = tid >> 6, j = tid & 63; w3s[od * 64 + j] = w3[(size_t)j * 4096 + od * 1024 + c]; }
        constexpr int NBLK = L / 256;
        const int frow = tid & 255, fo = tid >> 8;
        const float decf = fabsf(decay[(fo * 2) * 1024 + c]), decb = fabsf(decay[(fo * 2 + 1) * 1024 + c]);
        float ss = 0.f;
        float* stg = (float*)lds;
        bf16_t* c0 = (bf16_t*)(lds + C::FOFF + (fo * 2) * C::FCOPY); bf16_t* c1 = (bf16_t*)(lds + C::FOFF + (fo * 2 + 1) * C::FCOPY);
#pragma unroll 1
        for (int blk = 0; blk < NBLK; ++blk) {
            __syncthreads();
#pragma unroll
            for (int i = 0; i < 8; ++i) { const int q = tid + 512 * i, rr = q >> 4, c4 = (q & 15) * 4;
                const f32x4 x = *(const f32x4*)(h2 + (size_t)(blk * 256 + rr) * 64 + c4);
                float* d = stg + rr * 65 + c4; d[0] = x[0]; d[1] = x[1]; d[2] = x[2]; d[3] = x[3]; }
            __syncthreads();
            float df = 0.f, db = 0.f; const float* hrow = stg + frow * 65; const float* wf = w3s + (fo * 2) * 64;
#pragma unroll 8
            for (int j = 0; j < 64; ++j) { const float x = hrow[j]; df += x * wf[j]; db += x * wf[64 + j]; }
            const int tt = blk * 256 + frow;
            const float tl = (float)tt * (1.0f / (float)(L - 1));
            df *= expf(-tl * decf); db *= expf(-tl * decb);
            ss += df * df + db * db;
            const bf16_t f = f2bf(df); const int i = L - 1 - tt;
            c0[i] = f; if (i >= 1) c1[i - 1] = f;
            if (tt >= 1) { const bf16_t bw = f2bf(db); const int i2 = L - 1 + tt; c0[i2] = bw; c1[i2 - 1] = bw; }
        }
        if (frow == 0) { c0[2 * L - 1] = 0; c1[2 * L - 2] = 0; c1[2 * L - 1] = 0; }
        ss = wave_sum(ss);
        if (lane == 0) red[wid] = ss;
        __syncthreads();
        const float nrm0 = rsqrtf(red[0] + red[1] + red[2] + red[3] + 1e-6f), nrm1 = rsqrtf(red[4] + red[5] + red[6] + red[7] + 1e-6f);
        { const float w0 = cw[c], w1 = cw[3072 + c], w2 = cw[2 * 3072 + c], cbv = cb[c];
            for (int chunk = tid; chunk < NB * L / 8; chunk += 512) { const int b = chunk / (L / 8), s8 = (chunk % (L / 8)) * 8;
                const bf16_t* src = UT + ((size_t)b * 3072 + c) * L + s8;
                const bf16x8 x = *(const bf16x8*)src; float xe[10];
                xe[0] = s8 > 0 ? bf2f(src[-1]) : 0.f; xe[9] = (s8 + 8 < L) ? bf2f(src[8]) : 0.f;
#pragma unroll
                for (int e = 0; e < 8; ++e) xe[e + 1] = bf2f_s(x[e]);
                float y[8];
#pragma unroll
                for (int e = 0; e < 8; ++e) y[e] = w0 * xe[e] + w1 * xe[e + 1] + w2 * xe[e + 2] + cbv;
                u32x4 w; w.x = cvt_pk_bf16(y[0], y[1]); w.y = cvt_pk_bf16(y[2], y[3]); w.z = cvt_pk_bf16(y[4], y[5]); w.w = cvt_pk_bf16(y[6], y[7]);
                *(u32x4*)(lds + C::ZOFF + (b * C::ROWE + s8) * 2) = w; } }
        __syncthreads();
        f32x4 acc[16]; u32x2 zp[16];
        conv_main<NB>(lds, 0, acc);
        conv_epi<NB>(lds, acc, zp, UT, 1024 + c, cw[1024 + c], cw[3072 + 1024 + c], cw[2 * 3072 + 1024 + c], cb[1024 + c], fbias[c], nrm0);
        __syncthreads();
        conv_store_z<NB>(lds, zp);
        __syncthreads();
        conv_main<NB>(lds, 1, acc);
        conv_epi<NB>(lds, acc, zp, UT, 2048 + c, cw[2048 + c], cw[3072 + 2048 + c], cw[2 * 3072 + 2048 + c], cb[2048 + c], fbias[1024 + c], nrm1);
        __syncthreads();
        conv_store_z<NB>(lds, zp);
        __syncthreads();
        for (int chunk = tid; chunk < NB * L / 8; chunk += 512) { const int b = chunk / (L / 8), s8 = (chunk % (L / 8)) * 8;
            *(u32x4*)(UT + ((size_t)b * 3072 + c) * L + s8) = *(const u32x4*)(lds + C::ZOFF + (b * C::ROWE + s8) * 2); }
        __syncthreads();
    }
}

__device__ __forceinline__ void ygate_phase(const PV& p, int L, unsigned char* lds) {
    const bf16_t* UT = (const bf16_t*)(p.ws + WS_UT); const bf16_t* G = (const bf16_t*)(p.ws + WS_GATE); bf16_t* Y = (bf16_t*)(p.ws + WS_Y);
    const int tid = tidx(); constexpr int RS = 136;
    bf16_t* tile = (bf16_t*)lds;
    for (int it = blockIdx.x; it < (TG / 128) * 16; it += gridDim.x) {
        const int tc = it & 15, tt = it >> 4; const int tok0 = tt * 128, b = tok0 / L, t0 = tok0 - b * L, c0 = tc * 64;
#pragma unroll
        for (int i = 0; i < 2; ++i) { const int q = tid + i * 512, cc = q >> 4, tch = (q & 15) * 8;
            *(u32x4*)(tile + cc * RS + tch) = *(const u32x4*)(UT + ((size_t)b * 3072 + c0 + cc) * L + t0 + tch); }
        __syncthreads();
#pragma unroll
        for (int i = 0; i < 2; ++i) { const int q = tid + i * 512, t = q >> 3, cch = (q & 7) * 8;
            const bf16x8 gv = *(const bf16x8*)(G + (size_t)(tok0 + t) * DM + c0 + cch); float y[8];
#pragma unroll
            for (int e = 0; e < 8; ++e) y[e] = bf2f(tile[(cch + e) * RS + t]) * silu(bf2f_s(gv[e]));
            u32x4 w; w.x = cvt_pk_bf16(y[0], y[1]); w.y = cvt_pk_bf16(y[2], y[3]); w.z = cvt_pk_bf16(y[4], y[5]); w.w = cvt_pk_bf16(y[6], y[7]);
            *(u32x4*)(Y + (size_t)(tok0 + t) * DM + c0 + cch) = w; }
        __syncthreads();
    }
}

constexpr int LDU = 2560;
__device__ __forceinline__ void rope_phase(const PV& p, int aj, int L) {
    bf16_t* U = (bf16_t*)(p.ws + WS_UT);
    const float* qn = p.in(18) + aj * 128; const float* kn = p.in(19) + aj * 128;
    const int tid_ = tidx(); const int wid = __builtin_amdgcn_readfirstlane(tid_ >> 6), lane = tid_ & 63;
    const float inv = exp2f(-(float)(2 * (lane & 31)) * (13.287712379549449f / 64.f));
    const float q1 = qn[lane], q2 = qn[64 + lane], k1 = kn[lane], k2 = kn[64 + lane];
    for (int tok = blockIdx.x * 8 + wid; tok < TG; tok += gridDim.x * 8) {
        const int t = tok & (L - 1); const float pos = (float)(lane < 32 ? (t >> 6) : (t & 63));
        const float ang = pos * inv; const float cs = cosf(ang), sn = sinf(ang);
        bf16_t* u = U + (size_t)tok * LDU;
#pragma unroll
        for (int hd = 0; hd < 10; ++hd) {
            const int base = hd * 128;
            const float x1 = bf2f(u[base + lane]), x2 = bf2f(u[base + 64 + lane]);
            const float rs = rsqrtf(wave_sum(x1 * x1 + x2 * x2) * (1.f / 128.f) + 1e-6f);
            const float a = x1 * rs * (hd < 8 ? q1 : k1), bb = x2 * rs * (hd < 8 ? q2 : k2);
            u[base + lane] = f2bf(a * cs - bb * sn); u[base + 64 + lane] = f2bf(bb * cs + a * sn);
        }
    }
}

namespace att {
constexpr int D = 128, NW = 8, QBLK = 32, KVBLK = 64;
constexpr float SCALE = 0.088388347648318440f;
constexpr float THR = 8.f;
constexpr int LDQ = LDU, LDK = LDU;
constexpr size_t SHM_V = KVBLK * D * 2, SHM_K = KVBLK * D * 2, SHM_ATTN = 2 * SHM_V + 2 * SHM_K + NW * 64 * 4;
#define KSWZ(row, colB) ((row) * 256 + ((colB) ^ (((row) & 7) << 4)))
#define SBAR() __builtin_amdgcn_sched_barrier(0)
__device__ __forceinline__ int crow(int r, int hi) { return (r & 3) + 8 * (r >> 2) + 4 * hi; }
__device__ __forceinline__ unsigned cvtpk(float lo, float hi) { unsigned r; asm volatile("v_cvt_pk_bf16_f32 %0, %1, %2" : "=v"(r) : "v"(lo), "v"(hi)); return r; }
__device__ __forceinline__ bf16x8 ld8(const bf16_t* p) { return *reinterpret_cast<const bf16x8*>(p); }
__device__ __forceinline__ void partialSM(f32x16& p0, f32x16& p1, float& m_reg, float& mn, float& alpha) {
  constexpr float C = SCALE * 1.4426950408889634f;
  float pmax = p0[0]; for (int r = 1; r < 16; ++r) pmax = fmaxf(pmax, p0[r]); for (int r = 0; r < 16; ++r) pmax = fmaxf(pmax, p1[r]);
  { auto rr = __builtin_amdgcn_permlane32_swap(__float_as_uint(pmax), __float_as_uint(pmax), false, false);
    pmax = fmaxf(__uint_as_float(rr[0]), __uint_as_float(rr[1])); }
  if (__builtin_expect(__all(pmax - m_reg <= THR / SCALE), 1)) { mn = m_reg; alpha = 1.f; }
  else { mn = fmaxf(m_reg, pmax); alpha = __builtin_amdgcn_exp2f((m_reg - mn) * C); m_reg = mn; }
  float mnC = -mn * C;
  for (int r = 0; r < 16; ++r) p0[r] = fmaf(p0[r], C, mnC); for (int r = 0; r < 16; ++r) p1[r] = fmaf(p1[r], C, mnC);
  for (int r = 0; r < 16; ++r) p0[r] = __builtin_amdgcn_exp2f(p0[r]);
}
__device__ __forceinline__ void finishSM(f32x16& p0, f32x16& p1, float alpha, float& l_reg, bf16x8& pa0, bf16x8& pa1, bf16x8& pa2, bf16x8& pa3) {
  for (int r = 0; r < 16; ++r) p1[r] = __builtin_amdgcn_exp2f(p1[r]);
  float ps = 0; for (int r = 0; r < 16; ++r) ps += p0[r]; for (int r = 0; r < 16; ++r) ps += p1[r];
  { auto rr = __builtin_amdgcn_permlane32_swap(__float_as_uint(ps), __float_as_uint(ps), false, false);
    ps = __uint_as_float(rr[0]) + __uint_as_float(rr[1]); }
  l_reg = l_reg * alpha + ps;
#define PK4(P, BASE, OUT) do { unsigned a0 = cvtpk(P[BASE + 0], P[BASE + 1]), a1 = cvtpk(P[BASE + 2], P[BASE + 3]);   \
    unsigned b0 = cvtpk(P[BASE + 4], P[BASE + 5]), b1 = cvtpk(P[BASE + 6], P[BASE + 7]);                              \
    auto r0 = __builtin_amdgcn_permlane32_swap(a0, b0, false, false); auto r1 = __builtin_amdgcn_permlane32_swap(a1, b1, false, false); \
    u32x4 w = {r0[0], r1[0], r0[1], r1[1]}; OUT = *reinterpret_cast<bf16x8*>(&w); } while (0)
  PK4(p0, 0, pa0); PK4(p0, 8, pa1); PK4(p1, 0, pa2); PK4(p1, 8, pa3);
#undef PK4
}
__device__ __forceinline__ void qkt(f32x16& p0, f32x16& p1, const bf16_t* Ks, const bf16x8* qr, int r32, int hi) {
  p0 = f32x16{}; p1 = f32x16{};
  for (int d0 = 0; d0 < 8; ++d0) { int cb = (d0 * 16 + hi * 8) * 2;
    bf16x8 b0 = *reinterpret_cast<const bf16x8*>((const char*)Ks + KSWZ(r32, cb));
    bf16x8 b1 = *reinterpret_cast<const bf16x8*>((const char*)Ks + KSWZ(32 + r32, cb));
    p0 = __builtin_amdgcn_mfma_f32_32x32x16_bf16(b0, qr[d0], p0, 0, 0, 0);
    p1 = __builtin_amdgcn_mfma_f32_32x32x16_bf16(b1, qr[d0], p1, 0, 0, 0); }
}
__device__ __forceinline__ int v_st(int k, int c) { const int kk = (k & ~0xC) | ((k & 4) << 1) | ((k & 8) >> 1); return ((kk >> 3) * 4 + (c >> 5)) * 512 + ((kk & 7) * 32 + (c & 31)) * 2; }
__device__ __forceinline__ int v_rd_base(int lane) { return ((lane & 3) << 3) | (((lane >> 2) & 3) << 6) | (((lane >> 4) & 1) << 5) | (((lane >> 5) & 1) << 8); }
constexpr int v_rd_off(int d0, int ks, int half) { return d0 * 512 + ks * 4096 + half * 2048; }
template <int OFF> __device__ __forceinline__ s16x4 tr_read(int vb) {
  s16x4 r; asm volatile("ds_read_b64_tr_b16 %0, %1 offset:%2" : "=&v"(r) : "v"(vb), "i"(OFF) : "memory"); return r;
}
template <int D0> __device__ __forceinline__ void pv_one(f32x16& od, int vb, bf16x8 pa0, bf16x8 pa1, bf16x8 pa2, bf16x8 pa3) {
  const s16x4 l0 = tr_read<v_rd_off(D0, 0, 0)>(vb), h0 = tr_read<v_rd_off(D0, 0, 1)>(vb), l1 = tr_read<v_rd_off(D0, 1, 0)>(vb), h1 = tr_read<v_rd_off(D0, 1, 1)>(vb);
  const s16x4 l2 = tr_read<v_rd_off(D0, 2, 0)>(vb), h2 = tr_read<v_rd_off(D0, 2, 1)>(vb), l3 = tr_read<v_rd_off(D0, 3, 0)>(vb), h3 = tr_read<v_rd_off(D0, 3, 1)>(vb);
  asm volatile("s_waitcnt lgkmcnt(0)" ::: "memory"); SBAR();
#define PK(L, H) (bf16x8){L[0], L[1], L[2], L[3], H[0], H[1], H[2], H[3]}
  od = __builtin_amdgcn_mfma_f32_32x32x16_bf16(pa0, PK(l0, h0), od, 0, 0, 0);
  od = __builtin_amdgcn_mfma_f32_32x32x16_bf16(pa1, PK(l1, h1), od, 0, 0, 0);
  od = __builtin_amdgcn_mfma_f32_32x32x16_bf16(pa2, PK(l2, h2), od, 0, 0, 0);
  od = __builtin_amdgcn_mfma_f32_32x32x16_bf16(pa3, PK(l3, h3), od, 0, 0, 0);
#undef PK
}
__device__ __forceinline__ void pv_d0(f32x16* o, int vb, bf16x8 pa0, bf16x8 pa1, bf16x8 pa2, bf16x8 pa3) {
  pv_one<0>(o[0], vb, pa0, pa1, pa2, pa3); pv_one<1>(o[1], vb, pa0, pa1, pa2, pa3); pv_one<2>(o[2], vb, pa0, pa1, pa2, pa3); pv_one<3>(o[3], vb, pa0, pa1, pa2, pa3);
}
__device__ __forceinline__ void attn_dense_body(const bf16_t* __restrict__ Qb, const bf16_t* __restrict__ Kh, const bf16_t* __restrict__ Vh,
                                                const bf16_t* __restrict__ Gb, bf16_t* __restrict__ Yb, int seq, char* lds) {
  constexpr int SDEPTH = 2;
  const int tid = tidx(), wid = __builtin_amdgcn_readfirstlane(tid >> 6), lane = tid & 63, r32 = lane & 31, hi = lane >> 5;
  bf16_t* V_lds = (bf16_t*)lds; bf16_t* K_lds = (bf16_t*)(lds + 2 * SHM_V);
  float* ws = (float*)(lds + 2 * SHM_V + 2 * SHM_K) + wid * 64; float* li_l = ws; float* al_l = ws + 32;
  float m_reg = -1e30f, l_reg = 0; f32x16 o[4] = {}; bf16x8 qr[8];
  const bf16_t* Qw = Qb + (long)(wid * QBLK + r32) * LDQ + hi * 8;
#pragma unroll
  for (int d0 = 0; d0 < 8; ++d0) qr[d0] = ld8(Qw + d0 * 16);
  const int sr = tid >> 4, sc = (tid & 15) * 8, vst0 = v_st(sr, sc), vst1 = v_st(32 + sr, sc);
  const int vb0 = (int)(uintptr_t)V_lds + v_rd_base(lane);
  struct { bf16x8 vs0, vs1, ks0, ks1; } sr_[SDEPTH];
#define SLOAD(i, k0) do { sr_[i].vs0 = ld8(&Vh[(long)((k0) + sr) * LDK + sc]); sr_[i].vs1 = ld8(&Vh[(long)((k0) + 32 + sr) * LDK + sc]); \
    sr_[i].ks0 = ld8(&Kh[(long)((k0) + sr) * LDK + sc]); sr_[i].ks1 = ld8(&Kh[(long)((k0) + 32 + sr) * LDK + sc]); } while (0)
#define SWRITE(b, i) do { *(bf16x8*)((char*)V_lds + (b) * SHM_V + vst0) = sr_[i].vs0;          \
    *(bf16x8*)((char*)V_lds + (b) * SHM_V + vst1) = sr_[i].vs1; int kc = sc * 2;               \
    *(bf16x8*)((char*)K_lds + (b) * SHM_K + KSWZ(sr, kc)) = sr_[i].ks0;                       \
    *(bf16x8*)((char*)K_lds + (b) * SHM_K + KSWZ(32 + sr, kc)) = sr_[i].ks1; } while (0)
#define SWAIT() do { asm volatile("s_waitcnt vmcnt(4)" ::: "memory"); } while (0)
#define RESC(a) do { if (__any((a) < 1.f)) { if (hi == 0) al_l[r32] = (a); asm volatile("s_waitcnt lgkmcnt(0)" ::: "memory"); \
    for (int d = 0; d < 4; ++d) for (int r = 0; r < 16; ++r) o[d][r] *= al_l[crow(r, hi)]; } } while (0)
  f32x16 pA0, pA1, pB0, pB1; float mnA, mnB, alA, alB; bf16x8 pa0, pa1, pa2, pa3; const int NT = seq / KVBLK;
  constexpr int SE = 0, SO = SDEPTH - 1;
  SLOAD(SE, 0); asm volatile("s_waitcnt vmcnt(0)" ::: "memory"); SWRITE(0, SE); __syncthreads();
  qkt(pA0, pA1, K_lds, qr, r32, hi); partialSM(pA0, pA1, m_reg, mnA, alA);
  SLOAD(SO, KVBLK); if (2 < NT) SLOAD(SE, 2 * KVBLK);
  SWAIT(); SWRITE(1, SO); __syncthreads();
  for (int j = 1; j + 1 < NT; j += 2) {
    SBAR(); qkt(pB0, pB1, (bf16_t*)((char*)K_lds + SHM_K), qr, r32, hi);
    finishSM(pA0, pA1, alA, l_reg, pa0, pa1, pa2, pa3); SBAR();
    SLOAD(SO, (j + SDEPTH) * KVBLK); SBAR();
    pv_d0(o, vb0, pa0, pa1, pa2, pa3); partialSM(pB0, pB1, m_reg, mnB, alB);
    __syncthreads(); SWAIT(); SWRITE(0, SE);
    RESC(alB); __syncthreads();
    SBAR(); qkt(pA0, pA1, K_lds, qr, r32, hi);
    finishSM(pB0, pB1, alB, l_reg, pa0, pa1, pa2, pa3); SBAR();
    if (j + 3 < NT) SLOAD(SE, (j + 1 + SDEPTH) * KVBLK); SBAR();
    pv_d0(o, vb0 + (int)SHM_V, pa0, pa1, pa2, pa3); partialSM(pA0, pA1, m_reg, mnA, alA);
    __syncthreads(); SWAIT(); SWRITE(1, SO);
    RESC(alA); __syncthreads();
  }
  SBAR(); qkt(pB0, pB1, (bf16_t*)((char*)K_lds + SHM_K), qr, r32, hi);
  finishSM(pA0, pA1, alA, l_reg, pa0, pa1, pa2, pa3); SBAR();
  pv_d0(o, vb0, pa0, pa1, pa2, pa3); partialSM(pB0, pB1, m_reg, mnB, alB);
  __syncthreads(); RESC(alB);
  finishSM(pB0, pB1, alB, l_reg, pa0, pa1, pa2, pa3); SBAR();
  pv_d0(o, vb0 + (int)SHM_V, pa0, pa1, pa2, pa3);
  if (hi == 0) li_l[r32] = l_reg; asm volatile("s_waitcnt lgkmcnt(0)" ::: "memory");
  { const int ln = opaque(lane), r32e = ln & 31, hie = ln >> 5;
    const bf16_t* Gl = Gb + (long)(wid * QBLK + 4 * hie) * LDU + r32e; bf16_t* Yl = Yb + (long)(wid * QBLK + 4 * hie) * DM + r32e;
#pragma unroll
  for (int r = 0; r < 16; ++r) { const int ro = (r & 3) + 8 * (r >> 2); const float rl = __builtin_amdgcn_rcpf(li_l[ro + 4 * hie]);
    asm volatile("" ::: "memory");
#pragma unroll
    for (int d0 = 0; d0 < 4; ++d0) { const float gv = bf2f(Gl[ro * LDU + d0 * 32]);
      Yl[ro * DM + d0 * 32] = f2bf(o[d0][r] * rl * silu(gv)); } } }
  __syncthreads();
#undef SLOAD
#undef SWRITE
#undef SWAIT
#undef RESC
}
}

__device__ __forceinline__ void attn_phase(const PV& p, int L, unsigned char* lds) {
    const bf16_t* U = (const bf16_t*)(p.ws + WS_UT); bf16_t* Y = (bf16_t*)(p.ws + WS_Y);
    const int nqb = L / 256, NB = TG / L;
    const int nitem = NB * 8 * nqb;
    for (int it = blockIdx.x; it < nitem; it += gridDim.x) {
        const int qb = it % nqb; const int hq = (it / nqb) & 7; const int b = it / (nqb * 8); const int kvh = hq >> 2;
        const size_t row0 = (size_t)b * L + (size_t)qb * 256;
        att::attn_dense_body(U + row0 * LDU + hq * 128, U + (size_t)b * L * LDU + 1024 + kvh * 128, U + (size_t)b * L * LDU + 1280 + kvh * 128,
                             U + row0 * LDU + 1536 + hq * 128, Y + row0 * DM + hq * 128, L, (char*)lds);
    }
}

__device__ __forceinline__ void run_phase(const Params& pin, int ph, unsigned char* lds) {
    const PV p(pin, opaque_zero());
    if (ph == 0) { if (PHMASK & 1) prologue_phase(p, lds); return; }
    const int q = ph - 1, g = q / 21, r = q % 21;
    const int L = g == 0 ? 2048 : 4096;
    if (r == 0) { if (PHMASK & 2) cvt_phase(p, g); return; }
    const int layer = (r - 1) / 5, sub = (r - 1) % 5, j = layer >> 1;
    bf16_t* XB = (bf16_t*)(p.ws + WS_XB); bf16_t* UT = (bf16_t*)(p.ws + WS_UT); bf16_t* Y = (bf16_t*)(p.ws + WS_Y);
    if (sub == 4) { if (PHMASK & 4) ln_phase(p, g, layer); return; }
    if (sub == 3) {
        const bf16_t* WT = (const bf16_t*)(p.ws + ((layer & 1) ? WS_AWOUT : WS_HWOUT)) + (size_t)j * 1024 * 1024;
        EpiRes E; E.out = p.out + (size_t)g * TG * DM; E.xin = layer == 0 ? p.in(g) : E.out; E.bias = ((layer & 1) ? p.in(21) : p.in(15)) + j * 1024;
        if (PHMASK & 8) run_gemm(lds, Y, WT, TG, 1024, E); return;
    }
    if ((layer & 1) == 0) {
        if (sub == 0) {
            const bf16_t* WT = (const bf16_t*)(p.ws + WS_HWIN) + (size_t)j * 4096 * 1024;
            EpiUT E1; E1.O = UT; E1.bias = p.in(3) + j * 4096; E1.L = L;
            if (PHMASK & 16) run_gemm(lds, WT, XB, 3072, TG, E1);
            EpiBf16B E2; E2.O = (bf16_t*)(p.ws + WS_GATE); E2.ldc = 1024; E2.bias = p.in(3) + j * 4096 + 3072;
            if (PHMASK & 32) run_gemm(lds, XB, WT + (size_t)3072 * 1024, TG, 1024, E2);
        } else if (sub == 1) { if (g == 0) { if (PHMASK & 64) conv_phase<16>(p, j, lds); } else { if (PHMASK & 128) conv_phase<8>(p, j, lds); } }
        else if (sub == 2) { if (PHMASK & 256) ygate_phase(p, L, lds); }
    } else {
        if (sub == 0) {
            const bf16_t* WT = (const bf16_t*)(p.ws + WS_AWIN) + (size_t)j * 2560 * 1024;
            EpiBf16B E; E.O = UT; E.ldc = LDU; E.bias = p.in(17) + j * 2560;
            if (PHMASK & 32) run_gemm(lds, XB, WT, TG, 2560, E);
        } else if (sub == 1) { if (PHMASK & 512) rope_phase(p, j, L); }
        else if (sub == 2) { if (PHMASK & 1024) attn_phase(p, L, lds); }
    }
}

__global__ __launch_bounds__(512, 2) void mk_forward(Params p) {
    extern __shared__ __attribute__((aligned(16))) unsigned char smem[];
    cg::grid_group grid = cg::this_grid();
    for (int ph = p.ph_lo; ph < p.ph_hi; ++ph) {
        run_phase(p, ph, smem);
        if (ph + 1 < p.ph_hi) grid.sync();
    }
}

extern "C" void kernel_launch(void* const* d_in, const int* in_sizes, int n_in, void* d_out, int out_size, void* d_ws, size_t ws_size, hipStream_t stream) {
    static int grid = 0;
    if (grid == 0) {
        if (n_in != 24 || ws_size < WS_END) { fprintf(stderr, "kernel_launch: unexpected n_in %d / ws %zu\n", n_in, ws_size); grid = -1; return; }
        int dev = 0, cus = 0, per_cu = 0;
        hipGetDevice(&dev); hipDeviceGetAttribute(&cus, hipDeviceAttributeMultiprocessorCount, dev);
        if (hipFuncSetAttribute((const void*)mk_forward, hipFuncAttributeMaxDynamicSharedMemorySize, LDS_BYTES) != hipSuccess) { fprintf(stderr, "kernel_launch: hipFuncSetAttribute failed\n"); grid = -1; return; }
        if (hipOccupancyMaxActiveBlocksPerMultiprocessor(&per_cu, (const void*)mk_forward, 512, LDS_BYTES) != hipSuccess || per_cu < 1) { fprintf(stderr, "kernel_launch: occupancy query gives %d\n", per_cu); per_cu = 1; }
        (void)hipGetLastError();
        grid = cus * per_cu;
    }
    if (grid < 0) return;
    Params p{};
    for (int i = 0; i < 24; ++i) p.in[i] = (const float*)d_in[i];
    p.out = (float*)d_out; p.ws = (unsigned char*)d_ws;
#if MK_LAUNCHES == 1
    p.ph_lo = 0; p.ph_hi = NPHASE;
    void* args[] = {&p};
    hipError_t e = hipLaunchCooperativeKernel((const void*)mk_forward, dim3(grid), dim3(512), args, LDS_BYTES, stream);
    if (e != hipSuccess) fprintf(stderr, "cooperative launch failed: %s (grid %d)\n", hipGetErrorString(e), grid);
#else
    for (int ph = 0; ph < NPHASE; ++ph) { p.ph_lo = ph; p.ph_hi = ph + 1;
        hipLaunchKernelGGL(mk_forward, dim3(grid), dim3(512), LDS_BYTES, stream, p); }
#endif
}
```

```cpp
#include <hip/hip_runtime.h>
#include <hip/hip_cooperative_groups.h>
#include <cstdio>
#include <cstdint>
namespace cg = cooperative_groups;

#ifndef MK_LAUNCHES
#define MK_LAUNCHES 1
#endif

__device__ __forceinline__ int tidx() { int t = threadIdx.x; asm volatile("" : "+v"(t)); return t; }

namespace pg8 {
#define PG8_LAS __attribute__((address_space(3)))
typedef unsigned short bf16_t;
typedef short bf16x8 __attribute__((ext_vector_type(8)));
typedef float f32x4 __attribute__((ext_vector_type(4)));
typedef unsigned u32x4 __attribute__((ext_vector_type(4)));
constexpr int BM = 256, BK = 64, HALF = 128, HTB = HALF * BK * 2  , STAGE_BYTES = 8 * HTB, NXCD = 8, WGM = 8;

__host__ __device__ __forceinline__ int lds_byte(int r, int c) { const int st = (r >> 4) * 2 + (c >> 5), rr = r & 15, cc = c & 31, ob = rr * 64 + cc * 2; return st * 1024 + (ob ^ (((ob >> 9) & 1) << 5)); }
__host__ __device__ __forceinline__ void stage_rc(int b, int& R, int& C) { const int st = b / 1024, sb = b % 1024, swz = sb ^ (((sb >> 9) & 1) << 5); R = (st >> 1) * 16 + swz / 64; C = (st & 1) * 32 + (swz % 64) / 2; }
__host__ __device__ __forceinline__ int perm32(int rho) { const int n = rho >> 4, i = rho & 15; return 8 * (i >> 2) + 4 * n + (i & 3); }

struct Unit { int pm, pn; };
struct Gemm { const bf16_t* A; const bf16_t* Bt; int M, N, K; };
struct StaticOrder {
    int nM, nN, nwg, G, c;
    __host__ __device__ void init(int M, int N, int G_, int c_) { nM = M / BM; nN = N / BM; nwg = nM * nN; G = G_; c = c_; }
    __host__ __device__ bool next(int i, Unit& u) const {
        const long L = (long)i * G + c; if (L >= nwg) return false;
        int wgid = (int)L; { const int q = nwg / NXCD, r = nwg % NXCD, xcd = wgid % NXCD, off = wgid / NXCD; wgid = (xcd < r ? xcd * (q + 1) : r * (q + 1) + (xcd - r) * q) + off; }
        const int nig = WGM * nN, gid = wgid / nig, fm = gid * WGM, gsz = (nM - fm) < WGM ? (nM - fm) : WGM;
        u.pm = fm + ((wgid % nig) % gsz); u.pn = (wgid % nig) / gsz; return true;
    }
    __device__ __forceinline__ void a_ready(const Unit&) const {}
    __device__ __forceinline__ void done(const Unit&) const {}
};
__device__ __forceinline__ unsigned cvt_pk_bf16(float lo, float hi) { unsigned r; asm volatile("v_cvt_pk_bf16_f32 %0, %1, %2" : "=v"(r) : "v"(lo), "v"(hi)); return r; }
template <class Epi, class Sched, bool STAMP = false>
__device__ __forceinline__ void gemm_phase(PG8_LAS unsigned char* lds, const Gemm g, const Sched& S, const Epi& E, unsigned long long* stamps) {
    const int tid = tidx(), wid = __builtin_amdgcn_readfirstlane(tid >> 6), lane = tid & 63, wr = wid >> 2, wc = wid & 3, fr = lane & 15, fq = lane >> 4;
    const int K = g.K, nt = K / BK;
    unsigned voffA[2], voffB[2];
#pragma unroll
    for (int i = 0; i < 2; ++i) { int R, C; stage_rc(tid * 16 + i * 8192, R, C); const int Rb = Epi::PERM ? ((R & ~31) + perm32(R & 31)) : R;
        voffA[i] = (unsigned)(R * K + C) * 2u; voffB[i] = (unsigned)(Rb * K + C) * 2u; }
    const size_t kstep = (size_t)(BK * 2);
    const size_t hstep = (size_t)HALF * K * 2;
    const size_t tstep = 2 * hstep;
    const unsigned ldsw = (unsigned)wid * 1024u;
    const int aoff = lds_byte(wr * 64 + fr, fq * 8), boff = lds_byte(wc * 32 + fr, fq * 8);
#define PG8_SA(b, h) (((b) * 2 + (h)) * HTB)
#define PG8_SB(b, h) ((4 + (b) * 2 + (h)) * HTB)
#define PG8_STAGE(bufoff, gbase, voff) do { _Pragma("unroll") for (int _i = 0; _i < 2; ++_i) \
        __builtin_amdgcn_global_load_lds((const unsigned*)((const char*)(gbase) + (voff)[_i]), (PG8_LAS unsigned*)(lds + (bufoff) + ldsw + _i * 8192), 16, 0, 0); } while (0)
#define PG8_LDA(dst, b, h) do { _Pragma("unroll") for (int m = 0; m < 4; ++m) _Pragma("unroll") for (int k = 0; k < 2; ++k) dst[m][k] = *(const PG8_LAS bf16x8*)(lds + PG8_SA(b, h) + aoff + m * 2048 + k * 1024); } while (0)
#define PG8_LDB(dst, b, h) do { _Pragma("unroll") for (int n = 0; n < 2; ++n) _Pragma("unroll") for (int k = 0; k < 2; ++k) dst[n][k] = *(const PG8_LAS bf16x8*)(lds + PG8_SB(b, h) + boff + n * 2048 + k * 1024); } while (0)
#define PG8_MMA(ai, bj, At, Bt) do { __builtin_amdgcn_s_setprio(1); _Pragma("unroll") for (int m = 0; m < 4; ++m) _Pragma("unroll") for (int n = 0; n < 2; ++n) _Pragma("unroll") for (int k = 0; k < 2; ++k) \
        acc[ai][bj][m][n] = __builtin_amdgcn_mfma_f32_16x16x32_bf16(Bt[n][k], At[m][k], acc[ai][bj][m][n], 0, 0, 0); __builtin_amdgcn_s_setprio(0); } while (0)
#define PG8_WAIT_V(n) asm volatile("s_waitcnt vmcnt(" #n ")" ::: "memory")
#define PG8_WAIT_L(n) asm volatile("s_waitcnt lgkmcnt(" #n ")" ::: "memory")
#define PG8_BAR __builtin_amdgcn_s_barrier()
#define PG8_SCHED __builtin_amdgcn_sched_barrier(0)
    Unit cur, nxt; int ui = 0;
    if (!S.next(0, cur)) return;
    f32x4 acc[2][2][4][2];
#pragma unroll
    for (int a = 0; a < 2; ++a)
#pragma unroll
        for (int b = 0; b < 2; ++b)
#pragma unroll
            for (int m = 0; m < 4; ++m)
#pragma unroll
                for (int n = 0; n < 2; ++n) acc[a][b][m][n] = (f32x4){0.f, 0.f, 0.f, 0.f};
    bf16x8 At[4][2], B0[2][2], B1[2][2];
    const char* cA = (const char*)g.A + (size_t)cur.pm * tstep; const char* cB = (const char*)g.Bt + (size_t)cur.pn * tstep;
    S.a_ready(cur);
    PG8_STAGE(PG8_SB(0, 0), cB, voffB); PG8_STAGE(PG8_SA(0, 0), cA, voffA); PG8_STAGE(PG8_SB(0, 1), cB + hstep, voffB); PG8_STAGE(PG8_SA(0, 1), cA + hstep, voffA);
    if (wr == 1) PG8_BAR;
    PG8_WAIT_V(4); PG8_BAR;
    PG8_STAGE(PG8_SB(1, 0), cB + kstep, voffB); PG8_STAGE(PG8_SA(1, 0), cA + kstep, voffA); PG8_STAGE(PG8_SB(1, 1), cB + hstep + kstep, voffB);
    PG8_WAIT_V(6); PG8_BAR;
    for (;;) {
        const bool has_next = S.next(ui + 1, nxt);
        const char* nA = has_next ? (const char*)g.A + (size_t)nxt.pm * tstep : cA; const char* nB = has_next ? (const char*)g.Bt + (size_t)nxt.pn * tstep : cB;
        for (int t = 0; t < nt; t += 2) {
            const bool last = (t == nt - 2);
            const char* a1 = cA + (size_t)(t + 1) * kstep;
            const char* a2 = last ? nA : cA + (size_t)(t + 2) * kstep; const char* b2 = last ? nB : cB + (size_t)(t + 2) * kstep;
            const char* a3 = a2 + kstep; const char* b3 = b2 + kstep;
            if (last && has_next) S.a_ready(nxt);
            PG8_LDB(B0, 0, 0); PG8_SCHED; PG8_LDA(At, 0, 0); PG8_STAGE(PG8_SA(1, 1), a1 + hstep, voffA);
            PG8_WAIT_L(8); PG8_BAR; PG8_WAIT_L(0); PG8_MMA(0, 0, At, B0); PG8_BAR; PG8_SCHED;
            PG8_LDB(B1, 0, 1); PG8_STAGE(PG8_SB(0, 0), b2, voffB);
            PG8_BAR; PG8_WAIT_L(0); PG8_MMA(0, 1, At, B1); PG8_BAR;
            PG8_LDA(At, 0, 1); PG8_STAGE(PG8_SA(0, 0), a2, voffA);
            PG8_BAR; PG8_WAIT_L(0); PG8_MMA(1, 0, At, B0); PG8_BAR; PG8_SCHED;
            PG8_STAGE(PG8_SB(0, 1), b2 + hstep, voffB);
            PG8_WAIT_V(6); PG8_BAR; PG8_MMA(1, 1, At, B1); PG8_BAR;
            PG8_LDB(B0, 1, 0); PG8_SCHED; PG8_LDA(At, 1, 0); PG8_STAGE(PG8_SA(0, 1), a2 + hstep, voffA);
            PG8_WAIT_L(8); PG8_BAR; PG8_WAIT_L(0); PG8_MMA(0, 0, At, B0); PG8_BAR; PG8_SCHED;
            PG8_LDB(B1, 1, 1); PG8_STAGE(PG8_SB(1, 0), b3, voffB);
            PG8_BAR; PG8_WAIT_L(0); PG8_MMA(0, 1, At, B1); PG8_BAR;
            PG8_LDA(At, 1, 1); PG8_STAGE(PG8_SA(1, 0), a3, voffA);
            PG8_BAR; PG8_WAIT_L(0); PG8_MMA(1, 0, At, B0); PG8_BAR; PG8_SCHED;
            PG8_STAGE(PG8_SB(1, 1), b3 + hstep, voffB);
            PG8_WAIT_V(6); PG8_BAR; PG8_MMA(1, 1, At, B1); PG8_BAR;
        }
        if constexpr (!Epi::AFTER_DRAIN) { E(acc, cur, wr, wc, fr, fq); S.done(cur); }
        if (!has_next) break;
#pragma unroll
        for (int a = 0; a < 2; ++a)
#pragma unroll
            for (int b = 0; b < 2; ++b)
#pragma unroll
                for (int m = 0; m < 4; ++m)
#pragma unroll
                    for (int n = 0; n < 2; ++n) acc[a][b][m][n] = (f32x4){0.f, 0.f, 0.f, 0.f};
        cur = nxt; cA = nA; cB = nB; ++ui;
    }
    PG8_WAIT_V(0);
    if (wr == 0) PG8_BAR;
    PG8_BAR;
    if constexpr (Epi::AFTER_DRAIN) { E.fused(acc, cur, wr, wc, fr, fq, lds, wid, lane); S.done(cur); }
#undef PG8_SA
#undef PG8_SB
#undef PG8_STAGE
#undef PG8_LDA
#undef PG8_LDB
#undef PG8_MMA
#undef PG8_WAIT_V
#undef PG8_WAIT_L
#undef PG8_BAR
#undef PG8_SCHED
}
}

using pg8::bf16_t; using pg8::bf16x8; using pg8::f32x4; using pg8::u32x4; using pg8::cvt_pk_bf16;
typedef short s16x4 __attribute__((ext_vector_type(4)));
typedef float f32x8 __attribute__((ext_vector_type(8)));
typedef float f32x16 __attribute__((ext_vector_type(16)));
typedef unsigned u32x2 __attribute__((ext_vector_type(2)));

constexpr int DM = 1024, TG = 32768;
constexpr size_t MiB = 1u << 20;
constexpr size_t WS_HWIN = 0, WS_HWOUT = 16 * MiB, WS_AWIN = 20 * MiB, WS_AWOUT = 30 * MiB, WS_H2 = 34 * MiB, WS_XB = 38 * MiB,
                 WS_UT = 102 * MiB, WS_GATE = 294 * MiB, WS_Y = 358 * MiB, WS_Z2T = 422 * MiB, WS_END = 486 * MiB;
constexpr int LDS_BYTES = 136 * 1024;
constexpr float ALPHA = 1.681792830507429f;
constexpr int NPHASE = 1 + 2 * 21;
#ifndef PHMASK
#define PHMASK 0xFFFF
#endif

struct Params { const float* in[24]; float* out; unsigned char* ws; int ph_lo, ph_hi; };
struct PV { const Params& q; int z; float* out; unsigned char* ws;
    __device__ __forceinline__ PV(const Params& q_, int z_) : q(q_), z(z_), out(q_.out + z_), ws(q_.ws + z_) {}
    __device__ __forceinline__ const float* in(int k) const { return q.in[k + z]; } };

__device__ __forceinline__ float bf2f(unsigned short x) { return __uint_as_float(((unsigned)x) << 16); }
__device__ __forceinline__ float bf2f_s(short x) { return __uint_as_float(((unsigned)(unsigned short)x) << 16); }
__device__ __forceinline__ unsigned short f2bf(float x) { return (unsigned short)(cvt_pk_bf16(x, 0.f) & 0xffffu); }
__device__ __forceinline__ float wave_sum(float v) {
#pragma unroll
    for (int o = 32; o >= 1; o >>= 1) v += __shfl_xor(v, o, 64);
    return v;
}
template <class T> __device__ __forceinline__ T* launder(T* q) {
    unsigned long long w = (unsigned long long)q; unsigned lo = (unsigned)w, hi = (unsigned)(w >> 32);
    asm volatile("" : "+v"(lo), "+v"(hi));
    lo = __builtin_amdgcn_readfirstlane(lo); hi = __builtin_amdgcn_readfirstlane(hi);
    return (T*)(((unsigned long long)hi << 32) | lo);
}
__device__ __forceinline__ int opaque_zero() { int z = 0; asm volatile("" : "+v"(z)); return __builtin_amdgcn_readfirstlane(z); }
__device__ __forceinline__ int opaque(int x) { asm volatile("" : "+v"(x)); return x; }
__device__ __forceinline__ float silu(float x) { return x / (1.f + __expf(-x)); }

struct EpiBf16B {
    static constexpr bool PERM = true, AFTER_DRAIN = false;
    bf16_t* O; int ldc; const float* bias;
    __device__ __forceinline__ void operator()(const f32x4 (&acc)[2][2][4][2], const pg8::Unit& u, int wr, int wc, int fr, int fq) const {
        const int row0 = u.pm * 256 + wr * 64 + fr, col0 = u.pn * 256 + wc * 32 + 8 * fq;
        f32x4 bv[2][2];
#pragma unroll
        for (int bj = 0; bj < 2; ++bj)
#pragma unroll
            for (int n = 0; n < 2; ++n) bv[bj][n] = *(const f32x4*)(bias + col0 + bj * 128 + 4 * n);
#pragma unroll
        for (int ai = 0; ai < 2; ++ai)
#pragma unroll
            for (int m = 0; m < 4; ++m) { bf16_t* rowp = O + (size_t)(row0 + ai * 128 + m * 16) * ldc + col0;
#pragma unroll
                for (int bj = 0; bj < 2; ++bj) { f32x4 v0 = acc[ai][bj][m][0] + bv[bj][0], v1 = acc[ai][bj][m][1] + bv[bj][1];
                    u32x4 w; w.x = cvt_pk_bf16(v0[0], v0[1]); w.y = cvt_pk_bf16(v0[2], v0[3]); w.z = cvt_pk_bf16(v1[0], v1[1]); w.w = cvt_pk_bf16(v1[2], v1[3]);
                    *(u32x4*)(rowp + bj * 128) = w; } }
    }
};
struct EpiUT {
    static constexpr bool PERM = true, AFTER_DRAIN = false;
    bf16_t* O; const float* bias; int L;
    __device__ __forceinline__ void operator()(const f32x4 (&acc)[2][2][4][2], const pg8::Unit& u, int wr, int wc, int fr, int fq) const {
        const int row0 = u.pm * 256 + wr * 64 + fr; const int tokt = u.pn * 256; const int b = tokt / L; const int t0 = tokt - b * L + wc * 32 + 8 * fq;
#pragma unroll
        for (int ai = 0; ai < 2; ++ai)
#pragma unroll
            for (int m = 0; m < 4; ++m) { const int ch = row0 + ai * 128 + m * 16; const float bs = bias[ch];
                bf16_t* rowp = O + ((size_t)b * 3072 + ch) * L + t0;
#pragma unroll
                for (int bj = 0; bj < 2; ++bj) { f32x4 v0 = acc[ai][bj][m][0] + bs, v1 = acc[ai][bj][m][1] + bs;
                    u32x4 w; w.x = cvt_pk_bf16(v0[0], v0[1]); w.y = cvt_pk_bf16(v0[2], v0[3]); w.z = cvt_pk_bf16(v1[0], v1[1]); w.w = cvt_pk_bf16(v1[2], v1[3]);
                    *(u32x4*)(rowp + bj * 128) = w; } }
    }
};
struct EpiRes {
    static constexpr bool PERM = true, AFTER_DRAIN = false;
    float* out; bf16_t* xb; const float* bias; int last;
    __device__ __forceinline__ void operator()(const f32x4 (&acc)[2][2][4][2], const pg8::Unit& u, int wr, int wc, int fr, int fq) const {
        const int row0 = u.pm * 256 + wr * 64 + fr, col0 = u.pn * 256 + wc * 32 + 8 * fq;
        f32x4 bv[2][2];
#pragma unroll
        for (int bj = 0; bj < 2; ++bj)
#pragma unroll
            for (int n = 0; n < 2; ++n) bv[bj][n] = *(const f32x4*)(bias + col0 + bj * 128 + 4 * n);
#pragma unroll
        for (int ai = 0; ai < 2; ++ai)
#pragma unroll
            for (int m = 0; m < 4; ++m) { const size_t ro = (size_t)(row0 + ai * 128 + m * 16) * DM + col0;
#pragma unroll
                for (int bj = 0; bj < 2; ++bj) { const bf16x8 xv = *(const bf16x8*)(xb + ro + bj * 128);
                    f32x4 v0, v1;
#pragma unroll
                    for (int e = 0; e < 4; ++e) { v0[e] = bf2f_s(xv[e]) * ALPHA + acc[ai][bj][m][0][e] + bv[bj][0][e]; v1[e] = bf2f_s(xv[4 + e]) * ALPHA + acc[ai][bj][m][1][e] + bv[bj][1][e]; }
                    if (last) { *(f32x4*)(out + ro + bj * 128) = v0; *(f32x4*)(out + ro + bj * 128 + 4) = v1; }
                    else { u32x4 w; w.x = cvt_pk_bf16(v0[0], v0[1]); w.y = cvt_pk_bf16(v0[2], v0[3]); w.z = cvt_pk_bf16(v1[0], v1[1]); w.w = cvt_pk_bf16(v1[2], v1[3]);
                        *(u32x4*)(xb + ro + bj * 128) = w; } } }
    }
};

template <class Epi> __device__ __forceinline__ void run_gemm(unsigned char* lds, const bf16_t* A, const bf16_t* Bt, int M, int N, const Epi& E) {
    pg8::Gemm g; g.A = A; g.Bt = Bt; g.M = M; g.N = N; g.K = DM;
    pg8::StaticOrder S; S.init(M, N, (int)gridDim.x, (int)blockIdx.x);
    pg8::gemm_phase<Epi, pg8::StaticOrder, false>((PG8_LAS unsigned char*)lds, g, S, E, nullptr);
    __syncthreads();
}

__device__ __forceinline__ void transpose_tile(const float* __restrict__ W, bf16_t* __restrict__ WT, int K, int N, int tk, int tn, unsigned char* lds) {
    float* tile = (float*)lds;
    const int tid = tidx();
#pragma unroll
    for (int i = 0; i < 2; ++i) { const int q = tid + i * 512, k = q >> 4, n4 = (q & 15) * 4;
        const f32x4 v = *(const f32x4*)(W + (size_t)(tk * 64 + k) * N + tn * 64 + n4);
        tile[k * 65 + n4 + 0] = v[0]; tile[k * 65 + n4 + 1] = v[1]; tile[k * 65 + n4 + 2] = v[2]; tile[k * 65 + n4 + 3] = v[3]; }
    __syncthreads();
    { const int n = tid >> 3, k8 = (tid & 7) * 8; float v[8];
#pragma unroll
        for (int e = 0; e < 8; ++e) v[e] = tile[(k8 + e) * 65 + n];
        u32x4 w; w.x = cvt_pk_bf16(v[0], v[1]); w.y = cvt_pk_bf16(v[2], v[3]); w.z = cvt_pk_bf16(v[4], v[5]); w.w = cvt_pk_bf16(v[6], v[7]);
        *(u32x4*)(WT + (size_t)(tn * 64 + n) * K + tk * 64 + k8) = w; }
    __syncthreads();
}

__device__ __forceinline__ void prologue_phase(const PV& p, unsigned char* lds) {
    const int total = 2 * 2176;
    for (int it = blockIdx.x; it < total; it += gridDim.x) {
        const int j = it / 2176; int r = it - j * 2176; int kind;
        if (r < 1024) kind = 0; else if (r < 1280) { kind = 1; r -= 1024; } else if (r < 1920) { kind = 2; r -= 1280; } else { kind = 3; r -= 1920; }
        const int N = kind == 0 ? 4096 : (kind == 2 ? 2560 : 1024);
        const int nN = N / 64; const int tk = r / nN, tn = r % nN;
        const float* W = (kind == 0 ? p.in(2) : kind == 1 ? p.in(14) : kind == 2 ? p.in(16) : p.in(20)) + (size_t)j * 1024 * N;
        bf16_t* WT = (bf16_t*)(p.ws + (kind == 0 ? WS_HWIN : kind == 1 ? WS_HWOUT : kind == 2 ? WS_AWIN : WS_AWOUT)) + (size_t)j * 1024 * N;
        transpose_tile(W, WT, 1024, N, tk, tn, lds);
    }
    const int tid_ = tidx(); const int wid = __builtin_amdgcn_readfirstlane(tid_ >> 6), lane = tid_ & 63;
    for (int row = blockIdx.x * 8 + wid; row < 2 * 6144; row += gridDim.x * 8) {
        const int j = row / 6144; int t = row - j * 6144; const int sel = t >= 2048 ? 1 : 0; if (sel) t -= 2048; const int L = sel ? 4096 : 2048;
        const float* w1 = p.in(6) + j * 33 * 64; const float* b1 = p.in(7) + j * 64; const float* fq = p.in(8) + j * 64;
        const float* w2 = p.in(9) + j * 64 * 64; const float* b2 = p.in(10) + j * 64;
        float feat = 0.f;
        if (lane == 0) feat = (float)t / (float)(L - 1);
        else if (lane <= 32) { const int i = (lane - 1) & 15; const double f = 1e-4 + (double)i * ((15.0 - 1e-4) / 15.0);
            double ph = f * (double)t / (double)L; ph -= (double)(long long)ph;
            const float a = (float)(ph * 6.283185307179586);
            feat = lane <= 16 ? cosf(a) : -sinf(a); }
        float s = b1[lane];
        for (int i = 0; i < 33; ++i) s += __shfl(feat, i, 64) * w1[i * 64 + lane];
        const float fr = fq[lane];
        const float h1 = sinf(fr * s);
        float s2 = b2[lane];
        for (int i = 0; i < 64; ++i) s2 += __shfl(h1, i, 64) * w2[i * 64 + lane];
        const float h2 = sinf(fr * s2);
        ((float*)(p.ws + WS_H2))[((size_t)(j * 2 + sel) * 4096 + t) * 64 + lane] = h2;
    }
}

__device__ __forceinline__ void cvt_phase(const PV& p, int g) {
    const float* x = p.in(g); bf16_t* xb = (bf16_t*)(p.ws + WS_XB);
    const size_t n8 = (size_t)TG * DM / 8;
    for (size_t i = (size_t)blockIdx.x * 512 + tidx(); i < n8; i += (size_t)gridDim.x * 512) {
        const f32x4 a = *(const f32x4*)(x + i * 8), b = *(const f32x4*)(x + i * 8 + 4);
        u32x4 w; w.x = cvt_pk_bf16(a[0], a[1]); w.y = cvt_pk_bf16(a[2], a[3]); w.z = cvt_pk_bf16(b[0], b[1]); w.w = cvt_pk_bf16(b[2], b[3]);
        *(u32x4*)(xb + i * 8) = w;
    }
}

__device__ __forceinline__ void ln_phase(const PV& p, int g, int layer) {
    float* x = p.out + (size_t)g * TG * DM; bf16_t* xb = (bf16_t*)(p.ws + WS_XB);
    const float* gam = p.in(22) + layer * DM; const float* bet = p.in(23) + layer * DM;
    const int tid_ = tidx(); const int wid = __builtin_amdgcn_readfirstlane(tid_ >> 6), lane = tid_ & 63;
    const bool last = layer == 3;
    f32x4 gv[4], bv[4];
#pragma unroll
    for (int k = 0; k < 4; ++k) { const int c = (k >> 1) * 512 + lane * 8 + (k & 1) * 4; gv[k] = *(const f32x4*)(gam + c); bv[k] = *(const f32x4*)(bet + c); }
    for (int row = blockIdx.x * 8 + wid; row < TG; row += gridDim.x * 8) {
        f32x4 v[4];
        if (last) {
#pragma unroll
            for (int k = 0; k < 4; ++k) v[k] = *(const f32x4*)(x + (size_t)row * DM + (k >> 1) * 512 + lane * 8 + (k & 1) * 4);
        } else {
#pragma unroll
            for (int hh = 0; hh < 2; ++hh) { const bf16x8 t = *(const bf16x8*)(xb + (size_t)row * DM + hh * 512 + lane * 8);
#pragma unroll
                for (int e = 0; e < 4; ++e) { v[hh * 2][e] = bf2f_s(t[e]); v[hh * 2 + 1][e] = bf2f_s(t[4 + e]); } }
        }
        float s = 0.f;
#pragma unroll
        for (int k = 0; k < 4; ++k) s += v[k][0] + v[k][1] + v[k][2] + v[k][3];
        const float mu = wave_sum(s) * (1.f / DM); float q = 0.f;
#pragma unroll
        for (int k = 0; k < 4; ++k) { v[k] = v[k] - mu; q += v[k][0] * v[k][0] + v[k][1] * v[k][1] + v[k][2] * v[k][2] + v[k][3] * v[k][3]; }
        const float rstd = rsqrtf(wave_sum(q) * (1.f / DM) + 1e-5f);
#pragma unroll
        for (int k = 0; k < 4; ++k) v[k] = v[k] * rstd * gv[k] + bv[k];
        if (last) {
#pragma unroll
            for (int k = 0; k < 4; ++k) *(f32x4*)(x + (size_t)row * DM + (k >> 1) * 512 + lane * 8 + (k & 1) * 4) = v[k];
        } else {
#pragma unroll
            for (int hh = 0; hh < 2; ++hh) { u32x4 w; w.x = cvt_pk_bf16(v[hh * 2][0], v[hh * 2][1]); w.y = cvt_pk_bf16(v[hh * 2][2], v[hh * 2][3]);
                w.z = cvt_pk_bf16(v[hh * 2 + 1][0], v[hh * 2 + 1][1]); w.w = cvt_pk_bf16(v[hh * 2 + 1][2], v[hh * 2 + 1][3]);
                *(u32x4*)(xb + (size_t)row * DM + hh * 512 + lane * 8) = w; }
        }
    }
}

__device__ __forceinline__ bf16x8 lds_a4(const unsigned char* lds, unsigned addr) {
    const unsigned* q = (const unsigned*)(lds + addr); u32x4 w; w.x = q[0]; w.y = q[1]; w.z = q[2]; w.w = q[3]; return *reinterpret_cast<bf16x8*>(&w);
}
template <int NB> struct ConvCfg {
    static constexpr int L = NB == 16 ? 2048 : 4096, ROWE = L + 8, SB = NB == 16 ? 0 : -2048, NT = NB == 16 ? 64 : 192;
    static constexpr int ZOFF = 0, FOFF = 66560, FCOPY = 2 * L * 2, W3OFF = FOFF + 4 * FCOPY, REDOFF = W3OFF + 1024;
};
template <int NB> __device__ __forceinline__ void conv_main(const unsigned char* lds, int o, f32x4 (&acc)[16]) {
    using C = ConvCfg<NB>;
    const int tid_ = tidx(); const int lane = tid_ & 63, wid = __builtin_amdgcn_readfirstlane(tid_ >> 6), r = lane & 15, gq = lane >> 4;
    const int b = NB == 16 ? r : (r & 7), h = NB == 16 ? 0 : (r >> 3);
    const int E0 = (C::L - 1) + C::SB - 256 * wid + 8 * gq - r;
    const int P = E0 & 1;
    unsigned aPtr = (unsigned)(C::FOFF + (o * 2 + P) * C::FCOPY + 2 * (E0 - P));
    const int bBase = C::ZOFF + b * C::ROWE * 2 + 2 * (C::SB + 2048 * h + 8 * gq);
    const int s_lane0 = C::SB + 2048 * h;
    bf16x8 A[16];
#pragma unroll
    for (int i = 0; i < 16; ++i) { A[i] = lds_a4(lds, aPtr - 32 * i); acc[i] = (f32x4){0.f, 0.f, 0.f, 0.f}; }
    auto ldb = [&](int j) -> bf16x8 {
        if (NB == 16) return *(const bf16x8*)(lds + bBase + 64 * j);
        const bool valid = (unsigned)(s_lane0 + 32 * j) < (unsigned)C::L;
        const bf16x8 t = *(const bf16x8*)(lds + (valid ? bBase + 64 * j : C::ZOFF));
        const bf16x8 z = {0, 0, 0, 0, 0, 0, 0, 0}; return valid ? t : z; };
    bf16x8 bnext = ldb(0);
    for (int jo = 0; jo < C::NT / 8; ++jo) {
#pragma unroll
        for (int jj = 0; jj < 8; ++jj) {
            const int j = jo * 8 + jj;
            const bf16x8 bf = bnext;
            bnext = ldb(j + 1 < C::NT ? j + 1 : j);
            acc[15] = __builtin_amdgcn_mfma_f32_16x16x32_bf16(A[(15 - 2 * jj) & 15], bf, acc[15], 0, 0, 0);
            acc[14] = __builtin_amdgcn_mfma_f32_16x16x32_bf16(A[(14 - 2 * jj) & 15], bf, acc[14], 0, 0, 0);
            A[(14 - 2 * jj) & 15] = lds_a4(lds, aPtr + 64 * (jj + 1));
            A[(15 - 2 * jj) & 15] = lds_a4(lds, aPtr + 64 * (jj + 1) - 32);
#pragma unroll
            for (int i = 13; i >= 0; --i) acc[i] = __builtin_amdgcn_mfma_f32_16x16x32_bf16(A[(i - 2 * jj) & 15], bf, acc[i], 0, 0, 0);
            __builtin_amdgcn_sched_barrier(0);
        }
        aPtr += 512;
    }
}
template <int NB> __device__ __forceinline__ void conv_epi(const unsigned char* lds, const f32x4 (&acc)[16], u32x2 (&zp)[16], const bf16_t* UT, int gch,
                                                          float gw0, float gw1, float gw2, float gcb, float fb, float nrm) {
    using C = ConvCfg<NB>;
    const int tid_ = tidx(); const int lane = tid_ & 63, wid = __builtin_amdgcn_readfirstlane(tid_ >> 6), r = lane & 15, gq = lane >> 4;
    const int b = NB == 16 ? r : (r & 7), h = NB == 16 ? 0 : (r >> 3);
    const bf16_t* grow = UT + ((size_t)b * 3072 + gch) * C::L;
#pragma unroll
    for (int i = 0; i < 16; ++i) {
        const int t = 256 * wid + 16 * i + 4 * gq + 2048 * h;
        const s16x4 gu = *(const s16x4*)(grow + t);
        const float gl = t > 0 ? bf2f(grow[t - 1]) : 0.f, gr = (t + 4 < C::L) ? bf2f(grow[t + 4]) : 0.f;
        const float u0 = bf2f_s(gu[0]), u1 = bf2f_s(gu[1]), u2 = bf2f_s(gu[2]), u3 = bf2f_s(gu[3]);
        const float g0 = gw0 * gl + gw1 * u0 + gw2 * u1 + gcb, g1 = gw0 * u0 + gw1 * u1 + gw2 * u2 + gcb;
        const float g2 = gw0 * u1 + gw1 * u2 + gw2 * u3 + gcb, g3 = gw0 * u2 + gw1 * u3 + gw2 * gr + gcb;
        const s16x4 vz = *(const s16x4*)(lds + C::ZOFF + (b * C::ROWE + t) * 2);
        const float z0 = g0 * (acc[i][0] * nrm + bf2f_s(vz[0]) * fb), z1 = g1 * (acc[i][1] * nrm + bf2f_s(vz[1]) * fb);
        const float z2 = g2 * (acc[i][2] * nrm + bf2f_s(vz[2]) * fb), z3 = g3 * (acc[i][3] * nrm + bf2f_s(vz[3]) * fb);
        zp[i].x = cvt_pk_bf16(z0, z1); zp[i].y = cvt_pk_bf16(z2, z3);
    }
}
template <int NB> __device__ __forceinline__ void conv_store_z(unsigned char* lds, const u32x2 (&zp)[16]) {
    using C = ConvCfg<NB>;
    const int tid_ = tidx(); const int lane = tid_ & 63, wid = __builtin_amdgcn_readfirstlane(tid_ >> 6), r = lane & 15, gq = lane >> 4;
    const int b = NB == 16 ? r : (r & 7), h = NB == 16 ? 0 : (r >> 3);
#pragma unroll
    for (int i = 0; i < 16; ++i) { const int t = 256 * wid + 16 * i + 4 * gq + 2048 * h; *(u32x2*)(lds + C::ZOFF + (b * C::ROWE + t) * 2) = zp[i]; }
}

template <int NB> __device__ __forceinline__ void conv_phase(const PV& p, int hj, unsigned char* lds) {
    using C = ConvCfg<NB>;
    constexpr int L = C::L;
    const int tid = tidx(), wid = __builtin_amdgcn_readfirstlane(tid >> 6), lane = tid & 63;
    bf16_t* UT = (bf16_t*)(p.ws + WS_UT);
    const float* h2 = (const float*)(p.ws + WS_H2) + (size_t)(hj * 2 + (NB == 16 ? 0 : 1)) * 4096 * 64;
    const float* w3 = p.in(11) + (size_t)hj * 64 * 4096; const float* decay = p.in(12) + hj * 4096;
    const float* fbias = p.in(13) + hj * 2048; const float* cw = p.in(4) + hj * 3 * 3072; const float* cb = p.in(5) + hj * 3072;
    float* w3s = (float*)(lds + C::W3OFF); float* red = (float*)(lds + C::REDOFF);
    for (int c = blockIdx.x; c < 1024; c += gridDim.x) {
        if (tid < 256) { const int od = tid >> 6, j = tid & 63; w3s[od * 64 + j] = w3[(size_t)j * 4096 + od * 1024 + c]; }
        constexpr int NBLK = L / 256;
        const int frow = tid & 255, fo = tid >> 8;
        const float decf = fabsf(decay[(fo * 2) * 1024 + c]), decb = fabsf(decay[(fo * 2 + 1) * 1024 + c]);
        float ss = 0.f;
        float* stg = (float*)lds;
        bf16_t* c0 = (bf16_t*)(lds + C::FOFF + (fo * 2) * C::FCOPY); bf16_t* c1 = (bf16_t*)(lds + C::FOFF + (fo * 2 + 1) * C::FCOPY);
#pragma unroll 1
        for (int blk = 0; blk < NBLK; ++blk) {
            __syncthreads();
#pragma unroll
            for (int i = 0; i < 8; ++i) { const int q = tid + 512 * i, rr = q >> 4, c4 = (q & 15) * 4;
                const f32x4 x = *(const f32x4*)(h2 + (size_t)(blk * 256 + rr) * 64 + c4);
                float* d = stg + rr * 65 + c4; d[0] = x[0]; d[1] = x[1]; d[2] = x[2]; d[3] = x[3]; }
            __syncthreads();
            float df = 0.f, db = 0.f; const float* hrow = stg + frow * 65; const float* wf = w3s + (fo * 2) * 64;
#pragma unroll 8
            for (int j = 0; j < 64; ++j) { const float x = hrow[j]; df += x * wf[j]; db += x * wf[64 + j]; }
            const int tt = blk * 256 + frow;
            const float tl = (float)tt * (1.0f / (float)(L - 1));
            df *= expf(-tl * decf); db *= expf(-tl * decb);
            ss += df * df + db * db;
            const bf16_t f = f2bf(df); const int i = L - 1 - tt;
            c0[i] = f; if (i >= 1) c1[i - 1] = f;
            if (tt >= 1) { const bf16_t bw = f2bf(db); const int i2 = L - 1 + tt; c0[i2] = bw; c1[i2 - 1] = bw; }
        }
        if (frow == 0) { c0[2 * L - 1] = 0; c1[2 * L - 2] = 0; c1[2 * L - 1] = 0; }
        ss = wave_sum(ss);
        if (lane == 0) red[wid] = ss;
        __syncthreads();
        const float nrm0 = rsqrtf(red[0] + red[1] + red[2] + red[3] + 1e-6f), nrm1 = rsqrtf(red[4] + red[5] + red[6] + red[7] + 1e-6f);
        { const float w0 = cw[c], w1 = cw[3072 + c], w2 = cw[2 * 3072 + c], cbv = cb[c];
            for (int chunk = tid; chunk < NB * L / 8; chunk += 512) { const int b = chunk / (L / 8), s8 = (chunk % (L / 8)) * 8;
                const bf16_t* src = UT + ((size_t)b * 3072 + c) * L + s8;
                const bf16x8 x = *(const bf16x8*)src; float xe[10];
                xe[0] = s8 > 0 ? bf2f(src[-1]) : 0.f; xe[9] = (s8 + 8 < L) ? bf2f(src[8]) : 0.f;
#pragma unroll
                for (int e = 0; e < 8; ++e) xe[e + 1] = bf2f_s(x[e]);
                float y[8];
#pragma unroll
                for (int e = 0; e < 8; ++e) y[e] = w0 * xe[e] + w1 * xe[e + 1] + w2 * xe[e + 2] + cbv;
                u32x4 w; w.x = cvt_pk_bf16(y[0], y[1]); w.y = cvt_pk_bf16(y[2], y[3]); w.z = cvt_pk_bf16(y[4], y[5]); w.w = cvt_pk_bf16(y[6], y[7]);
                *(u32x4*)(lds + C::ZOFF + (b * C::ROWE + s8) * 2) = w; } }
        __syncthreads();
        f32x4 acc[16]; u32x2 zp[16];
        conv_main<NB>(lds, 0, acc);
        conv_epi<NB>(lds, acc, zp, UT, 1024 + c, cw[1024 + c], cw[3072 + 1024 + c], cw[2 * 3072 + 1024 + c], cb[1024 + c], fbias[c], nrm0);
        __syncthreads();
        conv_store_z<NB>(lds, zp);
        __syncthreads();
        conv_main<NB>(lds, 1, acc);
        conv_epi<NB>(lds, acc, zp, UT, 2048 + c, cw[2048 + c], cw[3072 + 2048 + c], cw[2 * 3072 + 2048 + c], cb[2048 + c], fbias[1024 + c], nrm1);
        __syncthreads();
        conv_store_z<NB>(lds, zp);
        __syncthreads();
        for (int chunk = tid; chunk < NB * L / 8; chunk += 512) { const int b = chunk / (L / 8), s8 = (chunk % (L / 8)) * 8;
            *(u32x4*)((bf16_t*)(p.ws + WS_Z2T) + ((size_t)b * 1024 + c) * L + s8) = *(const u32x4*)(lds + C::ZOFF + (b * C::ROWE + s8) * 2); }
        __syncthreads();
    }
}

__device__ __forceinline__ void ygate_phase(const PV& p, int L, unsigned char* lds) {
    const bf16_t* UT = (const bf16_t*)(p.ws + WS_Z2T); const bf16_t* G = (const bf16_t*)(p.ws + WS_GATE); bf16_t* Y = (bf16_t*)(p.ws + WS_Y);
    const int tid = tidx(); constexpr int RS = 136;
    bf16_t* tile = (bf16_t*)lds;
    for (int it = blockIdx.x; it < (TG / 128) * 16; it += gridDim.x) {
        const int tc = it & 15, tt = it >> 4; const int tok0 = tt * 128, b = tok0 / L, t0 = tok0 - b * L, c0 = tc * 64;
#pragma unroll
        for (int i = 0; i < 2; ++i) { const int q = tid + i * 512, cc = q >> 4, tch = (q & 15) * 8;
            *(u32x4*)(tile + cc * RS + tch) = *(const u32x4*)(UT + ((size_t)b * 1024 + c0 + cc) * L + t0 + tch); }
        __syncthreads();
#pragma unroll
        for (int i = 0; i < 2; ++i) { const int q = tid + i * 512, t = q >> 3, cch = (q & 7) * 8;
            const bf16x8 gv = *(const bf16x8*)(G + (size_t)(tok0 + t) * DM + c0 + cch); float y[8];
#pragma unroll
            for (int e = 0; e < 8; ++e) y[e] = bf2f(tile[(cch + e) * RS + t]) * silu(bf2f_s(gv[e]));
            u32x4 w; w.x = cvt_pk_bf16(y[0], y[1]); w.y = cvt_pk_bf16(y[2], y[3]); w.z = cvt_pk_bf16(y[4], y[5]); w.w = cvt_pk_bf16(y[6], y[7]);
            *(u32x4*)(Y + (size_t)(tok0 + t) * DM + c0 + cch) = w; }
        __syncthreads();
    }
}

constexpr int LDU = 2560;
__device__ __forceinline__ void rope_phase(const PV& p, int aj, int L) {
    bf16_t* U = (bf16_t*)(p.ws + WS_UT);
    const float* qn = p.in(18) + aj * 128; const float* kn = p.in(19) + aj * 128;
    const int tid = tidx(), sub = tid & 7;
    float inv[8], q1[8], q2[8], k1[8], k2[8];
#pragma unroll
    for (int e = 0; e < 8; ++e) { inv[e] = exp2f(-(float)((8 * sub + e) & 31) * (13.287712379549449f / 32.f));
        q1[e] = qn[8 * sub + e]; q2[e] = qn[64 + 8 * sub + e]; k1[e] = kn[8 * sub + e]; k2[e] = kn[64 + 8 * sub + e]; }
    for (int tok = blockIdx.x * 64 + (tid >> 3); tok < TG; tok += gridDim.x * 64) {
        const int t = tok & (L - 1); const float pos = (float)(sub < 4 ? (t >> 6) : (t & 63));
        float cs[8], sn[8];
#pragma unroll
        for (int e = 0; e < 8; ++e) { const float ang = pos * inv[e]; cs[e] = __cosf(ang); sn[e] = __sinf(ang); }
        bf16_t* u = U + (size_t)tok * LDU + 8 * sub;
#pragma unroll
        for (int hd = 0; hd < 10; ++hd) {
            const bf16x8 a = *(const bf16x8*)(u + hd * 128), bq = *(const bf16x8*)(u + hd * 128 + 64);
            float x1[8], x2[8]; float ss = 0.f;
#pragma unroll
            for (int e = 0; e < 8; ++e) { x1[e] = bf2f_s(a[e]); x2[e] = bf2f_s(bq[e]); ss += x1[e] * x1[e] + x2[e] * x2[e]; }
            ss += __shfl_xor(ss, 1, 64); ss += __shfl_xor(ss, 2, 64); ss += __shfl_xor(ss, 4, 64);
            const float rs = rsqrtf(ss * (1.f / 128.f) + 1e-6f);
            float o1[8], o2[8];
#pragma unroll
            for (int e = 0; e < 8; ++e) { const float xa = x1[e] * rs * (hd < 8 ? q1[e] : k1[e]), xb2 = x2[e] * rs * (hd < 8 ? q2[e] : k2[e]);
                o1[e] = xa * cs[e] - xb2 * sn[e]; o2[e] = xb2 * cs[e] + xa * sn[e]; }
            u32x4 w1, w2; w1.x = cvt_pk_bf16(o1[0], o1[1]); w1.y = cvt_pk_bf16(o1[2], o1[3]); w1.z = cvt_pk_bf16(o1[4], o1[5]); w1.w = cvt_pk_bf16(o1[6], o1[7]);
            w2.x = cvt_pk_bf16(o2[0], o2[1]); w2.y = cvt_pk_bf16(o2[2], o2[3]); w2.z = cvt_pk_bf16(o2[4], o2[5]); w2.w = cvt_pk_bf16(o2[6], o2[7]);
            *(u32x4*)(u + hd * 128) = w1; *(u32x4*)(u + hd * 128 + 64) = w2;
        }
    }
}

namespace att {
constexpr int D = 128, NW = 8, QBLK = 32, KVBLK = 64;
constexpr float SCALE = 0.088388347648318440f;
constexpr float THR = 8.f;
constexpr int LDQ = LDU, LDK = LDU;
constexpr size_t SHM_V = KVBLK * D * 2, SHM_K = KVBLK * D * 2, SHM_ATTN = 2 * SHM_V + 2 * SHM_K + NW * 64 * 4;
#define KSWZ(row, colB) ((row) * 256 + ((colB) ^ (((row) & 7) << 4)))
#define SBAR() __builtin_amdgcn_sched_barrier(0)
__device__ __forceinline__ int crow(int r, int hi) { return (r & 3) + 8 * (r >> 2) + 4 * hi; }
__device__ __forceinline__ unsigned cvtpk(float lo, float hi) { unsigned r; asm volatile("v_cvt_pk_bf16_f32 %0, %1, %2" : "=v"(r) : "v"(lo), "v"(hi)); return r; }
__device__ __forceinline__ bf16x8 ld8(const bf16_t* p) { return *reinterpret_cast<const bf16x8*>(p); }
__device__ __forceinline__ void partialSM(f32x16& p0, f32x16& p1, float& m_reg, float& mn, float& alpha) {
  constexpr float C = SCALE * 1.4426950408889634f;
  float pmax = p0[0]; for (int r = 1; r < 16; ++r) pmax = fmaxf(pmax, p0[r]); for (int r = 0; r < 16; ++r) pmax = fmaxf(pmax, p1[r]);
  { auto rr = __builtin_amdgcn_permlane32_swap(__float_as_uint(pmax), __float_as_uint(pmax), false, false);
    pmax = fmaxf(__uint_as_float(rr[0]), __uint_as_float(rr[1])); }
  if (__builtin_expect(__all(pmax - m_reg <= THR / SCALE), 1)) { mn = m_reg; alpha = 1.f; }
  else { mn = fmaxf(m_reg, pmax); alpha = __builtin_amdgcn_exp2f((m_reg - mn) * C); m_reg = mn; }
  float mnC = -mn * C;
  for (int r = 0; r < 16; ++r) p0[r] = fmaf(p0[r], C, mnC); for (int r = 0; r < 16; ++r) p1[r] = fmaf(p1[r], C, mnC);
  for (int r = 0; r < 16; ++r) p0[r] = __builtin_amdgcn_exp2f(p0[r]);
}
__device__ __forceinline__ void finishSM(f32x16& p0, f32x16& p1, float alpha, float& l_reg, bf16x8& pa0, bf16x8& pa1, bf16x8& pa2, bf16x8& pa3) {
  for (int r = 0; r < 16; ++r) p1[r] = __builtin_amdgcn_exp2f(p1[r]);
  float ps = 0; for (int r = 0; r < 16; ++r) ps += p0[r]; for (int r = 0; r < 16; ++r) ps += p1[r];
  { auto rr = __builtin_amdgcn_permlane32_swap(__float_as_uint(ps), __float_as_uint(ps), false, false);
    ps = __uint_as_float(rr[0]) + __uint_as_float(rr[1]); }
  l_reg = l_reg * alpha + ps;
#define PK4(P, BASE, OUT) do { unsigned a0 = cvtpk(P[BASE + 0], P[BASE + 1]), a1 = cvtpk(P[BASE + 2], P[BASE + 3]);   \
    unsigned b0 = cvtpk(P[BASE + 4], P[BASE + 5]), b1 = cvtpk(P[BASE + 6], P[BASE + 7]);                              \
    auto r0 = __builtin_amdgcn_permlane32_swap(a0, b0, false, false); auto r1 = __builtin_amdgcn_permlane32_swap(a1, b1, false, false); \
    u32x4 w = {r0[0], r1[0], r0[1], r1[1]}; OUT = *reinterpret_cast<bf16x8*>(&w); } while (0)
  PK4(p0, 0, pa0); PK4(p0, 8, pa1); PK4(p1, 0, pa2); PK4(p1, 8, pa3);
#undef PK4
}
__device__ __forceinline__ void qkt(f32x16& p0, f32x16& p1, const bf16_t* Ks, const bf16x8* qr, int r32, int hi) {
  p0 = f32x16{}; p1 = f32x16{};
  for (int d0 = 0; d0 < 8; ++d0) { int cb = (d0 * 16 + hi * 8) * 2;
    bf16x8 b0 = *reinterpret_cast<const bf16x8*>((const char*)Ks + KSWZ(r32, cb));
    bf16x8 b1 = *reinterpret_cast<const bf16x8*>((const char*)Ks + KSWZ(32 + r32, cb));
    p0 = __builtin_amdgcn_mfma_f32_32x32x16_bf16(b0, qr[d0], p0, 0, 0, 0);
    p1 = __builtin_amdgcn_mfma_f32_32x32x16_bf16(b1, qr[d0], p1, 0, 0, 0); }
}
__device__ __forceinline__ int v_st(int k, int c) { const int kk = (k & ~0xC) | ((k & 4) << 1) | ((k & 8) >> 1); return ((kk >> 3) * 4 + (c >> 5)) * 512 + ((kk & 7) * 32 + (c & 31)) * 2; }
__device__ __forceinline__ int v_rd_base(int lane) { return ((lane & 3) << 3) | (((lane >> 2) & 3) << 6) | (((lane >> 4) & 1) << 5) | (((lane >> 5) & 1) << 8); }
constexpr int v_rd_off(int d0, int ks, int half) { return d0 * 512 + ks * 4096 + half * 2048; }
template <int OFF> __device__ __forceinline__ s16x4 tr_read(int vb) {
  s16x4 r; asm volatile("ds_read_b64_tr_b16 %0, %1 offset:%2" : "=&v"(r) : "v"(vb), "i"(OFF) : "memory"); return r;
}
template <int D0> __device__ __forceinline__ void pv_one(f32x16& od, int vb, bf16x8 pa0, bf16x8 pa1, bf16x8 pa2, bf16x8 pa3) {
  const s16x4 l0 = tr_read<v_rd_off(D0, 0, 0)>(vb), h0 = tr_read<v_rd_off(D0, 0, 1)>(vb), l1 = tr_read<v_rd_off(D0, 1, 0)>(vb), h1 = tr_read<v_rd_off(D0, 1, 1)>(vb);
  const s16x4 l2 = tr_read<v_rd_off(D0, 2, 0)>(vb), h2 = tr_read<v_rd_off(D0, 2, 1)>(vb), l3 = tr_read<v_rd_off(D0, 3, 0)>(vb), h3 = tr_read<v_rd_off(D0, 3, 1)>(vb);
  asm volatile("s_waitcnt lgkmcnt(0)" ::: "memory"); SBAR();
#define PK(L, H) (bf16x8){L[0], L[1], L[2], L[3], H[0], H[1], H[2], H[3]}
  od = __builtin_amdgcn_mfma_f32_32x32x16_bf16(pa0, PK(l0, h0), od, 0, 0, 0);
  od = __builtin_amdgcn_mfma_f32_32x32x16_bf16(pa1, PK(l1, h1), od, 0, 0, 0);
  od = __builtin_amdgcn_mfma_f32_32x32x16_bf16(pa2, PK(l2, h2), od, 0, 0, 0);
  od = __builtin_amdgcn_mfma_f32_32x32x16_bf16(pa3, PK(l3, h3), od, 0, 0, 0);
#undef PK
}
__device__ __forceinline__ void pv_d0(f32x16* o, int vb, bf16x8 pa0, bf16x8 pa1, bf16x8 pa2, bf16x8 pa3) {
  pv_one<0>(o[0], vb, pa0, pa1, pa2, pa3); pv_one<1>(o[1], vb, pa0, pa1, pa2, pa3); pv_one<2>(o[2], vb, pa0, pa1, pa2, pa3); pv_one<3>(o[3], vb, pa0, pa1, pa2, pa3);
}
__device__ __forceinline__ void attn_dense_body(const bf16_t* __restrict__ Qb, const bf16_t* __restrict__ Kh, const bf16_t* __restrict__ Vh,
                                                const bf16_t* __restrict__ Gb, bf16_t* __restrict__ Yb, int seq, char* lds) {
  constexpr int SDEPTH = 1;
  const int tid = tidx(), wid = __builtin_amdgcn_readfirstlane(tid >> 6), lane = tid & 63, r32 = lane & 31, hi = lane >> 5;
  bf16_t* V_lds = (bf16_t*)lds; bf16_t* K_lds = (bf16_t*)(lds + 2 * SHM_V);
  float* ws = (float*)(lds + 2 * SHM_V + 2 * SHM_K) + wid * 64; float* li_l = ws; float* al_l = ws + 32;
  float m_reg = -1e30f, l_reg = 0; f32x16 o[4] = {}; bf16x8 qr[8];
  const bf16_t* Qw = Qb + (long)(wid * QBLK + r32) * LDQ + hi * 8;
#pragma unroll
  for (int d0 = 0; d0 < 8; ++d0) qr[d0] = ld8(Qw + d0 * 16);
  const int sr = tid >> 4, sc = (tid & 15) * 8, vst0 = v_st(sr, sc), vst1 = v_st(32 + sr, sc);
  const int vb0 = (int)(uintptr_t)V_lds + v_rd_base(lane);
  struct { bf16x8 vs0, vs1, ks0, ks1; } sr_[SDEPTH];
#define SLOAD(i, k0) do { sr_[i].vs0 = ld8(&Vh[(long)((k0) + sr) * LDK + sc]); sr_[i].vs1 = ld8(&Vh[(long)((k0) + 32 + sr) * LDK + sc]); \
    sr_[i].ks0 = ld8(&Kh[(long)((k0) + sr) * LDK + sc]); sr_[i].ks1 = ld8(&Kh[(long)((k0) + 32 + sr) * LDK + sc]); } while (0)
#define SWRITE(b, i) do { *(bf16x8*)((char*)V_lds + (b) * SHM_V + vst0) = sr_[i].vs0;          \
    *(bf16x8*)((char*)V_lds + (b) * SHM_V + vst1) = sr_[i].vs1; int kc = sc * 2;               \
    *(bf16x8*)((char*)K_lds + (b) * SHM_K + KSWZ(sr, kc)) = sr_[i].ks0;                       \
    *(bf16x8*)((char*)K_lds + (b) * SHM_K + KSWZ(32 + sr, kc)) = sr_[i].ks1; } while (0)
#define SWAIT() do { asm volatile("s_waitcnt vmcnt(0)" ::: "memory"); } while (0)
#define RESC(a) do { if (__any((a) < 1.f)) { if (hi == 0) al_l[r32] = (a); asm volatile("s_waitcnt lgkmcnt(0)" ::: "memory"); \
    for (int d = 0; d < 4; ++d) for (int r = 0; r < 16; ++r) o[d][r] *= al_l[crow(r, hi)]; } } while (0)
  f32x16 pA0, pA1, pB0, pB1; float mnA, mnB, alA, alB; bf16x8 pa0, pa1, pa2, pa3; const int NT = seq / KVBLK;
  constexpr int SE = 0, SO = SDEPTH - 1;
  SLOAD(SE, 0); asm volatile("s_waitcnt vmcnt(0)" ::: "memory"); SWRITE(0, SE); __syncthreads();
  qkt(pA0, pA1, K_lds, qr, r32, hi); partialSM(pA0, pA1, m_reg, mnA, alA);
  SLOAD(SO, KVBLK);
  SWAIT(); SWRITE(1, SO); __syncthreads();
  for (int j = 1; j + 1 < NT; j += 2) {
    SBAR(); qkt(pB0, pB1, (bf16_t*)((char*)K_lds + SHM_K), qr, r32, hi);
    finishSM(pA0, pA1, alA, l_reg, pa0, pa1, pa2, pa3); SBAR();
    SLOAD(SO, (j + SDEPTH) * KVBLK); SBAR();
    pv_d0(o, vb0, pa0, pa1, pa2, pa3); partialSM(pB0, pB1, m_reg, mnB, alB);
    __syncthreads(); SWAIT(); SWRITE(0, SE);
    RESC(alB); __syncthreads();
    SBAR(); qkt(pA0, pA1, K_lds, qr, r32, hi);
    finishSM(pB0, pB1, alB, l_reg, pa0, pa1, pa2, pa3); SBAR();
    SLOAD(SE, (j + 1 + SDEPTH) * KVBLK); SBAR();
    pv_d0(o, vb0 + (int)SHM_V, pa0, pa1, pa2, pa3); partialSM(pA0, pA1, m_reg, mnA, alA);
    __syncthreads(); SWAIT(); SWRITE(1, SO);
    RESC(alA); __syncthreads();
  }
  SBAR(); qkt(pB0, pB1, (bf16_t*)((char*)K_lds + SHM_K), qr, r32, hi);
  finishSM(pA0, pA1, alA, l_reg, pa0, pa1, pa2, pa3); SBAR();
  pv_d0(o, vb0, pa0, pa1, pa2, pa3); partialSM(pB0, pB1, m_reg, mnB, alB);
  __syncthreads(); RESC(alB);
  finishSM(pB0, pB1, alB, l_reg, pa0, pa1, pa2, pa3); SBAR();
  pv_d0(o, vb0 + (int)SHM_V, pa0, pa1, pa2, pa3);
  if (hi == 0) li_l[r32] = l_reg; asm volatile("s_waitcnt lgkmcnt(0)" ::: "memory");
  { const int ln = opaque(lane), r32e = ln & 31, hie = ln >> 5;
    const bf16_t* Gl = Gb + (long)(wid * QBLK + 4 * hie) * LDU + r32e; bf16_t* Yl = Yb + (long)(wid * QBLK + 4 * hie) * DM + r32e;
#pragma unroll
  for (int r = 0; r < 16; ++r) { const int ro = (r & 3) + 8 * (r >> 2); const float rl = __builtin_amdgcn_rcpf(li_l[ro + 4 * hie]);
    asm volatile("" ::: "memory");
#pragma unroll
    for (int d0 = 0; d0 < 4; ++d0) { const float gv = bf2f(Gl[ro * LDU + d0 * 32]);
      Yl[ro * DM + d0 * 32] = f2bf(o[d0][r] * rl * silu(gv)); } } }
  __syncthreads();
#undef SLOAD
#undef SWRITE
#undef SWAIT
#undef RESC
}
}

__device__ __forceinline__ void attn_phase(const PV& p, int L, unsigned char* lds) {
    const bf16_t* U = (const bf16_t*)(p.ws + WS_UT); bf16_t* Y = (bf16_t*)(p.ws + WS_Y);
    const int nqb = L / 256, NB = TG / L;
    const int nitem = NB * 8 * nqb;
    for (int it = blockIdx.x; it < nitem; it += gridDim.x) {
        const int qb = it % nqb; const int hq = (it / nqb) & 7; const int b = it / (nqb * 8); const int kvh = hq >> 2;
        const size_t row0 = (size_t)b * L + (size_t)qb * 256;
        att::attn_dense_body(U + row0 * LDU + hq * 128, U + (size_t)b * L * LDU + 1024 + kvh * 128, U + (size_t)b * L * LDU + 1280 + kvh * 128,
                             U + row0 * LDU + 1536 + hq * 128, Y + row0 * DM + hq * 128, L, (char*)lds);
    }
}

__device__ __forceinline__ void run_phase(const Params& pin, int ph, unsigned char* lds) {
    const PV p(pin, opaque_zero());
    if (ph == 0) { if (PHMASK & 1) prologue_phase(p, lds); return; }
    const int q = ph - 1, g = q / 21, r = q % 21;
    const int L = g == 0 ? 2048 : 4096;
    if (r == 0) { if (PHMASK & 2) cvt_phase(p, g); return; }
    const int layer = (r - 1) / 5, sub = (r - 1) % 5, j = layer >> 1;
    bf16_t* XB = (bf16_t*)(p.ws + WS_XB); bf16_t* UT = (bf16_t*)(p.ws + WS_UT); bf16_t* Y = (bf16_t*)(p.ws + WS_Y);
    if (sub == 4) { if (PHMASK & 4) ln_phase(p, g, layer); return; }
    if (sub == 3) {
        const bf16_t* WT = (const bf16_t*)(p.ws + ((layer & 1) ? WS_AWOUT : WS_HWOUT)) + (size_t)j * 1024 * 1024;
        EpiRes E; E.out = p.out + (size_t)g * TG * DM; E.xb = XB; E.last = layer == 3; E.bias = ((layer & 1) ? p.in(21) : p.in(15)) + j * 1024;
        if (PHMASK & 8) run_gemm(lds, Y, WT, TG, 1024, E); return;
    }
    if ((layer & 1) == 0) {
        if (sub == 0) {
            const bf16_t* WT = (const bf16_t*)(p.ws + WS_HWIN) + (size_t)j * 4096 * 1024;
            EpiUT E1; E1.O = UT; E1.bias = p.in(3) + j * 4096; E1.L = L;
            if (PHMASK & 16) run_gemm(lds, WT, XB, 3072, TG, E1);
            EpiBf16B E2; E2.O = (bf16_t*)(p.ws + WS_GATE); E2.ldc = 1024; E2.bias = p.in(3) + j * 4096 + 3072;
            if (PHMASK & 32) run_gemm(lds, XB, WT + (size_t)3072 * 1024, TG, 1024, E2);
        } else if (sub == 1) { if (g == 0) { if (PHMASK & 64) conv_phase<16>(p, j, lds); } else { if (PHMASK & 128) conv_phase<8>(p, j, lds); } }
        else if (sub == 2) { if (PHMASK & 256) ygate_phase(p, L, lds); }
    } else {
        if (sub == 0) {
            const bf16_t* WT = (const bf16_t*)(p.ws + WS_AWIN) + (size_t)j * 2560 * 1024;
            EpiBf16B E; E.O = UT; E.ldc = LDU; E.bias = p.in(17) + j * 2560;
            if (PHMASK & 32) run_gemm(lds, XB, WT, TG, 2560, E);
        } else if (sub == 1) { if (PHMASK & 512) rope_phase(p, j, L); }
        else if (sub == 2) { if (PHMASK & 1024) attn_phase(p, L, lds); }
    }
}

#ifndef DUPMASK
#define DUPMASK 0
#endif
__device__ __forceinline__ bool dup_phase(int ph) {
    if (ph == 0) return (DUPMASK >> 5) & 1;
    const int r = (ph - 1) % 21; if (r == 0) return (DUPMASK >> 5) & 1;
    const int layer = (r - 1) / 5, sub = (r - 1) % 5;
    if (sub > 2) return false;
    if ((layer & 1) == 0) return (DUPMASK >> sub) & 1;
    if (sub == 0) return (DUPMASK >> 3) & 1;
    if (sub == 2) return (DUPMASK >> 4) & 1;
    return false;
}
__global__ __launch_bounds__(512, 2) void mk_forward(Params p) {
    extern __shared__ __attribute__((aligned(16))) unsigned char smem[];
    cg::grid_group grid = cg::this_grid();
    bool dupd = false; (void)dupd;
    for (int ph = p.ph_lo; ph < p.ph_hi; ++ph) {
        run_phase(p, ph, smem);
#if DUPMASK
        if (!dupd && dup_phase(ph)) { dupd = true; --ph; } else dupd = false;
#endif
        if (ph + 1 < p.ph_hi) grid.sync();
    }
}

extern "C" void kernel_launch(void* const* d_in, const int* in_sizes, int n_in, void* d_out, int out_size, void* d_ws, size_t ws_size, hipStream_t stream) {
    static int grid = 0;
    if (grid == 0) {
        if (n_in != 24 || ws_size < WS_END) { fprintf(stderr, "kernel_launch: unexpected n_in %d / ws %zu\n", n_in, ws_size); grid = -1; return; }
        int dev = 0, cus = 0, per_cu = 0;
        hipGetDevice(&dev); hipDeviceGetAttribute(&cus, hipDeviceAttributeMultiprocessorCount, dev);
        if (hipFuncSetAttribute((const void*)mk_forward, hipFuncAttributeMaxDynamicSharedMemorySize, LDS_BYTES) != hipSuccess) { fprintf(stderr, "kernel_launch: hipFuncSetAttribute failed\n"); grid = -1; return; }
        if (hipOccupancyMaxActiveBlocksPerMultiprocessor(&per_cu, (const void*)mk_forward, 512, LDS_BYTES) != hipSuccess || per_cu < 1) { fprintf(stderr, "kernel_launch: occupancy query gives %d\n", per_cu); per_cu = 1; }
        (void)hipGetLastError();
        grid = cus * per_cu;
    }
    if (grid < 0) return;
    Params p{};
    for (int i = 0; i < 24; ++i) p.in[i] = (const float*)d_in[i];
    p.out = (float*)d_out; p.ws = (unsigned char*)d_ws;
#if MK_LAUNCHES == 1
    p.ph_lo = 0; p.ph_hi = NPHASE;
    void* args[] = {&p};
    hipError_t e = hipLaunchCooperativeKernel((const void*)mk_forward, dim3(grid), dim3(512), args, LDS_BYTES, stream);
    if (e != hipSuccess) fprintf(stderr, "cooperative launch failed: %s (grid %d)\n", hipGetErrorString(e), grid);
#else
    for (int ph = 0; ph < NPHASE; ++ph) { p.ph_lo = ph; p.ph_hi = ph + 1;
        hipLaunchKernelGGL(mk_forward, dim3(grid), dim3(512), LDS_BYTES, stream, p); }
#endif
}
```

```cpp
#include <hip/hip_runtime.h>
#include <hip/hip_cooperative_groups.h>
#include <cstdio>
#include <cstdint>
namespace cg = cooperative_groups;

#ifndef MK_LAUNCHES
#define MK_LAUNCHES 1
#endif

__device__ __forceinline__ int tidx() { int t = threadIdx.x; asm volatile("" : "+v"(t)); return t; }

namespace pg8 {
#define PG8_LAS __attribute__((address_space(3)))
typedef unsigned short bf16_t;
typedef short bf16x8 __attribute__((ext_vector_type(8)));
typedef float f32x4 __attribute__((ext_vector_type(4)));
typedef unsigned u32x4 __attribute__((ext_vector_type(4)));
constexpr int BM = 256, BK = 64, HALF = 128, HTB = HALF * BK * 2  , STAGE_BYTES = 8 * HTB, NXCD = 8, WGM = 8;

__host__ __device__ __forceinline__ int lds_byte(int r, int c) { const int st = (r >> 4) * 2 + (c >> 5), rr = r & 15, cc = c & 31, ob = rr * 64 + cc * 2; return st * 1024 + (ob ^ (((ob >> 9) & 1) << 5)); }
__host__ __device__ __forceinline__ void stage_rc(int b, int& R, int& C) { const int st = b / 1024, sb = b % 1024, swz = sb ^ (((sb >> 9) & 1) << 5); R = (st >> 1) * 16 + swz / 64; C = (st & 1) * 32 + (swz % 64) / 2; }
__host__ __device__ __forceinline__ int perm32(int rho) { const int n = rho >> 4, i = rho & 15; return 8 * (i >> 2) + 4 * n + (i & 3); }

struct Unit { int pm, pn; };
struct Gemm { const bf16_t* A; const bf16_t* Bt; int M, N, K; };
struct StaticOrder {
    int nM, nN, nwg, G, c;
    __host__ __device__ void init(int M, int N, int G_, int c_) { nM = M / BM; nN = N / BM; nwg = nM * nN; G = G_; c = c_; }
    __host__ __device__ bool next(int i, Unit& u) const {
        const long L = (long)i * G + c; if (L >= nwg) return false;
        int wgid = (int)L; { const int q = nwg / NXCD, r = nwg % NXCD, xcd = wgid % NXCD, off = wgid / NXCD; wgid = (xcd < r ? xcd * (q + 1) : r * (q + 1) + (xcd - r) * q) + off; }
        const int nig = WGM * nN, gid = wgid / nig, fm = gid * WGM, gsz = (nM - fm) < WGM ? (nM - fm) : WGM;
        u.pm = fm + ((wgid % nig) % gsz); u.pn = (wgid % nig) / gsz; return true;
    }
    __device__ __forceinline__ void a_ready(const Unit&) const {}
    __device__ __forceinline__ void done(const Unit&) const {}
};
__device__ __forceinline__ unsigned cvt_pk_bf16(float lo, float hi) { unsigned r; asm volatile("v_cvt_pk_bf16_f32 %0, %1, %2" : "=v"(r) : "v"(lo), "v"(hi)); return r; }
template <class Epi, class Sched, bool STAMP = false>
__device__ __forceinline__ void gemm_phase(PG8_LAS unsigned char* lds, const Gemm g, const Sched& S, const Epi& E, unsigned long long* stamps) {
    const int tid = tidx(), wid = __builtin_amdgcn_readfirstlane(tid >> 6), lane = tid & 63, wr = wid >> 2, wc = wid & 3, fr = lane & 15, fq = lane >> 4;
    const int K = g.K, nt = K / BK;
    unsigned voffA[2], voffB[2];
#pragma unroll
    for (int i = 0; i < 2; ++i) { int R, C; stage_rc(tid * 16 + i * 8192, R, C); const int Rb = Epi::PERM ? ((R & ~31) + perm32(R & 31)) : R;
        voffA[i] = (unsigned)(R * K + C) * 2u; voffB[i] = (unsigned)(Rb * K + C) * 2u; }
    const size_t kstep = (size_t)(BK * 2);
    const size_t hstep = (size_t)HALF * K * 2;
    const size_t tstep = 2 * hstep;
    const unsigned ldsw = (unsigned)wid * 1024u;
    const int aoff = lds_byte(wr * 64 + fr, fq * 8), boff = lds_byte(wc * 32 + fr, fq * 8);
#define PG8_SA(b, h) (((b) * 2 + (h)) * HTB)
#define PG8_SB(b, h) ((4 + (b) * 2 + (h)) * HTB)
#define PG8_STAGE(bufoff, gbase, voff) do { _Pragma("unroll") for (int _i = 0; _i < 2; ++_i) \
        __builtin_amdgcn_global_load_lds((const unsigned*)((const char*)(gbase) + (voff)[_i]), (PG8_LAS unsigned*)(lds + (bufoff) + ldsw + _i * 8192), 16, 0, 0); } while (0)
#define PG8_LDA(dst, b, h) do { _Pragma("unroll") for (int m = 0; m < 4; ++m) _Pragma("unroll") for (int k = 0; k < 2; ++k) dst[m][k] = *(const PG8_LAS bf16x8*)(lds + PG8_SA(b, h) + aoff + m * 2048 + k * 1024); } while (0)
#define PG8_LDB(dst, b, h) do { _Pragma("unroll") for (int n = 0; n < 2; ++n) _Pragma("unroll") for (int k = 0; k < 2; ++k) dst[n][k] = *(const PG8_LAS bf16x8*)(lds + PG8_SB(b, h) + boff + n * 2048 + k * 1024); } while (0)
#define PG8_MMA(ai, bj, At, Bt) do { __builtin_amdgcn_s_setprio(1); _Pragma("unroll") for (int m = 0; m < 4; ++m) _Pragma("unroll") for (int n = 0; n < 2; ++n) _Pragma("unroll") for (int k = 0; k < 2; ++k) \
        acc[ai][bj][m][n] = __builtin_amdgcn_mfma_f32_16x16x32_bf16(Bt[n][k], At[m][k], acc[ai][bj][m][n], 0, 0, 0); __builtin_amdgcn_s_setprio(0); } while (0)
#define PG8_WAIT_V(n) asm volatile("s_waitcnt vmcnt(" #n ")" ::: "memory")
#define PG8_WAIT_L(n) asm volatile("s_waitcnt lgkmcnt(" #n ")" ::: "memory")
#define PG8_BAR __builtin_amdgcn_s_barrier()
#define PG8_SCHED __builtin_amdgcn_sched_barrier(0)
    Unit cur, nxt; int ui = 0;
    if (!S.next(0, cur)) return;
    f32x4 acc[2][2][4][2];
#pragma unroll
    for (int a = 0; a < 2; ++a)
#pragma unroll
        for (int b = 0; b < 2; ++b)
#pragma unroll
            for (int m = 0; m < 4; ++m)
#pragma unroll
                for (int n = 0; n < 2; ++n) acc[a][b][m][n] = (f32x4){0.f, 0.f, 0.f, 0.f};
    bf16x8 At[4][2], B0[2][2], B1[2][2];
    const char* cA = (const char*)g.A + (size_t)cur.pm * tstep; const char* cB = (const char*)g.Bt + (size_t)cur.pn * tstep;
    S.a_ready(cur);
    PG8_STAGE(PG8_SB(0, 0), cB, voffB); PG8_STAGE(PG8_SA(0, 0), cA, voffA); PG8_STAGE(PG8_SB(0, 1), cB + hstep, voffB); PG8_STAGE(PG8_SA(0, 1), cA + hstep, voffA);
    if (wr == 1) PG8_BAR;
    PG8_WAIT_V(4); PG8_BAR;
    PG8_STAGE(PG8_SB(1, 0), cB + kstep, voffB); PG8_STAGE(PG8_SA(1, 0), cA + kstep, voffA); PG8_STAGE(PG8_SB(1, 1), cB + hstep + kstep, voffB);
    PG8_WAIT_V(6); PG8_BAR;
    for (;;) {
        const bool has_next = S.next(ui + 1, nxt);
        const char* nA = has_next ? (const char*)g.A + (size_t)nxt.pm * tstep : cA; const char* nB = has_next ? (const char*)g.Bt + (size_t)nxt.pn * tstep : cB;
        for (int t = 0; t < nt; t += 2) {
            const bool last = (t == nt - 2);
            const char* a1 = cA + (size_t)(t + 1) * kstep;
            const char* a2 = last ? nA : cA + (size_t)(t + 2) * kstep; const char* b2 = last ? nB : cB + (size_t)(t + 2) * kstep;
            const char* a3 = a2 + kstep; const char* b3 = b2 + kstep;
            if (last && has_next) S.a_ready(nxt);
            PG8_LDB(B0, 0, 0); PG8_SCHED; PG8_LDA(At, 0, 0); PG8_STAGE(PG8_SA(1, 1), a1 + hstep, voffA);
            PG8_WAIT_L(8); PG8_BAR; PG8_WAIT_L(0); PG8_MMA(0, 0, At, B0); PG8_BAR; PG8_SCHED;
            PG8_LDB(B1, 0, 1); PG8_STAGE(PG8_SB(0, 0), b2, voffB);
            PG8_BAR; PG8_WAIT_L(0); PG8_MMA(0, 1, At, B1); PG8_BAR;
            PG8_LDA(At, 0, 1); PG8_STAGE(PG8_SA(0, 0), a2, voffA);
            PG8_BAR; PG8_WAIT_L(0); PG8_MMA(1, 0, At, B0); PG8_BAR; PG8_SCHED;
            PG8_STAGE(PG8_SB(0, 1), b2 + hstep, voffB);
            PG8_WAIT_V(6); PG8_BAR; PG8_MMA(1, 1, At, B1); PG8_BAR;
            PG8_LDB(B0, 1, 0); PG8_SCHED; PG8_LDA(At, 1, 0); PG8_STAGE(PG8_SA(0, 1), a2 + hstep, voffA);
            PG8_WAIT_L(8); PG8_BAR; PG8_WAIT_L(0); PG8_MMA(0, 0, At, B0); PG8_BAR; PG8_SCHED;
            PG8_LDB(B1, 1, 1); PG8_STAGE(PG8_SB(1, 0), b3, voffB);
            PG8_BAR; PG8_WAIT_L(0); PG8_MMA(0, 1, At, B1); PG8_BAR;
            PG8_LDA(At, 1, 1); PG8_STAGE(PG8_SA(1, 0), a3, voffA);
            PG8_BAR; PG8_WAIT_L(0); PG8_MMA(1, 0, At, B0); PG8_BAR; PG8_SCHED;
            PG8_STAGE(PG8_SB(1, 1), b3 + hstep, voffB);
            PG8_WAIT_V(6); PG8_BAR; PG8_MMA(1, 1, At, B1); PG8_BAR;
        }
        if constexpr (!Epi::AFTER_DRAIN) { E(acc, cur, wr, wc, fr, fq); S.done(cur); }
        if (!has_next) break;
#pragma unroll
        for (int a = 0; a < 2; ++a)
#pragma unroll
            for (int b = 0; b < 2; ++b)
#pragma unroll
                for (int m = 0; m < 4; ++m)
#pragma unroll
                    for (int n = 0; n < 2; ++n) acc[a][b][m][n] = (f32x4){0.f, 0.f, 0.f, 0.f};
        cur = nxt; cA = nA; cB = nB; ++ui;
    }
    PG8_WAIT_V(0);
    if (wr == 0) PG8_BAR;
    PG8_BAR;
    if constexpr (Epi::AFTER_DRAIN) { E.fused(acc, cur, wr, wc, fr, fq, lds, wid, lane); S.done(cur); }
#undef PG8_SA
#undef PG8_SB
#undef PG8_STAGE
#undef PG8_LDA
#undef PG8_LDB
#undef PG8_MMA
#undef PG8_WAIT_V
#undef PG8_WAIT_L
#undef PG8_BAR
#undef PG8_SCHED
}
}

using pg8::bf16_t; using pg8::bf16x8; using pg8::f32x4; using pg8::u32x4; using pg8::cvt_pk_bf16;
typedef short s16x4 __attribute__((ext_vector_type(4)));
typedef float f32x8 __attribute__((ext_vector_type(8)));
typedef float f32x16 __attribute__((ext_vector_type(16)));
typedef unsigned u32x2 __attribute__((ext_vector_type(2)));

constexpr int DM = 1024, TG = 32768;
constexpr size_t MiB = 1u << 20;
constexpr size_t WS_HWIN = 0, WS_HWOUT = 16 * MiB, WS_AWIN = 20 * MiB, WS_AWOUT = 30 * MiB, WS_H2 = 34 * MiB, WS_XB = 38 * MiB,
                 WS_UT = 102 * MiB, WS_GATE = 294 * MiB, WS_Y = 358 * MiB, WS_FILT = 422 * MiB, WS_SUMSQ = 454 * MiB, WS_END = 456 * MiB;
constexpr int LDS_BYTES = 136 * 1024;
constexpr float ALPHA = 1.681792830507429f;
constexpr int NPHASE = 1 + 2 * 21;
#ifndef PHMASK
#define PHMASK 0xFFFF
#endif

struct Params { const float* in[24]; float* out; unsigned char* ws; int ph_lo, ph_hi; };
struct PV { const Params& q; int z; float* out; unsigned char* ws;
    __device__ __forceinline__ PV(const Params& q_, int z_) : q(q_), z(z_), out(q_.out + z_), ws(q_.ws + z_) {}
    __device__ __forceinline__ const float* in(int k) const { return q.in[k + z]; } };

__device__ __forceinline__ float bf2f(unsigned short x) { return __uint_as_float(((unsigned)x) << 16); }
__device__ __forceinline__ float bf2f_s(short x) { return __uint_as_float(((unsigned)(unsigned short)x) << 16); }
__device__ __forceinline__ unsigned short f2bf(float x) { return (unsigned short)(cvt_pk_bf16(x, 0.f) & 0xffffu); }
__device__ __forceinline__ float wave_sum(float v) {
#pragma unroll
    for (int o = 32; o >= 1; o >>= 1) v += __shfl_xor(v, o, 64);
    return v;
}
template <class T> __device__ __forceinline__ T* launder(T* q) {
    unsigned long long w = (unsigned long long)q; unsigned lo = (unsigned)w, hi = (unsigned)(w >> 32);
    asm volatile("" : "+v"(lo), "+v"(hi));
    lo = __builtin_amdgcn_readfirstlane(lo); hi = __builtin_amdgcn_readfirstlane(hi);
    return (T*)(((unsigned long long)hi << 32) | lo);
}
__device__ __forceinline__ int opaque_zero() { int z = 0; asm volatile("" : "+v"(z)); return __builtin_amdgcn_readfirstlane(z); }
__device__ __forceinline__ int opaque(int x) { asm volatile("" : "+v"(x)); return x; }
__device__ __forceinline__ float silu(float x) { return x / (1.f + __expf(-x)); }

struct EpiBf16B {
    static constexpr bool PERM = true, AFTER_DRAIN = false;
    bf16_t* O; int ldc; const float* bias;
    __device__ __forceinline__ void operator()(const f32x4 (&acc)[2][2][4][2], const pg8::Unit& u, int wr, int wc, int fr, int fq) const {
        const int row0 = u.pm * 256 + wr * 64 + fr, col0 = u.pn * 256 + wc * 32 + 8 * fq;
        f32x4 bv[2][2];
#pragma unroll
        for (int bj = 0; bj < 2; ++bj)
#pragma unroll
            for (int n = 0; n < 2; ++n) bv[bj][n] = *(const f32x4*)(bias + col0 + bj * 128 + 4 * n);
#pragma unroll
        for (int ai = 0; ai < 2; ++ai)
#pragma unroll
            for (int m = 0; m < 4; ++m) { bf16_t* rowp = O + (size_t)(row0 + ai * 128 + m * 16) * ldc + col0;
#pragma unroll
                for (int bj = 0; bj < 2; ++bj) { f32x4 v0 = acc[ai][bj][m][0] + bv[bj][0], v1 = acc[ai][bj][m][1] + bv[bj][1];
                    u32x4 w; w.x = cvt_pk_bf16(v0[0], v0[1]); w.y = cvt_pk_bf16(v0[2], v0[3]); w.z = cvt_pk_bf16(v1[0], v1[1]); w.w = cvt_pk_bf16(v1[2], v1[3]);
                    *(u32x4*)(rowp + bj * 128) = w; } }
    }
};
struct EpiUT {
    static constexpr bool PERM = true, AFTER_DRAIN = false;
    bf16_t* O; const float* bias; int L;
    __device__ __forceinline__ void operator()(const f32x4 (&acc)[2][2][4][2], const pg8::Unit& u, int wr, int wc, int fr, int fq) const {
        const int row0 = u.pm * 256 + wr * 64 + fr; const int tokt = u.pn * 256; const int b = tokt / L; const int t0 = tokt - b * L + wc * 32 + 8 * fq;
#pragma unroll
        for (int ai = 0; ai < 2; ++ai)
#pragma unroll
            for (int m = 0; m < 4; ++m) { const int ch = row0 + ai * 128 + m * 16; const float bs = bias[ch];
                bf16_t* rowp = O + ((size_t)b * 3072 + ch) * L + t0;
#pragma unroll
                for (int bj = 0; bj < 2; ++bj) { f32x4 v0 = acc[ai][bj][m][0] + bs, v1 = acc[ai][bj][m][1] + bs;
                    u32x4 w; w.x = cvt_pk_bf16(v0[0], v0[1]); w.y = cvt_pk_bf16(v0[2], v0[3]); w.z = cvt_pk_bf16(v1[0], v1[1]); w.w = cvt_pk_bf16(v1[2], v1[3]);
                    *(u32x4*)(rowp + bj * 128) = w; } }
    }
};
struct EpiRes {
    static constexpr bool PERM = true, AFTER_DRAIN = false;
    float* out; bf16_t* xb; const float* bias; int last;
    __device__ __forceinline__ void operator()(const f32x4 (&acc)[2][2][4][2], const pg8::Unit& u, int wr, int wc, int fr, int fq) const {
        const int row0 = u.pm * 256 + wr * 64 + fr, col0 = u.pn * 256 + wc * 32 + 8 * fq;
        f32x4 bv[2][2];
#pragma unroll
        for (int bj = 0; bj < 2; ++bj)
#pragma unroll
            for (int n = 0; n < 2; ++n) bv[bj][n] = *(const f32x4*)(bias + col0 + bj * 128 + 4 * n);
#pragma unroll
        for (int ai = 0; ai < 2; ++ai)
#pragma unroll
            for (int m = 0; m < 4; ++m) { const size_t ro = (size_t)(row0 + ai * 128 + m * 16) * DM + col0;
#pragma unroll
                for (int bj = 0; bj < 2; ++bj) { const bf16x8 xv = *(const bf16x8*)(xb + ro + bj * 128);
                    f32x4 v0, v1;
#pragma unroll
                    for (int e = 0; e < 4; ++e) { v0[e] = bf2f_s(xv[e]) * ALPHA + acc[ai][bj][m][0][e] + bv[bj][0][e]; v1[e] = bf2f_s(xv[4 + e]) * ALPHA + acc[ai][bj][m][1][e] + bv[bj][1][e]; }
                    if (last) { *(f32x4*)(out + ro + bj * 128) = v0; *(f32x4*)(out + ro + bj * 128 + 4) = v1; }
                    else { u32x4 w; w.x = cvt_pk_bf16(v0[0], v0[1]); w.y = cvt_pk_bf16(v0[2], v0[3]); w.z = cvt_pk_bf16(v1[0], v1[1]); w.w = cvt_pk_bf16(v1[2], v1[3]);
                        *(u32x4*)(xb + ro + bj * 128) = w; } } }
    }
};

template <class Epi> __device__ __forceinline__ void run_gemm(unsigned char* lds, const bf16_t* A, const bf16_t* Bt, int M, int N, const Epi& E) {
    pg8::Gemm g; g.A = A; g.Bt = Bt; g.M = M; g.N = N; g.K = DM;
    pg8::StaticOrder S; S.init(M, N, (int)gridDim.x, (int)blockIdx.x);
    pg8::gemm_phase<Epi, pg8::StaticOrder, false>((PG8_LAS unsigned char*)lds, g, S, E, nullptr);
    __syncthreads();
}

__device__ __forceinline__ void transpose_tile(const float* __restrict__ W, bf16_t* __restrict__ WT, int K, int N, int tk, int tn, unsigned char* lds) {
    float* tile = (float*)lds;
    const int tid = tidx();
#pragma unroll
    for (int i = 0; i < 2; ++i) { const int q = tid + i * 512, k = q >> 4, n4 = (q & 15) * 4;
        const f32x4 v = *(const f32x4*)(W + (size_t)(tk * 64 + k) * N + tn * 64 + n4);
        tile[k * 65 + n4 + 0] = v[0]; tile[k * 65 + n4 + 1] = v[1]; tile[k * 65 + n4 + 2] = v[2]; tile[k * 65 + n4 + 3] = v[3]; }
    __syncthreads();
    { const int n = tid >> 3, k8 = (tid & 7) * 8; float v[8];
#pragma unroll
        for (int e = 0; e < 8; ++e) v[e] = tile[(k8 + e) * 65 + n];
        u32x4 w; w.x = cvt_pk_bf16(v[0], v[1]); w.y = cvt_pk_bf16(v[2], v[3]); w.z = cvt_pk_bf16(v[4], v[5]); w.w = cvt_pk_bf16(v[6], v[7]);
        *(u32x4*)(WT + (size_t)(tn * 64 + n) * K + tk * 64 + k8) = w; }
    __syncthreads();
}

__device__ __forceinline__ void prologue_phase(const PV& p, unsigned char* lds) {
    const int total = 2 * 2176;
    for (int it = blockIdx.x; it < total; it += gridDim.x) {
        const int j = it / 2176; int r = it - j * 2176; int kind;
        if (r < 1024) kind = 0; else if (r < 1280) { kind = 1; r -= 1024; } else if (r < 1920) { kind = 2; r -= 1280; } else { kind = 3; r -= 1920; }
        const int N = kind == 0 ? 4096 : (kind == 2 ? 2560 : 1024);
        const int nN = N / 64; const int tk = r / nN, tn = r % nN;
        const float* W = (kind == 0 ? p.in(2) : kind == 1 ? p.in(14) : kind == 2 ? p.in(16) : p.in(20)) + (size_t)j * 1024 * N;
        bf16_t* WT = (bf16_t*)(p.ws + (kind == 0 ? WS_HWIN : kind == 1 ? WS_HWOUT : kind == 2 ? WS_AWIN : WS_AWOUT)) + (size_t)j * 1024 * N;
        transpose_tile(W, WT, 1024, N, tk, tn, lds);
    }
    const int tid_ = tidx(); const int wid = __builtin_amdgcn_readfirstlane(tid_ >> 6), lane = tid_ & 63;
    for (int row = blockIdx.x * 8 + wid; row < 2 * 6144; row += gridDim.x * 8) {
        const int j = row / 6144; int t = row - j * 6144; const int sel = t >= 2048 ? 1 : 0; if (sel) t -= 2048; const int L = sel ? 4096 : 2048;
        const float* w1 = p.in(6) + j * 33 * 64; const float* b1 = p.in(7) + j * 64; const float* fq = p.in(8) + j * 64;
        const float* w2 = p.in(9) + j * 64 * 64; const float* b2 = p.in(10) + j * 64;
        float feat = 0.f;
        if (lane == 0) feat = (float)t / (float)(L - 1);
        else if (lane <= 32) { const int i = (lane - 1) & 15; const double f = 1e-4 + (double)i * ((15.0 - 1e-4) / 15.0);
            double ph = f * (double)t / (double)L; ph -= (double)(long long)ph;
            const float a = (float)(ph * 6.283185307179586);
            feat = lane <= 16 ? cosf(a) : -sinf(a); }
        float s = b1[lane];
        for (int i = 0; i < 33; ++i) s += __shfl(feat, i, 64) * w1[i * 64 + lane];
        const float fr = fq[lane];
        const float h1 = sinf(fr * s);
        float s2 = b2[lane];
        for (int i = 0; i < 64; ++i) s2 += __shfl(h1, i, 64) * w2[i * 64 + lane];
        const float h2 = sinf(fr * s2);
        ((float*)(p.ws + WS_H2))[((size_t)(j * 2 + sel) * 4096 + t) * 64 + lane] = h2;
    }
}

__device__ __forceinline__ void cvt_phase(const PV& p, int g) {
    const float* x = p.in(g); bf16_t* xb = (bf16_t*)(p.ws + WS_XB);
    const size_t n8 = (size_t)TG * DM / 8;
    for (size_t i = (size_t)blockIdx.x * 512 + tidx(); i < n8; i += (size_t)gridDim.x * 512) {
        const f32x4 a = *(const f32x4*)(x + i * 8), b = *(const f32x4*)(x + i * 8 + 4);
        u32x4 w; w.x = cvt_pk_bf16(a[0], a[1]); w.y = cvt_pk_bf16(a[2], a[3]); w.z = cvt_pk_bf16(b[0], b[1]); w.w = cvt_pk_bf16(b[2], b[3]);
        *(u32x4*)(xb + i * 8) = w;
    }
}

__device__ __forceinline__ void ln_phase(const PV& p, int g, int layer) {
    float* x = p.out + (size_t)g * TG * DM; bf16_t* xb = (bf16_t*)(p.ws + WS_XB);
    const float* gam = p.in(22) + layer * DM; const float* bet = p.in(23) + layer * DM;
    const int tid_ = tidx(); const int wid = __builtin_amdgcn_readfirstlane(tid_ >> 6), lane = tid_ & 63;
    const bool last = layer == 3;
    f32x4 gv[4], bv[4];
#pragma unroll
    for (int k = 0; k < 4; ++k) { const int c = (k >> 1) * 512 + lane * 8 + (k & 1) * 4; gv[k] = *(const f32x4*)(gam + c); bv[k] = *(const f32x4*)(bet + c); }
    for (int row = blockIdx.x * 8 + wid; row < TG; row += gridDim.x * 8) {
        f32x4 v[4];
        if (last) {
#pragma unroll
            for (int k = 0; k < 4; ++k) v[k] = *(const f32x4*)(x + (size_t)row * DM + (k >> 1) * 512 + lane * 8 + (k & 1) * 4);
        } else {
#pragma unroll
            for (int hh = 0; hh < 2; ++hh) { const bf16x8 t = *(const bf16x8*)(xb + (size_t)row * DM + hh * 512 + lane * 8);
#pragma unroll
                for (int e = 0; e < 4; ++e) { v[hh * 2][e] = bf2f_s(t[e]); v[hh * 2 + 1][e] = bf2f_s(t[4 + e]); } }
        }
        float s = 0.f;
#pragma unroll
        for (int k = 0; k < 4; ++k) s += v[k][0] + v[k][1] + v[k][2] + v[k][3];
        const float mu = wave_sum(s) * (1.f / DM); float q = 0.f;
#pragma unroll
        for (int k = 0; k < 4; ++k) { v[k] = v[k] - mu; q += v[k][0] * v[k][0] + v[k][1] * v[k][1] + v[k][2] * v[k][2] + v[k][3] * v[k][3]; }
        const float rstd = rsqrtf(wave_sum(q) * (1.f / DM) + 1e-5f);
#pragma unroll
        for (int k = 0; k < 4; ++k) v[k] = v[k] * rstd * gv[k] + bv[k];
        if (last) {
#pragma unroll
            for (int k = 0; k < 4; ++k) *(f32x4*)(x + (size_t)row * DM + (k >> 1) * 512 + lane * 8 + (k & 1) * 4) = v[k];
        } else {
#pragma unroll
            for (int hh = 0; hh < 2; ++hh) { u32x4 w; w.x = cvt_pk_bf16(v[hh * 2][0], v[hh * 2][1]); w.y = cvt_pk_bf16(v[hh * 2][2], v[hh * 2][3]);
                w.z = cvt_pk_bf16(v[hh * 2 + 1][0], v[hh * 2 + 1][1]); w.w = cvt_pk_bf16(v[hh * 2 + 1][2], v[hh * 2 + 1][3]);
                *(u32x4*)(xb + (size_t)row * DM + hh * 512 + lane * 8) = w; }
        }
    }
}


template <int L> __device__ __forceinline__ void filter_phase(const PV& p, int hj, int slot, unsigned char* lds) {
    const int tid = tidx(), wid = __builtin_amdgcn_readfirstlane(tid >> 6), lane = tid & 63;
    const float* h2 = (const float*)(p.ws + WS_H2) + (size_t)(hj * 2 + (L == 2048 ? 0 : 1)) * 4096 * 64;
    const float* w3 = p.in(11) + (size_t)hj * 64 * 4096; const float* decay = p.in(12) + hj * 4096;
    bf16_t* FILT = (bf16_t*)(p.ws + WS_FILT); float* PART = (float*)(p.ws + WS_SUMSQ);
    float* stg = (float*)lds;
    unsigned* tile = (unsigned*)(lds + 65536);
    constexpr int NCH = L / 256;
    for (int it = blockIdx.x; it < 64 * NCH; it += gridDim.x) {
        const int cb = it / NCH, chunk = it - cb * NCH, t0 = chunk * 256;
        const int od = cb >> 4, dir = od & 1, o = od >> 1, col = cb * 64 + lane, c = col & 1023;
        const int tb = t0 + dir;
        __syncthreads();
#pragma unroll
        for (int i = 0; i < 8; ++i) { const int q = tid + 512 * i, rr = q >> 4, c4 = (q & 15) * 4; int tr = tb + rr; tr = tr < L ? tr : L - 1;
            *(f32x4*)(stg + rr * 64 + c4) = *(const f32x4*)(h2 + (size_t)tr * 64 + c4); }
        float w[64];
#pragma unroll
        for (int j = 0; j < 64; ++j) w[j] = w3[(size_t)j * 4096 + col];
        const float dec = fabsf(decay[col]);
        float ss = 0.f;
        if (dir == 1 && t0 == 0 && wid == 0) {
            float d = 0.f;
#pragma unroll
            for (int j = 0; j < 64; ++j) d += h2[j] * w[j];
            ss = d * d; }
        __syncthreads();
        unsigned short* trow = (unsigned short*)(tile + lane * 129);
#pragma unroll 2
        for (int tt = 0; tt < 32; ++tt) {
            const int tl = wid * 32 + tt, t = tb + tl; const f32x4* hr = (const f32x4*)(stg + tl * 64);
            float d = 0.f;
#pragma unroll
            for (int jq = 0; jq < 16; ++jq) { const f32x4 x = hr[jq]; d += x[0] * w[jq * 4] + x[1] * w[jq * 4 + 1] + x[2] * w[jq * 4 + 2] + x[3] * w[jq * 4 + 3]; }
            d *= expf(-(float)t * (1.0f / (float)(L - 1)) * dec);
            if (t >= L) d = 0.f;
            ss += d * d;
            trow[dir ? tl : 255 - tl] = f2bf(d);
        }
        PART[(size_t)col * (NCH * 8) + chunk * 8 + wid] = ss;
        __syncthreads();
        { const int cc = tid >> 3, part = tid & 7; const unsigned* src = tile + cc * 129 + part * 16;
            const int ccol = cb * 64 + cc, c2 = ccol & 1023;
            bf16_t* dst = FILT + ((size_t)(o * 1024 + c2)) * (2 * L) + (dir ? L + t0 : L - 256 - t0) + part * 32;
#pragma unroll
            for (int k = 0; k < 4; ++k) { u32x4 v; v.x = src[k * 4]; v.y = src[k * 4 + 1]; v.z = src[k * 4 + 2]; v.w = src[k * 4 + 3]; *(u32x4*)(dst + k * 8) = v; } }
    }
    __syncthreads();
}

__device__ __forceinline__ bf16x8 lds_a4(const unsigned char* lds, unsigned addr) {
    const unsigned* q = (const unsigned*)(lds + addr); u32x4 w; w.x = q[0]; w.y = q[1]; w.z = q[2]; w.w = q[3]; return *reinterpret_cast<bf16x8*>(&w);
}
template <int NB> struct ConvCfg {
    static constexpr int L = NB == 16 ? 2048 : 4096, ROWE = L + 8, SB = NB == 16 ? 0 : -2048, NT = NB == 16 ? 64 : 192;
    static constexpr int ZOFF = 0, FOFF = 66560, FCOPY = 2 * L * 2, W3OFF = FOFF + 4 * FCOPY, REDOFF = W3OFF + 1024;
};
template <int NB> __device__ __forceinline__ void conv_main(const unsigned char* lds, int o, f32x4 (&acc)[16]) {
    using C = ConvCfg<NB>;
    const int tid_ = tidx(); const int lane = tid_ & 63, wid = __builtin_amdgcn_readfirstlane(tid_ >> 6), r = lane & 15, gq = lane >> 4;
    const int b = NB == 16 ? r : (r & 7), h = NB == 16 ? 0 : (r >> 3);
    const int E0 = (C::L - 1) + C::SB - 256 * wid + 8 * gq - r;
    const int P = E0 & 1;
    unsigned aPtr = (unsigned)(C::FOFF + (o * 2 + P) * C::FCOPY + 2 * (E0 - P));
    const int bBase = C::ZOFF + b * C::ROWE * 2 + 2 * (C::SB + 2048 * h + 8 * gq);
    const int s_lane0 = C::SB + 2048 * h;
    bf16x8 A[16];
#pragma unroll
    for (int i = 0; i < 16; ++i) { A[i] = lds_a4(lds, aPtr - 32 * i); acc[i] = (f32x4){0.f, 0.f, 0.f, 0.f}; }
    auto ldb = [&](int j) -> bf16x8 {
        if (NB == 16) return *(const bf16x8*)(lds + bBase + 64 * j);
        const bool valid = (unsigned)(s_lane0 + 32 * j) < (unsigned)C::L;
        const bf16x8 t = *(const bf16x8*)(lds + (valid ? bBase + 64 * j : C::ZOFF));
        const bf16x8 z = {0, 0, 0, 0, 0, 0, 0, 0}; return valid ? t : z; };
    bf16x8 bnext = ldb(0);
    for (int jo = 0; jo < C::NT / 8; ++jo) {
#pragma unroll
        for (int jj = 0; jj < 8; ++jj) {
            const int j = jo * 8 + jj;
            const bf16x8 bf = bnext;
            bnext = ldb(j + 1 < C::NT ? j + 1 : j);
            acc[15] = __builtin_amdgcn_mfma_f32_16x16x32_bf16(A[(15 - 2 * jj) & 15], bf, acc[15], 0, 0, 0);
            acc[14] = __builtin_amdgcn_mfma_f32_16x16x32_bf16(A[(14 - 2 * jj) & 15], bf, acc[14], 0, 0, 0);
            A[(14 - 2 * jj) & 15] = lds_a4(lds, aPtr + 64 * (jj + 1));
            A[(15 - 2 * jj) & 15] = lds_a4(lds, aPtr + 64 * (jj + 1) - 32);
#pragma unroll
            for (int i = 13; i >= 0; --i) acc[i] = __builtin_amdgcn_mfma_f32_16x16x32_bf16(A[(i - 2 * jj) & 15], bf, acc[i], 0, 0, 0);
            __builtin_amdgcn_sched_barrier(0);
        }
        aPtr += 512;
    }
}
template <int NB> __device__ __forceinline__ void conv_epi(const unsigned char* lds, const f32x4 (&acc)[16], u32x2 (&zp)[16], const bf16_t* UT, int gch,
                                                          float gw0, float gw1, float gw2, float gcb, float fb, float nrm) {
    using C = ConvCfg<NB>;
    const int tid_ = tidx(); const int lane = tid_ & 63, wid = __builtin_amdgcn_readfirstlane(tid_ >> 6), r = lane & 15, gq = lane >> 4;
    const int b = NB == 16 ? r : (r & 7), h = NB == 16 ? 0 : (r >> 3);
    const bf16_t* grow = UT + ((size_t)b * 3072 + gch) * C::L;
#pragma unroll
    for (int i = 0; i < 16; ++i) {
        const int t = 256 * wid + 16 * i + 4 * gq + 2048 * h;
        const s16x4 gu = *(const s16x4*)(grow + t);
        const float gl = t > 0 ? bf2f(grow[t - 1]) : 0.f, gr = (t + 4 < C::L) ? bf2f(grow[t + 4]) : 0.f;
        const float u0 = bf2f_s(gu[0]), u1 = bf2f_s(gu[1]), u2 = bf2f_s(gu[2]), u3 = bf2f_s(gu[3]);
        const float g0 = gw0 * gl + gw1 * u0 + gw2 * u1 + gcb, g1 = gw0 * u0 + gw1 * u1 + gw2 * u2 + gcb;
        const float g2 = gw0 * u1 + gw1 * u2 + gw2 * u3 + gcb, g3 = gw0 * u2 + gw1 * u3 + gw2 * gr + gcb;
        const s16x4 vz = *(const s16x4*)(lds + C::ZOFF + (b * C::ROWE + t) * 2);
        const float z0 = g0 * (acc[i][0] * nrm + bf2f_s(vz[0]) * fb), z1 = g1 * (acc[i][1] * nrm + bf2f_s(vz[1]) * fb);
        const float z2 = g2 * (acc[i][2] * nrm + bf2f_s(vz[2]) * fb), z3 = g3 * (acc[i][3] * nrm + bf2f_s(vz[3]) * fb);
        zp[i].x = cvt_pk_bf16(z0, z1); zp[i].y = cvt_pk_bf16(z2, z3);
    }
}
template <int NB> __device__ __forceinline__ void conv_store_z(unsigned char* lds, const u32x2 (&zp)[16]) {
    using C = ConvCfg<NB>;
    const int tid_ = tidx(); const int lane = tid_ & 63, wid = __builtin_amdgcn_readfirstlane(tid_ >> 6), r = lane & 15, gq = lane >> 4;
    const int b = NB == 16 ? r : (r & 7), h = NB == 16 ? 0 : (r >> 3);
#pragma unroll
    for (int i = 0; i < 16; ++i) { const int t = 256 * wid + 16 * i + 4 * gq + 2048 * h; *(u32x2*)(lds + C::ZOFF + (b * C::ROWE + t) * 2) = zp[i]; }
}

template <int NB> __device__ __forceinline__ void conv_phase(const PV& p, int hj, int slot, unsigned char* lds) {
    using C = ConvCfg<NB>;
    constexpr int L = C::L;
    const int tid = tidx(), wid = __builtin_amdgcn_readfirstlane(tid >> 6), lane = tid & 63;
    bf16_t* UT = (bf16_t*)(p.ws + WS_UT);
    const float* h2 = (const float*)(p.ws + WS_H2) + (size_t)(hj * 2 + (NB == 16 ? 0 : 1)) * 4096 * 64;
    const float* w3 = p.in(11) + (size_t)hj * 64 * 4096; const float* decay = p.in(12) + hj * 4096;
    const float* fbias = p.in(13) + hj * 2048; const float* cw = p.in(4) + hj * 3 * 3072; const float* cb = p.in(5) + hj * 3072;
    float* w3s = (float*)(lds + C::W3OFF); float* red = (float*)(lds + C::REDOFF);
    for (int c = blockIdx.x; c < 1024; c += gridDim.x) {
        __syncthreads();
        { const bf16_t* FILT = (const bf16_t*)(p.ws + WS_FILT);
            for (int q = tid; q < 2 * (2 * L / 8); q += 512) { const int o = q / (2 * L / 8), i8 = (q - o * (2 * L / 8)) * 8;
                *(u32x4*)(lds + C::FOFF + (o * 2) * C::FCOPY + i8 * 2) = *(const u32x4*)(FILT + ((size_t)(o * 1024 + c)) * (2 * L) + i8); } }
        { constexpr int NP = (L / 256) * 8; const float* PART = (const float*)(p.ws + WS_SUMSQ);
            const int o = tid >> 8, idx = tid & 255, dir = idx / NP, k = idx - dir * NP;
            float v = (idx < 2 * NP) ? PART[(size_t)((o * 2 + dir) * 1024 + c) * NP + k] : 0.f;
            v = wave_sum(v); if (lane == 0) red[wid] = v; }
        __syncthreads();
        const float nrm0 = rsqrtf(red[0] + red[1] + red[2] + red[3] + 1e-6f), nrm1 = rsqrtf(red[4] + red[5] + red[6] + red[7] + 1e-6f);
        { const float w0 = cw[c], w1 = cw[3072 + c], w2 = cw[2 * 3072 + c], cbv = cb[c];
            for (int chunk = tid; chunk < NB * L / 8; chunk += 512) { const int b = chunk / (L / 8), s8 = (chunk % (L / 8)) * 8;
                const bf16_t* src = UT + ((size_t)b * 3072 + c) * L + s8;
                const bf16x8 x = *(const bf16x8*)src; float xe[10];
                xe[0] = s8 > 0 ? bf2f(src[-1]) : 0.f; xe[9] = (s8 + 8 < L) ? bf2f(src[8]) : 0.f;
#pragma unroll
                for (int e = 0; e < 8; ++e) xe[e + 1] = bf2f_s(x[e]);
                float y[8];
#pragma unroll
                for (int e = 0; e < 8; ++e) y[e] = w0 * xe[e] + w1 * xe[e + 1] + w2 * xe[e + 2] + cbv;
                u32x4 w; w.x = cvt_pk_bf16(y[0], y[1]); w.y = cvt_pk_bf16(y[2], y[3]); w.z = cvt_pk_bf16(y[4], y[5]); w.w = cvt_pk_bf16(y[6], y[7]);
                *(u32x4*)(lds + C::ZOFF + (b * C::ROWE + s8) * 2) = w; } }
        __syncthreads();
        for (int q = tid; q < 2 * (2 * L / 8); q += 512) { const int o = q / (2 * L / 8), m4 = (q - o * (2 * L / 8)) * 4;
            const unsigned* s0 = (const unsigned*)(lds + C::FOFF + (o * 2) * C::FCOPY) + m4; unsigned* d1 = (unsigned*)(lds + C::FOFF + (o * 2 + 1) * C::FCOPY) + m4;
            const u32x4 a = *(const u32x4*)s0; const unsigned nx = (m4 + 4 < L) ? s0[4] : 0u;
            u32x4 r; r.x = __builtin_amdgcn_alignbit(a.y, a.x, 16); r.y = __builtin_amdgcn_alignbit(a.z, a.y, 16); r.z = __builtin_amdgcn_alignbit(a.w, a.z, 16); r.w = __builtin_amdgcn_alignbit(nx, a.w, 16);
            *(u32x4*)d1 = r; }
        __syncthreads();
        f32x4 acc[16]; u32x2 zp[16];
        conv_main<NB>(lds, 0, acc);
        conv_epi<NB>(lds, acc, zp, UT, 1024 + c, cw[1024 + c], cw[3072 + 1024 + c], cw[2 * 3072 + 1024 + c], cb[1024 + c], fbias[c], nrm0);
        __syncthreads();
        conv_store_z<NB>(lds, zp);
        __syncthreads();
        conv_main<NB>(lds, 1, acc);
        conv_epi<NB>(lds, acc, zp, UT, 2048 + c, cw[2048 + c], cw[3072 + 2048 + c], cw[2 * 3072 + 2048 + c], cb[2048 + c], fbias[1024 + c], nrm1);
        __syncthreads();
        conv_store_z<NB>(lds, zp);
        __syncthreads();
        for (int chunk = tid; chunk < NB * L / 8; chunk += 512) { const int b = chunk / (L / 8), s8 = (chunk % (L / 8)) * 8;
            *(u32x4*)(UT + ((size_t)b * 3072 + c) * L + s8) = *(const u32x4*)(lds + C::ZOFF + (b * C::ROWE + s8) * 2); }
        __syncthreads();
    }
}

__device__ __forceinline__ void ygate_phase(const PV& p, int L, unsigned char* lds) {
    const bf16_t* UT = (const bf16_t*)(p.ws + WS_UT); const bf16_t* G = (const bf16_t*)(p.ws + WS_GATE); bf16_t* Y = (bf16_t*)(p.ws + WS_Y);
    const int tid = tidx(); constexpr int RS = 136;
    bf16_t* tile = (bf16_t*)lds;
    for (int it = blockIdx.x; it < (TG / 128) * 16; it += gridDim.x) {
        const int tc = it & 15, tt = it >> 4; const int tok0 = tt * 128, b = tok0 / L, t0 = tok0 - b * L, c0 = tc * 64;
#pragma unroll
        for (int i = 0; i < 2; ++i) { const int q = tid + i * 512, cc = q >> 4, tch = (q & 15) * 8;
            *(u32x4*)(tile + cc * RS + tch) = *(const u32x4*)(UT + ((size_t)b * 3072 + c0 + cc) * L + t0 + tch); }
        __syncthreads();
#pragma unroll
        for (int i = 0; i < 2; ++i) { const int q = tid + i * 512, t = q >> 3, cch = (q & 7) * 8;
            const bf16x8 gv = *(const bf16x8*)(G + (size_t)(tok0 + t) * DM + c0 + cch); float y[8];
#pragma unroll
            for (int e = 0; e < 8; ++e) y[e] = bf2f(tile[(cch + e) * RS + t]) * silu(bf2f_s(gv[e]));
            u32x4 w; w.x = cvt_pk_bf16(y[0], y[1]); w.y = cvt_pk_bf16(y[2], y[3]); w.z = cvt_pk_bf16(y[4], y[5]); w.w = cvt_pk_bf16(y[6], y[7]);
            *(u32x4*)(Y + (size_t)(tok0 + t) * DM + c0 + cch) = w; }
        __syncthreads();
    }
}

constexpr int LDU = 2560;
__device__ __forceinline__ void rope_phase(const PV& p, int aj, int L) {
    bf16_t* U = (bf16_t*)(p.ws + WS_UT);
    const float* qn = p.in(18) + aj * 128; const float* kn = p.in(19) + aj * 128;
    const int tid = tidx(), sub = tid & 7;
    float inv[8], q1[8], q2[8], k1[8], k2[8];
#pragma unroll
    for (int e = 0; e < 8; ++e) { inv[e] = exp2f(-(float)((8 * sub + e) & 31) * (13.287712379549449f / 32.f));
        q1[e] = qn[8 * sub + e]; q2[e] = qn[64 + 8 * sub + e]; k1[e] = kn[8 * sub + e]; k2[e] = kn[64 + 8 * sub + e]; }
    for (int tok = blockIdx.x * 64 + (tid >> 3); tok < TG; tok += gridDim.x * 64) {
        const int t = tok & (L - 1); const float pos = (float)(sub < 4 ? (t >> 6) : (t & 63));
        float cs[8], sn[8];
#pragma unroll
        for (int e = 0; e < 8; ++e) { const float ang = pos * inv[e]; cs[e] = __cosf(ang); sn[e] = __sinf(ang); }
        bf16_t* u = U + (size_t)tok * LDU + 8 * sub;
#pragma unroll
        for (int hd = 0; hd < 10; ++hd) {
            const bf16x8 a = *(const bf16x8*)(u + hd * 128), bq = *(const bf16x8*)(u + hd * 128 + 64);
            float x1[8], x2[8]; float ss = 0.f;
#pragma unroll
            for (int e = 0; e < 8; ++e) { x1[e] = bf2f_s(a[e]); x2[e] = bf2f_s(bq[e]); ss += x1[e] * x1[e] + x2[e] * x2[e]; }
            ss += __shfl_xor(ss, 1, 64); ss += __shfl_xor(ss, 2, 64); ss += __shfl_xor(ss, 4, 64);
            const float rs = rsqrtf(ss * (1.f / 128.f) + 1e-6f);
            float o1[8], o2[8];
#pragma unroll
            for (int e = 0; e < 8; ++e) { const float xa = x1[e] * rs * (hd < 8 ? q1[e] : k1[e]), xb2 = x2[e] * rs * (hd < 8 ? q2[e] : k2[e]);
                o1[e] = xa * cs[e] - xb2 * sn[e]; o2[e] = xb2 * cs[e] + xa * sn[e]; }
            u32x4 w1, w2; w1.x = cvt_pk_bf16(o1[0], o1[1]); w1.y = cvt_pk_bf16(o1[2], o1[3]); w1.z = cvt_pk_bf16(o1[4], o1[5]); w1.w = cvt_pk_bf16(o1[6], o1[7]);
            w2.x = cvt_pk_bf16(o2[0], o2[1]); w2.y = cvt_pk_bf16(o2[2], o2[3]); w2.z = cvt_pk_bf16(o2[4], o2[5]); w2.w = cvt_pk_bf16(o2[6], o2[7]);
            *(u32x4*)(u + hd * 128) = w1; *(u32x4*)(u + hd * 128 + 64) = w2;
        }
    }
}

namespace att {
constexpr int D = 128, NW = 8, QBLK = 32, KVBLK = 64;
constexpr float SCALE = 0.088388347648318440f;
constexpr float THR = 8.f;
constexpr int LDQ = LDU, LDK = LDU;
constexpr size_t SHM_V = KVBLK * D * 2, SHM_K = KVBLK * D * 2, SHM_ATTN = 2 * SHM_V + 2 * SHM_K + NW * 64 * 4;
#define KSWZ(row, colB) ((row) * 256 + ((colB) ^ (((row) & 7) << 4)))
#define SBAR() __builtin_amdgcn_sched_barrier(0)
__device__ __forceinline__ int crow(int r, int hi) { return (r & 3) + 8 * (r >> 2) + 4 * hi; }
__device__ __forceinline__ unsigned cvtpk(float lo, float hi) { unsigned r; asm volatile("v_cvt_pk_bf16_f32 %0, %1, %2" : "=v"(r) : "v"(lo), "v"(hi)); return r; }
__device__ __forceinline__ bf16x8 ld8(const bf16_t* p) { return *reinterpret_cast<const bf16x8*>(p); }
__device__ __forceinline__ void partialSM(f32x16& p0, f32x16& p1, float& m_reg, float& mn, float& alpha) {
  constexpr float C = SCALE * 1.4426950408889634f;
  float pmax = p0[0]; for (int r = 1; r < 16; ++r) pmax = fmaxf(pmax, p0[r]); for (int r = 0; r < 16; ++r) pmax = fmaxf(pmax, p1[r]);
  { auto rr = __builtin_amdgcn_permlane32_swap(__float_as_uint(pmax), __float_as_uint(pmax), false, false);
    pmax = fmaxf(__uint_as_float(rr[0]), __uint_as_float(rr[1])); }
  if (__builtin_expect(__all(pmax - m_reg <= THR / SCALE), 1)) { mn = m_reg; alpha = 1.f; }
  else { mn = fmaxf(m_reg, pmax); alpha = __builtin_amdgcn_exp2f((m_reg - mn) * C); m_reg = mn; }
  float mnC = -mn * C;
  for (int r = 0; r < 16; ++r) p0[r] = fmaf(p0[r], C, mnC); for (int r = 0; r < 16; ++r) p1[r] = fmaf(p1[r], C, mnC);
  for (int r = 0; r < 16; ++r) p0[r] = __builtin_amdgcn_exp2f(p0[r]);
}
__device__ __forceinline__ void finishSM(f32x16& p0, f32x16& p1, float alpha, float& l_reg, bf16x8& pa0, bf16x8& pa1, bf16x8& pa2, bf16x8& pa3) {
  for (int r = 0; r < 16; ++r) p1[r] = __builtin_amdgcn_exp2f(p1[r]);
  float ps = 0; for (int r = 0; r < 16; ++r) ps += p0[r]; for (int r = 0; r < 16; ++r) ps += p1[r];
  { auto rr = __builtin_amdgcn_permlane32_swap(__float_as_uint(ps), __float_as_uint(ps), false, false);
    ps = __uint_as_float(rr[0]) + __uint_as_float(rr[1]); }
  l_reg = l_reg * alpha + ps;
#define PK4(P, BASE, OUT) do { unsigned a0 = cvtpk(P[BASE + 0], P[BASE + 1]), a1 = cvtpk(P[BASE + 2], P[BASE + 3]);   \
    unsigned b0 = cvtpk(P[BASE + 4], P[BASE + 5]), b1 = cvtpk(P[BASE + 6], P[BASE + 7]);                              \
    auto r0 = __builtin_amdgcn_permlane32_swap(a0, b0, false, false); auto r1 = __builtin_amdgcn_permlane32_swap(a1, b1, false, false); \
    u32x4 w = {r0[0], r1[0], r0[1], r1[1]}; OUT = *reinterpret_cast<bf16x8*>(&w); } while (0)
  PK4(p0, 0, pa0); PK4(p0, 8, pa1); PK4(p1, 0, pa2); PK4(p1, 8, pa3);
#undef PK4
}
__device__ __forceinline__ void qkt(f32x16& p0, f32x16& p1, const bf16_t* Ks, const bf16x8* qr, int r32, int hi) {
  p0 = f32x16{}; p1 = f32x16{};
  for (int d0 = 0; d0 < 8; ++d0) { int cb = (d0 * 16 + hi * 8) * 2;
    bf16x8 b0 = *reinterpret_cast<const bf16x8*>((const char*)Ks + KSWZ(r32, cb));
    bf16x8 b1 = *reinterpret_cast<const bf16x8*>((const char*)Ks + KSWZ(32 + r32, cb));
    p0 = __builtin_amdgcn_mfma_f32_32x32x16_bf16(b0, qr[d0], p0, 0, 0, 0);
    p1 = __builtin_amdgcn_mfma_f32_32x32x16_bf16(b1, qr[d0], p1, 0, 0, 0); }
}
__device__ __forceinline__ int v_st(int k, int c) { const int kk = (k & ~0xC) | ((k & 4) << 1) | ((k & 8) >> 1); return ((kk >> 3) * 4 + (c >> 5)) * 512 + ((kk & 7) * 32 + (c & 31)) * 2; }
__device__ __forceinline__ int v_rd_base(int lane) { return ((lane & 3) << 3) | (((lane >> 2) & 3) << 6) | (((lane >> 4) & 1) << 5) | (((lane >> 5) & 1) << 8); }
constexpr int v_rd_off(int d0, int ks, int half) { return d0 * 512 + ks * 4096 + half * 2048; }
template <int OFF> __device__ __forceinline__ s16x4 tr_read(int vb) {
  s16x4 r; asm volatile("ds_read_b64_tr_b16 %0, %1 offset:%2" : "=&v"(r) : "v"(vb), "i"(OFF) : "memory"); return r;
}
template <int D0> __device__ __forceinline__ void pv_one(f32x16& od, int vb, bf16x8 pa0, bf16x8 pa1, bf16x8 pa2, bf16x8 pa3) {
  const s16x4 l0 = tr_read<v_rd_off(D0, 0, 0)>(vb), h0 = tr_read<v_rd_off(D0, 0, 1)>(vb), l1 = tr_read<v_rd_off(D0, 1, 0)>(vb), h1 = tr_read<v_rd_off(D0, 1, 1)>(vb);
  const s16x4 l2 = tr_read<v_rd_off(D0, 2, 0)>(vb), h2 = tr_read<v_rd_off(D0, 2, 1)>(vb), l3 = tr_read<v_rd_off(D0, 3, 0)>(vb), h3 = tr_read<v_rd_off(D0, 3, 1)>(vb);
  asm volatile("s_waitcnt lgkmcnt(0)" ::: "memory"); SBAR();
#define PK(L, H) (bf16x8){L[0], L[1], L[2], L[3], H[0], H[1], H[2], H[3]}
  od = __builtin_amdgcn_mfma_f32_32x32x16_bf16(pa0, PK(l0, h0), od, 0, 0, 0);
  od = __builtin_amdgcn_mfma_f32_32x32x16_bf16(pa1, PK(l1, h1), od, 0, 0, 0);
  od = __builtin_amdgcn_mfma_f32_32x32x16_bf16(pa2, PK(l2, h2), od, 0, 0, 0);
  od = __builtin_amdgcn_mfma_f32_32x32x16_bf16(pa3, PK(l3, h3), od, 0, 0, 0);
#undef PK
}
__device__ __forceinline__ void pv_d0(f32x16* o, int vb, bf16x8 pa0, bf16x8 pa1, bf16x8 pa2, bf16x8 pa3) {
  pv_one<0>(o[0], vb, pa0, pa1, pa2, pa3); pv_one<1>(o[1], vb, pa0, pa1, pa2, pa3); pv_one<2>(o[2], vb, pa0, pa1, pa2, pa3); pv_one<3>(o[3], vb, pa0, pa1, pa2, pa3);
}
__device__ __forceinline__ void attn_dense_body(const bf16_t* __restrict__ Qb, const bf16_t* __restrict__ Kh, const bf16_t* __restrict__ Vh,
                                                const bf16_t* __restrict__ Gb, bf16_t* __restrict__ Yb, int seq, char* lds) {
  constexpr int SDEPTH = 1;
  const int tid = tidx(), wid = __builtin_amdgcn_readfirstlane(tid >> 6), lane = tid & 63, r32 = lane & 31, hi = lane >> 5;
  bf16_t* V_lds = (bf16_t*)lds; bf16_t* K_lds = (bf16_t*)(lds + 2 * SHM_V);
  float* ws = (float*)(lds + 2 * SHM_V + 2 * SHM_K) + wid * 64; float* li_l = ws; float* al_l = ws + 32;
  float m_reg = -1e30f, l_reg = 0; f32x16 o[4] = {}; bf16x8 qr[8];
  const bf16_t* Qw = Qb + (long)(wid * QBLK + r32) * LDQ + hi * 8;
#pragma unroll
  for (int d0 = 0; d0 < 8; ++d0) qr[d0] = ld8(Qw + d0 * 16);
  const int sr = tid >> 4, sc = (tid & 15) * 8, vst0 = v_st(sr, sc), vst1 = v_st(32 + sr, sc);
  const int vb0 = (int)(uintptr_t)V_lds + v_rd_base(lane);
  struct { bf16x8 vs0, vs1, ks0, ks1; } sr_[SDEPTH];
#define SLOAD(i, k0) do { sr_[i].vs0 = ld8(&Vh[(long)((k0) + sr) * LDK + sc]); sr_[i].vs1 = ld8(&Vh[(long)((k0) + 32 + sr) * LDK + sc]); \
    sr_[i].ks0 = ld8(&Kh[(long)((k0) + sr) * LDK + sc]); sr_[i].ks1 = ld8(&Kh[(long)((k0) + 32 + sr) * LDK + sc]); } while (0)
#define SWRITE(b, i) do { *(bf16x8*)((char*)V_lds + (b) * SHM_V + vst0) = sr_[i].vs0;          \
    *(bf16x8*)((char*)V_lds + (b) * SHM_V + vst1) = sr_[i].vs1; int kc = sc * 2;               \
    *(bf16x8*)((char*)K_lds + (b) * SHM_K + KSWZ(sr, kc)) = sr_[i].ks0;                       \
    *(bf16x8*)((char*)K_lds + (b) * SHM_K + KSWZ(32 + sr, kc)) = sr_[i].ks1; } while (0)
#define SWAIT() do { asm volatile("s_waitcnt vmcnt(0)" ::: "memory"); } while (0)
#define RESC(a) do { if (__any((a) < 1.f)) { if (hi == 0) al_l[r32] = (a); asm volatile("s_waitcnt lgkmcnt(0)" ::: "memory"); \
    for (int d = 0; d < 4; ++d) for (int r = 0; r < 16; ++r) o[d][r] *= al_l[crow(r, hi)]; } } while (0)
  f32x16 pA0, pA1, pB0, pB1; float mnA, mnB, alA, alB; bf16x8 pa0, pa1, pa2, pa3; const int NT = seq / KVBLK;
  constexpr int SE = 0, SO = SDEPTH - 1;
  SLOAD(SE, 0); asm volatile("s_waitcnt vmcnt(0)" ::: "memory"); SWRITE(0, SE); __syncthreads();
  qkt(pA0, pA1, K_lds, qr, r32, hi); partialSM(pA0, pA1, m_reg, mnA, alA);
  SLOAD(SO, KVBLK);
  SWAIT(); SWRITE(1, SO); __syncthreads();
  for (int j = 1; j + 1 < NT; j += 2) {
    SBAR(); qkt(pB0, pB1, (bf16_t*)((char*)K_lds + SHM_K), qr, r32, hi);
    finishSM(pA0, pA1, alA, l_reg, pa0, pa1, pa2, pa3); SBAR();
    SLOAD(SO, (j + SDEPTH) * KVBLK); SBAR();
    pv_d0(o, vb0, pa0, pa1, pa2, pa3); partialSM(pB0, pB1, m_reg, mnB, alB);
    __syncthreads(); SWAIT(); SWRITE(0, SE);
    RESC(alB); __syncthreads();
    SBAR(); qkt(pA0, pA1, K_lds, qr, r32, hi);
    finishSM(pB0, pB1, alB, l_reg, pa0, pa1, pa2, pa3); SBAR();
    SLOAD(SE, (j + 1 + SDEPTH) * KVBLK); SBAR();
    pv_d0(o, vb0 + (int)SHM_V, pa0, pa1, pa2, pa3); partialSM(pA0, pA1, m_reg, mnA, alA);
    __syncthreads(); SWAIT(); SWRITE(1, SO);
    RESC(alA); __syncthreads();
  }
  SBAR(); qkt(pB0, pB1, (bf16_t*)((char*)K_lds + SHM_K), qr, r32, hi);
  finishSM(pA0, pA1, alA, l_reg, pa0, pa1, pa2, pa3); SBAR();
  pv_d0(o, vb0, pa0, pa1, pa2, pa3); partialSM(pB0, pB1, m_reg, mnB, alB);
  __syncthreads(); RESC(alB);
  finishSM(pB0, pB1, alB, l_reg, pa0, pa1, pa2, pa3); SBAR();
  pv_d0(o, vb0 + (int)SHM_V, pa0, pa1, pa2, pa3);
  if (hi == 0) li_l[r32] = l_reg; asm volatile("s_waitcnt lgkmcnt(0)" ::: "memory");
  { const int ln = opaque(lane), r32e = ln & 31, hie = ln >> 5;
    const bf16_t* Gl = Gb + (long)(wid * QBLK + 4 * hie) * LDU + r32e; bf16_t* Yl = Yb + (long)(wid * QBLK + 4 * hie) * DM + r32e;
#pragma unroll
  for (int r = 0; r < 16; ++r) { const int ro = (r & 3) + 8 * (r >> 2); const float rl = __builtin_amdgcn_rcpf(li_l[ro + 4 * hie]);
    asm volatile("" ::: "memory");
#pragma unroll
    for (int d0 = 0; d0 < 4; ++d0) { const float gv = bf2f(Gl[ro * LDU + d0 * 32]);
      Yl[ro * DM + d0 * 32] = f2bf(o[d0][r] * rl * silu(gv)); } } }
  __syncthreads();
#undef SLOAD
#undef SWRITE
#undef SWAIT
#undef RESC
}
}

__device__ __forceinline__ void attn_phase(const PV& p, int L, unsigned char* lds) {
    const bf16_t* U = (const bf16_t*)(p.ws + WS_UT); bf16_t* Y = (bf16_t*)(p.ws + WS_Y);
    const int nqb = L / 256, NB = TG / L;
    const int nitem = NB * 8 * nqb;
    for (int it = blockIdx.x; it < nitem; it += gridDim.x) {
        const int qb = it % nqb; const int hq = (it / nqb) & 7; const int b = it / (nqb * 8); const int kvh = hq >> 2;
        const size_t row0 = (size_t)b * L + (size_t)qb * 256;
        att::attn_dense_body(U + row0 * LDU + hq * 128, U + (size_t)b * L * LDU + 1024 + kvh * 128, U + (size_t)b * L * LDU + 1280 + kvh * 128,
                             U + row0 * LDU + 1536 + hq * 128, Y + row0 * DM + hq * 128, L, (char*)lds);
    }
}

__device__ __forceinline__ void run_phase(const Params& pin, int ph, unsigned char* lds) {
    const PV p(pin, opaque_zero());
    if (ph == 0) { if (PHMASK & 1) prologue_phase(p, lds); return; }
    const int q = ph - 1, g = q / 21, r = q % 21;
    const int L = g == 0 ? 2048 : 4096;
    if (r == 0) { if (PHMASK & 2) cvt_phase(p, g); return; }
    const int layer = (r - 1) / 5, sub = (r - 1) % 5, j = layer >> 1;
    bf16_t* XB = (bf16_t*)(p.ws + WS_XB); bf16_t* UT = (bf16_t*)(p.ws + WS_UT); bf16_t* Y = (bf16_t*)(p.ws + WS_Y);
    if (sub == 4) { if (PHMASK & 4) ln_phase(p, g, layer); return; }
    if (sub == 3) {
        const bf16_t* WT = (const bf16_t*)(p.ws + ((layer & 1) ? WS_AWOUT : WS_HWOUT)) + (size_t)j * 1024 * 1024;
        EpiRes E; E.out = p.out + (size_t)g * TG * DM; E.xb = XB; E.last = layer == 3; E.bias = ((layer & 1) ? p.in(21) : p.in(15)) + j * 1024;
        if (PHMASK & 8) run_gemm(lds, Y, WT, TG, 1024, E); return;
    }
    if ((layer & 1) == 0) {
        if (sub == 0) {
            const bf16_t* WT = (const bf16_t*)(p.ws + WS_HWIN) + (size_t)j * 4096 * 1024;
            EpiUT E1; E1.O = UT; E1.bias = p.in(3) + j * 4096; E1.L = L;
            if (PHMASK & 16) run_gemm(lds, WT, XB, 3072, TG, E1);
            EpiBf16B E2; E2.O = (bf16_t*)(p.ws + WS_GATE); E2.ldc = 1024; E2.bias = p.in(3) + j * 4096 + 3072;
            if (PHMASK & 32) run_gemm(lds, XB, WT + (size_t)3072 * 1024, TG, 1024, E2);
            if (PHMASK & 2048) { if (g == 0) filter_phase<2048>(p, j, g * 2 + j, lds); else filter_phase<4096>(p, j, g * 2 + j, lds); }
        } else if (sub == 1) { if (g == 0) { if (PHMASK & 64) conv_phase<16>(p, j, g * 2 + j, lds); } else { if (PHMASK & 128) conv_phase<8>(p, j, g * 2 + j, lds); } }
        else if (sub == 2) { if (PHMASK & 256) ygate_phase(p, L, lds); }
    } else {
        if (sub == 0) {
            const bf16_t* WT = (const bf16_t*)(p.ws + WS_AWIN) + (size_t)j * 2560 * 1024;
            EpiBf16B E; E.O = UT; E.ldc = LDU; E.bias = p.in(17) + j * 2560;
            if (PHMASK & 32) run_gemm(lds, XB, WT, TG, 2560, E);
        } else if (sub == 1) { if (PHMASK & 512) rope_phase(p, j, L); }
        else if (sub == 2) { if (PHMASK & 1024) attn_phase(p, L, lds); }
    }
}

#ifndef DUPMASK
#define DUPMASK 0
#endif
__device__ __forceinline__ bool dup_phase(int ph) {
    if (ph == 0) return (DUPMASK >> 5) & 1;
    const int r = (ph - 1) % 21; if (r == 0) return (DUPMASK >> 5) & 1;
    const int layer = (r - 1) / 5, sub = (r - 1) % 5;
    if (sub > 2) return false;
    if ((layer & 1) == 0) return (DUPMASK >> sub) & 1;
    if (sub == 0) return (DUPMASK >> 3) & 1;
    if (sub == 2) return (DUPMASK >> 4) & 1;
    return false;
}
__global__ __launch_bounds__(512, 2) void mk_forward(Params p) {
    extern __shared__ __attribute__((aligned(16))) unsigned char smem[];
    cg::grid_group grid = cg::this_grid();
    bool dupd = false; (void)dupd;
    for (int ph = p.ph_lo; ph < p.ph_hi; ++ph) {
        run_phase(p, ph, smem);
#if DUPMASK
        if (!dupd && dup_phase(ph)) { dupd = true; --ph; } else dupd = false;
#endif
        if (ph + 1 < p.ph_hi) grid.sync();
    }
}

extern "C" void kernel_launch(void* const* d_in, const int* in_sizes, int n_in, void* d_out, int out_size, void* d_ws, size_t ws_size, hipStream_t stream) {
    static int grid = 0;
    if (grid == 0) {
        if (n_in != 24 || ws_size < WS_END) { fprintf(stderr, "kernel_launch: unexpected n_in %d / ws %zu\n", n_in, ws_size); grid = -1; return; }
        int dev = 0, cus = 0, per_cu = 0;
        hipGetDevice(&dev); hipDeviceGetAttribute(&cus, hipDeviceAttributeMultiprocessorCount, dev);
        if (hipFuncSetAttribute((const void*)mk_forward, hipFuncAttributeMaxDynamicSharedMemorySize, LDS_BYTES) != hipSuccess) { fprintf(stderr, "kernel_launch: hipFuncSetAttribute failed\n"); grid = -1; return; }
        if (hipOccupancyMaxActiveBlocksPerMultiprocessor(&per_cu, (const void*)mk_forward, 512, LDS_BYTES) != hipSuccess || per_cu < 1) { fprintf(stderr, "kernel_launch: occupancy query gives %d\n", per_cu); per_cu = 1; }
        (void)hipGetLastError();
        grid = cus * per_cu;
    }
    if (grid < 0) return;
    Params p{};
    for (int i = 0; i < 24; ++i) p.in[i] = (const float*)d_in[i];
    p.out = (float*)d_out; p.ws = (unsigned char*)d_ws;
#if MK_LAUNCHES == 1
    p.ph_lo = 0; p.ph_hi = NPHASE;
    void* args[] = {&p};
    hipError_t e = hipLaunchCooperativeKernel((const void*)mk_forward, dim3(grid), dim3(512), args, LDS_BYTES, stream);
    if (e != hipSuccess) fprintf(stderr, "cooperative launch failed: %s (grid %d)\n", hipGetErrorString(e), grid);
#else
    for (int ph = 0; ph < NPHASE; ++ph) { p.ph_lo = ph; p.ph_hi = ph + 1;
        hipLaunchKernelGGL(mk_forward, dim3(grid), dim3(512), LDS_BYTES, stream, p); }
#endif
}
```

```cpp
#include <hip/hip_runtime.h>
#include <hip/hip_cooperative_groups.h>
#include <cstdio>
#include <cstdint>
namespace cg = cooperative_groups;

#ifndef MK_LAUNCHES
#define MK_LAUNCHES 1
#endif

__device__ __forceinline__ int tidx() { int t = threadIdx.x; asm volatile("" : "+v"(t)); return t; }

namespace pg8 {
#define PG8_LAS __attribute__((address_space(3)))
typedef unsigned short bf16_t;
typedef short bf16x8 __attribute__((ext_vector_type(8)));
typedef float f32x4 __attribute__((ext_vector_type(4)));
typedef unsigned u32x4 __attribute__((ext_vector_type(4)));
constexpr int BM = 256, BK = 64, HALF = 128, HTB = HALF * BK * 2  , STAGE_BYTES = 8 * HTB, NXCD = 8, WGM = 8;

__host__ __device__ __forceinline__ int lds_byte(int r, int c) { const int st = (r >> 4) * 2 + (c >> 5), rr = r & 15, cc = c & 31, ob = rr * 64 + cc * 2; return st * 1024 + (ob ^ (((ob >> 9) & 1) << 5)); }
__host__ __device__ __forceinline__ void stage_rc(int b, int& R, int& C) { const int st = b / 1024, sb = b % 1024, swz = sb ^ (((sb >> 9) & 1) << 5); R = (st >> 1) * 16 + swz / 64; C = (st & 1) * 32 + (swz % 64) / 2; }
__host__ __device__ __forceinline__ int perm32(int rho) { const int n = rho >> 4, i = rho & 15; return 8 * (i >> 2) + 4 * n + (i & 3); }

struct Unit { int pm, pn; };
struct Gemm { const bf16_t* A; const bf16_t* Bt; int M, N, K; };
struct StaticOrder {
    int nM, nN, nwg, G, c;
    __host__ __device__ void init(int M, int N, int G_, int c_) { nM = M / BM; nN = N / BM; nwg = nM * nN; G = G_; c = c_; }
    __host__ __device__ bool next(int i, Unit& u) const {
        const long L = (long)i * G + c; if (L >= nwg) return false;
        int wgid = (int)L; { const int q = nwg / NXCD, r = nwg % NXCD, xcd = wgid % NXCD, off = wgid / NXCD; wgid = (xcd < r ? xcd * (q + 1) : r * (q + 1) + (xcd - r) * q) + off; }
        const int nig = WGM * nN, gid = wgid / nig, fm = gid * WGM, gsz = (nM - fm) < WGM ? (nM - fm) : WGM;
        u.pm = fm + ((wgid % nig) % gsz); u.pn = (wgid % nig) / gsz; return true;
    }
    __device__ __forceinline__ void a_ready(const Unit&) const {}
    __device__ __forceinline__ void done(const Unit&) const {}
};
__device__ __forceinline__ unsigned cvt_pk_bf16(float lo, float hi) { unsigned r; asm volatile("v_cvt_pk_bf16_f32 %0, %1, %2" : "=v"(r) : "v"(lo), "v"(hi)); return r; }
template <class Epi, class Sched, bool STAMP = false>
__device__ __forceinline__ void gemm_phase(PG8_LAS unsigned char* lds, const Gemm g, const Sched& S, const Epi& E, unsigned long long* stamps) {
    const int tid = tidx(), wid = __builtin_amdgcn_readfirstlane(tid >> 6), lane = tid & 63, wr = wid >> 2, wc = wid & 3, fr = lane & 15, fq = lane >> 4;
    const int K = g.K, nt = K / BK;
    unsigned voffA[2], voffB[2];
#pragma unroll
    for (int i = 0; i < 2; ++i) { int R, C; stage_rc(tid * 16 + i * 8192, R, C); const int Rb = Epi::PERM ? ((R & ~31) + perm32(R & 31)) : R;
        voffA[i] = (unsigned)(R * K + C) * 2u; voffB[i] = (unsigned)(Rb * K + C) * 2u; }
    const size_t kstep = (size_t)(BK * 2);
    const size_t hstep = (size_t)HALF * K * 2;
    const size_t tstep = 2 * hstep;
    const unsigned ldsw = (unsigned)wid * 1024u;
    const int aoff = lds_byte(wr * 64 + fr, fq * 8), boff = lds_byte(wc * 32 + fr, fq * 8);
#define PG8_SA(b, h) (((b) * 2 + (h)) * HTB)
#define PG8_SB(b, h) ((4 + (b) * 2 + (h)) * HTB)
#define PG8_STAGE(bufoff, gbase, voff) do { _Pragma("unroll") for (int _i = 0; _i < 2; ++_i) \
        __builtin_amdgcn_global_load_lds((const unsigned*)((const char*)(gbase) + (voff)[_i]), (PG8_LAS unsigned*)(lds + (bufoff) + ldsw + _i * 8192), 16, 0, 0); } while (0)
#define PG8_LDA(dst, b, h) do { _Pragma("unroll") for (int m = 0; m < 4; ++m) _Pragma("unroll") for (int k = 0; k < 2; ++k) dst[m][k] = *(const PG8_LAS bf16x8*)(lds + PG8_SA(b, h) + aoff + m * 2048 + k * 1024); } while (0)
#define PG8_LDB(dst, b, h) do { _Pragma("unroll") for (int n = 0; n < 2; ++n) _Pragma("unroll") for (int k = 0; k < 2; ++k) dst[n][k] = *(const PG8_LAS bf16x8*)(lds + PG8_SB(b, h) + boff + n * 2048 + k * 1024); } while (0)
#define PG8_MMA(ai, bj, At, Bt) do { __builtin_amdgcn_s_setprio(1); _Pragma("unroll") for (int m = 0; m < 4; ++m) _Pragma("unroll") for (int n = 0; n < 2; ++n) _Pragma("unroll") for (int k = 0; k < 2; ++k) \
        acc[ai][bj][m][n] = __builtin_amdgcn_mfma_f32_16x16x32_bf16(Bt[n][k], At[m][k], acc[ai][bj][m][n], 0, 0, 0); __builtin_amdgcn_s_setprio(0); } while (0)
#define PG8_WAIT_V(n) asm volatile("s_waitcnt vmcnt(" #n ")" ::: "memory")
#define PG8_WAIT_L(n) asm volatile("s_waitcnt lgkmcnt(" #n ")" ::: "memory")
#define PG8_BAR __builtin_amdgcn_s_barrier()
#define PG8_SCHED __builtin_amdgcn_sched_barrier(0)
    Unit cur, nxt; int ui = 0;
    if (!S.next(0, cur)) return;
    f32x4 acc[2][2][4][2];
#pragma unroll
    for (int a = 0; a < 2; ++a)
#pragma unroll
        for (int b = 0; b < 2; ++b)
#pragma unroll
            for (int m = 0; m < 4; ++m)
#pragma unroll
                for (int n = 0; n < 2; ++n) acc[a][b][m][n] = (f32x4){0.f, 0.f, 0.f, 0.f};
    bf16x8 At[4][2], B0[2][2], B1[2][2];
    const char* cA = (const char*)g.A + (size_t)cur.pm * tstep; const char* cB = (const char*)g.Bt + (size_t)cur.pn * tstep;
    S.a_ready(cur);
    PG8_STAGE(PG8_SB(0, 0), cB, voffB); PG8_STAGE(PG8_SA(0, 0), cA, voffA); PG8_STAGE(PG8_SB(0, 1), cB + hstep, voffB); PG8_STAGE(PG8_SA(0, 1), cA + hstep, voffA);
    if (wr == 1) PG8_BAR;
    PG8_WAIT_V(4); PG8_BAR;
    PG8_STAGE(PG8_SB(1, 0), cB + kstep, voffB); PG8_STAGE(PG8_SA(1, 0), cA + kstep, voffA); PG8_STAGE(PG8_SB(1, 1), cB + hstep + kstep, voffB);
    PG8_WAIT_V(6); PG8_BAR;
    for (;;) {
        const bool has_next = S.next(ui + 1, nxt);
        const char* nA = has_next ? (const char*)g.A + (size_t)nxt.pm * tstep : cA; const char* nB = has_next ? (const char*)g.Bt + (size_t)nxt.pn * tstep : cB;
        for (int t = 0; t < nt; t += 2) {
            const bool last = (t == nt - 2);
            const char* a1 = cA + (size_t)(t + 1) * kstep;
            const char* a2 = last ? nA : cA + (size_t)(t + 2) * kstep; const char* b2 = last ? nB : cB + (size_t)(t + 2) * kstep;
            const char* a3 = a2 + kstep; const char* b3 = b2 + kstep;
            if (last && has_next) S.a_ready(nxt);
            PG8_LDB(B0, 0, 0); PG8_SCHED; PG8_LDA(At, 0, 0); PG8_STAGE(PG8_SA(1, 1), a1 + hstep, voffA);
            PG8_WAIT_L(8); PG8_BAR; PG8_WAIT_L(0); PG8_MMA(0, 0, At, B0); PG8_BAR; PG8_SCHED;
            PG8_LDB(B1, 0, 1); PG8_STAGE(PG8_SB(0, 0), b2, voffB);
            PG8_BAR; PG8_WAIT_L(0); PG8_MMA(0, 1, At, B1); PG8_BAR;
            PG8_LDA(At, 0, 1); PG8_STAGE(PG8_SA(0, 0), a2, voffA);
            PG8_BAR; PG8_WAIT_L(0); PG8_MMA(1, 0, At, B0); PG8_BAR; PG8_SCHED;
            PG8_STAGE(PG8_SB(0, 1), b2 + hstep, voffB);
            PG8_WAIT_V(6); PG8_BAR; PG8_MMA(1, 1, At, B1); PG8_BAR;
            PG8_LDB(B0, 1, 0); PG8_SCHED; PG8_LDA(At, 1, 0); PG8_STAGE(PG8_SA(0, 1), a2 + hstep, voffA);
            PG8_WAIT_L(8); PG8_BAR; PG8_WAIT_L(0); PG8_MMA(0, 0, At, B0); PG8_BAR; PG8_SCHED;
            PG8_LDB(B1, 1, 1); PG8_STAGE(PG8_SB(1, 0), b3, voffB);
            PG8_BAR; PG8_WAIT_L(0); PG8_MMA(0, 1, At, B1); PG8_BAR;
            PG8_LDA(At, 1, 1); PG8_STAGE(PG8_SA(1, 0), a3, voffA);
            PG8_BAR; PG8_WAIT_L(0); PG8_MMA(1, 0, At, B0); PG8_BAR; PG8_SCHED;
            PG8_STAGE(PG8_SB(1, 1), b3 + hstep, voffB);
            PG8_WAIT_V(6); PG8_BAR; PG8_MMA(1, 1, At, B1); PG8_BAR;
        }
        if constexpr (!Epi::AFTER_DRAIN) { E(acc, cur, wr, wc, fr, fq); S.done(cur); }
        if (!has_next) break;
#pragma unroll
        for (int a = 0; a < 2; ++a)
#pragma unroll
            for (int b = 0; b < 2; ++b)
#pragma unroll
                for (int m = 0; m < 4; ++m)
#pragma unroll
                    for (int n = 0; n < 2; ++n) acc[a][b][m][n] = (f32x4){0.f, 0.f, 0.f, 0.f};
        cur = nxt; cA = nA; cB = nB; ++ui;
    }
    PG8_WAIT_V(0);
    if (wr == 0) PG8_BAR;
    PG8_BAR;
    if constexpr (Epi::AFTER_DRAIN) { E.fused(acc, cur, wr, wc, fr, fq, lds, wid, lane); S.done(cur); }
#undef PG8_SA
#undef PG8_SB
#undef PG8_STAGE
#undef PG8_LDA
#undef PG8_LDB
#undef PG8_MMA
#undef PG8_WAIT_V
#undef PG8_WAIT_L
#undef PG8_BAR
#undef PG8_SCHED
}
}

using pg8::bf16_t; using pg8::bf16x8; using pg8::f32x4; using pg8::u32x4; using pg8::cvt_pk_bf16;
typedef short s16x4 __attribute__((ext_vector_type(4)));
typedef float f32x8 __attribute__((ext_vector_type(8)));
typedef float f32x16 __attribute__((ext_vector_type(16)));
typedef unsigned u32x2 __attribute__((ext_vector_type(2)));

constexpr int DM = 1024, TG = 32768;
constexpr size_t MiB = 1u << 20;
constexpr size_t WS_HWIN = 0, WS_HWOUT = 16 * MiB, WS_AWIN = 20 * MiB, WS_AWOUT = 30 * MiB, WS_H2 = 34 * MiB, WS_XB = 38 * MiB,
                 WS_UT = 102 * MiB, WS_GATE = 294 * MiB, WS_Y = 358 * MiB, WS_FILT = 422 * MiB, WS_SUMSQ = 454 * MiB, WS_BAR = 456 * MiB, WS_END = 457 * MiB;
constexpr int LDS_BYTES = 136 * 1024;
constexpr float ALPHA = 1.681792830507429f;
constexpr int NPHASE = 1 + 2 * 21;
#ifndef PHMASK
#define PHMASK 0xFFFF
#endif

struct Params { const float* in[24]; float* out; unsigned char* ws; int ph_lo, ph_hi; };
struct PV { const Params& q; int z; float* out; unsigned char* ws;
    __device__ __forceinline__ PV(const Params& q_, int z_) : q(q_), z(z_), out(q_.out + z_), ws(q_.ws + z_) {}
    __device__ __forceinline__ const float* in(int k) const { return q.in[k + z]; } };

__device__ __forceinline__ float bf2f(unsigned short x) { return __uint_as_float(((unsigned)x) << 16); }
__device__ __forceinline__ float bf2f_s(short x) { return __uint_as_float(((unsigned)(unsigned short)x) << 16); }
__device__ __forceinline__ unsigned short f2bf(float x) { return (unsigned short)(cvt_pk_bf16(x, 0.f) & 0xffffu); }
__device__ __forceinline__ float wave_sum(float v) {
#pragma unroll
    for (int o = 32; o >= 1; o >>= 1) v += __shfl_xor(v, o, 64);
    return v;
}
template <class T> __device__ __forceinline__ T* launder(T* q) {
    unsigned long long w = (unsigned long long)q; unsigned lo = (unsigned)w, hi = (unsigned)(w >> 32);
    asm volatile("" : "+v"(lo), "+v"(hi));
    lo = __builtin_amdgcn_readfirstlane(lo); hi = __builtin_amdgcn_readfirstlane(hi);
    return (T*)(((unsigned long long)hi << 32) | lo);
}
__device__ __forceinline__ int opaque_zero() { int z = 0; asm volatile("" : "+v"(z)); return __builtin_amdgcn_readfirstlane(z); }
__device__ __forceinline__ int opaque(int x) { asm volatile("" : "+v"(x)); return x; }
__device__ __forceinline__ float silu(float x) { return x / (1.f + __expf(-x)); }

struct EpiBf16B {
    static constexpr bool PERM = true, AFTER_DRAIN = false;
    bf16_t* O; int ldc; const float* bias;
    __device__ __forceinline__ void operator()(const f32x4 (&acc)[2][2][4][2], const pg8::Unit& u, int wr, int wc, int fr, int fq) const {
        const int row0 = u.pm * 256 + wr * 64 + fr, col0 = u.pn * 256 + wc * 32 + 8 * fq;
        f32x4 bv[2][2];
#pragma unroll
        for (int bj = 0; bj < 2; ++bj)
#pragma unroll
            for (int n = 0; n < 2; ++n) bv[bj][n] = *(const f32x4*)(bias + col0 + bj * 128 + 4 * n);
#pragma unroll
        for (int ai = 0; ai < 2; ++ai)
#pragma unroll
            for (int m = 0; m < 4; ++m) { bf16_t* rowp = O + (size_t)(row0 + ai * 128 + m * 16) * ldc + col0;
#pragma unroll
                for (int bj = 0; bj < 2; ++bj) { f32x4 v0 = acc[ai][bj][m][0] + bv[bj][0], v1 = acc[ai][bj][m][1] + bv[bj][1];
                    u32x4 w; w.x = cvt_pk_bf16(v0[0], v0[1]); w.y = cvt_pk_bf16(v0[2], v0[3]); w.z = cvt_pk_bf16(v1[0], v1[1]); w.w = cvt_pk_bf16(v1[2], v1[3]);
                    *(u32x4*)(rowp + bj * 128) = w; } }
    }
};
struct EpiUT {
    static constexpr bool PERM = true, AFTER_DRAIN = false;
    bf16_t* O; const float* bias; int L;
    __device__ __forceinline__ void operator()(const f32x4 (&acc)[2][2][4][2], const pg8::Unit& u, int wr, int wc, int fr, int fq) const {
        const int row0 = u.pm * 256 + wr * 64 + fr; const int tokt = u.pn * 256; const int b = tokt / L; const int t0 = tokt - b * L + wc * 32 + 8 * fq;
#pragma unroll
        for (int ai = 0; ai < 2; ++ai)
#pragma unroll
            for (int m = 0; m < 4; ++m) { const int ch = row0 + ai * 128 + m * 16; const float bs = bias[ch];
                bf16_t* rowp = O + ((size_t)b * 3072 + ch) * L + t0;
#pragma unroll
                for (int bj = 0; bj < 2; ++bj) { f32x4 v0 = acc[ai][bj][m][0] + bs, v1 = acc[ai][bj][m][1] + bs;
                    u32x4 w; w.x = cvt_pk_bf16(v0[0], v0[1]); w.y = cvt_pk_bf16(v0[2], v0[3]); w.z = cvt_pk_bf16(v1[0], v1[1]); w.w = cvt_pk_bf16(v1[2], v1[3]);
                    *(u32x4*)(rowp + bj * 128) = w; } }
    }
};
struct EpiRes {
    static constexpr bool PERM = true, AFTER_DRAIN = false;
    float* out; bf16_t* xb; const float* bias; int last;
    __device__ __forceinline__ void operator()(const f32x4 (&acc)[2][2][4][2], const pg8::Unit& u, int wr, int wc, int fr, int fq) const {
        const int row0 = u.pm * 256 + wr * 64 + fr, col0 = u.pn * 256 + wc * 32 + 8 * fq;
        f32x4 bv[2][2];
#pragma unroll
        for (int bj = 0; bj < 2; ++bj)
#pragma unroll
            for (int n = 0; n < 2; ++n) bv[bj][n] = *(const f32x4*)(bias + col0 + bj * 128 + 4 * n);
#pragma unroll
        for (int ai = 0; ai < 2; ++ai)
#pragma unroll
            for (int m = 0; m < 4; ++m) { const size_t ro = (size_t)(row0 + ai * 128 + m * 16) * DM + col0;
#pragma unroll
                for (int bj = 0; bj < 2; ++bj) { const bf16x8 xv = *(const bf16x8*)(xb + ro + bj * 128);
                    f32x4 v0, v1;
#pragma unroll
                    for (int e = 0; e < 4; ++e) { v0[e] = bf2f_s(xv[e]) * ALPHA + acc[ai][bj][m][0][e] + bv[bj][0][e]; v1[e] = bf2f_s(xv[4 + e]) * ALPHA + acc[ai][bj][m][1][e] + bv[bj][1][e]; }
                    if (last) { *(f32x4*)(out + ro + bj * 128) = v0; *(f32x4*)(out + ro + bj * 128 + 4) = v1; }
                    else { u32x4 w; w.x = cvt_pk_bf16(v0[0], v0[1]); w.y = cvt_pk_bf16(v0[2], v0[3]); w.z = cvt_pk_bf16(v1[0], v1[1]); w.w = cvt_pk_bf16(v1[2], v1[3]);
                        *(u32x4*)(xb + ro + bj * 128) = w; } } }
    }
};

template <class Epi> __device__ __forceinline__ void run_gemm(unsigned char* lds, const bf16_t* A, const bf16_t* Bt, int M, int N, const Epi& E) {
    pg8::Gemm g; g.A = A; g.Bt = Bt; g.M = M; g.N = N; g.K = DM;
    pg8::StaticOrder S; S.init(M, N, (int)gridDim.x, (int)blockIdx.x);
    pg8::gemm_phase<Epi, pg8::StaticOrder, false>((PG8_LAS unsigned char*)lds, g, S, E, nullptr);
    __syncthreads();
}

__device__ __forceinline__ void transpose_tile(const float* __restrict__ W, bf16_t* __restrict__ WT, int K, int N, int tk, int tn, unsigned char* lds) {
    float* tile = (float*)lds;
    const int tid = tidx();
#pragma unroll
    for (int i = 0; i < 2; ++i) { const int q = tid + i * 512, k = q >> 4, n4 = (q & 15) * 4;
        const f32x4 v = *(const f32x4*)(W + (size_t)(tk * 64 + k) * N + tn * 64 + n4);
        tile[k * 65 + n4 + 0] = v[0]; tile[k * 65 + n4 + 1] = v[1]; tile[k * 65 + n4 + 2] = v[2]; tile[k * 65 + n4 + 3] = v[3]; }
    __syncthreads();
    { const int n = tid >> 3, k8 = (tid & 7) * 8; float v[8];
#pragma unroll
        for (int e = 0; e < 8; ++e) v[e] = tile[(k8 + e) * 65 + n];
        u32x4 w; w.x = cvt_pk_bf16(v[0], v[1]); w.y = cvt_pk_bf16(v[2], v[3]); w.z = cvt_pk_bf16(v[4], v[5]); w.w = cvt_pk_bf16(v[6], v[7]);
        *(u32x4*)(WT + (size_t)(tn * 64 + n) * K + tk * 64 + k8) = w; }
    __syncthreads();
}

__device__ __forceinline__ void prologue_phase(const PV& p, unsigned char* lds) {
    const int total = 2 * 2176;
    for (int it = blockIdx.x; it < total; it += gridDim.x) {
        const int j = it / 2176; int r = it - j * 2176; int kind;
        if (r < 1024) kind = 0; else if (r < 1280) { kind = 1; r -= 1024; } else if (r < 1920) { kind = 2; r -= 1280; } else { kind = 3; r -= 1920; }
        const int N = kind == 0 ? 4096 : (kind == 2 ? 2560 : 1024);
        const int nN = N / 64; const int tk = r / nN, tn = r % nN;
        const float* W = (kind == 0 ? p.in(2) : kind == 1 ? p.in(14) : kind == 2 ? p.in(16) : p.in(20)) + (size_t)j * 1024 * N;
        bf16_t* WT = (bf16_t*)(p.ws + (kind == 0 ? WS_HWIN : kind == 1 ? WS_HWOUT : kind == 2 ? WS_AWIN : WS_AWOUT)) + (size_t)j * 1024 * N;
        transpose_tile(W, WT, 1024, N, tk, tn, lds);
    }
    const int tid_ = tidx(); const int wid = __builtin_amdgcn_readfirstlane(tid_ >> 6), lane = tid_ & 63;
    for (int row = blockIdx.x * 8 + wid; row < 2 * 6144; row += gridDim.x * 8) {
        const int j = row / 6144; int t = row - j * 6144; const int sel = t >= 2048 ? 1 : 0; if (sel) t -= 2048; const int L = sel ? 4096 : 2048;
        const float* w1 = p.in(6) + j * 33 * 64; const float* b1 = p.in(7) + j * 64; const float* fq = p.in(8) + j * 64;
        const float* w2 = p.in(9) + j * 64 * 64; const float* b2 = p.in(10) + j * 64;
        float feat = 0.f;
        if (lane == 0) feat = (float)t / (float)(L - 1);
        else if (lane <= 32) { const int i = (lane - 1) & 15; const double f = 1e-4 + (double)i * ((15.0 - 1e-4) / 15.0);
            double ph = f * (double)t / (double)L; ph -= (double)(long long)ph;
            const float a = (float)(ph * 6.283185307179586);
            feat = lane <= 16 ? cosf(a) : -sinf(a); }
        float s = b1[lane];
        for (int i = 0; i < 33; ++i) s += __shfl(feat, i, 64) * w1[i * 64 + lane];
        const float fr = fq[lane];
        const float h1 = sinf(fr * s);
        float s2 = b2[lane];
        for (int i = 0; i < 64; ++i) s2 += __shfl(h1, i, 64) * w2[i * 64 + lane];
        const float h2 = sinf(fr * s2);
        ((float*)(p.ws + WS_H2))[((size_t)(j * 2 + sel) * 4096 + t) * 64 + lane] = h2;
    }
}

__device__ __forceinline__ void cvt_phase(const PV& p, int g) {
    const float* x = p.in(g); bf16_t* xb = (bf16_t*)(p.ws + WS_XB);
    const size_t n8 = (size_t)TG * DM / 8;
    for (size_t i = (size_t)blockIdx.x * 512 + tidx(); i < n8; i += (size_t)gridDim.x * 512) {
        const f32x4 a = *(const f32x4*)(x + i * 8), b = *(const f32x4*)(x + i * 8 + 4);
        u32x4 w; w.x = cvt_pk_bf16(a[0], a[1]); w.y = cvt_pk_bf16(a[2], a[3]); w.z = cvt_pk_bf16(b[0], b[1]); w.w = cvt_pk_bf16(b[2], b[3]);
        *(u32x4*)(xb + i * 8) = w;
    }
}

__device__ __forceinline__ void ln_phase(const PV& p, int g, int layer) {
    float* x = p.out + (size_t)g * TG * DM; bf16_t* xb = (bf16_t*)(p.ws + WS_XB);
    const float* gam = p.in(22) + layer * DM; const float* bet = p.in(23) + layer * DM;
    const int tid_ = tidx(); const int wid = __builtin_amdgcn_readfirstlane(tid_ >> 6), lane = tid_ & 63;
    const bool last = layer == 3;
    f32x4 gv[4], bv[4];
#pragma unroll
    for (int k = 0; k < 4; ++k) { const int c = (k >> 1) * 512 + lane * 8 + (k & 1) * 4; gv[k] = *(const f32x4*)(gam + c); bv[k] = *(const f32x4*)(bet + c); }
    for (int row = blockIdx.x * 8 + wid; row < TG; row += gridDim.x * 8) {
        f32x4 v[4];
        if (last) {
#pragma unroll
            for (int k = 0; k < 4; ++k) v[k] = *(const f32x4*)(x + (size_t)row * DM + (k >> 1) * 512 + lane * 8 + (k & 1) * 4);
        } else {
#pragma unroll
            for (int hh = 0; hh < 2; ++hh) { const bf16x8 t = *(const bf16x8*)(xb + (size_t)row * DM + hh * 512 + lane * 8);
#pragma unroll
                for (int e = 0; e < 4; ++e) { v[hh * 2][e] = bf2f_s(t[e]); v[hh * 2 + 1][e] = bf2f_s(t[4 + e]); } }
        }
        float s = 0.f;
#pragma unroll
        for (int k = 0; k < 4; ++k) s += v[k][0] + v[k][1] + v[k][2] + v[k][3];
        const float mu = wave_sum(s) * (1.f / DM); float q = 0.f;
#pragma unroll
        for (int k = 0; k < 4; ++k) { v[k] = v[k] - mu; q += v[k][0] * v[k][0] + v[k][1] * v[k][1] + v[k][2] * v[k][2] + v[k][3] * v[k][3]; }
        const float rstd = rsqrtf(wave_sum(q) * (1.f / DM) + 1e-5f);
#pragma unroll
        for (int k = 0; k < 4; ++k) v[k] = v[k] * rstd * gv[k] + bv[k];
        if (last) {
#pragma unroll
            for (int k = 0; k < 4; ++k) *(f32x4*)(x + (size_t)row * DM + (k >> 1) * 512 + lane * 8 + (k & 1) * 4) = v[k];
        } else {
#pragma unroll
            for (int hh = 0; hh < 2; ++hh) { u32x4 w; w.x = cvt_pk_bf16(v[hh * 2][0], v[hh * 2][1]); w.y = cvt_pk_bf16(v[hh * 2][2], v[hh * 2][3]);
                w.z = cvt_pk_bf16(v[hh * 2 + 1][0], v[hh * 2 + 1][1]); w.w = cvt_pk_bf16(v[hh * 2 + 1][2], v[hh * 2 + 1][3]);
                *(u32x4*)(xb + (size_t)row * DM + hh * 512 + lane * 8) = w; }
        }
    }
}


template <int L> __device__ __forceinline__ void filter_phase(const PV& p, int hj, int slot, unsigned char* lds) {
    const int tid = tidx(), wid = __builtin_amdgcn_readfirstlane(tid >> 6), lane = tid & 63;
    const float* h2 = (const float*)(p.ws + WS_H2) + (size_t)(hj * 2 + (L == 2048 ? 0 : 1)) * 4096 * 64;
    const float* w3 = p.in(11) + (size_t)hj * 64 * 4096; const float* decay = p.in(12) + hj * 4096;
    bf16_t* FILT = (bf16_t*)(p.ws + WS_FILT); float* PART = (float*)(p.ws + WS_SUMSQ);
    float* stg = (float*)lds;
    unsigned* tile = (unsigned*)(lds + 65536);
    constexpr int NCH = L / 256;
    for (int it = blockIdx.x; it < 64 * NCH; it += gridDim.x) {
        const int cb = it / NCH, chunk = it - cb * NCH, t0 = chunk * 256;
        const int od = cb >> 4, dir = od & 1, o = od >> 1, col = cb * 64 + lane, c = col & 1023;
        const int tb = t0 + dir;
        __syncthreads();
#pragma unroll
        for (int i = 0; i < 8; ++i) { const int q = tid + 512 * i, rr = q >> 4, c4 = (q & 15) * 4; int tr = tb + rr; tr = tr < L ? tr : L - 1;
            *(f32x4*)(stg + rr * 64 + c4) = *(const f32x4*)(h2 + (size_t)tr * 64 + c4); }
        float w[64];
#pragma unroll
        for (int j = 0; j < 64; ++j) w[j] = w3[(size_t)j * 4096 + col];
        const float dec = fabsf(decay[col]);
        float ss = 0.f;
        if (dir == 1 && t0 == 0 && wid == 0) {
            float d = 0.f;
#pragma unroll
            for (int j = 0; j < 64; ++j) d += h2[j] * w[j];
            ss = d * d; }
        __syncthreads();
        unsigned short* trow = (unsigned short*)(tile + lane * 129);
#pragma unroll 2
        for (int tt = 0; tt < 32; ++tt) {
            const int tl = wid * 32 + tt, t = tb + tl; const f32x4* hr = (const f32x4*)(stg + tl * 64);
            float d = 0.f;
#pragma unroll
            for (int jq = 0; jq < 16; ++jq) { const f32x4 x = hr[jq]; d += x[0] * w[jq * 4] + x[1] * w[jq * 4 + 1] + x[2] * w[jq * 4 + 2] + x[3] * w[jq * 4 + 3]; }
            d *= expf(-(float)t * (1.0f / (float)(L - 1)) * dec);
            if (t >= L) d = 0.f;
            ss += d * d;
            trow[dir ? tl : 255 - tl] = f2bf(d);
        }
        PART[(size_t)col * (NCH * 8) + chunk * 8 + wid] = ss;
        __syncthreads();
        { const int cc = tid >> 3, part = tid & 7; const unsigned* src = tile + cc * 129 + part * 16;
            const int ccol = cb * 64 + cc, c2 = ccol & 1023;
            bf16_t* dst = FILT + ((size_t)(o * 1024 + c2)) * (2 * L) + (dir ? L + t0 : L - 256 - t0) + part * 32;
#pragma unroll
            for (int k = 0; k < 4; ++k) { u32x4 v; v.x = src[k * 4]; v.y = src[k * 4 + 1]; v.z = src[k * 4 + 2]; v.w = src[k * 4 + 3]; *(u32x4*)(dst + k * 8) = v; } }
    }
    __syncthreads();
}

__device__ __forceinline__ bf16x8 lds_a4(const unsigned char* lds, unsigned addr) {
    const unsigned* q = (const unsigned*)(lds + addr); u32x4 w; w.x = q[0]; w.y = q[1]; w.z = q[2]; w.w = q[3]; return *reinterpret_cast<bf16x8*>(&w);
}
template <int NB> struct ConvCfg {
    static constexpr int L = NB == 16 ? 2048 : 4096, ROWE = L + 8, SB = NB == 16 ? 0 : -2048, NT = NB == 16 ? 64 : 192;
    static constexpr int ZOFF = 0, FOFF = 66560, FCOPY = 2 * L * 2, W3OFF = FOFF + 4 * FCOPY, REDOFF = W3OFF + 1024;
};
template <int NB> __device__ __forceinline__ void conv_main(const unsigned char* lds, int o, f32x4 (&acc)[16]) {
    using C = ConvCfg<NB>;
    const int tid_ = tidx(); const int lane = tid_ & 63, wid = __builtin_amdgcn_readfirstlane(tid_ >> 6), r = lane & 15, gq = lane >> 4;
    const int b = NB == 16 ? r : (r & 7), h = NB == 16 ? 0 : (r >> 3);
    const int E0 = (C::L - 1) + C::SB - 256 * wid + 8 * gq - r;
    const int P = E0 & 1;
    unsigned aPtr = (unsigned)(C::FOFF + (o * 2 + P) * C::FCOPY + 2 * (E0 - P));
    const int bBase = C::ZOFF + b * C::ROWE * 2 + 2 * (C::SB + 2048 * h + 8 * gq);
    const int s_lane0 = C::SB + 2048 * h;
    bf16x8 A[16];
#pragma unroll
    for (int i = 0; i < 16; ++i) { A[i] = lds_a4(lds, aPtr - 32 * i); acc[i] = (f32x4){0.f, 0.f, 0.f, 0.f}; }
    auto ldb = [&](int j) -> bf16x8 {
        if (NB == 16) return *(const bf16x8*)(lds + bBase + 64 * j);
        const bool valid = (unsigned)(s_lane0 + 32 * j) < (unsigned)C::L;
        const bf16x8 t = *(const bf16x8*)(lds + (valid ? bBase + 64 * j : C::ZOFF));
        const bf16x8 z = {0, 0, 0, 0, 0, 0, 0, 0}; return valid ? t : z; };
    bf16x8 bnext = ldb(0);
    for (int jo = 0; jo < C::NT / 8; ++jo) {
#pragma unroll
        for (int jj = 0; jj < 8; ++jj) {
            const int j = jo * 8 + jj;
            const bf16x8 bf = bnext;
            bnext = ldb(j + 1 < C::NT ? j + 1 : j);
            acc[15] = __builtin_amdgcn_mfma_f32_16x16x32_bf16(A[(15 - 2 * jj) & 15], bf, acc[15], 0, 0, 0);
            acc[14] = __builtin_amdgcn_mfma_f32_16x16x32_bf16(A[(14 - 2 * jj) & 15], bf, acc[14], 0, 0, 0);
            A[(14 - 2 * jj) & 15] = lds_a4(lds, aPtr + 64 * (jj + 1));
            A[(15 - 2 * jj) & 15] = lds_a4(lds, aPtr + 64 * (jj + 1) - 32);
#pragma unroll
            for (int i = 13; i >= 0; --i) acc[i] = __builtin_amdgcn_mfma_f32_16x16x32_bf16(A[(i - 2 * jj) & 15], bf, acc[i], 0, 0, 0);
            __builtin_amdgcn_sched_barrier(0);
        }
        aPtr += 512;
    }
}
template <int NB> __device__ __forceinline__ void conv_epi(const unsigned char* lds, const f32x4 (&acc)[16], u32x2 (&zp)[16], const bf16_t* UT, int gch,
                                                          float gw0, float gw1, float gw2, float gcb, float fb, float nrm) {
    using C = ConvCfg<NB>;
    const int tid_ = tidx(); const int lane = tid_ & 63, wid = __builtin_amdgcn_readfirstlane(tid_ >> 6), r = lane & 15, gq = lane >> 4;
    const int b = NB == 16 ? r : (r & 7), h = NB == 16 ? 0 : (r >> 3);
    const bf16_t* grow = UT + ((size_t)b * 3072 + gch) * C::L;
#pragma unroll
    for (int i = 0; i < 16; ++i) {
        const int t = 256 * wid + 16 * i + 4 * gq + 2048 * h;
        const s16x4 gu = *(const s16x4*)(grow + t);
        const float gl = t > 0 ? bf2f(grow[t - 1]) : 0.f, gr = (t + 4 < C::L) ? bf2f(grow[t + 4]) : 0.f;
        const float u0 = bf2f_s(gu[0]), u1 = bf2f_s(gu[1]), u2 = bf2f_s(gu[2]), u3 = bf2f_s(gu[3]);
        const float g0 = gw0 * gl + gw1 * u0 + gw2 * u1 + gcb, g1 = gw0 * u0 + gw1 * u1 + gw2 * u2 + gcb;
        const float g2 = gw0 * u1 + gw1 * u2 + gw2 * u3 + gcb, g3 = gw0 * u2 + gw1 * u3 + gw2 * gr + gcb;
        const s16x4 vz = *(const s16x4*)(lds + C::ZOFF + (b * C::ROWE + t) * 2);
        const float z0 = g0 * (acc[i][0] * nrm + bf2f_s(vz[0]) * fb), z1 = g1 * (acc[i][1] * nrm + bf2f_s(vz[1]) * fb);
        const float z2 = g2 * (acc[i][2] * nrm + bf2f_s(vz[2]) * fb), z3 = g3 * (acc[i][3] * nrm + bf2f_s(vz[3]) * fb);
        zp[i].x = cvt_pk_bf16(z0, z1); zp[i].y = cvt_pk_bf16(z2, z3);
    }
}
template <int NB> __device__ __forceinline__ void conv_store_z(unsigned char* lds, const u32x2 (&zp)[16]) {
    using C = ConvCfg<NB>;
    const int tid_ = tidx(); const int lane = tid_ & 63, wid = __builtin_amdgcn_readfirstlane(tid_ >> 6), r = lane & 15, gq = lane >> 4;
    const int b = NB == 16 ? r : (r & 7), h = NB == 16 ? 0 : (r >> 3);
#pragma unroll
    for (int i = 0; i < 16; ++i) { const int t = 256 * wid + 16 * i + 4 * gq + 2048 * h; *(u32x2*)(lds + C::ZOFF + (b * C::ROWE + t) * 2) = zp[i]; }
}

template <int NB> __device__ __forceinline__ void conv_phase(const PV& p, int hj, int slot, unsigned char* lds) {
    using C = ConvCfg<NB>;
    constexpr int L = C::L;
    const int tid = tidx(), wid = __builtin_amdgcn_readfirstlane(tid >> 6), lane = tid & 63;
    bf16_t* UT = (bf16_t*)(p.ws + WS_UT);
    const float* h2 = (const float*)(p.ws + WS_H2) + (size_t)(hj * 2 + (NB == 16 ? 0 : 1)) * 4096 * 64;
    const float* w3 = p.in(11) + (size_t)hj * 64 * 4096; const float* decay = p.in(12) + hj * 4096;
    const float* fbias = p.in(13) + hj * 2048; const float* cw = p.in(4) + hj * 3 * 3072; const float* cb = p.in(5) + hj * 3072;
    float* w3s = (float*)(lds + C::W3OFF); float* red = (float*)(lds + C::REDOFF);
    for (int c = blockIdx.x; c < 1024; c += gridDim.x) {
        __syncthreads();
        { const bf16_t* FILT = (const bf16_t*)(p.ws + WS_FILT);
            for (int q = tid; q < 2 * (2 * L / 8); q += 512) { const int o = q / (2 * L / 8), i8 = (q - o * (2 * L / 8)) * 8;
                *(u32x4*)(lds + C::FOFF + (o * 2) * C::FCOPY + i8 * 2) = *(const u32x4*)(FILT + ((size_t)(o * 1024 + c)) * (2 * L) + i8); } }
        { constexpr int NP = (L / 256) * 8; const float* PART = (const float*)(p.ws + WS_SUMSQ);
            const int o = tid >> 8, idx = tid & 255, dir = idx / NP, k = idx - dir * NP;
            float v = (idx < 2 * NP) ? PART[(size_t)((o * 2 + dir) * 1024 + c) * NP + k] : 0.f;
            v = wave_sum(v); if (lane == 0) red[wid] = v; }
        __syncthreads();
        const float nrm0 = rsqrtf(red[0] + red[1] + red[2] + red[3] + 1e-6f), nrm1 = rsqrtf(red[4] + red[5] + red[6] + red[7] + 1e-6f);
        { const float w0 = cw[c], w1 = cw[3072 + c], w2 = cw[2 * 3072 + c], cbv = cb[c];
            for (int chunk = tid; chunk < NB * L / 8; chunk += 512) { const int b = chunk / (L / 8), s8 = (chunk % (L / 8)) * 8;
                const bf16_t* src = UT + ((size_t)b * 3072 + c) * L + s8;
                const bf16x8 x = *(const bf16x8*)src; float xe[10];
                xe[0] = s8 > 0 ? bf2f(src[-1]) : 0.f; xe[9] = (s8 + 8 < L) ? bf2f(src[8]) : 0.f;
#pragma unroll
                for (int e = 0; e < 8; ++e) xe[e + 1] = bf2f_s(x[e]);
                float y[8];
#pragma unroll
                for (int e = 0; e < 8; ++e) y[e] = w0 * xe[e] + w1 * xe[e + 1] + w2 * xe[e + 2] + cbv;
                u32x4 w; w.x = cvt_pk_bf16(y[0], y[1]); w.y = cvt_pk_bf16(y[2], y[3]); w.z = cvt_pk_bf16(y[4], y[5]); w.w = cvt_pk_bf16(y[6], y[7]);
                *(u32x4*)(lds + C::ZOFF + (b * C::ROWE + s8) * 2) = w; } }
        __syncthreads();
        for (int q = tid; q < 2 * (2 * L / 8); q += 512) { const int o = q / (2 * L / 8), m4 = (q - o * (2 * L / 8)) * 4;
            const unsigned* s0 = (const unsigned*)(lds + C::FOFF + (o * 2) * C::FCOPY) + m4; unsigned* d1 = (unsigned*)(lds + C::FOFF + (o * 2 + 1) * C::FCOPY) + m4;
            const u32x4 a = *(const u32x4*)s0; const unsigned nx = (m4 + 4 < L) ? s0[4] : 0u;
            u32x4 r; r.x = __builtin_amdgcn_alignbit(a.y, a.x, 16); r.y = __builtin_amdgcn_alignbit(a.z, a.y, 16); r.z = __builtin_amdgcn_alignbit(a.w, a.z, 16); r.w = __builtin_amdgcn_alignbit(nx, a.w, 16);
            *(u32x4*)d1 = r; }
        __syncthreads();
        f32x4 acc[16]; u32x2 zp[16];
        conv_main<NB>(lds, 0, acc);
        conv_epi<NB>(lds, acc, zp, UT, 1024 + c, cw[1024 + c], cw[3072 + 1024 + c], cw[2 * 3072 + 1024 + c], cb[1024 + c], fbias[c], nrm0);
        __syncthreads();
        conv_store_z<NB>(lds, zp);
        __syncthreads();
        conv_main<NB>(lds, 1, acc);
        conv_epi<NB>(lds, acc, zp, UT, 2048 + c, cw[2048 + c], cw[3072 + 2048 + c], cw[2 * 3072 + 2048 + c], cb[2048 + c], fbias[1024 + c], nrm1);
        __syncthreads();
        conv_store_z<NB>(lds, zp);
        __syncthreads();
        for (int chunk = tid; chunk < NB * L / 8; chunk += 512) { const int b = chunk / (L / 8), s8 = (chunk % (L / 8)) * 8;
            *(u32x4*)(UT + ((size_t)b * 3072 + c) * L + s8) = *(const u32x4*)(lds + C::ZOFF + (b * C::ROWE + s8) * 2); }
        __syncthreads();
    }
}

__device__ __forceinline__ void ygate_phase(const PV& p, int L, unsigned char* lds) {
    const bf16_t* UT = (const bf16_t*)(p.ws + WS_UT); const bf16_t* G = (const bf16_t*)(p.ws + WS_GATE); bf16_t* Y = (bf16_t*)(p.ws + WS_Y);
    const int tid = tidx(); constexpr int RS = 136;
    bf16_t* tile = (bf16_t*)lds;
    for (int it = blockIdx.x; it < (TG / 128) * 16; it += gridDim.x) {
        const int tc = it & 15, tt = it >> 4; const int tok0 = tt * 128, b = tok0 / L, t0 = tok0 - b * L, c0 = tc * 64;
#pragma unroll
        for (int i = 0; i < 2; ++i) { const int q = tid + i * 512, cc = q >> 4, tch = (q & 15) * 8;
            *(u32x4*)(tile + cc * RS + tch) = *(const u32x4*)(UT + ((size_t)b * 3072 + c0 + cc) * L + t0 + tch); }
        __syncthreads();
#pragma unroll
        for (int i = 0; i < 2; ++i) { const int q = tid + i * 512, t = q >> 3, cch = (q & 7) * 8;
            const bf16x8 gv = *(const bf16x8*)(G + (size_t)(tok0 + t) * DM + c0 + cch); float y[8];
#pragma unroll
            for (int e = 0; e < 8; ++e) y[e] = bf2f(tile[(cch + e) * RS + t]) * silu(bf2f_s(gv[e]));
            u32x4 w; w.x = cvt_pk_bf16(y[0], y[1]); w.y = cvt_pk_bf16(y[2], y[3]); w.z = cvt_pk_bf16(y[4], y[5]); w.w = cvt_pk_bf16(y[6], y[7]);
            *(u32x4*)(Y + (size_t)(tok0 + t) * DM + c0 + cch) = w; }
        __syncthreads();
    }
}

constexpr int LDU = 2560;
__device__ __forceinline__ void rope_phase(const PV& p, int aj, int L) {
    bf16_t* U = (bf16_t*)(p.ws + WS_UT);
    const float* qn = p.in(18) + aj * 128; const float* kn = p.in(19) + aj * 128;
    const int tid = tidx(), sub = tid & 7;
    float inv[8], q1[8], q2[8], k1[8], k2[8];
#pragma unroll
    for (int e = 0; e < 8; ++e) { inv[e] = exp2f(-(float)((8 * sub + e) & 31) * (13.287712379549449f / 32.f));
        q1[e] = qn[8 * sub + e]; q2[e] = qn[64 + 8 * sub + e]; k1[e] = kn[8 * sub + e]; k2[e] = kn[64 + 8 * sub + e]; }
    for (int tok = blockIdx.x * 64 + (tid >> 3); tok < TG; tok += gridDim.x * 64) {
        const int t = tok & (L - 1); const float pos = (float)(sub < 4 ? (t >> 6) : (t & 63));
        float cs[8], sn[8];
#pragma unroll
        for (int e = 0; e < 8; ++e) { const float ang = pos * inv[e]; cs[e] = __cosf(ang); sn[e] = __sinf(ang); }
        bf16_t* u = U + (size_t)tok * LDU + 8 * sub;
#pragma unroll
        for (int hd = 0; hd < 10; ++hd) {
            const bf16x8 a = *(const bf16x8*)(u + hd * 128), bq = *(const bf16x8*)(u + hd * 128 + 64);
            float x1[8], x2[8]; float ss = 0.f;
#pragma unroll
            for (int e = 0; e < 8; ++e) { x1[e] = bf2f_s(a[e]); x2[e] = bf2f_s(bq[e]); ss += x1[e] * x1[e] + x2[e] * x2[e]; }
            ss += __shfl_xor(ss, 1, 64); ss += __shfl_xor(ss, 2, 64); ss += __shfl_xor(ss, 4, 64);
            const float rs = rsqrtf(ss * (1.f / 128.f) + 1e-6f);
            float o1[8], o2[8];
#pragma unroll
            for (int e = 0; e < 8; ++e) { const float xa = x1[e] * rs * (hd < 8 ? q1[e] : k1[e]), xb2 = x2[e] * rs * (hd < 8 ? q2[e] : k2[e]);
                o1[e] = xa * cs[e] - xb2 * sn[e]; o2[e] = xb2 * cs[e] + xa * sn[e]; }
            u32x4 w1, w2; w1.x = cvt_pk_bf16(o1[0], o1[1]); w1.y = cvt_pk_bf16(o1[2], o1[3]); w1.z = cvt_pk_bf16(o1[4], o1[5]); w1.w = cvt_pk_bf16(o1[6], o1[7]);
            w2.x = cvt_pk_bf16(o2[0], o2[1]); w2.y = cvt_pk_bf16(o2[2], o2[3]); w2.z = cvt_pk_bf16(o2[4], o2[5]); w2.w = cvt_pk_bf16(o2[6], o2[7]);
            *(u32x4*)(u + hd * 128) = w1; *(u32x4*)(u + hd * 128 + 64) = w2;
        }
    }
}

namespace att {
constexpr int D = 128, NW = 8, QBLK = 32, KVBLK = 64;
constexpr float SCALE = 0.088388347648318440f;
constexpr float THR = 8.f;
constexpr int LDQ = LDU, LDK = LDU;
constexpr size_t SHM_V = KVBLK * D * 2, SHM_K = KVBLK * D * 2, SHM_ATTN = 2 * SHM_V + 2 * SHM_K + NW * 64 * 4;
#define KSWZ(row, colB) ((row) * 256 + ((colB) ^ (((row) & 7) << 4)))
#define SBAR() __builtin_amdgcn_sched_barrier(0)
__device__ __forceinline__ int crow(int r, int hi) { return (r & 3) + 8 * (r >> 2) + 4 * hi; }
__device__ __forceinline__ unsigned cvtpk(float lo, float hi) { unsigned r; asm volatile("v_cvt_pk_bf16_f32 %0, %1, %2" : "=v"(r) : "v"(lo), "v"(hi)); return r; }
__device__ __forceinline__ bf16x8 ld8(const bf16_t* p) { return *reinterpret_cast<const bf16x8*>(p); }
__device__ __forceinline__ void partialSM(f32x16& p0, f32x16& p1, float& m_reg, float& mn, float& alpha) {
  constexpr float C = SCALE * 1.4426950408889634f;
  float pmax = p0[0]; for (int r = 1; r < 16; ++r) pmax = fmaxf(pmax, p0[r]); for (int r = 0; r < 16; ++r) pmax = fmaxf(pmax, p1[r]);
  { auto rr = __builtin_amdgcn_permlane32_swap(__float_as_uint(pmax), __float_as_uint(pmax), false, false);
    pmax = fmaxf(__uint_as_float(rr[0]), __uint_as_float(rr[1])); }
  if (__builtin_expect(__all(pmax - m_reg <= THR / SCALE), 1)) { mn = m_reg; alpha = 1.f; }
  else { mn = fmaxf(m_reg, pmax); alpha = __builtin_amdgcn_exp2f((m_reg - mn) * C); m_reg = mn; }
  float mnC = -mn * C;
  for (int r = 0; r < 16; ++r) p0[r] = fmaf(p0[r], C, mnC); for (int r = 0; r < 16; ++r) p1[r] = fmaf(p1[r], C, mnC);
  for (int r = 0; r < 16; ++r) p0[r] = __builtin_amdgcn_exp2f(p0[r]);
}
__device__ __forceinline__ void finishSM(f32x16& p0, f32x16& p1, float alpha, float& l_reg, bf16x8& pa0, bf16x8& pa1, bf16x8& pa2, bf16x8& pa3) {
  for (int r = 0; r < 16; ++r) p1[r] = __builtin_amdgcn_exp2f(p1[r]);
  float ps = 0; for (int r = 0; r < 16; ++r) ps += p0[r]; for (int r = 0; r < 16; ++r) ps += p1[r];
  { auto rr = __builtin_amdgcn_permlane32_swap(__float_as_uint(ps), __float_as_uint(ps), false, false);
    ps = __uint_as_float(rr[0]) + __uint_as_float(rr[1]); }
  l_reg = l_reg * alpha + ps;
#define PK4(P, BASE, OUT) do { unsigned a0 = cvtpk(P[BASE + 0], P[BASE + 1]), a1 = cvtpk(P[BASE + 2], P[BASE + 3]);   \
    unsigned b0 = cvtpk(P[BASE + 4], P[BASE + 5]), b1 = cvtpk(P[BASE + 6], P[BASE + 7]);                              \
    auto r0 = __builtin_amdgcn_permlane32_swap(a0, b0, false, false); auto r1 = __builtin_amdgcn_permlane32_swap(a1, b1, false, false); \
    u32x4 w = {r0[0], r1[0], r0[1], r1[1]}; OUT = *reinterpret_cast<bf16x8*>(&w); } while (0)
  PK4(p0, 0, pa0); PK4(p0, 8, pa1); PK4(p1, 0, pa2); PK4(p1, 8, pa3);
#undef PK4
}
__device__ __forceinline__ void qkt(f32x16& p0, f32x16& p1, const bf16_t* Ks, const bf16x8* qr, int r32, int hi) {
  p0 = f32x16{}; p1 = f32x16{};
  for (int d0 = 0; d0 < 8; ++d0) { int cb = (d0 * 16 + hi * 8) * 2;
    bf16x8 b0 = *reinterpret_cast<const bf16x8*>((const char*)Ks + KSWZ(r32, cb));
    bf16x8 b1 = *reinterpret_cast<const bf16x8*>((const char*)Ks + KSWZ(32 + r32, cb));
    p0 = __builtin_amdgcn_mfma_f32_32x32x16_bf16(b0, qr[d0], p0, 0, 0, 0);
    p1 = __builtin_amdgcn_mfma_f32_32x32x16_bf16(b1, qr[d0], p1, 0, 0, 0); }
}
__device__ __forceinline__ int v_st(int k, int c) { const int kk = (k & ~0xC) | ((k & 4) << 1) | ((k & 8) >> 1); return ((kk >> 3) * 4 + (c >> 5)) * 512 + ((kk & 7) * 32 + (c & 31)) * 2; }
__device__ __forceinline__ int v_rd_base(int lane) { return ((lane & 3) << 3) | (((lane >> 2) & 3) << 6) | (((lane >> 4) & 1) << 5) | (((lane >> 5) & 1) << 8); }
constexpr int v_rd_off(int d0, int ks, int half) { return d0 * 512 + ks * 4096 + half * 2048; }
template <int OFF> __device__ __forceinline__ s16x4 tr_read(int vb) {
  s16x4 r; asm volatile("ds_read_b64_tr_b16 %0, %1 offset:%2" : "=&v"(r) : "v"(vb), "i"(OFF) : "memory"); return r;
}
template <int D0> __device__ __forceinline__ void pv_one(f32x16& od, int vb, bf16x8 pa0, bf16x8 pa1, bf16x8 pa2, bf16x8 pa3) {
  const s16x4 l0 = tr_read<v_rd_off(D0, 0, 0)>(vb), h0 = tr_read<v_rd_off(D0, 0, 1)>(vb), l1 = tr_read<v_rd_off(D0, 1, 0)>(vb), h1 = tr_read<v_rd_off(D0, 1, 1)>(vb);
  const s16x4 l2 = tr_read<v_rd_off(D0, 2, 0)>(vb), h2 = tr_read<v_rd_off(D0, 2, 1)>(vb), l3 = tr_read<v_rd_off(D0, 3, 0)>(vb), h3 = tr_read<v_rd_off(D0, 3, 1)>(vb);
  asm volatile("s_waitcnt lgkmcnt(0)" ::: "memory"); SBAR();
#define PK(L, H) (bf16x8){L[0], L[1], L[2], L[3], H[0], H[1], H[2], H[3]}
  od = __builtin_amdgcn_mfma_f32_32x32x16_bf16(pa0, PK(l0, h0), od, 0, 0, 0);
  od = __builtin_amdgcn_mfma_f32_32x32x16_bf16(pa1, PK(l1, h1), od, 0, 0, 0);
  od = __builtin_amdgcn_mfma_f32_32x32x16_bf16(pa2, PK(l2, h2), od, 0, 0, 0);
  od = __builtin_amdgcn_mfma_f32_32x32x16_bf16(pa3, PK(l3, h3), od, 0, 0, 0);
#undef PK
}
__device__ __forceinline__ void pv_d0(f32x16* o, int vb, bf16x8 pa0, bf16x8 pa1, bf16x8 pa2, bf16x8 pa3) {
  pv_one<0>(o[0], vb, pa0, pa1, pa2, pa3); pv_one<1>(o[1], vb, pa0, pa1, pa2, pa3); pv_one<2>(o[2], vb, pa0, pa1, pa2, pa3); pv_one<3>(o[3], vb, pa0, pa1, pa2, pa3);
}
__device__ __forceinline__ void attn_dense_body(const bf16_t* __restrict__ Qb, const bf16_t* __restrict__ Kh, const bf16_t* __restrict__ Vh,
                                                const bf16_t* __restrict__ Gb, bf16_t* __restrict__ Yb, int seq, char* lds) {
  constexpr int SDEPTH = 1;
  const int tid = tidx(), wid = __builtin_amdgcn_readfirstlane(tid >> 6), lane = tid & 63, r32 = lane & 31, hi = lane >> 5;
  bf16_t* V_lds = (bf16_t*)lds; bf16_t* K_lds = (bf16_t*)(lds + 2 * SHM_V);
  float* ws = (float*)(lds + 2 * SHM_V + 2 * SHM_K) + wid * 64; float* li_l = ws; float* al_l = ws + 32;
  float m_reg = -1e30f, l_reg = 0; f32x16 o[4] = {}; bf16x8 qr[8];
  const bf16_t* Qw = Qb + (long)(wid * QBLK + r32) * LDQ + hi * 8;
#pragma unroll
  for (int d0 = 0; d0 < 8; ++d0) qr[d0] = ld8(Qw + d0 * 16);
  const int sr = tid >> 4, sc = (tid & 15) * 8, vst0 = v_st(sr, sc), vst1 = v_st(32 + sr, sc);
  const int vb0 = (int)(uintptr_t)V_lds + v_rd_base(lane);
  struct { bf16x8 vs0, vs1, ks0, ks1; } sr_[SDEPTH];
#define SLOAD(i, k0) do { sr_[i].vs0 = ld8(&Vh[(long)((k0) + sr) * LDK + sc]); sr_[i].vs1 = ld8(&Vh[(long)((k0) + 32 + sr) * LDK + sc]); \
    sr_[i].ks0 = ld8(&Kh[(long)((k0) + sr) * LDK + sc]); sr_[i].ks1 = ld8(&Kh[(long)((k0) + 32 + sr) * LDK + sc]); } while (0)
#define SWRITE(b, i) do { *(bf16x8*)((char*)V_lds + (b) * SHM_V + vst0) = sr_[i].vs0;          \
    *(bf16x8*)((char*)V_lds + (b) * SHM_V + vst1) = sr_[i].vs1; int kc = sc * 2;               \
    *(bf16x8*)((char*)K_lds + (b) * SHM_K + KSWZ(sr, kc)) = sr_[i].ks0;                       \
    *(bf16x8*)((char*)K_lds + (b) * SHM_K + KSWZ(32 + sr, kc)) = sr_[i].ks1; } while (0)
#define SWAIT() do { asm volatile("s_waitcnt vmcnt(0)" ::: "memory"); } while (0)
#define RESC(a) do { if (__any((a) < 1.f)) { if (hi == 0) al_l[r32] = (a); asm volatile("s_waitcnt lgkmcnt(0)" ::: "memory"); \
    for (int d = 0; d < 4; ++d) for (int r = 0; r < 16; ++r) o[d][r] *= al_l[crow(r, hi)]; } } while (0)
  f32x16 pA0, pA1, pB0, pB1; float mnA, mnB, alA, alB; bf16x8 pa0, pa1, pa2, pa3; const int NT = seq / KVBLK;
  constexpr int SE = 0, SO = SDEPTH - 1;
  SLOAD(SE, 0); asm volatile("s_waitcnt vmcnt(0)" ::: "memory"); SWRITE(0, SE); __syncthreads();
  qkt(pA0, pA1, K_lds, qr, r32, hi); partialSM(pA0, pA1, m_reg, mnA, alA);
  SLOAD(SO, KVBLK);
  SWAIT(); SWRITE(1, SO); __syncthreads();
  for (int j = 1; j + 1 < NT; j += 2) {
    SBAR(); qkt(pB0, pB1, (bf16_t*)((char*)K_lds + SHM_K), qr, r32, hi);
    finishSM(pA0, pA1, alA, l_reg, pa0, pa1, pa2, pa3); SBAR();
    SLOAD(SO, (j + SDEPTH) * KVBLK); SBAR();
    pv_d0(o, vb0, pa0, pa1, pa2, pa3); partialSM(pB0, pB1, m_reg, mnB, alB);
    __syncthreads(); SWAIT(); SWRITE(0, SE);
    RESC(alB); __syncthreads();
    SBAR(); qkt(pA0, pA1, K_lds, qr, r32, hi);
    finishSM(pB0, pB1, alB, l_reg, pa0, pa1, pa2, pa3); SBAR();
    SLOAD(SE, (j + 1 + SDEPTH) * KVBLK); SBAR();
    pv_d0(o, vb0 + (int)SHM_V, pa0, pa1, pa2, pa3); partialSM(pA0, pA1, m_reg, mnA, alA);
    __syncthreads(); SWAIT(); SWRITE(1, SO);
    RESC(alA); __syncthreads();
  }
  SBAR(); qkt(pB0, pB1, (bf16_t*)((char*)K_lds + SHM_K), qr, r32, hi);
  finishSM(pA0, pA1, alA, l_reg, pa0, pa1, pa2, pa3); SBAR();
  pv_d0(o, vb0, pa0, pa1, pa2, pa3); partialSM(pB0, pB1, m_reg, mnB, alB);
  __syncthreads(); RESC(alB);
  finishSM(pB0, pB1, alB, l_reg, pa0, pa1, pa2, pa3); SBAR();
  pv_d0(o, vb0 + (int)SHM_V, pa0, pa1, pa2, pa3);
  if (hi == 0) li_l[r32] = l_reg; asm volatile("s_waitcnt lgkmcnt(0)" ::: "memory");
  { const int ln = opaque(lane), r32e = ln & 31, hie = ln >> 5;
    const bf16_t* Gl = Gb + (long)(wid * QBLK + 4 * hie) * LDU + r32e; bf16_t* Yl = Yb + (long)(wid * QBLK + 4 * hie) * DM + r32e;
#pragma unroll
  for (int r = 0; r < 16; ++r) { const int ro = (r & 3) + 8 * (r >> 2); const float rl = __builtin_amdgcn_rcpf(li_l[ro + 4 * hie]);
    asm volatile("" ::: "memory");
#pragma unroll
    for (int d0 = 0; d0 < 4; ++d0) { const float gv = bf2f(Gl[ro * LDU + d0 * 32]);
      Yl[ro * DM + d0 * 32] = f2bf(o[d0][r] * rl * silu(gv)); } } }
  __syncthreads();
#undef SLOAD
#undef SWRITE
#undef SWAIT
#undef RESC
}
}

__device__ __forceinline__ void attn_phase(const PV& p, int L, unsigned char* lds) {
    const bf16_t* U = (const bf16_t*)(p.ws + WS_UT); bf16_t* Y = (bf16_t*)(p.ws + WS_Y);
    const int nqb = L / 256, NB = TG / L;
    const int nitem = NB * 8 * nqb;
    for (int it = blockIdx.x; it < nitem; it += gridDim.x) {
        const int qb = it % nqb; const int hq = (it / nqb) & 7; const int b = it / (nqb * 8); const int kvh = hq >> 2;
        const size_t row0 = (size_t)b * L + (size_t)qb * 256;
        att::attn_dense_body(U + row0 * LDU + hq * 128, U + (size_t)b * L * LDU + 1024 + kvh * 128, U + (size_t)b * L * LDU + 1280 + kvh * 128,
                             U + row0 * LDU + 1536 + hq * 128, Y + row0 * DM + hq * 128, L, (char*)lds);
    }
}

__device__ __forceinline__ void run_phase(const Params& pin, int ph, unsigned char* lds) {
    const PV p(pin, opaque_zero());
    if (ph == 0) { if (PHMASK & 1) prologue_phase(p, lds); return; }
    const int q = ph - 1, g = q / 21, r = q % 21;
    const int L = g == 0 ? 2048 : 4096;
    if (r == 0) { if (PHMASK & 2) cvt_phase(p, g); return; }
    const int layer = (r - 1) / 5, sub = (r - 1) % 5, j = layer >> 1;
    bf16_t* XB = (bf16_t*)(p.ws + WS_XB); bf16_t* UT = (bf16_t*)(p.ws + WS_UT); bf16_t* Y = (bf16_t*)(p.ws + WS_Y);
    if (sub == 4) { if (PHMASK & 4) ln_phase(p, g, layer); return; }
    if (sub == 3) {
        const bf16_t* WT = (const bf16_t*)(p.ws + ((layer & 1) ? WS_AWOUT : WS_HWOUT)) + (size_t)j * 1024 * 1024;
        EpiRes E; E.out = p.out + (size_t)g * TG * DM; E.xb = XB; E.last = layer == 3; E.bias = ((layer & 1) ? p.in(21) : p.in(15)) + j * 1024;
        if (PHMASK & 8) run_gemm(lds, Y, WT, TG, 1024, E); return;
    }
    if ((layer & 1) == 0) {
        if (sub == 0) {
            const bf16_t* WT = (const bf16_t*)(p.ws + WS_HWIN) + (size_t)j * 4096 * 1024;
            EpiUT E1; E1.O = UT; E1.bias = p.in(3) + j * 4096; E1.L = L;
            if (PHMASK & 16) run_gemm(lds, WT, XB, 3072, TG, E1);
            EpiBf16B E2; E2.O = (bf16_t*)(p.ws + WS_GATE); E2.ldc = 1024; E2.bias = p.in(3) + j * 4096 + 3072;
            if (PHMASK & 32) run_gemm(lds, XB, WT + (size_t)3072 * 1024, TG, 1024, E2);
            if (PHMASK & 2048) { if (g == 0) filter_phase<2048>(p, j, g * 2 + j, lds); else filter_phase<4096>(p, j, g * 2 + j, lds); }
        } else if (sub == 1) { if (g == 0) { if (PHMASK & 64) conv_phase<16>(p, j, g * 2 + j, lds); } else { if (PHMASK & 128) conv_phase<8>(p, j, g * 2 + j, lds); } }
        else if (sub == 2) { if (PHMASK & 256) ygate_phase(p, L, lds); }
    } else {
        if (sub == 0) {
            const bf16_t* WT = (const bf16_t*)(p.ws + WS_AWIN) + (size_t)j * 2560 * 1024;
            EpiBf16B E; E.O = UT; E.ldc = LDU; E.bias = p.in(17) + j * 2560;
            if (PHMASK & 32) run_gemm(lds, XB, WT, TG, 2560, E);
        } else if (sub == 1) { if (PHMASK & 512) rope_phase(p, j, L); }
        else if (sub == 2) { if (PHMASK & 1024) attn_phase(p, L, lds); }
    }
}

#ifndef DUPMASK
#define DUPMASK 0
#endif
__device__ __forceinline__ bool dup_phase(int ph) {
    if (ph == 0) return (DUPMASK >> 5) & 1;
    const int r = (ph - 1) % 21; if (r == 0) return (DUPMASK >> 5) & 1;
    const int layer = (r - 1) / 5, sub = (r - 1) % 5;
    if (sub > 2) return false;
    if ((layer & 1) == 0) return (DUPMASK >> sub) & 1;
    if (sub == 0) return (DUPMASK >> 3) & 1;
    if (sub == 2) return (DUPMASK >> 4) & 1;
    return false;
}
__device__ __forceinline__ void grid_barrier(unsigned* ctr, unsigned target) {
    asm volatile("s_waitcnt vmcnt(0)" ::: "memory");
    __syncthreads();
    if (tidx() == 0) {
        __builtin_amdgcn_fence(__ATOMIC_RELEASE, "agent");
        asm volatile("s_waitcnt vmcnt(0)" ::: "memory");
        (void)__hip_atomic_fetch_add(ctr, 1u, __ATOMIC_RELAXED, __HIP_MEMORY_SCOPE_AGENT);
        while (__hip_atomic_load(ctr, __ATOMIC_RELAXED, __HIP_MEMORY_SCOPE_AGENT) < target) __builtin_amdgcn_s_sleep(1);
        __builtin_amdgcn_fence(__ATOMIC_ACQUIRE, "agent");
        asm volatile("s_waitcnt vmcnt(0)" ::: "memory");
    }
    __syncthreads();
}

__global__ __launch_bounds__(512, 2) void mk_forward(Params p) {
    extern __shared__ __attribute__((aligned(16))) unsigned char smem[];
    cg::grid_group grid = cg::this_grid();
    unsigned* bar = (unsigned*)(p.ws + WS_BAR);
    unsigned nbar = 0;
    for (int ph = p.ph_lo; ph < p.ph_hi; ++ph) {
        if (ph == 0 && blockIdx.x == 0 && threadIdx.x == 0) __hip_atomic_store(bar, 0u, __ATOMIC_RELAXED, __HIP_MEMORY_SCOPE_AGENT);
        run_phase(p, ph, smem);
        if (ph + 1 < p.ph_hi) {
            if (ph == p.ph_lo) grid.sync();
            else { ++nbar; grid_barrier(bar, nbar * gridDim.x); }
        }
    }
}

extern "C" void kernel_launch(void* const* d_in, const int* in_sizes, int n_in, void* d_out, int out_size, void* d_ws, size_t ws_size, hipStream_t stream) {
    static int grid = 0;
    if (grid == 0) {
        if (n_in != 24 || ws_size < WS_END) { fprintf(stderr, "kernel_launch: unexpected n_in %d / ws %zu\n", n_in, ws_size); grid = -1; return; }
        int dev = 0, cus = 0, per_cu = 0;
        hipGetDevice(&dev); hipDeviceGetAttribute(&cus, hipDeviceAttributeMultiprocessorCount, dev);
        if (hipFuncSetAttribute((const void*)mk_forward, hipFuncAttributeMaxDynamicSharedMemorySize, LDS_BYTES) != hipSuccess) { fprintf(stderr, "kernel_launch: hipFuncSetAttribute failed\n"); grid = -1; return; }
        if (hipOccupancyMaxActiveBlocksPerMultiprocessor(&per_cu, (const void*)mk_forward, 512, LDS_BYTES) != hipSuccess || per_cu < 1) { fprintf(stderr, "kernel_launch: occupancy query gives %d\n", per_cu); per_cu = 1; }
        (void)hipGetLastError();
        grid = cus * per_cu;
    }
    if (grid < 0) return;
    Params p{};
    for (int i = 0; i < 24; ++i) p.in[i] = (const float*)d_in[i];
    p.out = (float*)d_out; p.ws = (unsigned char*)d_ws;
#if MK_LAUNCHES == 1
    p.ph_lo = 0; p.ph_hi = NPHASE;
    void* args[] = {&p};
    hipError_t e = hipLaunchCooperativeKernel((const void*)mk_forward, dim3(grid), dim3(512), args, LDS_BYTES, stream);
    if (e != hipSuccess) fprintf(stderr, "cooperative launch failed: %s (grid %d)\n", hipGetErrorString(e), grid);
#else
    for (int ph = 0; ph < NPHASE; ++ph) { p.ph_lo = ph; p.ph_hi = ph + 1;
        hipLaunchKernelGGL(mk_forward, dim3(grid), dim3(512), LDS_BYTES, stream, p); }
#endif
}
```

```cpp
#include <hip/hip_runtime.h>
#include <hip/hip_cooperative_groups.h>
#include <cstdio>
#include <cstdint>
namespace cg = cooperative_groups;

#ifndef MK_LAUNCHES
#define MK_LAUNCHES 1
#endif

__device__ __forceinline__ int tidx() { int t = threadIdx.x; asm volatile("" : "+v"(t)); return t; }

namespace pg8 {
#define PG8_LAS __attribute__((address_space(3)))
typedef unsigned short bf16_t;
typedef short bf16x8 __attribute__((ext_vector_type(8)));
typedef float f32x4 __attribute__((ext_vector_type(4)));
typedef unsigned u32x4 __attribute__((ext_vector_type(4)));
constexpr int BM = 256, BK = 64, HALF = 128, HTB = HALF * BK * 2  , STAGE_BYTES = 8 * HTB, NXCD = 8, WGM = 8;

__host__ __device__ __forceinline__ int lds_byte(int r, int c) { const int st = (r >> 4) * 2 + (c >> 5), rr = r & 15, cc = c & 31, ob = rr * 64 + cc * 2; return st * 1024 + (ob ^ (((ob >> 9) & 1) << 5)); }
__host__ __device__ __forceinline__ void stage_rc(int b, int& R, int& C) { const int st = b / 1024, sb = b % 1024, swz = sb ^ (((sb >> 9) & 1) << 5); R = (st >> 1) * 16 + swz / 64; C = (st & 1) * 32 + (swz % 64) / 2; }
__host__ __device__ __forceinline__ int perm32(int rho) { const int n = rho >> 4, i = rho & 15; return 8 * (i >> 2) + 4 * n + (i & 3); }

struct Unit { int pm, pn; };
struct Gemm { const bf16_t* A; const bf16_t* Bt; int M, N, K; };
struct StaticOrder {
    int nM, nN, nwg, G, c;
    __host__ __device__ void init(int M, int N, int G_, int c_) { nM = M / BM; nN = N / BM; nwg = nM * nN; G = G_; c = c_; }
    __host__ __device__ bool next(int i, Unit& u) const {
        const long L = (long)i * G + c; if (L >= nwg) return false;
        int wgid = (int)L; { const int q = nwg / NXCD, r = nwg % NXCD, xcd = wgid % NXCD, off = wgid / NXCD; wgid = (xcd < r ? xcd * (q + 1) : r * (q + 1) + (xcd - r) * q) + off; }
        const int nig = WGM * nN, gid = wgid / nig, fm = gid * WGM, gsz = (nM - fm) < WGM ? (nM - fm) : WGM;
        u.pm = fm + ((wgid % nig) % gsz); u.pn = (wgid % nig) / gsz; return true;
    }
    __device__ __forceinline__ void a_ready(const Unit&) const {}
    __device__ __forceinline__ void done(const Unit&) const {}
};
__device__ __forceinline__ unsigned cvt_pk_bf16(float lo, float hi) { unsigned r; asm volatile("v_cvt_pk_bf16_f32 %0, %1, %2" : "=v"(r) : "v"(lo), "v"(hi)); return r; }
template <class Epi, class Sched, bool STAMP = false>
__device__ __forceinline__ void gemm_phase(PG8_LAS unsigned char* lds, const Gemm g, const Sched& S, const Epi& E, unsigned long long* stamps) {
    const int tid = tidx(), wid = __builtin_amdgcn_readfirstlane(tid >> 6), lane = tid & 63, wr = wid >> 2, wc = wid & 3, fr = lane & 15, fq = lane >> 4;
    const int K = g.K, nt = K / BK;
    unsigned voffA[2], voffB[2];
#pragma unroll
    for (int i = 0; i < 2; ++i) { int R, C; stage_rc(tid * 16 + i * 8192, R, C); const int Rb = Epi::PERM ? ((R & ~31) + perm32(R & 31)) : R;
        voffA[i] = (unsigned)(R * K + C) * 2u; voffB[i] = (unsigned)(Rb * K + C) * 2u; }
    const size_t kstep = (size_t)(BK * 2);
    const size_t hstep = (size_t)HALF * K * 2;
    const size_t tstep = 2 * hstep;
    const unsigned ldsw = (unsigned)wid * 1024u;
    const int aoff = lds_byte(wr * 64 + fr, fq * 8), boff = lds_byte(wc * 32 + fr, fq * 8);
#define PG8_SA(b, h) (((b) * 2 + (h)) * HTB)
#define PG8_SB(b, h) ((4 + (b) * 2 + (h)) * HTB)
#define PG8_STAGE(bufoff, gbase, voff) do { _Pragma("unroll") for (int _i = 0; _i < 2; ++_i) \
        __builtin_amdgcn_global_load_lds((const unsigned*)((const char*)(gbase) + (voff)[_i]), (PG8_LAS unsigned*)(lds + (bufoff) + ldsw + _i * 8192), 16, 0, 0); } while (0)
#define PG8_LDA(dst, b, h) do { _Pragma("unroll") for (int m = 0; m < 4; ++m) _Pragma("unroll") for (int k = 0; k < 2; ++k) dst[m][k] = *(const PG8_LAS bf16x8*)(lds + PG8_SA(b, h) + aoff + m * 2048 + k * 1024); } while (0)
#define PG8_LDB(dst, b, h) do { _Pragma("unroll") for (int n = 0; n < 2; ++n) _Pragma("unroll") for (int k = 0; k < 2; ++k) dst[n][k] = *(const PG8_LAS bf16x8*)(lds + PG8_SB(b, h) + boff + n * 2048 + k * 1024); } while (0)
#define PG8_MMA(ai, bj, At, Bt) do { __builtin_amdgcn_s_setprio(1); _Pragma("unroll") for (int m = 0; m < 4; ++m) _Pragma("unroll") for (int n = 0; n < 2; ++n) _Pragma("unroll") for (int k = 0; k < 2; ++k) \
        acc[ai][bj][m][n] = __builtin_amdgcn_mfma_f32_16x16x32_bf16(Bt[n][k], At[m][k], acc[ai][bj][m][n], 0, 0, 0); __builtin_amdgcn_s_setprio(0); } while (0)
#define PG8_WAIT_V(n) asm volatile("s_waitcnt vmcnt(" #n ")" ::: "memory")
#define PG8_WAIT_L(n) asm volatile("s_waitcnt lgkmcnt(" #n ")" ::: "memory")
#define PG8_BAR __builtin_amdgcn_s_barrier()
#define PG8_SCHED __builtin_amdgcn_sched_barrier(0)
    Unit cur, nxt; int ui = 0;
    if (!S.next(0, cur)) return;
    f32x4 acc[2][2][4][2];
#pragma unroll
    for (int a = 0; a < 2; ++a)
#pragma unroll
        for (int b = 0; b < 2; ++b)
#pragma unroll
            for (int m = 0; m < 4; ++m)
#pragma unroll
                for (int n = 0; n < 2; ++n) acc[a][b][m][n] = (f32x4){0.f, 0.f, 0.f, 0.f};
    bf16x8 At[4][2], B0[2][2], B1[2][2];
    const char* cA = (const char*)g.A + (size_t)cur.pm * tstep; const char* cB = (const char*)g.Bt + (size_t)cur.pn * tstep;
    S.a_ready(cur);
    PG8_STAGE(PG8_SB(0, 0), cB, voffB); PG8_STAGE(PG8_SA(0, 0), cA, voffA); PG8_STAGE(PG8_SB(0, 1), cB + hstep, voffB); PG8_STAGE(PG8_SA(0, 1), cA + hstep, voffA);
    if (wr == 1) PG8_BAR;
    PG8_WAIT_V(4); PG8_BAR;
    PG8_STAGE(PG8_SB(1, 0), cB + kstep, voffB); PG8_STAGE(PG8_SA(1, 0), cA + kstep, voffA); PG8_STAGE(PG8_SB(1, 1), cB + hstep + kstep, voffB);
    PG8_WAIT_V(6); PG8_BAR;
    for (;;) {
        const bool has_next = S.next(ui + 1, nxt);
        const char* nA = has_next ? (const char*)g.A + (size_t)nxt.pm * tstep : cA; const char* nB = has_next ? (const char*)g.Bt + (size_t)nxt.pn * tstep : cB;
        for (int t = 0; t < nt; t += 2) {
            const bool last = (t == nt - 2);
            const char* a1 = cA + (size_t)(t + 1) * kstep;
            const char* a2 = last ? nA : cA + (size_t)(t + 2) * kstep; const char* b2 = last ? nB : cB + (size_t)(t + 2) * kstep;
            const char* a3 = a2 + kstep; const char* b3 = b2 + kstep;
            if (last && has_next) S.a_ready(nxt);
            PG8_LDB(B0, 0, 0); PG8_SCHED; PG8_LDA(At, 0, 0); PG8_STAGE(PG8_SA(1, 1), a1 + hstep, voffA);
            PG8_WAIT_L(8); PG8_BAR; PG8_WAIT_L(0); PG8_MMA(0, 0, At, B0); PG8_BAR; PG8_SCHED;
            PG8_LDB(B1, 0, 1); PG8_STAGE(PG8_SB(0, 0), b2, voffB);
            PG8_BAR; PG8_WAIT_L(0); PG8_MMA(0, 1, At, B1); PG8_BAR;
            PG8_LDA(At, 0, 1); PG8_STAGE(PG8_SA(0, 0), a2, voffA);
            PG8_BAR; PG8_WAIT_L(0); PG8_MMA(1, 0, At, B0); PG8_BAR; PG8_SCHED;
            PG8_STAGE(PG8_SB(0, 1), b2 + hstep, voffB);
            PG8_WAIT_V(6); PG8_BAR; PG8_MMA(1, 1, At, B1); PG8_BAR;
            PG8_LDB(B0, 1, 0); PG8_SCHED; PG8_LDA(At, 1, 0); PG8_STAGE(PG8_SA(0, 1), a2 + hstep, voffA);
            PG8_WAIT_L(8); PG8_BAR; PG8_WAIT_L(0); PG8_MMA(0, 0, At, B0); PG8_BAR; PG8_SCHED;
            PG8_LDB(B1, 1, 1); PG8_STAGE(PG8_SB(1, 0), b3, voffB);
            PG8_BAR; PG8_WAIT_L(0); PG8_MMA(0, 1, At, B1); PG8_BAR;
            PG8_LDA(At, 1, 1); PG8_STAGE(PG8_SA(1, 0), a3, voffA);
            PG8_BAR; PG8_WAIT_L(0); PG8_MMA(1, 0, At, B0); PG8_BAR; PG8_SCHED;
            PG8_STAGE(PG8_SB(1, 1), b3 + hstep, voffB);
            PG8_WAIT_V(6); PG8_BAR; PG8_MMA(1, 1, At, B1); PG8_BAR;
        }
        if constexpr (!Epi::AFTER_DRAIN) { E(acc, cur, wr, wc, fr, fq); S.done(cur); }
        if (!has_next) break;
#pragma unroll
        for (int a = 0; a < 2; ++a)
#pragma unroll
            for (int b = 0; b < 2; ++b)
#pragma unroll
                for (int m = 0; m < 4; ++m)
#pragma unroll
                    for (int n = 0; n < 2; ++n) acc[a][b][m][n] = (f32x4){0.f, 0.f, 0.f, 0.f};
        cur = nxt; cA = nA; cB = nB; ++ui;
    }
    PG8_WAIT_V(0);
    if (wr == 0) PG8_BAR;
    PG8_BAR;
    if constexpr (Epi::AFTER_DRAIN) { E.fused(acc, cur, wr, wc, fr, fq, lds, wid, lane); S.done(cur); }
#undef PG8_SA
#undef PG8_SB
#undef PG8_STAGE
#undef PG8_LDA
#undef PG8_LDB
#undef PG8_MMA
#undef PG8_WAIT_V
#undef PG8_WAIT_L
#undef PG8_BAR
#undef PG8_SCHED
}
}

using pg8::bf16_t; using pg8::bf16x8; using pg8::f32x4; using pg8::u32x4; using pg8::cvt_pk_bf16;
typedef short s16x4 __attribute__((ext_vector_type(4)));
typedef float f32x8 __attribute__((ext_vector_type(8)));
typedef float f32x16 __attribute__((ext_vector_type(16)));
typedef unsigned u32x2 __attribute__((ext_vector_type(2)));

constexpr int DM = 1024, TG = 32768;
constexpr size_t MiB = 1u << 20;
constexpr size_t WS_HWIN = 0, WS_HWOUT = 16 * MiB, WS_AWIN = 20 * MiB, WS_AWOUT = 30 * MiB, WS_H2 = 34 * MiB, WS_XB = 38 * MiB,
                 WS_UT = 102 * MiB, WS_GATE = 294 * MiB, WS_Y = 358 * MiB, WS_FILT = 422 * MiB, WS_SUMSQ = 454 * MiB, WS_BAR = 456 * MiB, WS_END = 457 * MiB;
constexpr int LDS_BYTES = 136 * 1024;
constexpr float ALPHA = 1.681792830507429f;
constexpr int NPHASE = 1 + 2 * 21;
#ifndef PHMASK
#define PHMASK 0xFFFF
#endif

struct Params { const float* in[24]; float* out; unsigned char* ws; int ph_lo, ph_hi; };
struct PV { const Params& q; int z; float* out; unsigned char* ws;
    __device__ __forceinline__ PV(const Params& q_, int z_) : q(q_), z(z_), out(q_.out + z_), ws(q_.ws + z_) {}
    __device__ __forceinline__ const float* in(int k) const { return q.in[k + z]; } };

__device__ __forceinline__ float bf2f(unsigned short x) { return __uint_as_float(((unsigned)x) << 16); }
__device__ __forceinline__ float bf2f_s(short x) { return __uint_as_float(((unsigned)(unsigned short)x) << 16); }
__device__ __forceinline__ unsigned short f2bf(float x) { return (unsigned short)(cvt_pk_bf16(x, 0.f) & 0xffffu); }
__device__ __forceinline__ float wave_sum(float v) {
#pragma unroll
    for (int o = 32; o >= 1; o >>= 1) v += __shfl_xor(v, o, 64);
    return v;
}
template <class T> __device__ __forceinline__ T* launder(T* q) {
    unsigned long long w = (unsigned long long)q; unsigned lo = (unsigned)w, hi = (unsigned)(w >> 32);
    asm volatile("" : "+v"(lo), "+v"(hi));
    lo = __builtin_amdgcn_readfirstlane(lo); hi = __builtin_amdgcn_readfirstlane(hi);
    return (T*)(((unsigned long long)hi << 32) | lo);
}
__device__ __forceinline__ int opaque_zero() { int z = 0; asm volatile("" : "+v"(z)); return __builtin_amdgcn_readfirstlane(z); }
__device__ __forceinline__ int opaque(int x) { asm volatile("" : "+v"(x)); return x; }
__device__ __forceinline__ float silu(float x) { return x / (1.f + __expf(-x)); }

struct EpiBf16B {
    static constexpr bool PERM = true, AFTER_DRAIN = false;
    bf16_t* O; int ldc; const float* bias;
    __device__ __forceinline__ void operator()(const f32x4 (&acc)[2][2][4][2], const pg8::Unit& u, int wr, int wc, int fr, int fq) const {
        const int row0 = u.pm * 256 + wr * 64 + fr, col0 = u.pn * 256 + wc * 32 + 8 * fq;
        f32x4 bv[2][2];
#pragma unroll
        for (int bj = 0; bj < 2; ++bj)
#pragma unroll
            for (int n = 0; n < 2; ++n) bv[bj][n] = *(const f32x4*)(bias + col0 + bj * 128 + 4 * n);
#pragma unroll
        for (int ai = 0; ai < 2; ++ai)
#pragma unroll
            for (int m = 0; m < 4; ++m) { bf16_t* rowp = O + (size_t)(row0 + ai * 128 + m * 16) * ldc + col0;
#pragma unroll
                for (int bj = 0; bj < 2; ++bj) { f32x4 v0 = acc[ai][bj][m][0] + bv[bj][0], v1 = acc[ai][bj][m][1] + bv[bj][1];
                    u32x4 w; w.x = cvt_pk_bf16(v0[0], v0[1]); w.y = cvt_pk_bf16(v0[2], v0[3]); w.z = cvt_pk_bf16(v1[0], v1[1]); w.w = cvt_pk_bf16(v1[2], v1[3]);
                    *(u32x4*)(rowp + bj * 128) = w; } }
    }
};
struct EpiUT {
    static constexpr bool PERM = true, AFTER_DRAIN = false;
    bf16_t* O; const float* bias; int L;
    __device__ __forceinline__ void operator()(const f32x4 (&acc)[2][2][4][2], const pg8::Unit& u, int wr, int wc, int fr, int fq) const {
        const int row0 = u.pm * 256 + wr * 64 + fr; const int tokt = u.pn * 256; const int b = tokt / L; const int t0 = tokt - b * L + wc * 32 + 8 * fq;
#pragma unroll
        for (int ai = 0; ai < 2; ++ai)
#pragma unroll
            for (int m = 0; m < 4; ++m) { const int ch = row0 + ai * 128 + m * 16; const float bs = bias[ch];
                bf16_t* rowp = O + ((size_t)b * 3072 + ch) * L + t0;
#pragma unroll
                for (int bj = 0; bj < 2; ++bj) { f32x4 v0 = acc[ai][bj][m][0] + bs, v1 = acc[ai][bj][m][1] + bs;
                    u32x4 w; w.x = cvt_pk_bf16(v0[0], v0[1]); w.y = cvt_pk_bf16(v0[2], v0[3]); w.z = cvt_pk_bf16(v1[0], v1[1]); w.w = cvt_pk_bf16(v1[2], v1[3]);
                    *(u32x4*)(rowp + bj * 128) = w; } }
    }
};
struct EpiRes {
    static constexpr bool PERM = true, AFTER_DRAIN = false;
    float* out; bf16_t* xb; const float* bias; int last;
    __device__ __forceinline__ void operator()(const f32x4 (&acc)[2][2][4][2], const pg8::Unit& u, int wr, int wc, int fr, int fq) const {
        const int row0 = u.pm * 256 + wr * 64 + fr, col0 = u.pn * 256 + wc * 32 + 8 * fq;
        f32x4 bv[2][2];
#pragma unroll
        for (int bj = 0; bj < 2; ++bj)
#pragma unroll
            for (int n = 0; n < 2; ++n) bv[bj][n] = *(const f32x4*)(bias + col0 + bj * 128 + 4 * n);
#pragma unroll
        for (int ai = 0; ai < 2; ++ai)
#pragma unroll
            for (int m = 0; m < 4; ++m) { const size_t ro = (size_t)(row0 + ai * 128 + m * 16) * DM + col0;
#pragma unroll
                for (int bj = 0; bj < 2; ++bj) { const bf16x8 xv = *(const bf16x8*)(xb + ro + bj * 128);
                    f32x4 v0, v1;
#pragma unroll
                    for (int e = 0; e < 4; ++e) { v0[e] = bf2f_s(xv[e]) * ALPHA + acc[ai][bj][m][0][e] + bv[bj][0][e]; v1[e] = bf2f_s(xv[4 + e]) * ALPHA + acc[ai][bj][m][1][e] + bv[bj][1][e]; }
                    if (last) { *(f32x4*)(out + ro + bj * 128) = v0; *(f32x4*)(out + ro + bj * 128 + 4) = v1; }
                    else { u32x4 w; w.x = cvt_pk_bf16(v0[0], v0[1]); w.y = cvt_pk_bf16(v0[2], v0[3]); w.z = cvt_pk_bf16(v1[0], v1[1]); w.w = cvt_pk_bf16(v1[2], v1[3]);
                        *(u32x4*)(xb + ro + bj * 128) = w; } } }
    }
};

template <class Epi> __device__ __forceinline__ void run_gemm(unsigned char* lds, const bf16_t* A, const bf16_t* Bt, int M, int N, const Epi& E) {
    pg8::Gemm g; g.A = A; g.Bt = Bt; g.M = M; g.N = N; g.K = DM;
    pg8::StaticOrder S; S.init(M, N, (int)gridDim.x, (int)blockIdx.x);
    pg8::gemm_phase<Epi, pg8::StaticOrder, false>((PG8_LAS unsigned char*)lds, g, S, E, nullptr);
    __syncthreads();
}

__device__ __forceinline__ void transpose_tile(const float* __restrict__ W, bf16_t* __restrict__ WT, int K, int N, int tk, int tn, unsigned char* lds) {
    float* tile = (float*)lds;
    const int tid = tidx();
#pragma unroll
    for (int i = 0; i < 2; ++i) { const int q = tid + i * 512, k = q >> 4, n4 = (q & 15) * 4;
        const f32x4 v = *(const f32x4*)(W + (size_t)(tk * 64 + k) * N + tn * 64 + n4);
        tile[k * 65 + n4 + 0] = v[0]; tile[k * 65 + n4 + 1] = v[1]; tile[k * 65 + n4 + 2] = v[2]; tile[k * 65 + n4 + 3] = v[3]; }
    __syncthreads();
    { const int n = tid >> 3, k8 = (tid & 7) * 8; float v[8];
#pragma unroll
        for (int e = 0; e < 8; ++e) v[e] = tile[(k8 + e) * 65 + n];
        u32x4 w; w.x = cvt_pk_bf16(v[0], v[1]); w.y = cvt_pk_bf16(v[2], v[3]); w.z = cvt_pk_bf16(v[4], v[5]); w.w = cvt_pk_bf16(v[6], v[7]);
        *(u32x4*)(WT + (size_t)(tn * 64 + n) * K + tk * 64 + k8) = w; }
    __syncthreads();
}

__device__ __forceinline__ void prologue_phase(const PV& p, unsigned char* lds) {
    const int total = 2 * 2176;
    for (int it = blockIdx.x; it < total; it += gridDim.x) {
        const int j = it / 2176; int r = it - j * 2176; int kind;
        if (r < 1024) kind = 0; else if (r < 1280) { kind = 1; r -= 1024; } else if (r < 1920) { kind = 2; r -= 1280; } else { kind = 3; r -= 1920; }
        const int N = kind == 0 ? 4096 : (kind == 2 ? 2560 : 1024);
        const int nN = N / 64; const int tk = r / nN, tn = r % nN;
        const float* W = (kind == 0 ? p.in(2) : kind == 1 ? p.in(14) : kind == 2 ? p.in(16) : p.in(20)) + (size_t)j * 1024 * N;
        bf16_t* WT = (bf16_t*)(p.ws + (kind == 0 ? WS_HWIN : kind == 1 ? WS_HWOUT : kind == 2 ? WS_AWIN : WS_AWOUT)) + (size_t)j * 1024 * N;
        transpose_tile(W, WT, 1024, N, tk, tn, lds);
    }
    const int tid_ = tidx(); const int wid = __builtin_amdgcn_readfirstlane(tid_ >> 6), lane = tid_ & 63;
    for (int row = blockIdx.x * 8 + wid; row < 2 * 6144; row += gridDim.x * 8) {
        const int j = row / 6144; int t = row - j * 6144; const int sel = t >= 2048 ? 1 : 0; if (sel) t -= 2048; const int L = sel ? 4096 : 2048;
        const float* w1 = p.in(6) + j * 33 * 64; const float* b1 = p.in(7) + j * 64; const float* fq = p.in(8) + j * 64;
        const float* w2 = p.in(9) + j * 64 * 64; const float* b2 = p.in(10) + j * 64;
        float feat = 0.f;
        if (lane == 0) feat = (float)t / (float)(L - 1);
        else if (lane <= 32) { const int i = (lane - 1) & 15; const double f = 1e-4 + (double)i * ((15.0 - 1e-4) / 15.0);
            double ph = f * (double)t / (double)L; ph -= (double)(long long)ph;
            const float a = (float)(ph * 6.283185307179586);
            feat = lane <= 16 ? cosf(a) : -sinf(a); }
        float s = b1[lane];
        for (int i = 0; i < 33; ++i) s += __shfl(feat, i, 64) * w1[i * 64 + lane];
        const float fr = fq[lane];
        const float h1 = sinf(fr * s);
        float s2 = b2[lane];
        for (int i = 0; i < 64; ++i) s2 += __shfl(h1, i, 64) * w2[i * 64 + lane];
        const float h2 = sinf(fr * s2);
        ((float*)(p.ws + WS_H2))[((size_t)(j * 2 + sel) * 4096 + t) * 64 + lane] = h2;
    }
}

__device__ __forceinline__ void cvt_phase(const PV& p, int g) {
    const float* x = p.in(g); bf16_t* xb = (bf16_t*)(p.ws + WS_XB);
    const size_t n8 = (size_t)TG * DM / 8;
    for (size_t i = (size_t)blockIdx.x * 512 + tidx(); i < n8; i += (size_t)gridDim.x * 512) {
        const f32x4 a = *(const f32x4*)(x + i * 8), b = *(const f32x4*)(x + i * 8 + 4);
        u32x4 w; w.x = cvt_pk_bf16(a[0], a[1]); w.y = cvt_pk_bf16(a[2], a[3]); w.z = cvt_pk_bf16(b[0], b[1]); w.w = cvt_pk_bf16(b[2], b[3]);
        *(u32x4*)(xb + i * 8) = w;
    }
}

__device__ __forceinline__ void ln_phase(const PV& p, int g, int layer) {
    float* x = p.out + (size_t)g * TG * DM; bf16_t* xb = (bf16_t*)(p.ws + WS_XB);
    const float* gam = p.in(22) + layer * DM; const float* bet = p.in(23) + layer * DM;
    const int tid_ = tidx(); const int wid = __builtin_amdgcn_readfirstlane(tid_ >> 6), lane = tid_ & 63;
    const bool last = layer == 3;
    f32x4 gv[4], bv[4];
#pragma unroll
    for (int k = 0; k < 4; ++k) { const int c = (k >> 1) * 512 + lane * 8 + (k & 1) * 4; gv[k] = *(const f32x4*)(gam + c); bv[k] = *(const f32x4*)(bet + c); }
    for (int row = blockIdx.x * 8 + wid; row < TG; row += gridDim.x * 8) {
        f32x4 v[4];
        if (last) {
#pragma unroll
            for (int k = 0; k < 4; ++k) v[k] = *(const f32x4*)(x + (size_t)row * DM + (k >> 1) * 512 + lane * 8 + (k & 1) * 4);
        } else {
#pragma unroll
            for (int hh = 0; hh < 2; ++hh) { const bf16x8 t = *(const bf16x8*)(xb + (size_t)row * DM + hh * 512 + lane * 8);
#pragma unroll
                for (int e = 0; e < 4; ++e) { v[hh * 2][e] = bf2f_s(t[e]); v[hh * 2 + 1][e] = bf2f_s(t[4 + e]); } }
        }
        float s = 0.f;
#pragma unroll
        for (int k = 0; k < 4; ++k) s += v[k][0] + v[k][1] + v[k][2] + v[k][3];
        const float mu = wave_sum(s) * (1.f / DM); float q = 0.f;
#pragma unroll
        for (int k = 0; k < 4; ++k) { v[k] = v[k] - mu; q += v[k][0] * v[k][0] + v[k][1] * v[k][1] + v[k][2] * v[k][2] + v[k][3] * v[k][3]; }
        const float rstd = rsqrtf(wave_sum(q) * (1.f / DM) + 1e-5f);
#pragma unroll
        for (int k = 0; k < 4; ++k) v[k] = v[k] * rstd * gv[k] + bv[k];
        if (last) {
#pragma unroll
            for (int k = 0; k < 4; ++k) *(f32x4*)(x + (size_t)row * DM + (k >> 1) * 512 + lane * 8 + (k & 1) * 4) = v[k];
        } else {
#pragma unroll
            for (int hh = 0; hh < 2; ++hh) { u32x4 w; w.x = cvt_pk_bf16(v[hh * 2][0], v[hh * 2][1]); w.y = cvt_pk_bf16(v[hh * 2][2], v[hh * 2][3]);
                w.z = cvt_pk_bf16(v[hh * 2 + 1][0], v[hh * 2 + 1][1]); w.w = cvt_pk_bf16(v[hh * 2 + 1][2], v[hh * 2 + 1][3]);
                *(u32x4*)(xb + (size_t)row * DM + hh * 512 + lane * 8) = w; }
        }
    }
}


template <int L> __device__ __forceinline__ void filter_phase(const PV& p, int hj, int slot, unsigned char* lds) {
    const int tid = tidx(), wid = __builtin_amdgcn_readfirstlane(tid >> 6), lane = tid & 63;
    const float* h2 = (const float*)(p.ws + WS_H2) + (size_t)(hj * 2 + (L == 2048 ? 0 : 1)) * 4096 * 64;
    const float* w3 = p.in(11) + (size_t)hj * 64 * 4096; const float* decay = p.in(12) + hj * 4096;
    bf16_t* FILT = (bf16_t*)(p.ws + WS_FILT); float* PART = (float*)(p.ws + WS_SUMSQ);
    float* stg = (float*)lds;
    unsigned* tile = (unsigned*)(lds + 65536);
    constexpr int NCH = L / 256;
    for (int it = blockIdx.x; it < 64 * NCH; it += gridDim.x) {
        const int cb = it / NCH, chunk = it - cb * NCH, t0 = chunk * 256;
        const int od = cb >> 4, dir = od & 1, o = od >> 1, col = cb * 64 + lane, c = col & 1023;
        const int tb = t0 + dir;
        __syncthreads();
#pragma unroll
        for (int i = 0; i < 8; ++i) { const int q = tid + 512 * i, rr = q >> 4, c4 = (q & 15) * 4; int tr = tb + rr; tr = tr < L ? tr : L - 1;
            *(f32x4*)(stg + rr * 64 + c4) = *(const f32x4*)(h2 + (size_t)tr * 64 + c4); }
        float w[64];
#pragma unroll
        for (int j = 0; j < 64; ++j) w[j] = w3[(size_t)j * 4096 + col];
        const float dec = fabsf(decay[col]);
        float ss = 0.f;
        if (dir == 1 && t0 == 0 && wid == 0) {
            float d = 0.f;
#pragma unroll
            for (int j = 0; j < 64; ++j) d += h2[j] * w[j];
            ss = d * d; }
        __syncthreads();
        unsigned short* trow = (unsigned short*)(tile + lane * 129);
#pragma unroll 2
        for (int tt = 0; tt < 32; ++tt) {
            const int tl = wid * 32 + tt, t = tb + tl; const f32x4* hr = (const f32x4*)(stg + tl * 64);
            float d = 0.f;
#pragma unroll
            for (int jq = 0; jq < 16; ++jq) { const f32x4 x = hr[jq]; d += x[0] * w[jq * 4] + x[1] * w[jq * 4 + 1] + x[2] * w[jq * 4 + 2] + x[3] * w[jq * 4 + 3]; }
            d *= expf(-(float)t * (1.0f / (float)(L - 1)) * dec);
            if (t >= L) d = 0.f;
            ss += d * d;
            trow[dir ? tl : 255 - tl] = f2bf(d);
        }
        PART[(size_t)col * (NCH * 8) + chunk * 8 + wid] = ss;
        __syncthreads();
        { const int cc = tid >> 3, part = tid & 7; const unsigned* src = tile + cc * 129 + part * 16;
            const int ccol = cb * 64 + cc, c2 = ccol & 1023;
            bf16_t* dst = FILT + ((size_t)(o * 1024 + c2)) * (2 * L) + (dir ? L + t0 : L - 256 - t0) + part * 32;
#pragma unroll
            for (int k = 0; k < 4; ++k) { u32x4 v; v.x = src[k * 4]; v.y = src[k * 4 + 1]; v.z = src[k * 4 + 2]; v.w = src[k * 4 + 3]; *(u32x4*)(dst + k * 8) = v; } }
    }
    __syncthreads();
}

__device__ __forceinline__ bf16x8 lds_a4(const unsigned char* lds, unsigned addr) {
    const unsigned* q = (const unsigned*)(lds + addr); u32x4 w; w.x = q[0]; w.y = q[1]; w.z = q[2]; w.w = q[3]; return *reinterpret_cast<bf16x8*>(&w);
}
template <int NB> struct ConvCfg {
    static constexpr int L = NB == 16 ? 2048 : 4096, ROWE = L + 8, SB = NB == 16 ? 0 : -2048, NT = NB == 16 ? 64 : 192;
    static constexpr int ZOFF = 0, FOFF = 66560, FCOPY = 2 * L * 2, W3OFF = FOFF + 4 * FCOPY, REDOFF = W3OFF + 1024;
};
template <int NB> __device__ __forceinline__ void conv_main(const unsigned char* lds, int o, f32x4 (&acc)[16]) {
    using C = ConvCfg<NB>;
    const int tid_ = tidx(); const int lane = tid_ & 63, wid = __builtin_amdgcn_readfirstlane(tid_ >> 6), r = lane & 15, gq = lane >> 4;
    const int b = NB == 16 ? r : (r & 7), h = NB == 16 ? 0 : (r >> 3);
    const int E0 = (C::L - 1) + C::SB - 256 * wid + 8 * gq - r;
    const int P = E0 & 1;
    unsigned aPtr = (unsigned)(C::FOFF + (o * 2 + P) * C::FCOPY + 2 * (E0 - P));
    const int bBase = C::ZOFF + b * C::ROWE * 2 + 2 * (C::SB + 2048 * h + 8 * gq);
    const int s_lane0 = C::SB + 2048 * h;
    bf16x8 A[16];
#pragma unroll
    for (int i = 0; i < 16; ++i) { A[i] = lds_a4(lds, aPtr - 32 * i); acc[i] = (f32x4){0.f, 0.f, 0.f, 0.f}; }
    auto ldb = [&](int j) -> bf16x8 {
        if (NB == 16) return *(const bf16x8*)(lds + bBase + 64 * j);
        const bool valid = (unsigned)(s_lane0 + 32 * j) < (unsigned)C::L;
        const bf16x8 t = *(const bf16x8*)(lds + (valid ? bBase + 64 * j : C::ZOFF));
        const bf16x8 z = {0, 0, 0, 0, 0, 0, 0, 0}; return valid ? t : z; };
    bf16x8 bnext = ldb(0);
    for (int jo = 0; jo < C::NT / 8; ++jo) {
#pragma unroll
        for (int jj = 0; jj < 8; ++jj) {
            const int j = jo * 8 + jj;
            const bf16x8 bf = bnext;
            bnext = ldb(j + 1 < C::NT ? j + 1 : j);
            acc[15] = __builtin_amdgcn_mfma_f32_16x16x32_bf16(A[(15 - 2 * jj) & 15], bf, acc[15], 0, 0, 0);
            acc[14] = __builtin_amdgcn_mfma_f32_16x16x32_bf16(A[(14 - 2 * jj) & 15], bf, acc[14], 0, 0, 0);
            A[(14 - 2 * jj) & 15] = lds_a4(lds, aPtr + 64 * (jj + 1));
            A[(15 - 2 * jj) & 15] = lds_a4(lds, aPtr + 64 * (jj + 1) - 32);
#pragma unroll
            for (int i = 13; i >= 0; --i) acc[i] = __builtin_amdgcn_mfma_f32_16x16x32_bf16(A[(i - 2 * jj) & 15], bf, acc[i], 0, 0, 0);
            __builtin_amdgcn_sched_barrier(0);
        }
        aPtr += 512;
    }
}
template <int NB> __device__ __forceinline__ void conv_epi(const unsigned char* lds, const f32x4 (&acc)[16], u32x2 (&zp)[16], const bf16_t* UT, int gch,
                                                          float gw0, float gw1, float gw2, float gcb, float fb, float nrm) {
    using C = ConvCfg<NB>;
    const int tid_ = tidx(); const int lane = tid_ & 63, wid = __builtin_amdgcn_readfirstlane(tid_ >> 6), r = lane & 15, gq = lane >> 4;
    const int b = NB == 16 ? r : (r & 7), h = NB == 16 ? 0 : (r >> 3);
    const bf16_t* grow = UT + ((size_t)b * 3072 + gch) * C::L;
#pragma unroll
    for (int i = 0; i < 16; ++i) {
        const int t = 256 * wid + 16 * i + 4 * gq + 2048 * h;
        const s16x4 gu = *(const s16x4*)(grow + t);
        const float gl = t > 0 ? bf2f(grow[t - 1]) : 0.f, gr = (t + 4 < C::L) ? bf2f(grow[t + 4]) : 0.f;
        const float u0 = bf2f_s(gu[0]), u1 = bf2f_s(gu[1]), u2 = bf2f_s(gu[2]), u3 = bf2f_s(gu[3]);
        const float g0 = gw0 * gl + gw1 * u0 + gw2 * u1 + gcb, g1 = gw0 * u0 + gw1 * u1 + gw2 * u2 + gcb;
        const float g2 = gw0 * u1 + gw1 * u2 + gw2 * u3 + gcb, g3 = gw0 * u2 + gw1 * u3 + gw2 * gr + gcb;
        const s16x4 vz = *(const s16x4*)(lds + C::ZOFF + (b * C::ROWE + t) * 2);
        const float z0 = g0 * (acc[i][0] * nrm + bf2f_s(vz[0]) * fb), z1 = g1 * (acc[i][1] * nrm + bf2f_s(vz[1]) * fb);
        const float z2 = g2 * (acc[i][2] * nrm + bf2f_s(vz[2]) * fb), z3 = g3 * (acc[i][3] * nrm + bf2f_s(vz[3]) * fb);
        zp[i].x = cvt_pk_bf16(z0, z1); zp[i].y = cvt_pk_bf16(z2, z3);
    }
}
template <int NB> __device__ __forceinline__ void conv_store_z(unsigned char* lds, const u32x2 (&zp)[16]) {
    using C = ConvCfg<NB>;
    const int tid_ = tidx(); const int lane = tid_ & 63, wid = __builtin_amdgcn_readfirstlane(tid_ >> 6), r = lane & 15, gq = lane >> 4;
    const int b = NB == 16 ? r : (r & 7), h = NB == 16 ? 0 : (r >> 3);
#pragma unroll
    for (int i = 0; i < 16; ++i) { const int t = 256 * wid + 16 * i + 4 * gq + 2048 * h; *(u32x2*)(lds + C::ZOFF + (b * C::ROWE + t) * 2) = zp[i]; }
}

template <int NB> __device__ __forceinline__ void conv_phase(const PV& p, int hj, int slot, unsigned char* lds) {
    using C = ConvCfg<NB>;
    constexpr int L = C::L;
    const int tid = tidx(), wid = __builtin_amdgcn_readfirstlane(tid >> 6), lane = tid & 63;
    bf16_t* UT = (bf16_t*)(p.ws + WS_UT);
    const float* h2 = (const float*)(p.ws + WS_H2) + (size_t)(hj * 2 + (NB == 16 ? 0 : 1)) * 4096 * 64;
    const float* w3 = p.in(11) + (size_t)hj * 64 * 4096; const float* decay = p.in(12) + hj * 4096;
    const float* fbias = p.in(13) + hj * 2048; const float* cw = p.in(4) + hj * 3 * 3072; const float* cb = p.in(5) + hj * 3072;
    float* w3s = (float*)(lds + C::W3OFF); float* red = (float*)(lds + C::REDOFF);
    for (int c = blockIdx.x; c < 1024; c += gridDim.x) {
        __syncthreads();
        { const bf16_t* FILT = (const bf16_t*)(p.ws + WS_FILT);
            for (int q = tid; q < 2 * (2 * L / 8); q += 512) { const int o = q / (2 * L / 8), i8 = (q - o * (2 * L / 8)) * 8;
                *(u32x4*)(lds + C::FOFF + (o * 2) * C::FCOPY + i8 * 2) = *(const u32x4*)(FILT + ((size_t)(o * 1024 + c)) * (2 * L) + i8); } }
        { constexpr int NP = (L / 256) * 8; const float* PART = (const float*)(p.ws + WS_SUMSQ);
            const int o = tid >> 8, idx = tid & 255, dir = idx / NP, k = idx - dir * NP;
            float v = (idx < 2 * NP) ? PART[(size_t)((o * 2 + dir) * 1024 + c) * NP + k] : 0.f;
            v = wave_sum(v); if (lane == 0) red[wid] = v; }
        __syncthreads();
        const float nrm0 = rsqrtf(red[0] + red[1] + red[2] + red[3] + 1e-6f), nrm1 = rsqrtf(red[4] + red[5] + red[6] + red[7] + 1e-6f);
        { const float w0 = cw[c], w1 = cw[3072 + c], w2 = cw[2 * 3072 + c], cbv = cb[c];
            for (int chunk = tid; chunk < NB * L / 8; chunk += 512) { const int b = chunk / (L / 8), s8 = (chunk % (L / 8)) * 8;
                const bf16_t* src = UT + ((size_t)b * 3072 + c) * L + s8;
                const bf16x8 x = *(const bf16x8*)src; float xe[10];
                xe[0] = s8 > 0 ? bf2f(src[-1]) : 0.f; xe[9] = (s8 + 8 < L) ? bf2f(src[8]) : 0.f;
#pragma unroll
                for (int e = 0; e < 8; ++e) xe[e + 1] = bf2f_s(x[e]);
                float y[8];
#pragma unroll
                for (int e = 0; e < 8; ++e) y[e] = w0 * xe[e] + w1 * xe[e + 1] + w2 * xe[e + 2] + cbv;
                u32x4 w; w.x = cvt_pk_bf16(y[0], y[1]); w.y = cvt_pk_bf16(y[2], y[3]); w.z = cvt_pk_bf16(y[4], y[5]); w.w = cvt_pk_bf16(y[6], y[7]);
                *(u32x4*)(lds + C::ZOFF + (b * C::ROWE + s8) * 2) = w; } }
        __syncthreads();
        for (int q = tid; q < 2 * (2 * L / 8); q += 512) { const int o = q / (2 * L / 8), m4 = (q - o * (2 * L / 8)) * 4;
            const unsigned* s0 = (const unsigned*)(lds + C::FOFF + (o * 2) * C::FCOPY) + m4; unsigned* d1 = (unsigned*)(lds + C::FOFF + (o * 2 + 1) * C::FCOPY) + m4;
            const u32x4 a = *(const u32x4*)s0; const unsigned nx = (m4 + 4 < L) ? s0[4] : 0u;
            u32x4 r; r.x = __builtin_amdgcn_alignbit(a.y, a.x, 16); r.y = __builtin_amdgcn_alignbit(a.z, a.y, 16); r.z = __builtin_amdgcn_alignbit(a.w, a.z, 16); r.w = __builtin_amdgcn_alignbit(nx, a.w, 16);
            *(u32x4*)d1 = r; }
        __syncthreads();
        f32x4 acc[16]; u32x2 zp[16];
        conv_main<NB>(lds, 0, acc);
        conv_epi<NB>(lds, acc, zp, UT, 1024 + c, cw[1024 + c], cw[3072 + 1024 + c], cw[2 * 3072 + 1024 + c], cb[1024 + c], fbias[c], nrm0);
        __syncthreads();
        conv_store_z<NB>(lds, zp);
        __syncthreads();
        conv_main<NB>(lds, 1, acc);
        conv_epi<NB>(lds, acc, zp, UT, 2048 + c, cw[2048 + c], cw[3072 + 2048 + c], cw[2 * 3072 + 2048 + c], cb[2048 + c], fbias[1024 + c], nrm1);
        __syncthreads();
        conv_store_z<NB>(lds, zp);
        __syncthreads();
        for (int chunk = tid; chunk < NB * L / 8; chunk += 512) { const int b = chunk / (L / 8), s8 = (chunk % (L / 8)) * 8;
            *(u32x4*)(UT + ((size_t)b * 3072 + c) * L + s8) = *(const u32x4*)(lds + C::ZOFF + (b * C::ROWE + s8) * 2); }
        __syncthreads();
    }
}

__device__ __forceinline__ void ygate_phase(const PV& p, int L, unsigned char* lds) {
    const bf16_t* UT = (const bf16_t*)(p.ws + WS_UT); const bf16_t* G = (const bf16_t*)(p.ws + WS_GATE); bf16_t* Y = (bf16_t*)(p.ws + WS_Y);
    const int tid = tidx(); constexpr int RS = 136;
    bf16_t* tile = (bf16_t*)lds;
    const int nit = (TG / 128) * 16;
    u32x4 zr[2]; bf16x8 gr[2];
    auto issue = [&](int it) {
        const int tc = it & 15, tt = it >> 4; const int tok0 = tt * 128, b = tok0 / L, t0 = tok0 - b * L, c0 = tc * 64;
#pragma unroll
        for (int i = 0; i < 2; ++i) { const int q = tid + i * 512;
            zr[i] = *(const u32x4*)(UT + ((size_t)b * 3072 + c0 + (q >> 4)) * L + t0 + (q & 15) * 8);
            gr[i] = *(const bf16x8*)(G + (size_t)(tok0 + (q >> 3)) * DM + c0 + (q & 7) * 8); } };
    int it = blockIdx.x;
    if (it < nit) issue(it);
    for (; it < nit; it += gridDim.x) {
        const int tc = it & 15, tt = it >> 4; const int tok0 = tt * 128, c0 = tc * 64;
#pragma unroll
        for (int i = 0; i < 2; ++i) { const int q = tid + i * 512; *(u32x4*)(tile + (q >> 4) * RS + (q & 15) * 8) = zr[i]; }
        const bf16x8 g0 = gr[0], g1 = gr[1];
        __syncthreads();
        if (it + (int)gridDim.x < nit) issue(it + gridDim.x);
#pragma unroll
        for (int i = 0; i < 2; ++i) { const int q = tid + i * 512, t = q >> 3, cch = (q & 7) * 8; const bf16x8 gv = i ? g1 : g0; float y[8];
#pragma unroll
            for (int e = 0; e < 8; ++e) y[e] = bf2f(tile[(cch + e) * RS + t]) * silu(bf2f_s(gv[e]));
            u32x4 w; w.x = cvt_pk_bf16(y[0], y[1]); w.y = cvt_pk_bf16(y[2], y[3]); w.z = cvt_pk_bf16(y[4], y[5]); w.w = cvt_pk_bf16(y[6], y[7]);
            *(u32x4*)(Y + (size_t)(tok0 + t) * DM + c0 + cch) = w; }
        __syncthreads();
    }
}

constexpr int LDU = 2560;
__device__ __forceinline__ void rope_phase(const PV& p, int aj, int L) {
    bf16_t* U = (bf16_t*)(p.ws + WS_UT);
    const float* qn = p.in(18) + aj * 128; const float* kn = p.in(19) + aj * 128;
    const int tid = tidx(), sub = tid & 7;
    float inv[8], q1[8], q2[8], k1[8], k2[8];
#pragma unroll
    for (int e = 0; e < 8; ++e) { inv[e] = exp2f(-(float)((8 * sub + e) & 31) * (13.287712379549449f / 32.f));
        q1[e] = qn[8 * sub + e]; q2[e] = qn[64 + 8 * sub + e]; k1[e] = kn[8 * sub + e]; k2[e] = kn[64 + 8 * sub + e]; }
    for (int tok = blockIdx.x * 64 + (tid >> 3); tok < TG; tok += gridDim.x * 64) {
        const int t = tok & (L - 1); const float pos = (float)(sub < 4 ? (t >> 6) : (t & 63));
        float cs[8], sn[8];
#pragma unroll
        for (int e = 0; e < 8; ++e) { const float ang = pos * inv[e]; cs[e] = __cosf(ang); sn[e] = __sinf(ang); }
        bf16_t* u = U + (size_t)tok * LDU + 8 * sub;
#pragma unroll
        for (int hd = 0; hd < 10; ++hd) {
            const bf16x8 a = *(const bf16x8*)(u + hd * 128), bq = *(const bf16x8*)(u + hd * 128 + 64);
            float x1[8], x2[8]; float ss = 0.f;
#pragma unroll
            for (int e = 0; e < 8; ++e) { x1[e] = bf2f_s(a[e]); x2[e] = bf2f_s(bq[e]); ss += x1[e] * x1[e] + x2[e] * x2[e]; }
            ss += __shfl_xor(ss, 1, 64); ss += __shfl_xor(ss, 2, 64); ss += __shfl_xor(ss, 4, 64);
            const float rs = rsqrtf(ss * (1.f / 128.f) + 1e-6f);
            float o1[8], o2[8];
#pragma unroll
            for (int e = 0; e < 8; ++e) { const float xa = x1[e] * rs * (hd < 8 ? q1[e] : k1[e]), xb2 = x2[e] * rs * (hd < 8 ? q2[e] : k2[e]);
                o1[e] = xa * cs[e] - xb2 * sn[e]; o2[e] = xb2 * cs[e] + xa * sn[e]; }
            u32x4 w1, w2; w1.x = cvt_pk_bf16(o1[0], o1[1]); w1.y = cvt_pk_bf16(o1[2], o1[3]); w1.z = cvt_pk_bf16(o1[4], o1[5]); w1.w = cvt_pk_bf16(o1[6], o1[7]);
            w2.x = cvt_pk_bf16(o2[0], o2[1]); w2.y = cvt_pk_bf16(o2[2], o2[3]); w2.z = cvt_pk_bf16(o2[4], o2[5]); w2.w = cvt_pk_bf16(o2[6], o2[7]);
            *(u32x4*)(u + hd * 128) = w1; *(u32x4*)(u + hd * 128 + 64) = w2;
        }
    }
}

namespace att {
constexpr int D = 128, NW = 8, QBLK = 32, KVBLK = 64;
constexpr float SCALE = 0.088388347648318440f;
constexpr float THR = 8.f;
constexpr int LDQ = LDU, LDK = LDU;
constexpr size_t SHM_V = KVBLK * D * 2, SHM_K = KVBLK * D * 2, SHM_ATTN = 2 * SHM_V + 2 * SHM_K + NW * 64 * 4;
#define KSWZ(row, colB) ((row) * 256 + ((colB) ^ (((row) & 7) << 4)))
#define SBAR() __builtin_amdgcn_sched_barrier(0)
__device__ __forceinline__ int crow(int r, int hi) { return (r & 3) + 8 * (r >> 2) + 4 * hi; }
__device__ __forceinline__ unsigned cvtpk(float lo, float hi) { unsigned r; asm volatile("v_cvt_pk_bf16_f32 %0, %1, %2" : "=v"(r) : "v"(lo), "v"(hi)); return r; }
__device__ __forceinline__ bf16x8 ld8(const bf16_t* p) { return *reinterpret_cast<const bf16x8*>(p); }
__device__ __forceinline__ void partialSM(f32x16& p0, f32x16& p1, float& m_reg, float& mn, float& alpha) {
  constexpr float C = SCALE * 1.4426950408889634f;
  float pmax = p0[0]; for (int r = 1; r < 16; ++r) pmax = fmaxf(pmax, p0[r]); for (int r = 0; r < 16; ++r) pmax = fmaxf(pmax, p1[r]);
  { auto rr = __builtin_amdgcn_permlane32_swap(__float_as_uint(pmax), __float_as_uint(pmax), false, false);
    pmax = fmaxf(__uint_as_float(rr[0]), __uint_as_float(rr[1])); }
  if (__builtin_expect(__all(pmax - m_reg <= THR / SCALE), 1)) { mn = m_reg; alpha = 1.f; }
  else { mn = fmaxf(m_reg, pmax); alpha = __builtin_amdgcn_exp2f((m_reg - mn) * C); m_reg = mn; }
  float mnC = -mn * C;
  for (int r = 0; r < 16; ++r) p0[r] = fmaf(p0[r], C, mnC); for (int r = 0; r < 16; ++r) p1[r] = fmaf(p1[r], C, mnC);
  for (int r = 0; r < 16; ++r) p0[r] = __builtin_amdgcn_exp2f(p0[r]);
}
__device__ __forceinline__ void finishSM(f32x16& p0, f32x16& p1, float alpha, float& l_reg, bf16x8& pa0, bf16x8& pa1, bf16x8& pa2, bf16x8& pa3) {
  for (int r = 0; r < 16; ++r) p1[r] = __builtin_amdgcn_exp2f(p1[r]);
  float ps = 0; for (int r = 0; r < 16; ++r) ps += p0[r]; for (int r = 0; r < 16; ++r) ps += p1[r];
  { auto rr = __builtin_amdgcn_permlane32_swap(__float_as_uint(ps), __float_as_uint(ps), false, false);
    ps = __uint_as_float(rr[0]) + __uint_as_float(rr[1]); }
  l_reg = l_reg * alpha + ps;
#define PK4(P, BASE, OUT) do { unsigned a0 = cvtpk(P[BASE + 0], P[BASE + 1]), a1 = cvtpk(P[BASE + 2], P[BASE + 3]);   \
    unsigned b0 = cvtpk(P[BASE + 4], P[BASE + 5]), b1 = cvtpk(P[BASE + 6], P[BASE + 7]);                              \
    auto r0 = __builtin_amdgcn_permlane32_swap(a0, b0, false, false); auto r1 = __builtin_amdgcn_permlane32_swap(a1, b1, false, false); \
    u32x4 w = {r0[0], r1[0], r0[1], r1[1]}; OUT = *reinterpret_cast<bf16x8*>(&w); } while (0)
  PK4(p0, 0, pa0); PK4(p0, 8, pa1); PK4(p1, 0, pa2); PK4(p1, 8, pa3);
#undef PK4
}
__device__ __forceinline__ void qkt(f32x16& p0, f32x16& p1, const bf16_t* Ks, const bf16x8* qr, int r32, int hi) {
  p0 = f32x16{}; p1 = f32x16{};
  for (int d0 = 0; d0 < 8; ++d0) { int cb = (d0 * 16 + hi * 8) * 2;
    bf16x8 b0 = *reinterpret_cast<const bf16x8*>((const char*)Ks + KSWZ(r32, cb));
    bf16x8 b1 = *reinterpret_cast<const bf16x8*>((const char*)Ks + KSWZ(32 + r32, cb));
    p0 = __builtin_amdgcn_mfma_f32_32x32x16_bf16(b0, qr[d0], p0, 0, 0, 0);
    p1 = __builtin_amdgcn_mfma_f32_32x32x16_bf16(b1, qr[d0], p1, 0, 0, 0); }
}
__device__ __forceinline__ int v_st(int k, int c) { const int kk = (k & ~0xC) | ((k & 4) << 1) | ((k & 8) >> 1); return ((kk >> 3) * 4 + (c >> 5)) * 512 + ((kk & 7) * 32 + (c & 31)) * 2; }
__device__ __forceinline__ int v_rd_base(int lane) { return ((lane & 3) << 3) | (((lane >> 2) & 3) << 6) | (((lane >> 4) & 1) << 5) | (((lane >> 5) & 1) << 8); }
constexpr int v_rd_off(int d0, int ks, int half) { return d0 * 512 + ks * 4096 + half * 2048; }
template <int OFF> __device__ __forceinline__ s16x4 tr_read(int vb) {
  s16x4 r; asm volatile("ds_read_b64_tr_b16 %0, %1 offset:%2" : "=&v"(r) : "v"(vb), "i"(OFF) : "memory"); return r;
}
template <int D0> __device__ __forceinline__ void pv_one(f32x16& od, int vb, bf16x8 pa0, bf16x8 pa1, bf16x8 pa2, bf16x8 pa3) {
  const s16x4 l0 = tr_read<v_rd_off(D0, 0, 0)>(vb), h0 = tr_read<v_rd_off(D0, 0, 1)>(vb), l1 = tr_read<v_rd_off(D0, 1, 0)>(vb), h1 = tr_read<v_rd_off(D0, 1, 1)>(vb);
  const s16x4 l2 = tr_read<v_rd_off(D0, 2, 0)>(vb), h2 = tr_read<v_rd_off(D0, 2, 1)>(vb), l3 = tr_read<v_rd_off(D0, 3, 0)>(vb), h3 = tr_read<v_rd_off(D0, 3, 1)>(vb);
  asm volatile("s_waitcnt lgkmcnt(0)" ::: "memory"); SBAR();
#define PK(L, H) (bf16x8){L[0], L[1], L[2], L[3], H[0], H[1], H[2], H[3]}
  od = __builtin_amdgcn_mfma_f32_32x32x16_bf16(pa0, PK(l0, h0), od, 0, 0, 0);
  od = __builtin_amdgcn_mfma_f32_32x32x16_bf16(pa1, PK(l1, h1), od, 0, 0, 0);
  od = __builtin_amdgcn_mfma_f32_32x32x16_bf16(pa2, PK(l2, h2), od, 0, 0, 0);
  od = __builtin_amdgcn_mfma_f32_32x32x16_bf16(pa3, PK(l3, h3), od, 0, 0, 0);
#undef PK
}
__device__ __forceinline__ void pv_d0(f32x16* o, int vb, bf16x8 pa0, bf16x8 pa1, bf16x8 pa2, bf16x8 pa3) {
  pv_one<0>(o[0], vb, pa0, pa1, pa2, pa3); pv_one<1>(o[1], vb, pa0, pa1, pa2, pa3); pv_one<2>(o[2], vb, pa0, pa1, pa2, pa3); pv_one<3>(o[3], vb, pa0, pa1, pa2, pa3);
}
__device__ __forceinline__ void attn_dense_body(const bf16_t* __restrict__ Qb, const bf16_t* __restrict__ Kh, const bf16_t* __restrict__ Vh,
                                                const bf16_t* __restrict__ Gb, bf16_t* __restrict__ Yb, int seq, char* lds) {
  constexpr int SDEPTH = 1;
  const int tid = tidx(), wid = __builtin_amdgcn_readfirstlane(tid >> 6), lane = tid & 63, r32 = lane & 31, hi = lane >> 5;
  bf16_t* V_lds = (bf16_t*)lds; bf16_t* K_lds = (bf16_t*)(lds + 2 * SHM_V);
  float* ws = (float*)(lds + 2 * SHM_V + 2 * SHM_K) + wid * 64; float* li_l = ws; float* al_l = ws + 32;
  float m_reg = -1e30f, l_reg = 0; f32x16 o[4] = {}; bf16x8 qr[8];
  const bf16_t* Qw = Qb + (long)(wid * QBLK + r32) * LDQ + hi * 8;
#pragma unroll
  for (int d0 = 0; d0 < 8; ++d0) qr[d0] = ld8(Qw + d0 * 16);
  const int sr = tid >> 4, sc = (tid & 15) * 8, vst0 = v_st(sr, sc), vst1 = v_st(32 + sr, sc);
  const int vb0 = (int)(uintptr_t)V_lds + v_rd_base(lane);
  struct { bf16x8 vs0, vs1, ks0, ks1; } sr_[SDEPTH];
#define SLOAD(i, k0) do { sr_[i].vs0 = ld8(&Vh[(long)((k0) + sr) * LDK + sc]); sr_[i].vs1 = ld8(&Vh[(long)((k0) + 32 + sr) * LDK + sc]); \
    sr_[i].ks0 = ld8(&Kh[(long)((k0) + sr) * LDK + sc]); sr_[i].ks1 = ld8(&Kh[(long)((k0) + 32 + sr) * LDK + sc]); } while (0)
#define SWRITE(b, i) do { *(bf16x8*)((char*)V_lds + (b) * SHM_V + vst0) = sr_[i].vs0;          \
    *(bf16x8*)((char*)V_lds + (b) * SHM_V + vst1) = sr_[i].vs1; int kc = sc * 2;               \
    *(bf16x8*)((char*)K_lds + (b) * SHM_K + KSWZ(sr, kc)) = sr_[i].ks0;                       \
    *(bf16x8*)((char*)K_lds + (b) * SHM_K + KSWZ(32 + sr, kc)) = sr_[i].ks1; } while (0)
#define SWAIT() do { asm volatile("s_waitcnt vmcnt(0)" ::: "memory"); } while (0)
#define RESC(a) do { if (__any((a) < 1.f)) { if (hi == 0) al_l[r32] = (a); asm volatile("s_waitcnt lgkmcnt(0)" ::: "memory"); \
    for (int d = 0; d < 4; ++d) for (int r = 0; r < 16; ++r) o[d][r] *= al_l[crow(r, hi)]; } } while (0)
  f32x16 pA0, pA1, pB0, pB1; float mnA, mnB, alA, alB; bf16x8 pa0, pa1, pa2, pa3; const int NT = seq / KVBLK;
  constexpr int SE = 0, SO = SDEPTH - 1;
  SLOAD(SE, 0); asm volatile("s_waitcnt vmcnt(0)" ::: "memory"); SWRITE(0, SE); __syncthreads();
  qkt(pA0, pA1, K_lds, qr, r32, hi); partialSM(pA0, pA1, m_reg, mnA, alA);
  SLOAD(SO, KVBLK);
  SWAIT(); SWRITE(1, SO); __syncthreads();
  for (int j = 1; j + 1 < NT; j += 2) {
    SBAR(); qkt(pB0, pB1, (bf16_t*)((char*)K_lds + SHM_K), qr, r32, hi);
    finishSM(pA0, pA1, alA, l_reg, pa0, pa1, pa2, pa3); SBAR();
    SLOAD(SO, (j + SDEPTH) * KVBLK); SBAR();
    pv_d0(o, vb0, pa0, pa1, pa2, pa3); partialSM(pB0, pB1, m_reg, mnB, alB);
    __syncthreads(); SWAIT(); SWRITE(0, SE);
    RESC(alB); __syncthreads();
    SBAR(); qkt(pA0, pA1, K_lds, qr, r32, hi);
    finishSM(pB0, pB1, alB, l_reg, pa0, pa1, pa2, pa3); SBAR();
    SLOAD(SE, (j + 1 + SDEPTH) * KVBLK); SBAR();
    pv_d0(o, vb0 + (int)SHM_V, pa0, pa1, pa2, pa3); partialSM(pA0, pA1, m_reg, mnA, alA);
    __syncthreads(); SWAIT(); SWRITE(1, SO);
    RESC(alA); __syncthreads();
  }
  SBAR(); qkt(pB0, pB1, (bf16_t*)((char*)K_lds + SHM_K), qr, r32, hi);
  finishSM(pA0, pA1, alA, l_reg, pa0, pa1, pa2, pa3); SBAR();
  pv_d0(o, vb0, pa0, pa1, pa2, pa3); partialSM(pB0, pB1, m_reg, mnB, alB);
  __syncthreads(); RESC(alB);
  finishSM(pB0, pB1, alB, l_reg, pa0, pa1, pa2, pa3); SBAR();
  pv_d0(o, vb0 + (int)SHM_V, pa0, pa1, pa2, pa3);
  if (hi == 0) li_l[r32] = l_reg; asm volatile("s_waitcnt lgkmcnt(0)" ::: "memory");
  { const int ln = opaque(lane), r32e = ln & 31, hie = ln >> 5;
    const bf16_t* Gl = Gb + (long)(wid * QBLK + 4 * hie) * LDU + r32e; bf16_t* Yl = Yb + (long)(wid * QBLK + 4 * hie) * DM + r32e;
#pragma unroll
  for (int r = 0; r < 16; ++r) { const int ro = (r & 3) + 8 * (r >> 2); const float rl = __builtin_amdgcn_rcpf(li_l[ro + 4 * hie]);
    asm volatile("" ::: "memory");
#pragma unroll
    for (int d0 = 0; d0 < 4; ++d0) { const float gv = bf2f(Gl[ro * LDU + d0 * 32]);
      Yl[ro * DM + d0 * 32] = f2bf(o[d0][r] * rl * silu(gv)); } } }
  __syncthreads();
#undef SLOAD
#undef SWRITE
#undef SWAIT
#undef RESC
}
}

__device__ __forceinline__ void attn_phase(const PV& p, int L, unsigned char* lds) {
    const bf16_t* U = (const bf16_t*)(p.ws + WS_UT); bf16_t* Y = (bf16_t*)(p.ws + WS_Y);
    const int nqb = L / 256, NB = TG / L;
    const int nitem = NB * 8 * nqb;
    const int ipp = 4 * nqb;
    for (int k = 0; k * (int)gridDim.x < nitem; ++k) {
        int it;
        if (gridDim.x == 256) { const int xcd = blockIdx.x & 7, slot = blockIdx.x >> 3; const int sub = ipp / 32;
            const int pair = (k / sub) * 8 + xcd; it = pair * ipp + (k % sub) * 32 + slot; }
        else { it = blockIdx.x + k * gridDim.x; if (it >= nitem) break; }
        const int qb = it % nqb; const int hq = (it / nqb) & 7; const int b = it / (nqb * 8); const int kvh = hq >> 2;
        const size_t row0 = (size_t)b * L + (size_t)qb * 256;
        att::attn_dense_body(U + row0 * LDU + hq * 128, U + (size_t)b * L * LDU + 1024 + kvh * 128, U + (size_t)b * L * LDU + 1280 + kvh * 128,
                             U + row0 * LDU + 1536 + hq * 128, Y + row0 * DM + hq * 128, L, (char*)lds);
    }
}

__device__ __forceinline__ void run_phase(const Params& pin, int ph, unsigned char* lds) {
    const PV p(pin, opaque_zero());
    if (ph == 0) { if (PHMASK & 1) prologue_phase(p, lds); return; }
    const int q = ph - 1, g = q / 21, r = q % 21;
    const int L = g == 0 ? 2048 : 4096;
    if (r == 0) { if (PHMASK & 2) cvt_phase(p, g); return; }
    const int layer = (r - 1) / 5, sub = (r - 1) % 5, j = layer >> 1;
    bf16_t* XB = (bf16_t*)(p.ws + WS_XB); bf16_t* UT = (bf16_t*)(p.ws + WS_UT); bf16_t* Y = (bf16_t*)(p.ws + WS_Y);
    if (sub == 4) { if (PHMASK & 4) ln_phase(p, g, layer); return; }
    if (sub == 3) {
        const bf16_t* WT = (const bf16_t*)(p.ws + ((layer & 1) ? WS_AWOUT : WS_HWOUT)) + (size_t)j * 1024 * 1024;
        EpiRes E; E.out = p.out + (size_t)g * TG * DM; E.xb = XB; E.last = layer == 3; E.bias = ((layer & 1) ? p.in(21) : p.in(15)) + j * 1024;
        if (PHMASK & 8) run_gemm(lds, Y, WT, TG, 1024, E); return;
    }
    if ((layer & 1) == 0) {
        if (sub == 0) {
            const bf16_t* WT = (const bf16_t*)(p.ws + WS_HWIN) + (size_t)j * 4096 * 1024;
            EpiUT E1; E1.O = UT; E1.bias = p.in(3) + j * 4096; E1.L = L;
            if (PHMASK & 16) run_gemm(lds, WT, XB, 3072, TG, E1);
            EpiBf16B E2; E2.O = (bf16_t*)(p.ws + WS_GATE); E2.ldc = 1024; E2.bias = p.in(3) + j * 4096 + 3072;
            if (PHMASK & 32) run_gemm(lds, XB, WT + (size_t)3072 * 1024, TG, 1024, E2);
            if (PHMASK & 2048) { if (g == 0) filter_phase<2048>(p, j, g * 2 + j, lds); else filter_phase<4096>(p, j, g * 2 + j, lds); }
        } else if (sub == 1) { if (g == 0) { if (PHMASK & 64) conv_phase<16>(p, j, g * 2 + j, lds); } else { if (PHMASK & 128) conv_phase<8>(p, j, g * 2 + j, lds); } }
        else if (sub == 2) { if (PHMASK & 256) ygate_phase(p, L, lds); }
    } else {
        if (sub == 0) {
            const bf16_t* WT = (const bf16_t*)(p.ws + WS_AWIN) + (size_t)j * 2560 * 1024;
            EpiBf16B E; E.O = UT; E.ldc = LDU; E.bias = p.in(17) + j * 2560;
            if (PHMASK & 32) run_gemm(lds, XB, WT, TG, 2560, E);
        } else if (sub == 1) { if (PHMASK & 512) rope_phase(p, j, L); }
        else if (sub == 2) { if (PHMASK & 1024) attn_phase(p, L, lds); }
    }
}

#ifndef DUPMASK
#define DUPMASK 0
#endif
__device__ __forceinline__ bool dup_phase(int ph) {
    if (ph == 0) return (DUPMASK >> 5) & 1;
    const int r = (ph - 1) % 21; if (r == 0) return (DUPMASK >> 5) & 1;
    const int layer = (r - 1) / 5, sub = (r - 1) % 5;
    if (sub > 2) return false;
    if ((layer & 1) == 0) return (DUPMASK >> sub) & 1;
    if (sub == 0) return (DUPMASK >> 3) & 1;
    if (sub == 2) return (DUPMASK >> 4) & 1;
    return false;
}
__device__ __forceinline__ void grid_barrier(unsigned* ctr, unsigned target) {
    asm volatile("s_waitcnt vmcnt(0)" ::: "memory");
    __syncthreads();
    if (tidx() == 0) {
        __builtin_amdgcn_fence(__ATOMIC_RELEASE, "agent");
        asm volatile("s_waitcnt vmcnt(0)" ::: "memory");
        (void)__hip_atomic_fetch_add(ctr, 1u, __ATOMIC_RELAXED, __HIP_MEMORY_SCOPE_AGENT);
        while (__hip_atomic_load(ctr, __ATOMIC_RELAXED, __HIP_MEMORY_SCOPE_AGENT) < target) __builtin_amdgcn_s_sleep(1);
        __builtin_amdgcn_fence(__ATOMIC_ACQUIRE, "agent");
        asm volatile("s_waitcnt vmcnt(0)" ::: "memory");
    }
    __syncthreads();
}

__global__ __launch_bounds__(512, 2) void mk_forward(Params p) {
    extern __shared__ __attribute__((aligned(16))) unsigned char smem[];
    cg::grid_group grid = cg::this_grid();
    unsigned* bar = (unsigned*)(p.ws + WS_BAR);
    unsigned nbar = 0;
    for (int ph = p.ph_lo; ph < p.ph_hi; ++ph) {
        if (ph == 0 && blockIdx.x == 0 && threadIdx.x == 0) __hip_atomic_store(bar, 0u, __ATOMIC_RELAXED, __HIP_MEMORY_SCOPE_AGENT);
        run_phase(p, ph, smem);
        if (ph + 1 < p.ph_hi) {
            if (ph == p.ph_lo) grid.sync();
            else { ++nbar; grid_barrier(bar, nbar * gridDim.x); }
        }
    }
}

extern "C" void kernel_launch(void* const* d_in, const int* in_sizes, int n_in, void* d_out, int out_size, void* d_ws, size_t ws_size, hipStream_t stream) {
    static int grid = 0;
    if (grid == 0) {
        if (n_in != 24 || ws_size < WS_END) { fprintf(stderr, "kernel_launch: unexpected n_in %d / ws %zu\n", n_in, ws_size); grid = -1; return; }
        int dev = 0, cus = 0, per_cu = 0;
        hipGetDevice(&dev); hipDeviceGetAttribute(&cus, hipDeviceAttributeMultiprocessorCount, dev);
        if (hipFuncSetAttribute((const void*)mk_forward, hipFuncAttributeMaxDynamicSharedMemorySize, LDS_BYTES) != hipSuccess) { fprintf(stderr, "kernel_launch: hipFuncSetAttribute failed\n"); grid = -1; return; }
        if (hipOccupancyMaxActiveBlocksPerMultiprocessor(&per_cu, (const void*)mk_forward, 512, LDS_BYTES) != hipSuccess || per_cu < 1) { fprintf(stderr, "kernel_launch: occupancy query gives %d\n", per_cu); per_cu = 1; }
        (void)hipGetLastError();
        grid = cus * per_cu;
    }
    if (grid < 0) return;
    Params p{};
    for (int i = 0; i < 24; ++i) p.in[i] = (const float*)d_in[i];
    p.out = (float*)d_out; p.ws = (unsigned char*)d_ws;
#if MK_LAUNCHES == 1
    p.ph_lo = 0; p.ph_hi = NPHASE;
    void* args[] = {&p};
    hipError_t e = hipLaunchCooperativeKernel((const void*)mk_forward, dim3(grid), dim3(512), args, LDS_BYTES, stream);
    if (e != hipSuccess) fprintf(stderr, "cooperative launch failed: %s (grid %d)\n", hipGetErrorString(e), grid);
#else
    for (int ph = 0; ph < NPHASE; ++ph) { p.ph_lo = ph; p.ph_hi = ph + 1;
        hipLaunchKernelGGL(mk_forward, dim3(grid), dim3(512), LDS_BYTES, stream, p); }
#endif
}
```

```cpp
#include <hip/hip_runtime.h>
#include <hip/hip_cooperative_groups.h>
#include <cstdio>
#include <cstdint>
namespace cg = cooperative_groups;

#ifndef MK_LAUNCHES
#define MK_LAUNCHES 1
#endif

__device__ __forceinline__ int tidx() { int t = threadIdx.x; asm volatile("" : "+v"(t)); return t; }

namespace pg8 {
#define PG8_LAS __attribute__((address_space(3)))
typedef unsigned short bf16_t;
typedef short bf16x8 __attribute__((ext_vector_type(8)));
typedef float f32x4 __attribute__((ext_vector_type(4)));
typedef unsigned u32x4 __attribute__((ext_vector_type(4)));
constexpr int BM = 256, BK = 64, HALF = 128, HTB = HALF * BK * 2  , STAGE_BYTES = 8 * HTB, NXCD = 8, WGM = 8;

__host__ __device__ __forceinline__ int lds_byte(int r, int c) { const int st = (r >> 4) * 2 + (c >> 5), rr = r & 15, cc = c & 31, ob = rr * 64 + cc * 2; return st * 1024 + (ob ^ (((ob >> 9) & 1) << 5)); }
__host__ __device__ __forceinline__ void stage_rc(int b, int& R, int& C) { const int st = b / 1024, sb = b % 1024, swz = sb ^ (((sb >> 9) & 1) << 5); R = (st >> 1) * 16 + swz / 64; C = (st & 1) * 32 + (swz % 64) / 2; }
__host__ __device__ __forceinline__ int perm32(int rho) { const int n = rho >> 4, i = rho & 15; return 8 * (i >> 2) + 4 * n + (i & 3); }

struct Unit { int pm, pn; };
struct Gemm { const bf16_t* A; const bf16_t* Bt; int M, N, K; };
struct StaticOrder {
    int nM, nN, nwg, G, c;
    __host__ __device__ void init(int M, int N, int G_, int c_) { nM = M / BM; nN = N / BM; nwg = nM * nN; G = G_; c = c_; }
    __host__ __device__ bool next(int i, Unit& u) const {
        const long L = (long)i * G + c; if (L >= nwg) return false;
        int wgid = (int)L; { const int q = nwg / NXCD, r = nwg % NXCD, xcd = wgid % NXCD, off = wgid / NXCD; wgid = (xcd < r ? xcd * (q + 1) : r * (q + 1) + (xcd - r) * q) + off; }
        const int nig = WGM * nN, gid = wgid / nig, fm = gid * WGM, gsz = (nM - fm) < WGM ? (nM - fm) : WGM;
        u.pm = fm + ((wgid % nig) % gsz); u.pn = (wgid % nig) / gsz; return true;
    }
    __device__ __forceinline__ void a_ready(const Unit&) const {}
    __device__ __forceinline__ void done(const Unit&) const {}
};
__device__ __forceinline__ unsigned cvt_pk_bf16(float lo, float hi) { unsigned r; asm volatile("v_cvt_pk_bf16_f32 %0, %1, %2" : "=v"(r) : "v"(lo), "v"(hi)); return r; }
template <class Epi, class Sched, bool STAMP = false>
__device__ __forceinline__ void gemm_phase(PG8_LAS unsigned char* lds, const Gemm g, const Sched& S, const Epi& E, unsigned long long* stamps) {
    const int tid = tidx(), wid = __builtin_amdgcn_readfirstlane(tid >> 6), lane = tid & 63, wr = wid >> 2, wc = wid & 3, fr = lane & 15, fq = lane >> 4;
    const int K = g.K, nt = K / BK;
    unsigned voffA[2], voffB[2];
#pragma unroll
    for (int i = 0; i < 2; ++i) { int R, C; stage_rc(tid * 16 + i * 8192, R, C); const int Rb = Epi::PERM ? ((R & ~31) + perm32(R & 31)) : R;
        voffA[i] = (unsigned)(R * K + C) * 2u; voffB[i] = (unsigned)(Rb * K + C) * 2u; }
    const size_t kstep = (size_t)(BK * 2);
    const size_t hstep = (size_t)HALF * K * 2;
    const size_t tstep = 2 * hstep;
    const unsigned ldsw = (unsigned)wid * 1024u;
    const int aoff = lds_byte(wr * 64 + fr, fq * 8), boff = lds_byte(wc * 32 + fr, fq * 8);
#define PG8_SA(b, h) (((b) * 2 + (h)) * HTB)
#define PG8_SB(b, h) ((4 + (b) * 2 + (h)) * HTB)
#define PG8_STAGE(bufoff, gbase, voff) do { _Pragma("unroll") for (int _i = 0; _i < 2; ++_i) \
        __builtin_amdgcn_global_load_lds((const unsigned*)((const char*)(gbase) + (voff)[_i]), (PG8_LAS unsigned*)(lds + (bufoff) + ldsw + _i * 8192), 16, 0, 0); } while (0)
#define PG8_LDA(dst, b, h) do { _Pragma("unroll") for (int m = 0; m < 4; ++m) _Pragma("unroll") for (int k = 0; k < 2; ++k) dst[m][k] = *(const PG8_LAS bf16x8*)(lds + PG8_SA(b, h) + aoff + m * 2048 + k * 1024); } while (0)
#define PG8_LDB(dst, b, h) do { _Pragma("unroll") for (int n = 0; n < 2; ++n) _Pragma("unroll") for (int k = 0; k < 2; ++k) dst[n][k] = *(const PG8_LAS bf16x8*)(lds + PG8_SB(b, h) + boff + n * 2048 + k * 1024); } while (0)
#define PG8_MMA(ai, bj, At, Bt) do { __builtin_amdgcn_s_setprio(1); _Pragma("unroll") for (int m = 0; m < 4; ++m) _Pragma("unroll") for (int n = 0; n < 2; ++n) _Pragma("unroll") for (int k = 0; k < 2; ++k) \
        acc[ai][bj][m][n] = __builtin_amdgcn_mfma_f32_16x16x32_bf16(Bt[n][k], At[m][k], acc[ai][bj][m][n], 0, 0, 0); __builtin_amdgcn_s_setprio(0); } while (0)
#define PG8_WAIT_V(n) asm volatile("s_waitcnt vmcnt(" #n ")" ::: "memory")
#define PG8_WAIT_L(n) asm volatile("s_waitcnt lgkmcnt(" #n ")" ::: "memory")
#define PG8_BAR __builtin_amdgcn_s_barrier()
#define PG8_SCHED __builtin_amdgcn_sched_barrier(0)
    Unit cur, nxt; int ui = 0;
    if (!S.next(0, cur)) return;
    f32x4 acc[2][2][4][2];
#pragma unroll
    for (int a = 0; a < 2; ++a)
#pragma unroll
        for (int b = 0; b < 2; ++b)
#pragma unroll
            for (int m = 0; m < 4; ++m)
#pragma unroll
                for (int n = 0; n < 2; ++n) acc[a][b][m][n] = (f32x4){0.f, 0.f, 0.f, 0.f};
    bf16x8 At[4][2], B0[2][2], B1[2][2];
    const char* cA = (const char*)g.A + (size_t)cur.pm * tstep; const char* cB = (const char*)g.Bt + (size_t)cur.pn * tstep;
    S.a_ready(cur);
    PG8_STAGE(PG8_SB(0, 0), cB, voffB); PG8_STAGE(PG8_SA(0, 0), cA, voffA); PG8_STAGE(PG8_SB(0, 1), cB + hstep, voffB); PG8_STAGE(PG8_SA(0, 1), cA + hstep, voffA);
    if (wr == 1) PG8_BAR;
    PG8_WAIT_V(4); PG8_BAR;
    PG8_STAGE(PG8_SB(1, 0), cB + kstep, voffB); PG8_STAGE(PG8_SA(1, 0), cA + kstep, voffA); PG8_STAGE(PG8_SB(1, 1), cB + hstep + kstep, voffB);
    PG8_WAIT_V(6); PG8_BAR;
    for (;;) {
        const bool has_next = S.next(ui + 1, nxt);
        const char* nA = has_next ? (const char*)g.A + (size_t)nxt.pm * tstep : cA; const char* nB = has_next ? (const char*)g.Bt + (size_t)nxt.pn * tstep : cB;
        for (int t = 0; t < nt; t += 2) {
            const bool last = (t == nt - 2);
            const char* a1 = cA + (size_t)(t + 1) * kstep;
            const char* a2 = last ? nA : cA + (size_t)(t + 2) * kstep; const char* b2 = last ? nB : cB + (size_t)(t + 2) * kstep;
            const char* a3 = a2 + kstep; const char* b3 = b2 + kstep;
            if (last && has_next) S.a_ready(nxt);
            PG8_LDB(B0, 0, 0); PG8_SCHED; PG8_LDA(At, 0, 0); PG8_STAGE(PG8_SA(1, 1), a1 + hstep, voffA);
            PG8_WAIT_L(8); PG8_BAR; PG8_WAIT_L(0); PG8_MMA(0, 0, At, B0); PG8_BAR; PG8_SCHED;
            PG8_LDB(B1, 0, 1); PG8_STAGE(PG8_SB(0, 0), b2, voffB);
            PG8_BAR; PG8_WAIT_L(0); PG8_MMA(0, 1, At, B1); PG8_BAR;
            PG8_LDA(At, 0, 1); PG8_STAGE(PG8_SA(0, 0), a2, voffA);
            PG8_BAR; PG8_WAIT_L(0); PG8_MMA(1, 0, At, B0); PG8_BAR; PG8_SCHED;
            PG8_STAGE(PG8_SB(0, 1), b2 + hstep, voffB);
            PG8_WAIT_V(6); PG8_BAR; PG8_MMA(1, 1, At, B1); PG8_BAR;
            PG8_LDB(B0, 1, 0); PG8_SCHED; PG8_LDA(At, 1, 0); PG8_STAGE(PG8_SA(0, 1), a2 + hstep, voffA);
            PG8_WAIT_L(8); PG8_BAR; PG8_WAIT_L(0); PG8_MMA(0, 0, At, B0); PG8_BAR; PG8_SCHED;
            PG8_LDB(B1, 1, 1); PG8_STAGE(PG8_SB(1, 0), b3, voffB);
            PG8_BAR; PG8_WAIT_L(0); PG8_MMA(0, 1, At, B1); PG8_BAR;
            PG8_LDA(At, 1, 1); PG8_STAGE(PG8_SA(1, 0), a3, voffA);
            PG8_BAR; PG8_WAIT_L(0); PG8_MMA(1, 0, At, B0); PG8_BAR; PG8_SCHED;
            PG8_STAGE(PG8_SB(1, 1), b3 + hstep, voffB);
            PG8_WAIT_V(6); PG8_BAR; PG8_MMA(1, 1, At, B1); PG8_BAR;
        }
        if constexpr (!Epi::AFTER_DRAIN) { E(acc, cur, wr, wc, fr, fq); S.done(cur); }
        if (!has_next) break;
#pragma unroll
        for (int a = 0; a < 2; ++a)
#pragma unroll
            for (int b = 0; b < 2; ++b)
#pragma unroll
                for (int m = 0; m < 4; ++m)
#pragma unroll
                    for (int n = 0; n < 2; ++n) acc[a][b][m][n] = (f32x4){0.f, 0.f, 0.f, 0.f};
        cur = nxt; cA = nA; cB = nB; ++ui;
    }
    PG8_WAIT_V(0);
    if (wr == 0) PG8_BAR;
    PG8_BAR;
    if constexpr (Epi::AFTER_DRAIN) { E.fused(acc, cur, wr, wc, fr, fq, lds, wid, lane); S.done(cur); }
#undef PG8_SA
#undef PG8_SB
#undef PG8_STAGE
#undef PG8_LDA
#undef PG8_LDB
#undef PG8_MMA
#undef PG8_WAIT_V
#undef PG8_WAIT_L
#undef PG8_BAR
#undef PG8_SCHED
}
}

using pg8::bf16_t; using pg8::bf16x8; using pg8::f32x4; using pg8::u32x4; using pg8::cvt_pk_bf16;
typedef short s16x4 __attribute__((ext_vector_type(4)));
typedef float f32x8 __attribute__((ext_vector_type(8)));
typedef float f32x16 __attribute__((ext_vector_type(16)));
typedef unsigned u32x2 __attribute__((ext_vector_type(2)));

constexpr int DM = 1024, TG = 32768;
constexpr size_t MiB = 1u << 20;
constexpr size_t WS_HWIN = 0, WS_HWOUT = 16 * MiB, WS_AWIN = 20 * MiB, WS_AWOUT = 30 * MiB, WS_H2 = 34 * MiB, WS_XB = 38 * MiB,
                 WS_UT = 102 * MiB, WS_GATE = 294 * MiB, WS_Y = 358 * MiB, WS_FILT = 422 * MiB, WS_SUMSQ = 454 * MiB, WS_BAR = 456 * MiB, WS_END = 457 * MiB;
constexpr int LDS_BYTES = 136 * 1024;
constexpr float ALPHA = 1.681792830507429f;
constexpr int NPHASE = 1 + 2 * 21;
#ifndef PHMASK
#define PHMASK 0xFFFF
#endif
#ifndef PROBE_WHAT
#define PROBE_WHAT 0
#endif

struct Params { const float* in[24]; float* out; unsigned char* ws; int ph_lo, ph_hi; };
struct PV { const Params& q; int z; float* out; unsigned char* ws;
    __device__ __forceinline__ PV(const Params& q_, int z_) : q(q_), z(z_), out(q_.out + z_), ws(q_.ws + z_) {}
    __device__ __forceinline__ const float* in(int k) const { return q.in[k + z]; } };

__device__ __forceinline__ float bf2f(unsigned short x) { return __uint_as_float(((unsigned)x) << 16); }
__device__ __forceinline__ float bf2f_s(short x) { return __uint_as_float(((unsigned)(unsigned short)x) << 16); }
__device__ __forceinline__ unsigned short f2bf(float x) { return (unsigned short)(cvt_pk_bf16(x, 0.f) & 0xffffu); }
__device__ __forceinline__ float wave_sum(float v) {
#pragma unroll
    for (int o = 32; o >= 1; o >>= 1) v += __shfl_xor(v, o, 64);
    return v;
}
template <class T> __device__ __forceinline__ T* launder(T* q) {
    unsigned long long w = (unsigned long long)q; unsigned lo = (unsigned)w, hi = (unsigned)(w >> 32);
    asm volatile("" : "+v"(lo), "+v"(hi));
    lo = __builtin_amdgcn_readfirstlane(lo); hi = __builtin_amdgcn_readfirstlane(hi);
    return (T*)(((unsigned long long)hi << 32) | lo);
}
__device__ __forceinline__ int opaque_zero() { int z = 0; asm volatile("" : "+v"(z)); return __builtin_amdgcn_readfirstlane(z); }
__device__ __forceinline__ int opaque(int x) { asm volatile("" : "+v"(x)); return x; }
__device__ __forceinline__ float silu(float x) { return x / (1.f + __expf(-x)); }

struct EpiBf16B {
    static constexpr bool PERM = true, AFTER_DRAIN = false;
    bf16_t* O; int ldc; const float* bias;
    __device__ __forceinline__ void operator()(const f32x4 (&acc)[2][2][4][2], const pg8::Unit& u, int wr, int wc, int fr, int fq) const {
        const int row0 = u.pm * 256 + wr * 64 + fr, col0 = u.pn * 256 + wc * 32 + 8 * fq;
        f32x4 bv[2][2];
#pragma unroll
        for (int bj = 0; bj < 2; ++bj)
#pragma unroll
            for (int n = 0; n < 2; ++n) bv[bj][n] = *(const f32x4*)(bias + col0 + bj * 128 + 4 * n);
#pragma unroll
        for (int ai = 0; ai < 2; ++ai)
#pragma unroll
            for (int m = 0; m < 4; ++m) { bf16_t* rowp = O + (size_t)(row0 + ai * 128 + m * 16) * ldc + col0;
#pragma unroll
                for (int bj = 0; bj < 2; ++bj) { f32x4 v0 = acc[ai][bj][m][0] + bv[bj][0], v1 = acc[ai][bj][m][1] + bv[bj][1];
                    u32x4 w; w.x = cvt_pk_bf16(v0[0], v0[1]); w.y = cvt_pk_bf16(v0[2], v0[3]); w.z = cvt_pk_bf16(v1[0], v1[1]); w.w = cvt_pk_bf16(v1[2], v1[3]);
                    *(u32x4*)(rowp + bj * 128) = w; } }
    }
};
struct EpiUT {
    static constexpr bool PERM = true, AFTER_DRAIN = false;
    bf16_t* O; const float* bias; int L;
    __device__ __forceinline__ void operator()(const f32x4 (&acc)[2][2][4][2], const pg8::Unit& u, int wr, int wc, int fr, int fq) const {
        const int row0 = u.pm * 256 + wr * 64 + fr; const int tokt = u.pn * 256; const int b = tokt / L; const int t0 = tokt - b * L + wc * 32 + 8 * fq;
#pragma unroll
        for (int ai = 0; ai < 2; ++ai)
#pragma unroll
            for (int m = 0; m < 4; ++m) { const int ch = row0 + ai * 128 + m * 16; const float bs = bias[ch];
                bf16_t* rowp = O + ((size_t)b * 3072 + ch) * L + t0;
#pragma unroll
                for (int bj = 0; bj < 2; ++bj) { f32x4 v0 = acc[ai][bj][m][0] + bs, v1 = acc[ai][bj][m][1] + bs;
                    u32x4 w; w.x = cvt_pk_bf16(v0[0], v0[1]); w.y = cvt_pk_bf16(v0[2], v0[3]); w.z = cvt_pk_bf16(v1[0], v1[1]); w.w = cvt_pk_bf16(v1[2], v1[3]);
                    *(u32x4*)(rowp + bj * 128) = w; } }
    }
};
struct EpiRes {
    static constexpr bool PERM = true, AFTER_DRAIN = false;
    float* out; bf16_t* xb; const float* bias; int last; bf16_t* dst;
    __device__ __forceinline__ void operator()(const f32x4 (&acc)[2][2][4][2], const pg8::Unit& u, int wr, int wc, int fr, int fq) const {
        const int row0 = u.pm * 256 + wr * 64 + fr, col0 = u.pn * 256 + wc * 32 + 8 * fq;
        f32x4 bv[2][2];
#pragma unroll
        for (int bj = 0; bj < 2; ++bj)
#pragma unroll
            for (int n = 0; n < 2; ++n) bv[bj][n] = *(const f32x4*)(bias + col0 + bj * 128 + 4 * n);
#pragma unroll
        for (int ai = 0; ai < 2; ++ai)
#pragma unroll
            for (int m = 0; m < 4; ++m) { const size_t ro = (size_t)(row0 + ai * 128 + m * 16) * DM + col0;
#pragma unroll
                for (int bj = 0; bj < 2; ++bj) { const bf16x8 xv = *(const bf16x8*)(xb + ro + bj * 128);
                    f32x4 v0, v1;
#pragma unroll
                    for (int e = 0; e < 4; ++e) { v0[e] = bf2f_s(xv[e]) * ALPHA + acc[ai][bj][m][0][e] + bv[bj][0][e]; v1[e] = bf2f_s(xv[4 + e]) * ALPHA + acc[ai][bj][m][1][e] + bv[bj][1][e]; }
                    if (last) { *(f32x4*)(out + ro + bj * 128) = v0; *(f32x4*)(out + ro + bj * 128 + 4) = v1; }
                    else { u32x4 w; w.x = cvt_pk_bf16(v0[0], v0[1]); w.y = cvt_pk_bf16(v0[2], v0[3]); w.z = cvt_pk_bf16(v1[0], v1[1]); w.w = cvt_pk_bf16(v1[2], v1[3]);
                        *(u32x4*)(dst + ro + bj * 128) = w; } } }
    }
};

template <class Epi> __device__ __forceinline__ void run_gemm(unsigned char* lds, const bf16_t* A, const bf16_t* Bt, int M, int N, const Epi& E) {
    pg8::Gemm g; g.A = A; g.Bt = Bt; g.M = M; g.N = N; g.K = DM;
    pg8::StaticOrder S; S.init(M, N, (int)gridDim.x, (int)blockIdx.x);
    pg8::gemm_phase<Epi, pg8::StaticOrder, false>((PG8_LAS unsigned char*)lds, g, S, E, nullptr);
    __syncthreads();
}

struct TileRef { const float* W; bf16_t* WT; int N, tk, tn; };
__device__ __forceinline__ TileRef tile_ref(const PV& p, int it) {
    const int j = it / 2176; int r = it - j * 2176; int kind;
    if (r < 1024) kind = 0; else if (r < 1280) { kind = 1; r -= 1024; } else if (r < 1920) { kind = 2; r -= 1280; } else { kind = 3; r -= 1920; }
    TileRef t; t.N = kind == 0 ? 4096 : (kind == 2 ? 2560 : 1024);
    const int nN = t.N / 64; t.tk = r / nN; t.tn = r % nN;
    t.W = (kind == 0 ? p.in(2) : kind == 1 ? p.in(14) : kind == 2 ? p.in(16) : p.in(20)) + (size_t)j * 1024 * t.N;
    t.WT = (bf16_t*)(p.ws + (kind == 0 ? WS_HWIN : kind == 1 ? WS_HWOUT : kind == 2 ? WS_AWIN : WS_AWOUT)) + (size_t)j * 1024 * t.N;
    return t;
}
__device__ __forceinline__ void prologue_phase(const PV& p, unsigned char* lds) {
    const int tid = tidx();
    { const int wid = __builtin_amdgcn_readfirstlane(tid >> 6), lane = tid & 63;
        for (int j = 0; j < 2; ++j) {
            const float* w1 = p.in(6) + j * 33 * 64; const float* w2 = p.in(9) + j * 64 * 64;
            float w1r[33], w2r[64];
#pragma unroll
            for (int i = 0; i < 33; ++i) w1r[i] = w1[i * 64 + lane];
#pragma unroll
            for (int i = 0; i < 64; ++i) w2r[i] = w2[i * 64 + lane];
            const float b1v = p.in(7)[j * 64 + lane], b2v = p.in(10)[j * 64 + lane], fr = p.in(8)[j * 64 + lane];
            for (int row = blockIdx.x * 8 + wid; row < 6144; row += gridDim.x * 8) {
                int t = row; const int sel = t >= 2048 ? 1 : 0; if (sel) t -= 2048; const int L = sel ? 4096 : 2048;
                float feat = 0.f;
                if (lane == 0) feat = (float)t / (float)(L - 1);
                else if (lane <= 32) { const int i = (lane - 1) & 15; const double f = 1e-4 + (double)i * ((15.0 - 1e-4) / 15.0);
                    double ph = f * (double)t / (double)L; ph -= (double)(long long)ph;
                    const float a = (float)(ph * 6.283185307179586);
                    feat = lane <= 16 ? cosf(a) : -sinf(a); }
                float s = b1v;
#pragma unroll
                for (int i = 0; i < 33; ++i) s += __shfl(feat, i, 64) * w1r[i];
                const float h1 = sinf(fr * s);
                float s2 = b2v;
#pragma unroll
                for (int i = 0; i < 64; ++i) s2 += __shfl(h1, i, 64) * w2r[i];
                ((float*)(p.ws + WS_H2))[((size_t)(j * 2 + sel) * 4096 + t) * 64 + lane] = sinf(fr * s2);
            }
        }
    }
    { float* tile = (float*)lds;
        const int total = 2 * 2176;
        f32x4 v[2];
        int it = blockIdx.x;
        if (it < total) { const TileRef t = tile_ref(p, it);
#pragma unroll
            for (int i = 0; i < 2; ++i) { const int q = tid + i * 512; v[i] = *(const f32x4*)(t.W + (size_t)(t.tk * 64 + (q >> 4)) * t.N + t.tn * 64 + (q & 15) * 4); } }
        for (; it < total; it += gridDim.x) {
            const TileRef t = tile_ref(p, it);
#pragma unroll
            for (int i = 0; i < 2; ++i) { const int q = tid + i * 512, k = q >> 4, n4 = (q & 15) * 4;
                tile[k * 65 + n4 + 0] = v[i][0]; tile[k * 65 + n4 + 1] = v[i][1]; tile[k * 65 + n4 + 2] = v[i][2]; tile[k * 65 + n4 + 3] = v[i][3]; }
            __syncthreads();
            if (it + (int)gridDim.x < total) { const TileRef t2 = tile_ref(p, it + gridDim.x);
#pragma unroll
                for (int i = 0; i < 2; ++i) { const int q = tid + i * 512; v[i] = *(const f32x4*)(t2.W + (size_t)(t2.tk * 64 + (q >> 4)) * t2.N + t2.tn * 64 + (q & 15) * 4); } }
            { const int n = tid >> 3, k8 = (tid & 7) * 8; float x[8];
#pragma unroll
                for (int e = 0; e < 8; ++e) x[e] = tile[(k8 + e) * 65 + n];
                u32x4 w; w.x = cvt_pk_bf16(x[0], x[1]); w.y = cvt_pk_bf16(x[2], x[3]); w.z = cvt_pk_bf16(x[4], x[5]); w.w = cvt_pk_bf16(x[6], x[7]);
                *(u32x4*)(t.WT + (size_t)(t.tn * 64 + n) * 1024 + t.tk * 64 + k8) = w; }
            __syncthreads();
        }
    }
}

__device__ __forceinline__ void cvt_phase(const PV& p, int g) {
    const float* x = p.in(g); bf16_t* xb = (bf16_t*)(p.ws + WS_XB);
    const size_t n8 = (size_t)TG * DM / 8;
    for (size_t i = (size_t)blockIdx.x * 512 + tidx(); i < n8; i += (size_t)gridDim.x * 512) {
        const f32x4 a = *(const f32x4*)(x + i * 8), b = *(const f32x4*)(x + i * 8 + 4);
        u32x4 w; w.x = cvt_pk_bf16(a[0], a[1]); w.y = cvt_pk_bf16(a[2], a[3]); w.z = cvt_pk_bf16(b[0], b[1]); w.w = cvt_pk_bf16(b[2], b[3]);
        *(u32x4*)(xb + i * 8) = w;
    }
}

__device__ __forceinline__ void ln_phase(const PV& p, int g, int layer, bf16_t* xdst) {
    float* x = p.out + (size_t)g * TG * DM; bf16_t* xb = (bf16_t*)(p.ws + WS_XB);
    const float* gam = p.in(22) + layer * DM; const float* bet = p.in(23) + layer * DM;
    const int tid_ = tidx(); const int wid = __builtin_amdgcn_readfirstlane(tid_ >> 6), lane = tid_ & 63;
    const bool last = layer == 3;
    f32x4 gv[4], bv[4];
#pragma unroll
    for (int k = 0; k < 4; ++k) { const int c = (k >> 1) * 512 + lane * 8 + (k & 1) * 4; gv[k] = *(const f32x4*)(gam + c); bv[k] = *(const f32x4*)(bet + c); }
    constexpr int NR = 2;
    for (int row0 = (blockIdx.x * 8 + wid) * NR; row0 < TG; row0 += gridDim.x * 8 * NR) {
        f32x4 v[NR][4];
#pragma unroll
        for (int rr = 0; rr < NR; ++rr) { const size_t ro = (size_t)(row0 + rr) * DM;
            if (last) {
#pragma unroll
                for (int k = 0; k < 4; ++k) v[rr][k] = *(const f32x4*)(x + ro + (k >> 1) * 512 + lane * 8 + (k & 1) * 4);
            } else {
#pragma unroll
                for (int hh = 0; hh < 2; ++hh) { const bf16x8 t = *(const bf16x8*)(xb + ro + hh * 512 + lane * 8);
#pragma unroll
                    for (int e = 0; e < 4; ++e) { v[rr][hh * 2][e] = bf2f_s(t[e]); v[rr][hh * 2 + 1][e] = bf2f_s(t[4 + e]); } }
            } }
        float s[NR], q[NR];
#pragma unroll
        for (int rr = 0; rr < NR; ++rr) { s[rr] = 0.f;
#pragma unroll
            for (int k = 0; k < 4; ++k) s[rr] += v[rr][k][0] + v[rr][k][1] + v[rr][k][2] + v[rr][k][3]; }
#pragma unroll
        for (int o = 32; o >= 1; o >>= 1) {
#pragma unroll
            for (int rr = 0; rr < NR; ++rr) s[rr] += __shfl_xor(s[rr], o, 64); }
#pragma unroll
        for (int rr = 0; rr < NR; ++rr) { const float mu = s[rr] * (1.f / DM); q[rr] = 0.f;
#pragma unroll
            for (int k = 0; k < 4; ++k) { v[rr][k] = v[rr][k] - mu; q[rr] += v[rr][k][0] * v[rr][k][0] + v[rr][k][1] * v[rr][k][1] + v[rr][k][2] * v[rr][k][2] + v[rr][k][3] * v[rr][k][3]; } }
#pragma unroll
        for (int o = 32; o >= 1; o >>= 1) {
#pragma unroll
            for (int rr = 0; rr < NR; ++rr) q[rr] += __shfl_xor(q[rr], o, 64); }
#pragma unroll
        for (int rr = 0; rr < NR; ++rr) { const size_t ro = (size_t)(row0 + rr) * DM; const float rstd = rsqrtf(q[rr] * (1.f / DM) + 1e-5f);
#pragma unroll
            for (int k = 0; k < 4; ++k) v[rr][k] = v[rr][k] * rstd * gv[k] + bv[k];
            if (last) {
#pragma unroll
                for (int k = 0; k < 4; ++k) *(f32x4*)(x + ro + (k >> 1) * 512 + lane * 8 + (k & 1) * 4) = v[rr][k];
            } else {
#pragma unroll
                for (int hh = 0; hh < 2; ++hh) { u32x4 w; w.x = cvt_pk_bf16(v[rr][hh * 2][0], v[rr][hh * 2][1]); w.y = cvt_pk_bf16(v[rr][hh * 2][2], v[rr][hh * 2][3]);
                    w.z = cvt_pk_bf16(v[rr][hh * 2 + 1][0], v[rr][hh * 2 + 1][1]); w.w = cvt_pk_bf16(v[rr][hh * 2 + 1][2], v[rr][hh * 2 + 1][3]);
                    *(u32x4*)(xdst + ro + hh * 512 + lane * 8) = w; }
            } }
    }
}

template <int L> __device__ __forceinline__ void filter_phase(const PV& p, int hj, int slot, unsigned char* lds) {
    const int tid = tidx(), wid = __builtin_amdgcn_readfirstlane(tid >> 6), lane = tid & 63;
    const float* h2 = (const float*)(p.ws + WS_H2) + (size_t)(hj * 2 + (L == 2048 ? 0 : 1)) * 4096 * 64;
    const float* w3 = p.in(11) + (size_t)hj * 64 * 4096; const float* decay = p.in(12) + hj * 4096;
    bf16_t* FILT = (bf16_t*)(p.ws + WS_FILT); float* PART = (float*)(p.ws + WS_SUMSQ);
    float* stg = (float*)lds;
    unsigned* tile = (unsigned*)(lds + 65536);
    constexpr int NCH = L / 256;
    for (int it = blockIdx.x; it < 64 * NCH; it += gridDim.x) {
        const int cb = it / NCH, chunk = it - cb * NCH, t0 = chunk * 256;
        const int od = cb >> 4, dir = od & 1, o = od >> 1, col = cb * 64 + lane, c = col & 1023;
        const int tb = t0 + dir;
        __syncthreads();
#pragma unroll
        for (int i = 0; i < 8; ++i) { const int q = tid + 512 * i, rr = q >> 4, c4 = (q & 15) * 4; int tr = tb + rr; tr = tr < L ? tr : L - 1;
            *(f32x4*)(stg + rr * 64 + c4) = *(const f32x4*)(h2 + (size_t)tr * 64 + c4); }
        float w[64];
#pragma unroll
        for (int j = 0; j < 64; ++j) w[j] = w3[(size_t)j * 4096 + col];
        const float dec = fabsf(decay[col]);
        float ss = 0.f;
        if (dir == 1 && t0 == 0 && wid == 0) {
            float d = 0.f;
#pragma unroll
            for (int j = 0; j < 64; ++j) d += h2[j] * w[j];
            ss = d * d; }
        __syncthreads();
        unsigned short* trow = (unsigned short*)(tile + lane * 129);
#pragma unroll 2
        for (int tt = 0; tt < 32; ++tt) {
            const int tl = wid * 32 + tt, t = tb + tl; const f32x4* hr = (const f32x4*)(stg + tl * 64);
            float d = 0.f;
#pragma unroll
            for (int jq = 0; jq < 16; ++jq) { const f32x4 x = hr[jq]; d += x[0] * w[jq * 4] + x[1] * w[jq * 4 + 1] + x[2] * w[jq * 4 + 2] + x[3] * w[jq * 4 + 3]; }
            d *= expf(-(float)t * (1.0f / (float)(L - 1)) * dec);
            if (t >= L) d = 0.f;
            ss += d * d;
            trow[dir ? tl : 255 - tl] = f2bf(d);
        }
        PART[(size_t)col * (NCH * 8) + chunk * 8 + wid] = ss;
        __syncthreads();
        { const int cc = tid >> 3, part = tid & 7; const unsigned* src = tile + cc * 129 + part * 16;
            const int ccol = cb * 64 + cc, c2 = ccol & 1023;
            bf16_t* dst = FILT + ((size_t)(o * 1024 + c2)) * (2 * L) + (dir ? L + t0 : L - 256 - t0) + part * 32;
#pragma unroll
            for (int k = 0; k < 4; ++k) { u32x4 v; v.x = src[k * 4]; v.y = src[k * 4 + 1]; v.z = src[k * 4 + 2]; v.w = src[k * 4 + 3]; *(u32x4*)(dst + k * 8) = v; } }
    }
    __syncthreads();
}

__device__ __forceinline__ bf16x8 lds_a4(const unsigned char* lds, unsigned addr) {
    const unsigned* q = (const unsigned*)(lds + addr); u32x4 w; w.x = q[0]; w.y = q[1]; w.z = q[2]; w.w = q[3]; return *reinterpret_cast<bf16x8*>(&w);
}
template <int NB> struct ConvCfg {
    static constexpr int L = NB == 16 ? 2048 : 4096, ROWE = L + 8, SB = NB == 16 ? 0 : -2048, NT = NB == 16 ? 64 : 192;
    static constexpr int ZOFF = 0, FOFF = 66560, FCOPY = 2 * L * 2, W3OFF = FOFF + 4 * FCOPY, REDOFF = W3OFF + 1024;
};
template <int NB> __device__ __forceinline__ void conv_main(const unsigned char* lds, int o, f32x4 (&acc)[16]) {
    using C = ConvCfg<NB>;
    const int tid_ = tidx(); const int lane = tid_ & 63, wid = __builtin_amdgcn_readfirstlane(tid_ >> 6), r = lane & 15, gq = lane >> 4;
    const int b = NB == 16 ? r : (r & 7), h = NB == 16 ? 0 : (r >> 3);
    const int E0 = (C::L - 1) + C::SB - 256 * wid + 8 * gq - r;
    const int P = E0 & 1;
    unsigned aPtr = (unsigned)(C::FOFF + (o * 2 + P) * C::FCOPY + 2 * (E0 - P));
    const int bBase = C::ZOFF + b * C::ROWE * 2 + 2 * (C::SB + 2048 * h + 8 * gq);
    const int s_lane0 = C::SB + 2048 * h;
    bf16x8 A[16];
#pragma unroll
    for (int i = 0; i < 16; ++i) { A[i] = lds_a4(lds, aPtr - 32 * i); acc[i] = (f32x4){0.f, 0.f, 0.f, 0.f}; }
    auto ldb = [&](int j) -> bf16x8 {
        if (NB == 16) return *(const bf16x8*)(lds + bBase + 64 * j);
        const bool valid = (unsigned)(s_lane0 + 32 * j) < (unsigned)C::L;
        const bf16x8 t = *(const bf16x8*)(lds + (valid ? bBase + 64 * j : C::ZOFF));
        const bf16x8 z = {0, 0, 0, 0, 0, 0, 0, 0}; return valid ? t : z; };
    bf16x8 bnext = ldb(0);
    for (int jo = 0; jo < C::NT / 8; ++jo) {
#pragma unroll
        for (int jj = 0; jj < 8; ++jj) {
            const int j = jo * 8 + jj;
            const bf16x8 bf = bnext;
            bnext = ldb(j + 1 < C::NT ? j + 1 : j);
            acc[15] = __builtin_amdgcn_mfma_f32_16x16x32_bf16(A[(15 - 2 * jj) & 15], bf, acc[15], 0, 0, 0);
            acc[14] = __builtin_amdgcn_mfma_f32_16x16x32_bf16(A[(14 - 2 * jj) & 15], bf, acc[14], 0, 0, 0);
            A[(14 - 2 * jj) & 15] = lds_a4(lds, aPtr + 64 * (jj + 1));
            A[(15 - 2 * jj) & 15] = lds_a4(lds, aPtr + 64 * (jj + 1) - 32);
#pragma unroll
            for (int i = 13; i >= 0; --i) acc[i] = __builtin_amdgcn_mfma_f32_16x16x32_bf16(A[(i - 2 * jj) & 15], bf, acc[i], 0, 0, 0);
            __builtin_amdgcn_sched_barrier(0);
        }
        aPtr += 512;
    }
}
template <int NB, int I0, int I1> __device__ __forceinline__ void conv_gload(const bf16_t* UT, int gch, s16x4 (&gu)[16], unsigned (&gh)[16]) {
    using C = ConvCfg<NB>;
    const int tid_ = tidx(); const int lane = tid_ & 63, wid = __builtin_amdgcn_readfirstlane(tid_ >> 6), r = lane & 15, gq = lane >> 4;
    const int b = NB == 16 ? r : (r & 7), h = NB == 16 ? 0 : (r >> 3);
    const bf16_t* grow = UT + ((size_t)b * 3072 + gch) * C::L;
#pragma unroll
    for (int i = I0; i < I1; ++i) {
        const int t = 256 * wid + 16 * i + 4 * gq + 2048 * h;
        gu[i] = *(const s16x4*)(grow + t);
        const unsigned lo = grow[t > 0 ? t - 1 : 0], hi = grow[(t + 4 < C::L) ? t + 4 : C::L - 1];
        gh[i] = lo | (hi << 16);
    }
}
template <int NB> __device__ __forceinline__ void conv_epi(const unsigned char* lds, const f32x4 (&acc)[16], u32x2 (&zp)[16], const s16x4 (&gu_)[16], const unsigned (&gh)[16],
                                                          float gw0, float gw1, float gw2, float gcb, float fb, float nrm) {
    using C = ConvCfg<NB>;
    const int tid_ = tidx(); const int lane = tid_ & 63, wid = __builtin_amdgcn_readfirstlane(tid_ >> 6), r = lane & 15, gq = lane >> 4;
    const int b = NB == 16 ? r : (r & 7), h = NB == 16 ? 0 : (r >> 3);
#pragma unroll
    for (int i = 0; i < 16; ++i) {
        const int t = 256 * wid + 16 * i + 4 * gq + 2048 * h;
        const s16x4 gu = gu_[i];
        const float gl = t > 0 ? bf2f((unsigned short)(gh[i] & 0xffffu)) : 0.f, gr = (t + 4 < C::L) ? bf2f((unsigned short)(gh[i] >> 16)) : 0.f;
        const float u0 = bf2f_s(gu[0]), u1 = bf2f_s(gu[1]), u2 = bf2f_s(gu[2]), u3 = bf2f_s(gu[3]);
        const float g0 = gw0 * gl + gw1 * u0 + gw2 * u1 + gcb, g1 = gw0 * u0 + gw1 * u1 + gw2 * u2 + gcb;
        const float g2 = gw0 * u1 + gw1 * u2 + gw2 * u3 + gcb, g3 = gw0 * u2 + gw1 * u3 + gw2 * gr + gcb;
        const s16x4 vz = *(const s16x4*)(lds + C::ZOFF + (b * C::ROWE + t) * 2);
        const float z0 = g0 * (acc[i][0] * nrm + bf2f_s(vz[0]) * fb), z1 = g1 * (acc[i][1] * nrm + bf2f_s(vz[1]) * fb);
        const float z2 = g2 * (acc[i][2] * nrm + bf2f_s(vz[2]) * fb), z3 = g3 * (acc[i][3] * nrm + bf2f_s(vz[3]) * fb);
        zp[i].x = cvt_pk_bf16(z0, z1); zp[i].y = cvt_pk_bf16(z2, z3);
    }
}
template <int NB> __device__ __forceinline__ void conv_store_z(unsigned char* lds, const u32x2 (&zp)[16]) {
    using C = ConvCfg<NB>;
    const int tid_ = tidx(); const int lane = tid_ & 63, wid = __builtin_amdgcn_readfirstlane(tid_ >> 6), r = lane & 15, gq = lane >> 4;
    const int b = NB == 16 ? r : (r & 7), h = NB == 16 ? 0 : (r >> 3);
#pragma unroll
    for (int i = 0; i < 16; ++i) { const int t = 256 * wid + 16 * i + 4 * gq + 2048 * h; *(u32x2*)(lds + C::ZOFF + (b * C::ROWE + t) * 2) = zp[i]; }
}

template <int NB> __device__ __forceinline__ void conv_phase(const PV& p, int hj, int slot, unsigned char* lds, bf16_t* zdst, int zstride) {
    using C = ConvCfg<NB>;
    constexpr int L = C::L;
    const int tid_wg = tidx(), wid = __builtin_amdgcn_readfirstlane(tid_wg >> 6), lane = tid_wg & 63;
    bf16_t* UT = (bf16_t*)(p.ws + WS_UT);
    const float* w3 = p.in(11) + (size_t)hj * 64 * 4096; const float* decay = p.in(12) + hj * 4096;
    const float* fbias = p.in(13) + hj * 2048; const float* cw = p.in(4) + hj * 3 * 3072; const float* cb = p.in(5) + hj * 3072;
    float* w3s = (float*)(lds + C::W3OFF); float* red = (float*)(lds + C::REDOFF);
    for (int c = blockIdx.x; c < 1024; c += gridDim.x) {
        __syncthreads();
        const int tid = opaque(tid_wg);
        constexpr int NF = (2 * (2 * L / 8)) / 512;
        u32x4 fr[NF]; bf16x8 vx[8]; float hl[8], hr[8];
        { const bf16_t* FILT = (const bf16_t*)(p.ws + WS_FILT);
#pragma unroll
            for (int i = 0; i < NF; ++i) { const int q = tid + 512 * i, o = q / (2 * L / 8), i8 = (q - o * (2 * L / 8)) * 8;
                fr[i] = *(const u32x4*)(FILT + ((size_t)(o * 1024 + c)) * (2 * L) + i8); } }
#pragma unroll
        for (int i = 0; i < 8; ++i) { const int chunk = tid + 512 * i, b = chunk / (L / 8), s8 = (chunk % (L / 8)) * 8;
            const bf16_t* src = UT + ((size_t)b * 3072 + c) * L + s8;
            vx[i] = *(const bf16x8*)src; const float a_ = bf2f(src[s8 > 0 ? -1 : 0]), b_ = bf2f(src[(s8 + 8 < L) ? 8 : 7]);
            hl[i] = s8 > 0 ? a_ : 0.f; hr[i] = (s8 + 8 < L) ? b_ : 0.f; }
        { constexpr int NP = (L / 256) * 8; const float* PART = (const float*)(p.ws + WS_SUMSQ);
            const int o = tid >> 8, idx = tid & 255, dir = idx / NP, k = idx - dir * NP;
            float v = (idx < 2 * NP) ? PART[(size_t)((o * 2 + dir) * 1024 + c) * NP + k] : 0.f;
            v = wave_sum(v); if (lane == 0) red[wid] = v; }
#pragma unroll
        for (int i = 0; i < NF; ++i) { const int q = tid + 512 * i, o = q / (2 * L / 8), i8 = (q - o * (2 * L / 8)) * 8;
            *(u32x4*)(lds + C::FOFF + (o * 2) * C::FCOPY + i8 * 2) = fr[i]; }
        { const float w0 = cw[c], w1 = cw[3072 + c], w2 = cw[2 * 3072 + c], cbv = cb[c];
#pragma unroll
            for (int i = 0; i < 8; ++i) { const int chunk = tid + 512 * i, b = chunk / (L / 8), s8 = (chunk % (L / 8)) * 8;
                float xe[10]; xe[0] = hl[i]; xe[9] = hr[i];
#pragma unroll
                for (int e = 0; e < 8; ++e) xe[e + 1] = bf2f_s(vx[i][e]);
                float y[8];
#pragma unroll
                for (int e = 0; e < 8; ++e) y[e] = w0 * xe[e] + w1 * xe[e + 1] + w2 * xe[e + 2] + cbv;
                u32x4 w; w.x = cvt_pk_bf16(y[0], y[1]); w.y = cvt_pk_bf16(y[2], y[3]); w.z = cvt_pk_bf16(y[4], y[5]); w.w = cvt_pk_bf16(y[6], y[7]);
                *(u32x4*)(lds + C::ZOFF + (b * C::ROWE + s8) * 2) = w;
                __builtin_amdgcn_sched_barrier(0); } }
        __syncthreads();
        const float nrm0 = rsqrtf(red[0] + red[1] + red[2] + red[3] + 1e-6f), nrm1 = rsqrtf(red[4] + red[5] + red[6] + red[7] + 1e-6f);
#pragma unroll
        for (int i = 0; i < NF; ++i) { const int q = tid + 512 * i, o = q / (2 * L / 8), m4 = (q - o * (2 * L / 8)) * 4;
            const unsigned* s0 = (const unsigned*)(lds + C::FOFF + (o * 2) * C::FCOPY) + m4; unsigned* d1 = (unsigned*)(lds + C::FOFF + (o * 2 + 1) * C::FCOPY) + m4;
            const u32x4 a = *(const u32x4*)s0; const unsigned nx = (m4 + 4 < L) ? s0[4] : 0u;
            u32x4 r; r.x = __builtin_amdgcn_alignbit(a.y, a.x, 16); r.y = __builtin_amdgcn_alignbit(a.z, a.y, 16); r.z = __builtin_amdgcn_alignbit(a.w, a.z, 16); r.w = __builtin_amdgcn_alignbit(nx, a.w, 16);
            *(u32x4*)d1 = r; }
        __syncthreads();
        f32x4 acc[16]; u32x2 zp[16]; s16x4 gu[16]; unsigned gh[16];
        conv_gload<NB, 0, 8>(UT, 1024 + c, gu, gh);
        conv_main<NB>(lds, 0, acc);
        conv_gload<NB, 8, 16>(UT, 1024 + c, gu, gh);
        conv_epi<NB>(lds, acc, zp, gu, gh, cw[1024 + c], cw[3072 + 1024 + c], cw[2 * 3072 + 1024 + c], cb[1024 + c], fbias[c], nrm0);
        __syncthreads();
        conv_store_z<NB>(lds, zp);
        __syncthreads();
        conv_gload<NB, 0, 8>(UT, 2048 + c, gu, gh);
        conv_main<NB>(lds, 1, acc);
        conv_gload<NB, 8, 16>(UT, 2048 + c, gu, gh);
        conv_epi<NB>(lds, acc, zp, gu, gh, cw[2048 + c], cw[3072 + 2048 + c], cw[2 * 3072 + 2048 + c], cb[2048 + c], fbias[1024 + c], nrm1);
        __syncthreads();
        conv_store_z<NB>(lds, zp);
        __syncthreads();
#pragma unroll
        for (int i = 0; i < 8; ++i) { const int chunk = tid + 512 * i, b = chunk / (L / 8), s8 = (chunk % (L / 8)) * 8;
            *(u32x4*)(zdst + ((size_t)b * zstride + c) * L + s8) = *(const u32x4*)(lds + C::ZOFF + (b * C::ROWE + s8) * 2); }
        __syncthreads();
    }
}

__device__ __forceinline__ void ygate_phase(const PV& p, int L, unsigned char* lds) {
    const bf16_t* UT = (const bf16_t*)(p.ws + WS_UT); const bf16_t* G = (const bf16_t*)(p.ws + WS_GATE); bf16_t* Y = (bf16_t*)(p.ws + WS_Y);
    const int tid = tidx(); constexpr int RS = 136;
    bf16_t* tile = (bf16_t*)lds;
    const int nit = (TG / 128) * 16;
    u32x4 zr[2]; bf16x8 gr[2];
    auto issue = [&](int it) {
        const int tc = it & 15, tt = it >> 4; const int tok0 = tt * 128, b = tok0 / L, t0 = tok0 - b * L, c0 = tc * 64;
#pragma unroll
        for (int i = 0; i < 2; ++i) { const int q = tid + i * 512;
            zr[i] = *(const u32x4*)(UT + ((size_t)b * 3072 + c0 + (q >> 4)) * L + t0 + (q & 15) * 8);
            gr[i] = *(const bf16x8*)(G + (size_t)(tok0 + (q >> 3)) * DM + c0 + (q & 7) * 8); } };
    int it = blockIdx.x;
    if (it < nit) issue(it);
    for (; it < nit; it += gridDim.x) {
        const int tc = it & 15, tt = it >> 4; const int tok0 = tt * 128, c0 = tc * 64;
#pragma unroll
        for (int i = 0; i < 2; ++i) { const int q = tid + i * 512; *(u32x4*)(tile + (q >> 4) * RS + (q & 15) * 8) = zr[i]; }
        const bf16x8 g0 = gr[0], g1 = gr[1];
        __syncthreads();
        if (it + (int)gridDim.x < nit) issue(it + gridDim.x);
#pragma unroll
        for (int i = 0; i < 2; ++i) { const int q = tid + i * 512, t = q >> 3, cch = (q & 7) * 8; const bf16x8 gv = i ? g1 : g0; float y[8];
#pragma unroll
            for (int e = 0; e < 8; ++e) y[e] = bf2f(tile[(cch + e) * RS + t]) * silu(bf2f_s(gv[e]));
            u32x4 w; w.x = cvt_pk_bf16(y[0], y[1]); w.y = cvt_pk_bf16(y[2], y[3]); w.z = cvt_pk_bf16(y[4], y[5]); w.w = cvt_pk_bf16(y[6], y[7]);
            *(u32x4*)(Y + (size_t)(tok0 + t) * DM + c0 + cch) = w; }
        __syncthreads();
    }
}

constexpr int LDU = 2560;
__device__ __forceinline__ void rope_phase(const PV& p, int aj, int L, bf16_t* D, int ldd) {
    bf16_t* U = (bf16_t*)(p.ws + WS_UT);
    const float* qn = p.in(18) + aj * 128; const float* kn = p.in(19) + aj * 128;
    const int tid = tidx(), sub = tid & 7;
    float inv[8], q1[8], q2[8], k1[8], k2[8];
#pragma unroll
    for (int e = 0; e < 8; ++e) { inv[e] = exp2f(-(float)((8 * sub + e) & 31) * (13.287712379549449f / 32.f));
        q1[e] = qn[8 * sub + e]; q2[e] = qn[64 + 8 * sub + e]; k1[e] = kn[8 * sub + e]; k2[e] = kn[64 + 8 * sub + e]; }
    for (int tok = blockIdx.x * 64 + (tid >> 3); tok < TG; tok += gridDim.x * 64) {
        const int t = tok & (L - 1); const float pos = (float)(sub < 4 ? (t >> 6) : (t & 63));
        float cs[8], sn[8];
#pragma unroll
        for (int e = 0; e < 8; ++e) { const float ang = pos * inv[e]; cs[e] = __cosf(ang); sn[e] = __sinf(ang); }
        bf16_t* u = U + (size_t)tok * LDU + 8 * sub;
#pragma unroll
        for (int hd = 0; hd < 10; ++hd) {
            const bf16x8 a = *(const bf16x8*)(u + hd * 128), bq = *(const bf16x8*)(u + hd * 128 + 64);
            float x1[8], x2[8]; float ss = 0.f;
#pragma unroll
            for (int e = 0; e < 8; ++e) { x1[e] = bf2f_s(a[e]); x2[e] = bf2f_s(bq[e]); ss += x1[e] * x1[e] + x2[e] * x2[e]; }
            ss += __shfl_xor(ss, 1, 64); ss += __shfl_xor(ss, 2, 64); ss += __shfl_xor(ss, 4, 64);
            const float rs = rsqrtf(ss * (1.f / 128.f) + 1e-6f);
            float o1[8], o2[8];
#pragma unroll
            for (int e = 0; e < 8; ++e) { const float xa = x1[e] * rs * (hd < 8 ? q1[e] : k1[e]), xb2 = x2[e] * rs * (hd < 8 ? q2[e] : k2[e]);
                o1[e] = xa * cs[e] - xb2 * sn[e]; o2[e] = xb2 * cs[e] + xa * sn[e]; }
            u32x4 w1, w2; w1.x = cvt_pk_bf16(o1[0], o1[1]); w1.y = cvt_pk_bf16(o1[2], o1[3]); w1.z = cvt_pk_bf16(o1[4], o1[5]); w1.w = cvt_pk_bf16(o1[6], o1[7]);
            w2.x = cvt_pk_bf16(o2[0], o2[1]); w2.y = cvt_pk_bf16(o2[2], o2[3]); w2.z = cvt_pk_bf16(o2[4], o2[5]); w2.w = cvt_pk_bf16(o2[6], o2[7]);
            bf16_t* d = D + (size_t)tok * ldd + 8 * sub; *(u32x4*)(d + hd * 128) = w1; *(u32x4*)(d + hd * 128 + 64) = w2;
        }
    }
}

namespace att {
constexpr int D = 128, NW = 8, QBLK = 32, KVBLK = 64;
constexpr float SCALE = 0.088388347648318440f;
constexpr float THR = 8.f;
constexpr int LDQ = LDU, LDK = LDU;
constexpr size_t SHM_V = KVBLK * D * 2, SHM_K = KVBLK * D * 2, SHM_ATTN = 2 * SHM_V + 2 * SHM_K + NW * 64 * 4;
#define KSWZ(row, colB) ((row) * 256 + ((colB) ^ (((row) & 7) << 4)))
#define SBAR() __builtin_amdgcn_sched_barrier(0)
__device__ __forceinline__ int crow(int r, int hi) { return (r & 3) + 8 * (r >> 2) + 4 * hi; }
__device__ __forceinline__ unsigned cvtpk(float lo, float hi) { unsigned r; asm volatile("v_cvt_pk_bf16_f32 %0, %1, %2" : "=v"(r) : "v"(lo), "v"(hi)); return r; }
__device__ __forceinline__ bf16x8 ld8(const bf16_t* p) { return *reinterpret_cast<const bf16x8*>(p); }
__device__ __forceinline__ void partialSM(f32x16& p0, f32x16& p1, float& m_reg, float& mn, float& alpha) {
  constexpr float C = SCALE * 1.4426950408889634f;
  float pmax = p0[0]; for (int r = 1; r < 16; ++r) pmax = fmaxf(pmax, p0[r]); for (int r = 0; r < 16; ++r) pmax = fmaxf(pmax, p1[r]);
  { auto rr = __builtin_amdgcn_permlane32_swap(__float_as_uint(pmax), __float_as_uint(pmax), false, false);
    pmax = fmaxf(__uint_as_float(rr[0]), __uint_as_float(rr[1])); }
  if (__builtin_expect(__all(pmax - m_reg <= THR / SCALE), 1)) { mn = m_reg; alpha = 1.f; }
  else { mn = fmaxf(m_reg, pmax); alpha = __builtin_amdgcn_exp2f((m_reg - mn) * C); m_reg = mn; }
  float mnC = -mn * C;
  for (int r = 0; r < 16; ++r) p0[r] = fmaf(p0[r], C, mnC); for (int r = 0; r < 16; ++r) p1[r] = fmaf(p1[r], C, mnC);
  for (int r = 0; r < 16; ++r) p0[r] = __builtin_amdgcn_exp2f(p0[r]);
}
__device__ __forceinline__ void finishSM(f32x16& p0, f32x16& p1, float alpha, float& l_reg, bf16x8& pa0, bf16x8& pa1, bf16x8& pa2, bf16x8& pa3) {
  for (int r = 0; r < 16; ++r) p1[r] = __builtin_amdgcn_exp2f(p1[r]);
  float ps = 0; for (int r = 0; r < 16; ++r) ps += p0[r]; for (int r = 0; r < 16; ++r) ps += p1[r];
  { auto rr = __builtin_amdgcn_permlane32_swap(__float_as_uint(ps), __float_as_uint(ps), false, false);
    ps = __uint_as_float(rr[0]) + __uint_as_float(rr[1]); }
  l_reg = l_reg * alpha + ps;
#define PK4(P, BASE, OUT) do { unsigned a0 = cvtpk(P[BASE + 0], P[BASE + 1]), a1 = cvtpk(P[BASE + 2], P[BASE + 3]);   \
    unsigned b0 = cvtpk(P[BASE + 4], P[BASE + 5]), b1 = cvtpk(P[BASE + 6], P[BASE + 7]);                              \
    auto r0 = __builtin_amdgcn_permlane32_swap(a0, b0, false, false); auto r1 = __builtin_amdgcn_permlane32_swap(a1, b1, false, false); \
    u32x4 w = {r0[0], r1[0], r0[1], r1[1]}; OUT = *reinterpret_cast<bf16x8*>(&w); } while (0)
  PK4(p0, 0, pa0); PK4(p0, 8, pa1); PK4(p1, 0, pa2); PK4(p1, 8, pa3);
#undef PK4
}
__device__ __forceinline__ void qkt(f32x16& p0, f32x16& p1, const bf16_t* Ks, const bf16x8* qr, int r32, int hi) {
  p0 = f32x16{}; p1 = f32x16{};
  for (int d0 = 0; d0 < 8; ++d0) { int cb = (d0 * 16 + hi * 8) * 2;
    bf16x8 b0 = *reinterpret_cast<const bf16x8*>((const char*)Ks + KSWZ(r32, cb));
    bf16x8 b1 = *reinterpret_cast<const bf16x8*>((const char*)Ks + KSWZ(32 + r32, cb));
    p0 = __builtin_amdgcn_mfma_f32_32x32x16_bf16(b0, qr[d0], p0, 0, 0, 0);
    p1 = __builtin_amdgcn_mfma_f32_32x32x16_bf16(b1, qr[d0], p1, 0, 0, 0); }
}
__device__ __forceinline__ int v_st(int k, int c) { const int kk = (k & ~0xC) | ((k & 4) << 1) | ((k & 8) >> 1); return ((kk >> 3) * 4 + (c >> 5)) * 512 + ((kk & 7) * 32 + (c & 31)) * 2; }
__device__ __forceinline__ int v_rd_base(int lane) { return ((lane & 3) << 3) | (((lane >> 2) & 3) << 6) | (((lane >> 4) & 1) << 5) | (((lane >> 5) & 1) << 8); }
constexpr int v_rd_off(int d0, int ks, int half) { return d0 * 512 + ks * 4096 + half * 2048; }
template <int OFF> __device__ __forceinline__ s16x4 tr_read(int vb) {
  s16x4 r; asm volatile("ds_read_b64_tr_b16 %0, %1 offset:%2" : "=&v"(r) : "v"(vb), "i"(OFF) : "memory"); return r;
}
template <int D0> __device__ __forceinline__ void pv_one(f32x16& od, int vb, bf16x8 pa0, bf16x8 pa1, bf16x8 pa2, bf16x8 pa3) {
  const s16x4 l0 = tr_read<v_rd_off(D0, 0, 0)>(vb), h0 = tr_read<v_rd_off(D0, 0, 1)>(vb), l1 = tr_read<v_rd_off(D0, 1, 0)>(vb), h1 = tr_read<v_rd_off(D0, 1, 1)>(vb);
  const s16x4 l2 = tr_read<v_rd_off(D0, 2, 0)>(vb), h2 = tr_read<v_rd_off(D0, 2, 1)>(vb), l3 = tr_read<v_rd_off(D0, 3, 0)>(vb), h3 = tr_read<v_rd_off(D0, 3, 1)>(vb);
  asm volatile("s_waitcnt lgkmcnt(0)" ::: "memory"); SBAR();
#define PK(L, H) (bf16x8){L[0], L[1], L[2], L[3], H[0], H[1], H[2], H[3]}
  od = __builtin_amdgcn_mfma_f32_32x32x16_bf16(pa0, PK(l0, h0), od, 0, 0, 0);
  od = __builtin_amdgcn_mfma_f32_32x32x16_bf16(pa1, PK(l1, h1), od, 0, 0, 0);
  od = __builtin_amdgcn_mfma_f32_32x32x16_bf16(pa2, PK(l2, h2), od, 0, 0, 0);
  od = __builtin_amdgcn_mfma_f32_32x32x16_bf16(pa3, PK(l3, h3), od, 0, 0, 0);
#undef PK
}
__device__ __forceinline__ void pv_d0(f32x16* o, int vb, bf16x8 pa0, bf16x8 pa1, bf16x8 pa2, bf16x8 pa3) {
  pv_one<0>(o[0], vb, pa0, pa1, pa2, pa3); pv_one<1>(o[1], vb, pa0, pa1, pa2, pa3); pv_one<2>(o[2], vb, pa0, pa1, pa2, pa3); pv_one<3>(o[3], vb, pa0, pa1, pa2, pa3);
}
__device__ __forceinline__ void attn_dense_body(const bf16_t* __restrict__ Qb, const bf16_t* __restrict__ Kh, const bf16_t* __restrict__ Vh,
                                                const bf16_t* __restrict__ Gb, bf16_t* __restrict__ Yb, int seq, char* lds) {
  constexpr int SDEPTH = 1;
  const int tid = tidx(), wid = __builtin_amdgcn_readfirstlane(tid >> 6), lane = tid & 63, r32 = lane & 31, hi = lane >> 5;
  bf16_t* V_lds = (bf16_t*)lds; bf16_t* K_lds = (bf16_t*)(lds + 2 * SHM_V);
  float* ws = (float*)(lds + 2 * SHM_V + 2 * SHM_K) + wid * 64; float* li_l = ws; float* al_l = ws + 32;
  float m_reg = -1e30f, l_reg = 0; f32x16 o[4] = {}; bf16x8 qr[8];
  const bf16_t* Qw = Qb + (long)(wid * QBLK + r32) * LDQ + hi * 8;
#pragma unroll
  for (int d0 = 0; d0 < 8; ++d0) qr[d0] = ld8(Qw + d0 * 16);
  const int sr = tid >> 4, sc = (tid & 15) * 8, vst0 = v_st(sr, sc), vst1 = v_st(32 + sr, sc);
  const int vb0 = (int)(uintptr_t)V_lds + v_rd_base(lane);
  struct { bf16x8 vs0, vs1, ks0, ks1; } sr_[SDEPTH];
#define SLOAD(i, k0) do { sr_[i].vs0 = ld8(&Vh[(long)((k0) + sr) * LDK + sc]); sr_[i].vs1 = ld8(&Vh[(long)((k0) + 32 + sr) * LDK + sc]); \
    sr_[i].ks0 = ld8(&Kh[(long)((k0) + sr) * LDK + sc]); sr_[i].ks1 = ld8(&Kh[(long)((k0) + 32 + sr) * LDK + sc]); } while (0)
#define SWRITE(b, i) do { *(bf16x8*)((char*)V_lds + (b) * SHM_V + vst0) = sr_[i].vs0;          \
    *(bf16x8*)((char*)V_lds + (b) * SHM_V + vst1) = sr_[i].vs1; int kc = sc * 2;               \
    *(bf16x8*)((char*)K_lds + (b) * SHM_K + KSWZ(sr, kc)) = sr_[i].ks0;                       \
    *(bf16x8*)((char*)K_lds + (b) * SHM_K + KSWZ(32 + sr, kc)) = sr_[i].ks1; } while (0)
#define SWAIT() do { asm volatile("s_waitcnt vmcnt(0)" ::: "memory"); } while (0)
#define RESC(a) do { if (__any((a) < 1.f)) { if (hi == 0) al_l[r32] = (a); asm volatile("s_waitcnt lgkmcnt(0)" ::: "memory"); \
    for (int d = 0; d < 4; ++d) for (int r = 0; r < 16; ++r) o[d][r] *= al_l[crow(r, hi)]; } } while (0)
  f32x16 pA0, pA1, pB0, pB1; float mnA, mnB, alA, alB; bf16x8 pa0, pa1, pa2, pa3; const int NT = seq / KVBLK;
  constexpr int SE = 0, SO = SDEPTH - 1;
  SLOAD(SE, 0); asm volatile("s_waitcnt vmcnt(0)" ::: "memory"); SWRITE(0, SE); __syncthreads();
  qkt(pA0, pA1, K_lds, qr, r32, hi); partialSM(pA0, pA1, m_reg, mnA, alA);
  SLOAD(SO, KVBLK);
  SWAIT(); SWRITE(1, SO); __syncthreads();
  for (int j = 1; j + 1 < NT; j += 2) {
    SBAR(); qkt(pB0, pB1, (bf16_t*)((char*)K_lds + SHM_K), qr, r32, hi);
    finishSM(pA0, pA1, alA, l_reg, pa0, pa1, pa2, pa3); SBAR();
    SLOAD(SO, (j + SDEPTH) * KVBLK); SBAR();
    pv_d0(o, vb0, pa0, pa1, pa2, pa3); partialSM(pB0, pB1, m_reg, mnB, alB);
    __syncthreads(); SWAIT(); SWRITE(0, SE);
    RESC(alB); __syncthreads();
    SBAR(); qkt(pA0, pA1, K_lds, qr, r32, hi);
    finishSM(pB0, pB1, alB, l_reg, pa0, pa1, pa2, pa3); SBAR();
    SLOAD(SE, (j + 1 + SDEPTH) * KVBLK); SBAR();
    pv_d0(o, vb0 + (int)SHM_V, pa0, pa1, pa2, pa3); partialSM(pA0, pA1, m_reg, mnA, alA);
    __syncthreads(); SWAIT(); SWRITE(1, SO);
    RESC(alA); __syncthreads();
  }
  SBAR(); qkt(pB0, pB1, (bf16_t*)((char*)K_lds + SHM_K), qr, r32, hi);
  finishSM(pA0, pA1, alA, l_reg, pa0, pa1, pa2, pa3); SBAR();
  pv_d0(o, vb0, pa0, pa1, pa2, pa3); partialSM(pB0, pB1, m_reg, mnB, alB);
  __syncthreads(); RESC(alB);
  finishSM(pB0, pB1, alB, l_reg, pa0, pa1, pa2, pa3); SBAR();
  pv_d0(o, vb0 + (int)SHM_V, pa0, pa1, pa2, pa3);
  if (hi == 0) li_l[r32] = l_reg; asm volatile("s_waitcnt lgkmcnt(0)" ::: "memory");
  { const int ln = opaque(lane), r32e = ln & 31, hie = ln >> 5;
    const bf16_t* Gl = Gb + (long)(wid * QBLK + 4 * hie) * LDU + r32e; bf16_t* Yl = Yb + (long)(wid * QBLK + 4 * hie) * DM + r32e;
#pragma unroll
  for (int r = 0; r < 16; ++r) { const int ro = (r & 3) + 8 * (r >> 2); const float rl = __builtin_amdgcn_rcpf(li_l[ro + 4 * hie]);
    asm volatile("" ::: "memory");
#pragma unroll
    for (int d0 = 0; d0 < 4; ++d0) { const float gv = bf2f(Gl[ro * LDU + d0 * 32]);
      Yl[ro * DM + d0 * 32] = f2bf(o[d0][r] * rl * silu(gv)); } } }
  __syncthreads();
#undef SLOAD
#undef SWRITE
#undef SWAIT
#undef RESC
}
}

__device__ __forceinline__ void attn_phase(const PV& p, int L, unsigned char* lds) {
    const bf16_t* U = (const bf16_t*)(p.ws + WS_UT); bf16_t* Y = (bf16_t*)(p.ws + WS_Y);
    const int nqb = L / 256, NB = TG / L;
    const int nitem = NB * 8 * nqb;
    const int ipp = 4 * nqb;
    for (int k = 0; k * (int)gridDim.x < nitem; ++k) {
        int it;
        if (gridDim.x == 256) { const int xcd = blockIdx.x & 7, slot = blockIdx.x >> 3; const int sub = ipp / 32;
            const int pair = (k / sub) * 8 + xcd; it = pair * ipp + (k % sub) * 32 + slot; }
        else { it = blockIdx.x + k * gridDim.x; if (it >= nitem) break; }
        const int qb = it % nqb; const int hq = (it / nqb) & 7; const int b = it / (nqb * 8); const int kvh = hq >> 2;
        const size_t row0 = (size_t)b * L + (size_t)qb * 256;
        att::attn_dense_body(U + row0 * LDU + hq * 128, U + (size_t)b * L * LDU + 1024 + kvh * 128, U + (size_t)b * L * LDU + 1280 + kvh * 128,
                             U + row0 * LDU + 1536 + hq * 128, Y + row0 * DM + hq * 128, L, (char*)lds);
    }
}

__device__ __forceinline__ void run_phase(const Params& pin, int ph, unsigned char* lds) {
    const PV p(pin, opaque_zero());
    if (ph == 0) { if (PHMASK & 1) prologue_phase(p, lds); return; }
    const int q = ph - 1, g = q / 21, r = q % 21;
    const int L = g == 0 ? 2048 : 4096;
    if (r == 0) { if (PHMASK & 2) cvt_phase(p, g); return; }
    const int layer = (r - 1) / 5, sub = (r - 1) % 5, j = layer >> 1;
    bf16_t* XB = (bf16_t*)(p.ws + WS_XB); bf16_t* UT = (bf16_t*)(p.ws + WS_UT); bf16_t* Y = (bf16_t*)(p.ws + WS_Y);
    if (sub == 4) {
#if PROBE_WHAT == 2
        if (layer != 3) ln_phase(p, g, layer, (bf16_t*)(p.ws + WS_GATE));
#endif
        if (PHMASK & 4) ln_phase(p, g, layer, XB); return; }
    if (sub == 3) {
        const bf16_t* WT = (const bf16_t*)(p.ws + ((layer & 1) ? WS_AWOUT : WS_HWOUT)) + (size_t)j * 1024 * 1024;
        EpiRes E; E.out = p.out + (size_t)g * TG * DM; E.xb = XB; E.last = layer == 3; E.bias = ((layer & 1) ? p.in(21) : p.in(15)) + j * 1024;
        E.dst = XB;
#if PROBE_WHAT == 1
        if (layer != 3) { EpiRes E0 = E; E0.dst = (bf16_t*)(p.ws + WS_GATE); run_gemm(lds, Y, WT, TG, 1024, E0); }
#endif
        if (PHMASK & 8) run_gemm(lds, Y, WT, TG, 1024, E); return;
    }
    if ((layer & 1) == 0) {
        if (sub == 0) {
            const bf16_t* WT = (const bf16_t*)(p.ws + WS_HWIN) + (size_t)j * 4096 * 1024;
            EpiUT E1; E1.O = UT; E1.bias = p.in(3) + j * 4096; E1.L = L;
            if (PHMASK & 16) run_gemm(lds, WT, XB, 3072, TG, E1);
            EpiBf16B E2; E2.O = (bf16_t*)(p.ws + WS_GATE); E2.ldc = 1024; E2.bias = p.in(3) + j * 4096 + 3072;
            if (PHMASK & 32) run_gemm(lds, XB, WT + (size_t)3072 * 1024, TG, 1024, E2);
            if (PHMASK & 2048) { if (g == 0) filter_phase<2048>(p, j, g * 2 + j, lds); else filter_phase<4096>(p, j, g * 2 + j, lds); }
        } else if (sub == 1) {
#if PROBE_WHAT == 4
            if (g == 0) conv_phase<16>(p, j, g * 2 + j, lds, Y, 1024); else conv_phase<8>(p, j, g * 2 + j, lds, Y, 1024);
#endif
            if (g == 0) { if (PHMASK & 64) conv_phase<16>(p, j, g * 2 + j, lds, UT, 3072); } else { if (PHMASK & 128) conv_phase<8>(p, j, g * 2 + j, lds, UT, 3072); } }
        else if (sub == 2) { if (PHMASK & 256) ygate_phase(p, L, lds); }
    } else {
        if (sub == 0) {
            const bf16_t* WT = (const bf16_t*)(p.ws + WS_AWIN) + (size_t)j * 2560 * 1024;
            EpiBf16B E; E.O = UT; E.ldc = LDU; E.bias = p.in(17) + j * 2560;
            if (PHMASK & 32) run_gemm(lds, XB, WT, TG, 2560, E);
        } else if (sub == 1) {
#if PROBE_WHAT == 3
            rope_phase(p, j, L, (bf16_t*)(p.ws + WS_GATE), 1280);
#endif
            if (PHMASK & 512) rope_phase(p, j, L, UT, LDU); }
        else if (sub == 2) { if (PHMASK & 1024) attn_phase(p, L, lds); }
    }
}

#ifndef DUPMASK
#define DUPMASK 0
#endif
__device__ __forceinline__ bool dup_phase(int ph) {
    if (ph == 0) return (DUPMASK >> 5) & 1;
    const int r = (ph - 1) % 21; if (r == 0) return (DUPMASK >> 5) & 1;
    const int layer = (r - 1) / 5, sub = (r - 1) % 5;
    if (sub > 2) return false;
    if ((layer & 1) == 0) return (DUPMASK >> sub) & 1;
    if (sub == 0) return (DUPMASK >> 3) & 1;
    if (sub == 2) return (DUPMASK >> 4) & 1;
    return false;
}
__device__ __forceinline__ void grid_barrier(unsigned* ctr, unsigned target) {
    asm volatile("s_waitcnt vmcnt(0)" ::: "memory");
    __syncthreads();
    if (tidx() == 0) {
        __builtin_amdgcn_fence(__ATOMIC_RELEASE, "agent");
        asm volatile("s_waitcnt vmcnt(0)" ::: "memory");
        (void)__hip_atomic_fetch_add(ctr, 1u, __ATOMIC_RELAXED, __HIP_MEMORY_SCOPE_AGENT);
        while (__hip_atomic_load(ctr, __ATOMIC_RELAXED, __HIP_MEMORY_SCOPE_AGENT) < target) __builtin_amdgcn_s_sleep(1);
        __builtin_amdgcn_fence(__ATOMIC_ACQUIRE, "agent");
        asm volatile("s_waitcnt vmcnt(0)" ::: "memory");
    }
    __syncthreads();
}

__global__ __launch_bounds__(512, 2) void mk_forward(Params p) {
    extern __shared__ __attribute__((aligned(16))) unsigned char smem[];
    cg::grid_group grid = cg::this_grid();
    unsigned* bar = (unsigned*)(p.ws + WS_BAR);
    unsigned nbar = 0;
    for (int ph = p.ph_lo; ph < p.ph_hi; ++ph) {
        if (ph == 0 && blockIdx.x == 0 && threadIdx.x == 0) __hip_atomic_store(bar, 0u, __ATOMIC_RELAXED, __HIP_MEMORY_SCOPE_AGENT);
        run_phase(p, ph, smem);
        if (ph + 1 < p.ph_hi) {
            if (ph == p.ph_lo) grid.sync();
            else { ++nbar; grid_barrier(bar, nbar * gridDim.x); }
        }
    }
}

extern "C" void kernel_launch(void* const* d_in, const int* in_sizes, int n_in, void* d_out, int out_size, void* d_ws, size_t ws_size, hipStream_t stream) {
    static int grid = 0;
    if (grid == 0) {
        if (n_in != 24 || ws_size < WS_END) { fprintf(stderr, "kernel_launch: unexpected n_in %d / ws %zu\n", n_in, ws_size); grid = -1; return; }
        int dev = 0, cus = 0, per_cu = 0;
        hipGetDevice(&dev); hipDeviceGetAttribute(&cus, hipDeviceAttributeMultiprocessorCount, dev);
        if (hipFuncSetAttribute((const void*)mk_forward, hipFuncAttributeMaxDynamicSharedMemorySize, LDS_BYTES) != hipSuccess) { fprintf(stderr, "kernel_launch: hipFuncSetAttribute failed\n"); grid = -1; return; }
        if (hipOccupancyMaxActiveBlocksPerMultiprocessor(&per_cu, (const void*)mk_forward, 512, LDS_BYTES) != hipSuccess || per_cu < 1) { fprintf(stderr, "kernel_launch: occupancy query gives %d\n", per_cu); per_cu = 1; }
        (void)hipGetLastError();
        grid = cus * per_cu;
    }
    if (grid < 0) return;
    Params p{};
    for (int i = 0; i < 24; ++i) p.in[i] = (const float*)d_in[i];
    p.out = (float*)d_out; p.ws = (unsigned char*)d_ws;
#if MK_LAUNCHES == 1
    p.ph_lo = 0; p.ph_hi = NPHASE;
    void* args[] = {&p};
    hipError_t e = hipLaunchCooperativeKernel((const void*)mk_forward, dim3(grid), dim3(512), args, LDS_BYTES, stream);
    if (e != hipSuccess) fprintf(stderr, "cooperative launch failed: %s (grid %d)\n", hipGetErrorString(e), grid);
#else
    for (int ph = 0; ph < NPHASE; ++ph) { p.ph_lo = ph; p.ph_hi = ph + 1;
        hipLaunchKernelGGL(mk_forward, dim3(grid), dim3(512), LDS_BYTES, stream, p); }
#endif
}
```

```cpp
#include <hip/hip_runtime.h>
#include <hip/hip_cooperative_groups.h>
#include <cstdio>
#include <cstdint>
namespace cg = cooperative_groups;

#ifndef MK_LAUNCHES
#define MK_LAUNCHES 1
#endif

__device__ __forceinline__ int tidx() { int t = threadIdx.x; asm volatile("" : "+v"(t)); return t; }

namespace pg8 {
#define PG8_LAS __attribute__((address_space(3)))
typedef unsigned short bf16_t;
typedef short bf16x8 __attribute__((ext_vector_type(8)));
typedef float f32x4 __attribute__((ext_vector_type(4)));
typedef unsigned u32x4 __attribute__((ext_vector_type(4)));
constexpr int BM = 256, BK = 64, HALF = 128, HTB = HALF * BK * 2  , STAGE_BYTES = 8 * HTB, NXCD = 8, WGM = 8;

__host__ __device__ __forceinline__ int lds_byte(int r, int c) { const int st = (r >> 4) * 2 + (c >> 5), rr = r & 15, cc = c & 31, ob = rr * 64 + cc * 2; return st * 1024 + (ob ^ (((ob >> 9) & 1) << 5)); }
__host__ __device__ __forceinline__ void stage_rc(int b, int& R, int& C) { const int st = b / 1024, sb = b % 1024, swz = sb ^ (((sb >> 9) & 1) << 5); R = (st >> 1) * 16 + swz / 64; C = (st & 1) * 32 + (swz % 64) / 2; }
__host__ __device__ __forceinline__ int perm32(int rho) { const int n = rho >> 4, i = rho & 15; return 8 * (i >> 2) + 4 * n + (i & 3); }

struct Unit { int pm, pn; };
struct Gemm { const bf16_t* A; const bf16_t* Bt; int M, N, K; };
struct StaticOrder {
    int nM, nN, nwg, G, c;
    __host__ __device__ void init(int M, int N, int G_, int c_) { nM = M / BM; nN = N / BM; nwg = nM * nN; G = G_; c = c_; }
    __host__ __device__ bool next(int i, Unit& u) const {
        const long L = (long)i * G + c; if (L >= nwg) return false;
        int wgid = (int)L; { const int q = nwg / NXCD, r = nwg % NXCD, xcd = wgid % NXCD, off = wgid / NXCD; wgid = (xcd < r ? xcd * (q + 1) : r * (q + 1) + (xcd - r) * q) + off; }
        const int nig = WGM * nN, gid = wgid / nig, fm = gid * WGM, gsz = (nM - fm) < WGM ? (nM - fm) : WGM;
        u.pm = fm + ((wgid % nig) % gsz); u.pn = (wgid % nig) / gsz; return true;
    }
    __device__ __forceinline__ void a_ready(const Unit&) const {}
    __device__ __forceinline__ void done(const Unit&) const {}
};
__device__ __forceinline__ unsigned cvt_pk_bf16(float lo, float hi) { unsigned r; asm volatile("v_cvt_pk_bf16_f32 %0, %1, %2" : "=v"(r) : "v"(lo), "v"(hi)); return r; }
template <class Epi, class Sched, bool STAMP = false>
__device__ __forceinline__ void gemm_phase(PG8_LAS unsigned char* lds, const Gemm g, const Sched& S, const Epi& E, unsigned long long* stamps) {
    const int tid = tidx(), wid = __builtin_amdgcn_readfirstlane(tid >> 6), lane = tid & 63, wr = wid >> 2, wc = wid & 3, fr = lane & 15, fq = lane >> 4;
    const int K = g.K, nt = K / BK;
    unsigned voffA[2], voffB[2];
#pragma unroll
    for (int i = 0; i < 2; ++i) { int R, C; stage_rc(tid * 16 + i * 8192, R, C); const int Rb = Epi::PERM ? ((R & ~31) + perm32(R & 31)) : R;
        voffA[i] = (unsigned)(R * K + C) * 2u; voffB[i] = (unsigned)(Rb * K + C) * 2u; }
    const size_t kstep = (size_t)(BK * 2);
    const size_t hstep = (size_t)HALF * K * 2;
    const size_t tstep = 2 * hstep;
    const unsigned ldsw = (unsigned)wid * 1024u;
    const int aoff = lds_byte(wr * 64 + fr, fq * 8), boff = lds_byte(wc * 32 + fr, fq * 8);
#define PG8_SA(b, h) (((b) * 2 + (h)) * HTB)
#define PG8_SB(b, h) ((4 + (b) * 2 + (h)) * HTB)
#define PG8_STAGE(bufoff, gbase, voff) do { _Pragma("unroll") for (int _i = 0; _i < 2; ++_i) \
        __builtin_amdgcn_global_load_lds((const unsigned*)((const char*)(gbase) + (voff)[_i]), (PG8_LAS unsigned*)(lds + (bufoff) + ldsw + _i * 8192), 16, 0, 0); } while (0)
#define PG8_LDA(dst, b, h) do { _Pragma("unroll") for (int m = 0; m < 4; ++m) _Pragma("unroll") for (int k = 0; k < 2; ++k) dst[m][k] = *(const PG8_LAS bf16x8*)(lds + PG8_SA(b, h) + aoff + m * 2048 + k * 1024); } while (0)
#define PG8_LDB(dst, b, h) do { _Pragma("unroll") for (int n = 0; n < 2; ++n) _Pragma("unroll") for (int k = 0; k < 2; ++k) dst[n][k] = *(const PG8_LAS bf16x8*)(lds + PG8_SB(b, h) + boff + n * 2048 + k * 1024); } while (0)
#define PG8_MMA(ai, bj, At, Bt) do { __builtin_amdgcn_s_setprio(1); _Pragma("unroll") for (int m = 0; m < 4; ++m) _Pragma("unroll") for (int n = 0; n < 2; ++n) _Pragma("unroll") for (int k = 0; k < 2; ++k) \
        acc[ai][bj][m][n] = __builtin_amdgcn_mfma_f32_16x16x32_bf16(Bt[n][k], At[m][k], acc[ai][bj][m][n], 0, 0, 0); __builtin_amdgcn_s_setprio(0); } while (0)
#define PG8_WAIT_V(n) asm volatile("s_waitcnt vmcnt(" #n ")" ::: "memory")
#define PG8_WAIT_L(n) asm volatile("s_waitcnt lgkmcnt(" #n ")" ::: "memory")
#define PG8_BAR __builtin_amdgcn_s_barrier()
#define PG8_SCHED __builtin_amdgcn_sched_barrier(0)
    Unit cur, nxt; int ui = 0;
    if (!S.next(0, cur)) return;
    f32x4 acc[2][2][4][2];
#pragma unroll
    for (int a = 0; a < 2; ++a)
#pragma unroll
        for (int b = 0; b < 2; ++b)
#pragma unroll
            for (int m = 0; m < 4; ++m)
#pragma unroll
                for (int n = 0; n < 2; ++n) acc[a][b][m][n] = (f32x4){0.f, 0.f, 0.f, 0.f};
    bf16x8 At[4][2], B0[2][2], B1[2][2];
    const char* cA = (const char*)g.A + (size_t)cur.pm * tstep; const char* cB = (const char*)g.Bt + (size_t)cur.pn * tstep;
    S.a_ready(cur);
    PG8_STAGE(PG8_SB(0, 0), cB, voffB); PG8_STAGE(PG8_SA(0, 0), cA, voffA); PG8_STAGE(PG8_SB(0, 1), cB + hstep, voffB); PG8_STAGE(PG8_SA(0, 1), cA + hstep, voffA);
    if (wr == 1) PG8_BAR;
    PG8_WAIT_V(4); PG8_BAR;
    PG8_STAGE(PG8_SB(1, 0), cB + kstep, voffB); PG8_STAGE(PG8_SA(1, 0), cA + kstep, voffA); PG8_STAGE(PG8_SB(1, 1), cB + hstep + kstep, voffB);
    PG8_WAIT_V(6); PG8_BAR;
    for (;;) {
        const bool has_next = S.next(ui + 1, nxt);
        const char* nA = has_next ? (const char*)g.A + (size_t)nxt.pm * tstep : cA; const char* nB = has_next ? (const char*)g.Bt + (size_t)nxt.pn * tstep : cB;
        for (int t = 0; t < nt; t += 2) {
            const bool last = (t == nt - 2);
            const char* a1 = cA + (size_t)(t + 1) * kstep;
            const char* a2 = last ? nA : cA + (size_t)(t + 2) * kstep; const char* b2 = last ? nB : cB + (size_t)(t + 2) * kstep;
            const char* a3 = a2 + kstep; const char* b3 = b2 + kstep;
            if (last && has_next) S.a_ready(nxt);
            PG8_LDB(B0, 0, 0); PG8_SCHED; PG8_LDA(At, 0, 0); PG8_STAGE(PG8_SA(1, 1), a1 + hstep, voffA);
            PG8_WAIT_L(8); PG8_BAR; PG8_WAIT_L(0); PG8_MMA(0, 0, At, B0); PG8_BAR; PG8_SCHED;
            PG8_LDB(B1, 0, 1); PG8_STAGE(PG8_SB(0, 0), b2, voffB);
            PG8_BAR; PG8_WAIT_L(0); PG8_MMA(0, 1, At, B1); PG8_BAR;
            PG8_LDA(At, 0, 1); PG8_STAGE(PG8_SA(0, 0), a2, voffA);
            PG8_BAR; PG8_WAIT_L(0); PG8_MMA(1, 0, At, B0); PG8_BAR; PG8_SCHED;
            PG8_STAGE(PG8_SB(0, 1), b2 + hstep, voffB);
            PG8_WAIT_V(6); PG8_BAR; PG8_MMA(1, 1, At, B1); PG8_BAR;
            PG8_LDB(B0, 1, 0); PG8_SCHED; PG8_LDA(At, 1, 0); PG8_STAGE(PG8_SA(0, 1), a2 + hstep, voffA);
            PG8_WAIT_L(8); PG8_BAR; PG8_WAIT_L(0); PG8_MMA(0, 0, At, B0); PG8_BAR; PG8_SCHED;
            PG8_LDB(B1, 1, 1); PG8_STAGE(PG8_SB(1, 0), b3, voffB);
            PG8_BAR; PG8_WAIT_L(0); PG8_MMA(0, 1, At, B1); PG8_BAR;
            PG8_LDA(At, 1, 1); PG8_STAGE(PG8_SA(1, 0), a3, voffA);
            PG8_BAR; PG8_WAIT_L(0); PG8_MMA(1, 0, At, B0); PG8_BAR; PG8_SCHED;
            PG8_STAGE(PG8_SB(1, 1), b3 + hstep, voffB);
            PG8_WAIT_V(6); PG8_BAR; PG8_MMA(1, 1, At, B1); PG8_BAR;
        }
        if constexpr (!Epi::AFTER_DRAIN) { E(acc, cur, wr, wc, fr, fq); S.done(cur); }
        if (!has_next) break;
#pragma unroll
        for (int a = 0; a < 2; ++a)
#pragma unroll
            for (int b = 0; b < 2; ++b)
#pragma unroll
                for (int m = 0; m < 4; ++m)
#pragma unroll
                    for (int n = 0; n < 2; ++n) acc[a][b][m][n] = (f32x4){0.f, 0.f, 0.f, 0.f};
        cur = nxt; cA = nA; cB = nB; ++ui;
    }
    PG8_WAIT_V(0);
    if (wr == 0) PG8_BAR;
    PG8_BAR;
    if constexpr (Epi::AFTER_DRAIN) { E.fused(acc, cur, wr, wc, fr, fq, lds, wid, lane); S.done(cur); }
#undef PG8_SA
#undef PG8_SB
#undef PG8_STAGE
#undef PG8_LDA
#undef PG8_LDB
#undef PG8_MMA
#undef PG8_WAIT_V
#undef PG8_WAIT_L
#undef PG8_BAR
#undef PG8_SCHED
}
}

using pg8::bf16_t; using pg8::bf16x8; using pg8::f32x4; using pg8::u32x4; using pg8::cvt_pk_bf16;
typedef short s16x4 __attribute__((ext_vector_type(4)));
typedef float f32x8 __attribute__((ext_vector_type(8)));
typedef float f32x16 __attribute__((ext_vector_type(16)));
typedef unsigned u32x2 __attribute__((ext_vector_type(2)));

constexpr int DM = 1024, TG = 32768;
constexpr size_t MiB = 1u << 20;
constexpr size_t WS_HWIN = 0, WS_HWOUT = 16 * MiB, WS_AWIN = 20 * MiB, WS_AWOUT = 30 * MiB, WS_H2 = 34 * MiB, WS_XB = 38 * MiB,
                 WS_UT = 102 * MiB, WS_GATE = 294 * MiB, WS_Y = 358 * MiB, WS_FILT = 422 * MiB, WS_SUMSQ = 454 * MiB, WS_BAR = 456 * MiB, WS_END = 457 * MiB;
constexpr int LDS_BYTES = 136 * 1024;
constexpr float ALPHA = 1.681792830507429f;
constexpr int NPHASE = 1 + 2 * 21;
#ifndef PHMASK
#define PHMASK 0xFFFF
#endif
#ifndef PROBE_WHAT
#define PROBE_WHAT 0
#endif

struct Params { const float* in[24]; float* out; unsigned char* ws; int ph_lo, ph_hi; };
struct PV { const Params& q; int z; float* out; unsigned char* ws;
    __device__ __forceinline__ PV(const Params& q_, int z_) : q(q_), z(z_), out(q_.out + z_), ws(q_.ws + z_) {}
    __device__ __forceinline__ const float* in(int k) const { return q.in[k + z]; } };

__device__ __forceinline__ float bf2f(unsigned short x) { return __uint_as_float(((unsigned)x) << 16); }
__device__ __forceinline__ float bf2f_s(short x) { return __uint_as_float(((unsigned)(unsigned short)x) << 16); }
__device__ __forceinline__ unsigned short f2bf(float x) { return (unsigned short)(cvt_pk_bf16(x, 0.f) & 0xffffu); }
__device__ __forceinline__ float wave_sum(float v) {
#pragma unroll
    for (int o = 32; o >= 1; o >>= 1) v += __shfl_xor(v, o, 64);
    return v;
}
template <class T> __device__ __forceinline__ T* launder(T* q) {
    unsigned long long w = (unsigned long long)q; unsigned lo = (unsigned)w, hi = (unsigned)(w >> 32);
    asm volatile("" : "+v"(lo), "+v"(hi));
    lo = __builtin_amdgcn_readfirstlane(lo); hi = __builtin_amdgcn_readfirstlane(hi);
    return (T*)(((unsigned long long)hi << 32) | lo);
}
__device__ __forceinline__ int opaque_zero() { int z = 0; asm volatile("" : "+v"(z)); return __builtin_amdgcn_readfirstlane(z); }
__device__ __forceinline__ int opaque(int x) { asm volatile("" : "+v"(x)); return x; }
__device__ __forceinline__ float silu(float x) { return x / (1.f + __expf(-x)); }

struct EpiBf16B {
    static constexpr bool PERM = true, AFTER_DRAIN = false;
    bf16_t* O; int ldc; const float* bias;
    __device__ __forceinline__ void operator()(const f32x4 (&acc)[2][2][4][2], const pg8::Unit& u, int wr, int wc, int fr, int fq) const {
        const int row0 = u.pm * 256 + wr * 64 + fr, col0 = u.pn * 256 + wc * 32 + 8 * fq;
        f32x4 bv[2][2];
#pragma unroll
        for (int bj = 0; bj < 2; ++bj)
#pragma unroll
            for (int n = 0; n < 2; ++n) bv[bj][n] = *(const f32x4*)(bias + col0 + bj * 128 + 4 * n);
#pragma unroll
        for (int ai = 0; ai < 2; ++ai)
#pragma unroll
            for (int m = 0; m < 4; ++m) { bf16_t* rowp = O + (size_t)(row0 + ai * 128 + m * 16) * ldc + col0;
#pragma unroll
                for (int bj = 0; bj < 2; ++bj) { f32x4 v0 = acc[ai][bj][m][0] + bv[bj][0], v1 = acc[ai][bj][m][1] + bv[bj][1];
                    u32x4 w; w.x = cvt_pk_bf16(v0[0], v0[1]); w.y = cvt_pk_bf16(v0[2], v0[3]); w.z = cvt_pk_bf16(v1[0], v1[1]); w.w = cvt_pk_bf16(v1[2], v1[3]);
                    *(u32x4*)(rowp + bj * 128) = w; } }
    }
};
struct EpiUT {
    static constexpr bool PERM = true, AFTER_DRAIN = false;
    bf16_t* O; const float* bias; int L;
    __device__ __forceinline__ void operator()(const f32x4 (&acc)[2][2][4][2], const pg8::Unit& u, int wr, int wc, int fr, int fq) const {
        const int row0 = u.pm * 256 + wr * 64 + fr; const int tokt = u.pn * 256; const int b = tokt / L; const int t0 = tokt - b * L + wc * 32 + 8 * fq;
#pragma unroll
        for (int ai = 0; ai < 2; ++ai)
#pragma unroll
            for (int m = 0; m < 4; ++m) { const int ch = row0 + ai * 128 + m * 16; const float bs = bias[ch];
                bf16_t* rowp = O + ((size_t)b * 3072 + ch) * L + t0;
#pragma unroll
                for (int bj = 0; bj < 2; ++bj) { f32x4 v0 = acc[ai][bj][m][0] + bs, v1 = acc[ai][bj][m][1] + bs;
                    u32x4 w; w.x = cvt_pk_bf16(v0[0], v0[1]); w.y = cvt_pk_bf16(v0[2], v0[3]); w.z = cvt_pk_bf16(v1[0], v1[1]); w.w = cvt_pk_bf16(v1[2], v1[3]);
                    *(u32x4*)(rowp + bj * 128) = w; } }
    }
};
struct EpiRes {
    static constexpr bool PERM = true, AFTER_DRAIN = false;
    float* out; bf16_t* xb; const float* bias; int last; bf16_t* dst;
    __device__ __forceinline__ void operator()(const f32x4 (&acc)[2][2][4][2], const pg8::Unit& u, int wr, int wc, int fr, int fq) const {
        const int row0 = u.pm * 256 + wr * 64 + fr, col0 = u.pn * 256 + wc * 32 + 8 * fq;
        f32x4 bv[2][2];
#pragma unroll
        for (int bj = 0; bj < 2; ++bj)
#pragma unroll
            for (int n = 0; n < 2; ++n) bv[bj][n] = *(const f32x4*)(bias + col0 + bj * 128 + 4 * n);
#pragma unroll
        for (int ai = 0; ai < 2; ++ai)
#pragma unroll
            for (int m = 0; m < 4; ++m) { const size_t ro = (size_t)(row0 + ai * 128 + m * 16) * DM + col0;
#pragma unroll
                for (int bj = 0; bj < 2; ++bj) { const bf16x8 xv = *(const bf16x8*)(xb + ro + bj * 128);
                    f32x4 v0, v1;
#pragma unroll
                    for (int e = 0; e < 4; ++e) { v0[e] = bf2f_s(xv[e]) * ALPHA + acc[ai][bj][m][0][e] + bv[bj][0][e]; v1[e] = bf2f_s(xv[4 + e]) * ALPHA + acc[ai][bj][m][1][e] + bv[bj][1][e]; }
                    if (last) { *(f32x4*)(out + ro + bj * 128) = v0; *(f32x4*)(out + ro + bj * 128 + 4) = v1; }
                    else { u32x4 w; w.x = cvt_pk_bf16(v0[0], v0[1]); w.y = cvt_pk_bf16(v0[2], v0[3]); w.z = cvt_pk_bf16(v1[0], v1[1]); w.w = cvt_pk_bf16(v1[2], v1[3]);
                        *(u32x4*)(dst + ro + bj * 128) = w; } } }
    }
};

template <class Epi> __device__ __forceinline__ void run_gemm(unsigned char* lds, const bf16_t* A, const bf16_t* Bt, int M, int N, const Epi& E) {
    pg8::Gemm g; g.A = A; g.Bt = Bt; g.M = M; g.N = N; g.K = DM;
    pg8::StaticOrder S; S.init(M, N, (int)gridDim.x, (int)blockIdx.x);
    pg8::gemm_phase<Epi, pg8::StaticOrder, false>((PG8_LAS unsigned char*)lds, g, S, E, nullptr);
    __syncthreads();
}

struct TileRef { const float* W; bf16_t* WT; int N, tk, tn; };
__device__ __forceinline__ TileRef tile_ref(const PV& p, int it) {
    const int j = it / 2176; int r = it - j * 2176; int kind;
    if (r < 1024) kind = 0; else if (r < 1280) { kind = 1; r -= 1024; } else if (r < 1920) { kind = 2; r -= 1280; } else { kind = 3; r -= 1920; }
    TileRef t; t.N = kind == 0 ? 4096 : (kind == 2 ? 2560 : 1024);
    const int nN = t.N / 64; t.tk = r / nN; t.tn = r % nN;
    t.W = (kind == 0 ? p.in(2) : kind == 1 ? p.in(14) : kind == 2 ? p.in(16) : p.in(20)) + (size_t)j * 1024 * t.N;
    t.WT = (bf16_t*)(p.ws + (kind == 0 ? WS_HWIN : kind == 1 ? WS_HWOUT : kind == 2 ? WS_AWIN : WS_AWOUT)) + (size_t)j * 1024 * t.N;
    return t;
}
__device__ __forceinline__ void prologue_phase(const PV& p, unsigned char* lds) {
    const int tid = tidx();
    { const int wid = __builtin_amdgcn_readfirstlane(tid >> 6), lane = tid & 63;
        for (int j = 0; j < 2; ++j) {
            const float* w1 = p.in(6) + j * 33 * 64; const float* w2 = p.in(9) + j * 64 * 64;
            float w1r[33], w2r[64];
#pragma unroll
            for (int i = 0; i < 33; ++i) w1r[i] = w1[i * 64 + lane];
#pragma unroll
            for (int i = 0; i < 64; ++i) w2r[i] = w2[i * 64 + lane];
            const float b1v = p.in(7)[j * 64 + lane], b2v = p.in(10)[j * 64 + lane], fr = p.in(8)[j * 64 + lane];
            for (int row = blockIdx.x * 8 + wid; row < 6144; row += gridDim.x * 8) {
                int t = row; const int sel = t >= 2048 ? 1 : 0; if (sel) t -= 2048; const int L = sel ? 4096 : 2048;
                float feat = 0.f;
                if (lane == 0) feat = (float)t / (float)(L - 1);
                else if (lane <= 32) { const int i = (lane - 1) & 15; const double f = 1e-4 + (double)i * ((15.0 - 1e-4) / 15.0);
                    double ph = f * (double)t / (double)L; ph -= (double)(long long)ph;
                    const float a = (float)(ph * 6.283185307179586);
                    feat = lane <= 16 ? cosf(a) : -sinf(a); }
                float s = b1v;
#pragma unroll
                for (int i = 0; i < 33; ++i) s += __shfl(feat, i, 64) * w1r[i];
                const float h1 = sinf(fr * s);
                float s2 = b2v;
#pragma unroll
                for (int i = 0; i < 64; ++i) s2 += __shfl(h1, i, 64) * w2r[i];
                ((float*)(p.ws + WS_H2))[((size_t)(j * 2 + sel) * 4096 + t) * 64 + lane] = sinf(fr * s2);
            }
        }
    }
    { float* tile = (float*)lds;
        const int total = 2 * 2176;
        f32x4 v[2];
        int it = blockIdx.x;
        if (it < total) { const TileRef t = tile_ref(p, it);
#pragma unroll
            for (int i = 0; i < 2; ++i) { const int q = tid + i * 512; v[i] = *(const f32x4*)(t.W + (size_t)(t.tk * 64 + (q >> 4)) * t.N + t.tn * 64 + (q & 15) * 4); } }
        for (; it < total; it += gridDim.x) {
            const TileRef t = tile_ref(p, it);
#pragma unroll
            for (int i = 0; i < 2; ++i) { const int q = tid + i * 512, k = q >> 4, n4 = (q & 15) * 4;
                tile[k * 65 + n4 + 0] = v[i][0]; tile[k * 65 + n4 + 1] = v[i][1]; tile[k * 65 + n4 + 2] = v[i][2]; tile[k * 65 + n4 + 3] = v[i][3]; }
            __syncthreads();
            if (it + (int)gridDim.x < total) { const TileRef t2 = tile_ref(p, it + gridDim.x);
#pragma unroll
                for (int i = 0; i < 2; ++i) { const int q = tid + i * 512; v[i] = *(const f32x4*)(t2.W + (size_t)(t2.tk * 64 + (q >> 4)) * t2.N + t2.tn * 64 + (q & 15) * 4); } }
            { const int n = tid >> 3, k8 = (tid & 7) * 8; float x[8];
#pragma unroll
                for (int e = 0; e < 8; ++e) x[e] = tile[(k8 + e) * 65 + n];
                u32x4 w; w.x = cvt_pk_bf16(x[0], x[1]); w.y = cvt_pk_bf16(x[2], x[3]); w.z = cvt_pk_bf16(x[4], x[5]); w.w = cvt_pk_bf16(x[6], x[7]);
                *(u32x4*)(t.WT + (size_t)(t.tn * 64 + n) * 1024 + t.tk * 64 + k8) = w; }
            __syncthreads();
        }
    }
}

__device__ __forceinline__ void cvt_phase(const PV& p, int g) {
    const float* x = p.in(g); bf16_t* xb = (bf16_t*)(p.ws + WS_XB);
    const size_t n8 = (size_t)TG * DM / 8;
    for (size_t i = (size_t)blockIdx.x * 512 + tidx(); i < n8; i += (size_t)gridDim.x * 512) {
        const f32x4 a = *(const f32x4*)(x + i * 8), b = *(const f32x4*)(x + i * 8 + 4);
        u32x4 w; w.x = cvt_pk_bf16(a[0], a[1]); w.y = cvt_pk_bf16(a[2], a[3]); w.z = cvt_pk_bf16(b[0], b[1]); w.w = cvt_pk_bf16(b[2], b[3]);
        *(u32x4*)(xb + i * 8) = w;
    }
}

__device__ __forceinline__ void ln_phase(const PV& p, int g, int layer, bf16_t* xdst) {
    float* x = p.out + (size_t)g * TG * DM; bf16_t* xb = (bf16_t*)(p.ws + WS_XB);
    const float* gam = p.in(22) + layer * DM; const float* bet = p.in(23) + layer * DM;
    const int tid_ = tidx(); const int wid = __builtin_amdgcn_readfirstlane(tid_ >> 6), lane = tid_ & 63;
    const bool last = layer == 3;
    f32x4 gv[4], bv[4];
#pragma unroll
    for (int k = 0; k < 4; ++k) { const int c = (k >> 1) * 512 + lane * 8 + (k & 1) * 4; gv[k] = *(const f32x4*)(gam + c); bv[k] = *(const f32x4*)(bet + c); }
    constexpr int NR = 2;
    for (int row0 = (blockIdx.x * 8 + wid) * NR; row0 < TG; row0 += gridDim.x * 8 * NR) {
        f32x4 v[NR][4];
#pragma unroll
        for (int rr = 0; rr < NR; ++rr) { const size_t ro = (size_t)(row0 + rr) * DM;
            if (last) {
#pragma unroll
                for (int k = 0; k < 4; ++k) v[rr][k] = *(const f32x4*)(x + ro + (k >> 1) * 512 + lane * 8 + (k & 1) * 4);
            } else {
#pragma unroll
                for (int hh = 0; hh < 2; ++hh) { const bf16x8 t = *(const bf16x8*)(xb + ro + hh * 512 + lane * 8);
#pragma unroll
                    for (int e = 0; e < 4; ++e) { v[rr][hh * 2][e] = bf2f_s(t[e]); v[rr][hh * 2 + 1][e] = bf2f_s(t[4 + e]); } }
            } }
        float s[NR], q[NR];
#pragma unroll
        for (int rr = 0; rr < NR; ++rr) { s[rr] = 0.f;
#pragma unroll
            for (int k = 0; k < 4; ++k) s[rr] += v[rr][k][0] + v[rr][k][1] + v[rr][k][2] + v[rr][k][3]; }
#pragma unroll
        for (int o = 32; o >= 1; o >>= 1) {
#pragma unroll
            for (int rr = 0; rr < NR; ++rr) s[rr] += __shfl_xor(s[rr], o, 64); }
#pragma unroll
        for (int rr = 0; rr < NR; ++rr) { const float mu = s[rr] * (1.f / DM); q[rr] = 0.f;
#pragma unroll
            for (int k = 0; k < 4; ++k) { v[rr][k] = v[rr][k] - mu; q[rr] += v[rr][k][0] * v[rr][k][0] + v[rr][k][1] * v[rr][k][1] + v[rr][k][2] * v[rr][k][2] + v[rr][k][3] * v[rr][k][3]; } }
#pragma unroll
        for (int o = 32; o >= 1; o >>= 1) {
#pragma unroll
            for (int rr = 0; rr < NR; ++rr) q[rr] += __shfl_xor(q[rr], o, 64); }
#pragma unroll
        for (int rr = 0; rr < NR; ++rr) { const size_t ro = (size_t)(row0 + rr) * DM; const float rstd = rsqrtf(q[rr] * (1.f / DM) + 1e-5f);
#pragma unroll
            for (int k = 0; k < 4; ++k) v[rr][k] = v[rr][k] * rstd * gv[k] + bv[k];
            if (last) {
#pragma unroll
                for (int k = 0; k < 4; ++k) *(f32x4*)(x + ro + (k >> 1) * 512 + lane * 8 + (k & 1) * 4) = v[rr][k];
            } else {
#pragma unroll
                for (int hh = 0; hh < 2; ++hh) { u32x4 w; w.x = cvt_pk_bf16(v[rr][hh * 2][0], v[rr][hh * 2][1]); w.y = cvt_pk_bf16(v[rr][hh * 2][2], v[rr][hh * 2][3]);
                    w.z = cvt_pk_bf16(v[rr][hh * 2 + 1][0], v[rr][hh * 2 + 1][1]); w.w = cvt_pk_bf16(v[rr][hh * 2 + 1][2], v[rr][hh * 2 + 1][3]);
                    *(u32x4*)(xdst + ro + hh * 512 + lane * 8) = w; }
            } }
    }
}

template <int L> __device__ __forceinline__ void filter_phase(const PV& p, int hj, int slot, unsigned char* lds) {
    const int tid = tidx(), wid = __builtin_amdgcn_readfirstlane(tid >> 6), lane = tid & 63;
    const float* h2 = (const float*)(p.ws + WS_H2) + (size_t)(hj * 2 + (L == 2048 ? 0 : 1)) * 4096 * 64;
    const float* w3 = p.in(11) + (size_t)hj * 64 * 4096; const float* decay = p.in(12) + hj * 4096;
    bf16_t* FILT = (bf16_t*)(p.ws + WS_FILT); float* PART = (float*)(p.ws + WS_SUMSQ);
    float* stg = (float*)lds;
    unsigned* tile = (unsigned*)(lds + 65536);
    constexpr int NCH = L / 256;
    for (int it = blockIdx.x; it < 64 * NCH; it += gridDim.x) {
        const int cb = it / NCH, chunk = it - cb * NCH, t0 = chunk * 256;
        const int od = cb >> 4, dir = od & 1, o = od >> 1, col = cb * 64 + lane, c = col & 1023;
        const int tb = t0 + dir;
        __syncthreads();
#pragma unroll
        for (int i = 0; i < 8; ++i) { const int q = tid + 512 * i, rr = q >> 4, c4 = (q & 15) * 4; int tr = tb + rr; tr = tr < L ? tr : L - 1;
            *(f32x4*)(stg + rr * 64 + c4) = *(const f32x4*)(h2 + (size_t)tr * 64 + c4); }
        float w[64];
#pragma unroll
        for (int j = 0; j < 64; ++j) w[j] = w3[(size_t)j * 4096 + col];
        const float dec = fabsf(decay[col]);
        float ss = 0.f;
        if (dir == 1 && t0 == 0 && wid == 0) {
            float d = 0.f;
#pragma unroll
            for (int j = 0; j < 64; ++j) d += h2[j] * w[j];
            ss = d * d; }
        __syncthreads();
        unsigned short* trow = (unsigned short*)(tile + lane * 129);
#pragma unroll 2
        for (int tt = 0; tt < 32; ++tt) {
            const int tl = wid * 32 + tt, t = tb + tl; const f32x4* hr = (const f32x4*)(stg + tl * 64);
            float d = 0.f;
#pragma unroll
            for (int jq = 0; jq < 16; ++jq) { const f32x4 x = hr[jq]; d += x[0] * w[jq * 4] + x[1] * w[jq * 4 + 1] + x[2] * w[jq * 4 + 2] + x[3] * w[jq * 4 + 3]; }
            d *= expf(-(float)t * (1.0f / (float)(L - 1)) * dec);
            if (t >= L) d = 0.f;
            ss += d * d;
            trow[dir ? tl : 255 - tl] = f2bf(d);
        }
        PART[(size_t)col * (NCH * 8) + chunk * 8 + wid] = ss;
        __syncthreads();
        { const int cc = tid >> 3, part = tid & 7; const unsigned* src = tile + cc * 129 + part * 16;
            const int ccol = cb * 64 + cc, c2 = ccol & 1023;
            bf16_t* dst = FILT + ((size_t)(o * 1024 + c2)) * (2 * L) + (dir ? L + t0 : L - 256 - t0) + part * 32;
#pragma unroll
            for (int k = 0; k < 4; ++k) { u32x4 v; v.x = src[k * 4]; v.y = src[k * 4 + 1]; v.z = src[k * 4 + 2]; v.w = src[k * 4 + 3]; *(u32x4*)(dst + k * 8) = v; } }
    }
    __syncthreads();
}

__device__ __forceinline__ bf16x8 lds_a4(const unsigned char* lds, unsigned addr) {
    const unsigned* q = (const unsigned*)(lds + addr); u32x4 w; w.x = q[0]; w.y = q[1]; w.z = q[2]; w.w = q[3]; return *reinterpret_cast<bf16x8*>(&w);
}
template <int NB> struct ConvCfg {
    static constexpr int L = NB == 16 ? 2048 : 4096, ROWE = L + 8, SB = NB == 16 ? 0 : -2048, NT = NB == 16 ? 64 : 192;
    static constexpr int ZOFF = 0, FOFF = 66560, FCOPY = 2 * L * 2, W3OFF = FOFF + 4 * FCOPY, REDOFF = W3OFF + 1024;
};
template <int NB> __device__ __forceinline__ void conv_main(const unsigned char* lds, int o, f32x4 (&acc)[16]) {
    using C = ConvCfg<NB>;
    const int tid_ = tidx(); const int lane = tid_ & 63, wid = __builtin_amdgcn_readfirstlane(tid_ >> 6), r = lane & 15, gq = lane >> 4;
    const int b = NB == 16 ? r : (r & 7), h = NB == 16 ? 0 : (r >> 3);
    const int E0 = (C::L - 1) + C::SB - 256 * wid + 8 * gq - r;
    const int P = E0 & 1;
    unsigned aPtr = (unsigned)(C::FOFF + (o * 2 + P) * C::FCOPY + 2 * (E0 - P));
    const int bBase = C::ZOFF + b * C::ROWE * 2 + 2 * (C::SB + 2048 * h + 8 * gq);
    const int s_lane0 = C::SB + 2048 * h;
    bf16x8 A[16];
#pragma unroll
    for (int i = 0; i < 16; ++i) { A[i] = lds_a4(lds, aPtr - 32 * i); acc[i] = (f32x4){0.f, 0.f, 0.f, 0.f}; }
    auto ldb = [&](int j) -> bf16x8 {
        if (NB == 16) return *(const bf16x8*)(lds + bBase + 64 * j);
        const bool valid = (unsigned)(s_lane0 + 32 * j) < (unsigned)C::L;
        const bf16x8 t = *(const bf16x8*)(lds + (valid ? bBase + 64 * j : C::ZOFF));
        const bf16x8 z = {0, 0, 0, 0, 0, 0, 0, 0}; return valid ? t : z; };
    bf16x8 bnext = ldb(0);
    for (int jo = 0; jo < C::NT / 8; ++jo) {
#pragma unroll
        for (int jj = 0; jj < 8; ++jj) {
            const int j = jo * 8 + jj;
            const bf16x8 bf = bnext;
            bnext = ldb(j + 1 < C::NT ? j + 1 : j);
            acc[15] = __builtin_amdgcn_mfma_f32_16x16x32_bf16(A[(15 - 2 * jj) & 15], bf, acc[15], 0, 0, 0);
            acc[14] = __builtin_amdgcn_mfma_f32_16x16x32_bf16(A[(14 - 2 * jj) & 15], bf, acc[14], 0, 0, 0);
            A[(14 - 2 * jj) & 15] = lds_a4(lds, aPtr + 64 * (jj + 1));
            A[(15 - 2 * jj) & 15] = lds_a4(lds, aPtr + 64 * (jj + 1) - 32);
#pragma unroll
            for (int i = 13; i >= 0; --i) acc[i] = __builtin_amdgcn_mfma_f32_16x16x32_bf16(A[(i - 2 * jj) & 15], bf, acc[i], 0, 0, 0);
            __builtin_amdgcn_sched_barrier(0);
        }
        aPtr += 512;
    }
}
template <int NB, int I0, int I1> __device__ __forceinline__ void conv_gload(const bf16_t* UT, int gch, s16x4 (&gu)[16], unsigned (&gh)[16]) {
    using C = ConvCfg<NB>;
    const int tid_ = tidx(); const int lane = tid_ & 63, wid = __builtin_amdgcn_readfirstlane(tid_ >> 6), r = lane & 15, gq = lane >> 4;
    const int b = NB == 16 ? r : (r & 7), h = NB == 16 ? 0 : (r >> 3);
    const bf16_t* grow = UT + ((size_t)b * 3072 + gch) * C::L;
#pragma unroll
    for (int i = I0; i < I1; ++i) {
        const int t = 256 * wid + 16 * i + 4 * gq + 2048 * h;
        gu[i] = *(const s16x4*)(grow + t);
        const unsigned lo = grow[t > 0 ? t - 1 : 0], hi = grow[(t + 4 < C::L) ? t + 4 : C::L - 1];
        gh[i] = lo | (hi << 16);
    }
}
template <int NB> __device__ __forceinline__ void conv_epi(const unsigned char* lds, const f32x4 (&acc)[16], u32x2 (&zp)[16], const s16x4 (&gu_)[16], const unsigned (&gh)[16],
                                                          float gw0, float gw1, float gw2, float gcb, float fb, float nrm) {
    using C = ConvCfg<NB>;
    const int tid_ = tidx(); const int lane = tid_ & 63, wid = __builtin_amdgcn_readfirstlane(tid_ >> 6), r = lane & 15, gq = lane >> 4;
    const int b = NB == 16 ? r : (r & 7), h = NB == 16 ? 0 : (r >> 3);
#pragma unroll
    for (int i = 0; i < 16; ++i) {
        const int t = 256 * wid + 16 * i + 4 * gq + 2048 * h;
        const s16x4 gu = gu_[i];
        const float gl = t > 0 ? bf2f((unsigned short)(gh[i] & 0xffffu)) : 0.f, gr = (t + 4 < C::L) ? bf2f((unsigned short)(gh[i] >> 16)) : 0.f;
        const float u0 = bf2f_s(gu[0]), u1 = bf2f_s(gu[1]), u2 = bf2f_s(gu[2]), u3 = bf2f_s(gu[3]);
        const float g0 = gw0 * gl + gw1 * u0 + gw2 * u1 + gcb, g1 = gw0 * u0 + gw1 * u1 + gw2 * u2 + gcb;
        const float g2 = gw0 * u1 + gw1 * u2 + gw2 * u3 + gcb, g3 = gw0 * u2 + gw1 * u3 + gw2 * gr + gcb;
        const s16x4 vz = *(const s16x4*)(lds + C::ZOFF + (b * C::ROWE + t) * 2);
        const float z0 = g0 * (acc[i][0] * nrm + bf2f_s(vz[0]) * fb), z1 = g1 * (acc[i][1] * nrm + bf2f_s(vz[1]) * fb);
        const float z2 = g2 * (acc[i][2] * nrm + bf2f_s(vz[2]) * fb), z3 = g3 * (acc[i][3] * nrm + bf2f_s(vz[3]) * fb);
        zp[i].x = cvt_pk_bf16(z0, z1); zp[i].y = cvt_pk_bf16(z2, z3);
    }
}
template <int NB> __device__ __forceinline__ void conv_store_z(unsigned char* lds, const u32x2 (&zp)[16]) {
    using C = ConvCfg<NB>;
    const int tid_ = tidx(); const int lane = tid_ & 63, wid = __builtin_amdgcn_readfirstlane(tid_ >> 6), r = lane & 15, gq = lane >> 4;
    const int b = NB == 16 ? r : (r & 7), h = NB == 16 ? 0 : (r >> 3);
#pragma unroll
    for (int i = 0; i < 16; ++i) { const int t = 256 * wid + 16 * i + 4 * gq + 2048 * h; *(u32x2*)(lds + C::ZOFF + (b * C::ROWE + t) * 2) = zp[i]; }
}

template <int NB> __device__ __forceinline__ void conv_phase(const PV& p, int hj, int slot, unsigned char* lds, bf16_t* zdst, int zstride) {
    using C = ConvCfg<NB>;
    constexpr int L = C::L;
    const int tid_wg = tidx(), wid = __builtin_amdgcn_readfirstlane(tid_wg >> 6), lane = tid_wg & 63;
    bf16_t* UT = (bf16_t*)(p.ws + WS_UT);
    const float* w3 = p.in(11) + (size_t)hj * 64 * 4096; const float* decay = p.in(12) + hj * 4096;
    const float* fbias = p.in(13) + hj * 2048; const float* cw = p.in(4) + hj * 3 * 3072; const float* cb = p.in(5) + hj * 3072;
    float* w3s = (float*)(lds + C::W3OFF); float* red = (float*)(lds + C::REDOFF);
    for (int c = blockIdx.x; c < 1024; c += gridDim.x) {
        __syncthreads();
        const int tid = opaque(tid_wg);
        constexpr int NF = (2 * (2 * L / 8)) / 512;
        u32x4 fr[NF]; bf16x8 vx[8]; float hl[8], hr[8];
        { const bf16_t* FILT = (const bf16_t*)(p.ws + WS_FILT);
#pragma unroll
            for (int i = 0; i < NF; ++i) { const int q = tid + 512 * i, o = q / (2 * L / 8), i8 = (q - o * (2 * L / 8)) * 8;
                fr[i] = *(const u32x4*)(FILT + ((size_t)(o * 1024 + c)) * (2 * L) + i8); } }
#pragma unroll
        for (int i = 0; i < 8; ++i) { const int chunk = tid + 512 * i, b = chunk / (L / 8), s8 = (chunk % (L / 8)) * 8;
            const bf16_t* src = UT + ((size_t)b * 3072 + c) * L + s8;
            vx[i] = *(const bf16x8*)src; const float a_ = bf2f(src[s8 > 0 ? -1 : 0]), b_ = bf2f(src[(s8 + 8 < L) ? 8 : 7]);
            hl[i] = s8 > 0 ? a_ : 0.f; hr[i] = (s8 + 8 < L) ? b_ : 0.f; }
        { constexpr int NP = (L / 256) * 8; const float* PART = (const float*)(p.ws + WS_SUMSQ);
            const int o = tid >> 8, idx = tid & 255, dir = idx / NP, k = idx - dir * NP;
            float v = (idx < 2 * NP) ? PART[(size_t)((o * 2 + dir) * 1024 + c) * NP + k] : 0.f;
            v = wave_sum(v); if (lane == 0) red[wid] = v; }
#pragma unroll
        for (int i = 0; i < NF; ++i) { const int q = tid + 512 * i, o = q / (2 * L / 8), i8 = (q - o * (2 * L / 8)) * 8;
            *(u32x4*)(lds + C::FOFF + (o * 2) * C::FCOPY + i8 * 2) = fr[i]; }
        { const float w0 = cw[c], w1 = cw[3072 + c], w2 = cw[2 * 3072 + c], cbv = cb[c];
#pragma unroll
            for (int i = 0; i < 8; ++i) { const int chunk = tid + 512 * i, b = chunk / (L / 8), s8 = (chunk % (L / 8)) * 8;
                float xe[10]; xe[0] = hl[i]; xe[9] = hr[i];
#pragma unroll
                for (int e = 0; e < 8; ++e) xe[e + 1] = bf2f_s(vx[i][e]);
                float y[8];
#pragma unroll
                for (int e = 0; e < 8; ++e) y[e] = w0 * xe[e] + w1 * xe[e + 1] + w2 * xe[e + 2] + cbv;
                u32x4 w; w.x = cvt_pk_bf16(y[0], y[1]); w.y = cvt_pk_bf16(y[2], y[3]); w.z = cvt_pk_bf16(y[4], y[5]); w.w = cvt_pk_bf16(y[6], y[7]);
                *(u32x4*)(lds + C::ZOFF + (b * C::ROWE + s8) * 2) = w;
                __builtin_amdgcn_sched_barrier(0); } }
        __syncthreads();
        const float nrm0 = rsqrtf(red[0] + red[1] + red[2] + red[3] + 1e-6f), nrm1 = rsqrtf(red[4] + red[5] + red[6] + red[7] + 1e-6f);
#pragma unroll
        for (int i = 0; i < NF; ++i) { const int q = tid + 512 * i, o = q / (2 * L / 8), m4 = (q - o * (2 * L / 8)) * 4;
            const unsigned* s0 = (const unsigned*)(lds + C::FOFF + (o * 2) * C::FCOPY) + m4; unsigned* d1 = (unsigned*)(lds + C::FOFF + (o * 2 + 1) * C::FCOPY) + m4;
            const u32x4 a = *(const u32x4*)s0; const unsigned nx = (m4 + 4 < L) ? s0[4] : 0u;
            u32x4 r; r.x = __builtin_amdgcn_alignbit(a.y, a.x, 16); r.y = __builtin_amdgcn_alignbit(a.z, a.y, 16); r.z = __builtin_amdgcn_alignbit(a.w, a.z, 16); r.w = __builtin_amdgcn_alignbit(nx, a.w, 16);
            *(u32x4*)d1 = r; }
        __syncthreads();
        f32x4 acc[16]; u32x2 zp[16]; s16x4 gu[16]; unsigned gh[16];
        conv_gload<NB, 0, 8>(UT, 1024 + c, gu, gh);
        conv_main<NB>(lds, 0, acc);
        conv_gload<NB, 8, 16>(UT, 1024 + c, gu, gh);
        conv_epi<NB>(lds, acc, zp, gu, gh, cw[1024 + c], cw[3072 + 1024 + c], cw[2 * 3072 + 1024 + c], cb[1024 + c], fbias[c], nrm0);
        __syncthreads();
        conv_store_z<NB>(lds, zp);
        __syncthreads();
        conv_gload<NB, 0, 8>(UT, 2048 + c, gu, gh);
        conv_main<NB>(lds, 1, acc);
        conv_gload<NB, 8, 16>(UT, 2048 + c, gu, gh);
        conv_epi<NB>(lds, acc, zp, gu, gh, cw[2048 + c], cw[3072 + 2048 + c], cw[2 * 3072 + 2048 + c], cb[2048 + c], fbias[1024 + c], nrm1);
        __syncthreads();
        conv_store_z<NB>(lds, zp);
        __syncthreads();
#pragma unroll
        for (int i = 0; i < 8; ++i) { const int chunk = tid + 512 * i, b = chunk / (L / 8), s8 = (chunk % (L / 8)) * 8;
            *(u32x4*)(zdst + ((size_t)b * zstride + c) * L + s8) = *(const u32x4*)(lds + C::ZOFF + (b * C::ROWE + s8) * 2); }
        __syncthreads();
    }
}

__device__ __forceinline__ void ygate_phase(const PV& p, int L, unsigned char* lds) {
    const bf16_t* UT = (const bf16_t*)(p.ws + WS_UT); const bf16_t* G = (const bf16_t*)(p.ws + WS_GATE); bf16_t* Y = (bf16_t*)(p.ws + WS_Y);
    const int tid = tidx(); constexpr int RS = 136;
    bf16_t* tile = (bf16_t*)lds;
    const int nit = (TG / 128) * 16;
    u32x4 zr[2]; bf16x8 gr[2];
    auto issue = [&](int it) {
        const int tc = it & 15, tt = it >> 4; const int tok0 = tt * 128, b = tok0 / L, t0 = tok0 - b * L, c0 = tc * 64;
#pragma unroll
        for (int i = 0; i < 2; ++i) { const int q = tid + i * 512;
            zr[i] = *(const u32x4*)(UT + ((size_t)b * 3072 + c0 + (q >> 4)) * L + t0 + (q & 15) * 8);
            gr[i] = *(const bf16x8*)(G + (size_t)(tok0 + (q >> 3)) * DM + c0 + (q & 7) * 8); } };
    int it = blockIdx.x;
    if (it < nit) issue(it);
    for (; it < nit; it += gridDim.x) {
        const int tc = it & 15, tt = it >> 4; const int tok0 = tt * 128, c0 = tc * 64;
#pragma unroll
        for (int i = 0; i < 2; ++i) { const int q = tid + i * 512; *(u32x4*)(tile + (q >> 4) * RS + (q & 15) * 8) = zr[i]; }
        const bf16x8 g0 = gr[0], g1 = gr[1];
        __syncthreads();
        if (it + (int)gridDim.x < nit) issue(it + gridDim.x);
#pragma unroll
        for (int i = 0; i < 2; ++i) { const int q = tid + i * 512, t = q >> 3, cch = (q & 7) * 8; const bf16x8 gv = i ? g1 : g0; float y[8];
#pragma unroll
            for (int e = 0; e < 8; ++e) y[e] = bf2f(tile[(cch + e) * RS + t]) * silu(bf2f_s(gv[e]));
            u32x4 w; w.x = cvt_pk_bf16(y[0], y[1]); w.y = cvt_pk_bf16(y[2], y[3]); w.z = cvt_pk_bf16(y[4], y[5]); w.w = cvt_pk_bf16(y[6], y[7]);
            *(u32x4*)(Y + (size_t)(tok0 + t) * DM + c0 + cch) = w; }
        __syncthreads();
    }
}

constexpr int LDU = 2560;
__device__ __forceinline__ void rope_phase(const PV& p, int aj, int L, bf16_t* D, int ldd) {
    bf16_t* U = (bf16_t*)(p.ws + WS_UT);
    const float* qn = p.in(18) + aj * 128; const float* kn = p.in(19) + aj * 128;
    const int tid = tidx(), sub = tid & 7;
    float inv[8], q1[8], q2[8], k1[8], k2[8];
#pragma unroll
    for (int e = 0; e < 8; ++e) { inv[e] = exp2f(-(float)((8 * sub + e) & 31) * (13.287712379549449f / 32.f));
        q1[e] = qn[8 * sub + e]; q2[e] = qn[64 + 8 * sub + e]; k1[e] = kn[8 * sub + e]; k2[e] = kn[64 + 8 * sub + e]; }
    for (int tok = blockIdx.x * 64 + (tid >> 3); tok < TG; tok += gridDim.x * 64) {
        const int t = tok & (L - 1); const float pos = (float)(sub < 4 ? (t >> 6) : (t & 63));
        float cs[8], sn[8];
#pragma unroll
        for (int e = 0; e < 8; ++e) { const float ang = pos * inv[e]; cs[e] = __cosf(ang); sn[e] = __sinf(ang); }
        bf16_t* u = U + (size_t)tok * LDU + 8 * sub;
#pragma unroll
        for (int hd = 0; hd < 10; ++hd) {
            const bf16x8 a = *(const bf16x8*)(u + hd * 128), bq = *(const bf16x8*)(u + hd * 128 + 64);
            float x1[8], x2[8]; float ss = 0.f;
#pragma unroll
            for (int e = 0; e < 8; ++e) { x1[e] = bf2f_s(a[e]); x2[e] = bf2f_s(bq[e]); ss += x1[e] * x1[e] + x2[e] * x2[e]; }
            ss += __shfl_xor(ss, 1, 64); ss += __shfl_xor(ss, 2, 64); ss += __shfl_xor(ss, 4, 64);
            const float rs = rsqrtf(ss * (1.f / 128.f) + 1e-6f);
            float o1[8], o2[8];
#pragma unroll
            for (int e = 0; e < 8; ++e) { const float xa = x1[e] * rs * (hd < 8 ? q1[e] : k1[e]), xb2 = x2[e] * rs * (hd < 8 ? q2[e] : k2[e]);
                o1[e] = xa * cs[e] - xb2 * sn[e]; o2[e] = xb2 * cs[e] + xa * sn[e]; }
            u32x4 w1, w2; w1.x = cvt_pk_bf16(o1[0], o1[1]); w1.y = cvt_pk_bf16(o1[2], o1[3]); w1.z = cvt_pk_bf16(o1[4], o1[5]); w1.w = cvt_pk_bf16(o1[6], o1[7]);
            w2.x = cvt_pk_bf16(o2[0], o2[1]); w2.y = cvt_pk_bf16(o2[2], o2[3]); w2.z = cvt_pk_bf16(o2[4], o2[5]); w2.w = cvt_pk_bf16(o2[6], o2[7]);
            bf16_t* d = D + (size_t)tok * ldd + 8 * sub; *(u32x4*)(d + hd * 128) = w1; *(u32x4*)(d + hd * 128 + 64) = w2;
        }
    }
}

namespace att {
constexpr int D = 128, NW = 8, QBLK = 32, KVBLK = 64;
constexpr float SCALE = 0.088388347648318440f;
constexpr float THR = 8.f;
constexpr int LDQ = LDU, LDK = LDU;
constexpr size_t SHM_V = KVBLK * D * 2, SHM_K = KVBLK * D * 2, SHM_ATTN = 2 * SHM_V + 2 * SHM_K + NW * 64 * 4;
#define KSWZ(row, colB) ((row) * 256 + ((colB) ^ (((row) & 7) << 4)))
#define SBAR() __builtin_amdgcn_sched_barrier(0)
__device__ __forceinline__ int crow(int r, int hi) { return (r & 3) + 8 * (r >> 2) + 4 * hi; }
__device__ __forceinline__ unsigned cvtpk(float lo, float hi) { unsigned r; asm volatile("v_cvt_pk_bf16_f32 %0, %1, %2" : "=v"(r) : "v"(lo), "v"(hi)); return r; }
__device__ __forceinline__ bf16x8 ld8(const bf16_t* p) { return *reinterpret_cast<const bf16x8*>(p); }
__device__ __forceinline__ void partialSM(f32x16& p0, f32x16& p1, float& m_reg, float& mn, float& alpha) {
  constexpr float C = SCALE * 1.4426950408889634f;
  float pmax = p0[0]; for (int r = 1; r < 16; ++r) pmax = fmaxf(pmax, p0[r]); for (int r = 0; r < 16; ++r) pmax = fmaxf(pmax, p1[r]);
  { auto rr = __builtin_amdgcn_permlane32_swap(__float_as_uint(pmax), __float_as_uint(pmax), false, false);
    pmax = fmaxf(__uint_as_float(rr[0]), __uint_as_float(rr[1])); }
  if (__builtin_expect(__all(pmax - m_reg <= THR / SCALE), 1)) { mn = m_reg; alpha = 1.f; }
  else { mn = fmaxf(m_reg, pmax); alpha = __builtin_amdgcn_exp2f((m_reg - mn) * C); m_reg = mn; }
  float mnC = -mn * C;
  for (int r = 0; r < 16; ++r) p0[r] = fmaf(p0[r], C, mnC); for (int r = 0; r < 16; ++r) p1[r] = fmaf(p1[r], C, mnC);
  for (int r = 0; r < 16; ++r) p0[r] = __builtin_amdgcn_exp2f(p0[r]);
}
__device__ __forceinline__ void finishSM(f32x16& p0, f32x16& p1, float alpha, float& l_reg, bf16x8& pa0, bf16x8& pa1, bf16x8& pa2, bf16x8& pa3) {
  for (int r = 0; r < 16; ++r) p1[r] = __builtin_amdgcn_exp2f(p1[r]);
  float ps = 0; for (int r = 0; r < 16; ++r) ps += p0[r]; for (int r = 0; r < 16; ++r) ps += p1[r];
  { auto rr = __builtin_amdgcn_permlane32_swap(__float_as_uint(ps), __float_as_uint(ps), false, false);
    ps = __uint_as_float(rr[0]) + __uint_as_float(rr[1]); }
  l_reg = l_reg * alpha + ps;
#define PK4(P, BASE, OUT) do { unsigned a0 = cvtpk(P[BASE + 0], P[BASE + 1]), a1 = cvtpk(P[BASE + 2], P[BASE + 3]);   \
    unsigned b0 = cvtpk(P[BASE + 4], P[BASE + 5]), b1 = cvtpk(P[BASE + 6], P[BASE + 7]);                              \
    auto r0 = __builtin_amdgcn_permlane32_swap(a0, b0, false, false); auto r1 = __builtin_amdgcn_permlane32_swap(a1, b1, false, false); \
    u32x4 w = {r0[0], r1[0], r0[1], r1[1]}; OUT = *reinterpret_cast<bf16x8*>(&w); } while (0)
  PK4(p0, 0, pa0); PK4(p0, 8, pa1); PK4(p1, 0, pa2); PK4(p1, 8, pa3);
#undef PK4
}
__device__ __forceinline__ void qkt(f32x16& p0, f32x16& p1, const bf16_t* Ks, const bf16x8* qr, int r32, int hi) {
  p0 = f32x16{}; p1 = f32x16{};
  for (int d0 = 0; d0 < 8; ++d0) { int cb = (d0 * 16 + hi * 8) * 2;
    bf16x8 b0 = *reinterpret_cast<const bf16x8*>((const char*)Ks + KSWZ(r32, cb));
    bf16x8 b1 = *reinterpret_cast<const bf16x8*>((const char*)Ks + KSWZ(32 + r32, cb));
    p0 = __builtin_amdgcn_mfma_f32_32x32x16_bf16(b0, qr[d0], p0, 0, 0, 0);
    p1 = __builtin_amdgcn_mfma_f32_32x32x16_bf16(b1, qr[d0], p1, 0, 0, 0); }
}
__device__ __forceinline__ int v_st(int k, int c) { const int kk = (k & ~0xC) | ((k & 4) << 1) | ((k & 8) >> 1); return ((kk >> 3) * 4 + (c >> 5)) * 512 + ((kk & 7) * 32 + (c & 31)) * 2; }
__device__ __forceinline__ int v_rd_base(int lane) { return ((lane & 3) << 3) | (((lane >> 2) & 3) << 6) | (((lane >> 4) & 1) << 5) | (((lane >> 5) & 1) << 8); }
constexpr int v_rd_off(int d0, int ks, int half) { return d0 * 512 + ks * 4096 + half * 2048; }
template <int OFF> __device__ __forceinline__ s16x4 tr_read(int vb) {
  s16x4 r; asm volatile("ds_read_b64_tr_b16 %0, %1 offset:%2" : "=&v"(r) : "v"(vb), "i"(OFF) : "memory"); return r;
}
template <int D0> __device__ __forceinline__ void pv_one(f32x16& od, int vb, bf16x8 pa0, bf16x8 pa1, bf16x8 pa2, bf16x8 pa3) {
  const s16x4 l0 = tr_read<v_rd_off(D0, 0, 0)>(vb), h0 = tr_read<v_rd_off(D0, 0, 1)>(vb), l1 = tr_read<v_rd_off(D0, 1, 0)>(vb), h1 = tr_read<v_rd_off(D0, 1, 1)>(vb);
  const s16x4 l2 = tr_read<v_rd_off(D0, 2, 0)>(vb), h2 = tr_read<v_rd_off(D0, 2, 1)>(vb), l3 = tr_read<v_rd_off(D0, 3, 0)>(vb), h3 = tr_read<v_rd_off(D0, 3, 1)>(vb);
  asm volatile("s_waitcnt lgkmcnt(0)" ::: "memory"); SBAR();
#define PK(L, H) (bf16x8){L[0], L[1], L[2], L[3], H[0], H[1], H[2], H[3]}
  od = __builtin_amdgcn_mfma_f32_32x32x16_bf16(pa0, PK(l0, h0), od, 0, 0, 0);
  od = __builtin_amdgcn_mfma_f32_32x32x16_bf16(pa1, PK(l1, h1), od, 0, 0, 0);
  od = __builtin_amdgcn_mfma_f32_32x32x16_bf16(pa2, PK(l2, h2), od, 0, 0, 0);
  od = __builtin_amdgcn_mfma_f32_32x32x16_bf16(pa3, PK(l3, h3), od, 0, 0, 0);
#undef PK
}
__device__ __forceinline__ void pv_d0(f32x16* o, int vb, bf16x8 pa0, bf16x8 pa1, bf16x8 pa2, bf16x8 pa3) {
  pv_one<0>(o[0], vb, pa0, pa1, pa2, pa3); pv_one<1>(o[1], vb, pa0, pa1, pa2, pa3); pv_one<2>(o[2], vb, pa0, pa1, pa2, pa3); pv_one<3>(o[3], vb, pa0, pa1, pa2, pa3);
}
__device__ __forceinline__ void attn_dense_body(const bf16_t* __restrict__ Qb, const bf16_t* __restrict__ Kh, const bf16_t* __restrict__ Vh,
                                                const bf16_t* __restrict__ Gb, bf16_t* __restrict__ Yb, int seq, char* lds) {
  constexpr int SDEPTH = 1;
  const int tid = tidx(), wid = __builtin_amdgcn_readfirstlane(tid >> 6), lane = tid & 63, r32 = lane & 31, hi = lane >> 5;
  bf16_t* V_lds = (bf16_t*)lds; bf16_t* K_lds = (bf16_t*)(lds + 2 * SHM_V);
  float* ws = (float*)(lds + 2 * SHM_V + 2 * SHM_K) + wid * 64; float* li_l = ws; float* al_l = ws + 32;
  float m_reg = -1e30f, l_reg = 0; f32x16 o[4] = {}; bf16x8 qr[8];
  const bf16_t* Qw = Qb + (long)(wid * QBLK + r32) * LDQ + hi * 8;
#pragma unroll
  for (int d0 = 0; d0 < 8; ++d0) qr[d0] = ld8(Qw + d0 * 16);
  const int sr = tid >> 4, sc = (tid & 15) * 8, vst0 = v_st(sr, sc), vst1 = v_st(32 + sr, sc);
  const int vb0 = (int)(uintptr_t)V_lds + v_rd_base(lane);
  struct { bf16x8 vs0, vs1, ks0, ks1; } sr_[SDEPTH];
#define SLOAD(i, k0) do { sr_[i].vs0 = ld8(&Vh[(long)((k0) + sr) * LDK + sc]); sr_[i].vs1 = ld8(&Vh[(long)((k0) + 32 + sr) * LDK + sc]); \
    sr_[i].ks0 = ld8(&Kh[(long)((k0) + sr) * LDK + sc]); sr_[i].ks1 = ld8(&Kh[(long)((k0) + 32 + sr) * LDK + sc]); } while (0)
#define SWRITE(b, i) do { *(bf16x8*)((char*)V_lds + (b) * SHM_V + vst0) = sr_[i].vs0;          \
    *(bf16x8*)((char*)V_lds + (b) * SHM_V + vst1) = sr_[i].vs1; int kc = sc * 2;               \
    *(bf16x8*)((char*)K_lds + (b) * SHM_K + KSWZ(sr, kc)) = sr_[i].ks0;                       \
    *(bf16x8*)((char*)K_lds + (b) * SHM_K + KSWZ(32 + sr, kc)) = sr_[i].ks1; } while (0)
#define SWAIT() do { asm volatile("s_waitcnt vmcnt(0)" ::: "memory"); } while (0)
#define RESC(a) do { if (__any((a) < 1.f)) { if (hi == 0) al_l[r32] = (a); asm volatile("s_waitcnt lgkmcnt(0)" ::: "memory"); \
    for (int d = 0; d < 4; ++d) for (int r = 0; r < 16; ++r) o[d][r] *= al_l[crow(r, hi)]; } } while (0)
  f32x16 pA0, pA1, pB0, pB1; float mnA, mnB, alA, alB; bf16x8 pa0, pa1, pa2, pa3; const int NT = seq / KVBLK;
  constexpr int SE = 0, SO = SDEPTH - 1;
  SLOAD(SE, 0); asm volatile("s_waitcnt vmcnt(0)" ::: "memory"); SWRITE(0, SE); __syncthreads();
  qkt(pA0, pA1, K_lds, qr, r32, hi); partialSM(pA0, pA1, m_reg, mnA, alA);
  SLOAD(SO, KVBLK);
  SWAIT(); SWRITE(1, SO); __syncthreads();
  for (int j = 1; j + 1 < NT; j += 2) {
    SBAR(); qkt(pB0, pB1, (bf16_t*)((char*)K_lds + SHM_K), qr, r32, hi);
    finishSM(pA0, pA1, alA, l_reg, pa0, pa1, pa2, pa3); SBAR();
    SLOAD(SO, (j + SDEPTH) * KVBLK); SBAR();
    pv_d0(o, vb0, pa0, pa1, pa2, pa3); partialSM(pB0, pB1, m_reg, mnB, alB);
    __syncthreads(); SWAIT(); SWRITE(0, SE);
    RESC(alB); __syncthreads();
    SBAR(); qkt(pA0, pA1, K_lds, qr, r32, hi);
    finishSM(pB0, pB1, alB, l_reg, pa0, pa1, pa2, pa3); SBAR();
    SLOAD(SE, (j + 1 + SDEPTH) * KVBLK); SBAR();
    pv_d0(o, vb0 + (int)SHM_V, pa0, pa1, pa2, pa3); partialSM(pA0, pA1, m_reg, mnA, alA);
    __syncthreads(); SWAIT(); SWRITE(1, SO);
    RESC(alA); __syncthreads();
  }
  SBAR(); qkt(pB0, pB1, (bf16_t*)((char*)K_lds + SHM_K), qr, r32, hi);
  finishSM(pA0, pA1, alA, l_reg, pa0, pa1, pa2, pa3); SBAR();
  pv_d0(o, vb0, pa0, pa1, pa2, pa3); partialSM(pB0, pB1, m_reg, mnB, alB);
  __syncthreads(); RESC(alB);
  finishSM(pB0, pB1, alB, l_reg, pa0, pa1, pa2, pa3); SBAR();
  pv_d0(o, vb0 + (int)SHM_V, pa0, pa1, pa2, pa3);
  if (hi == 0) li_l[r32] = l_reg; asm volatile("s_waitcnt lgkmcnt(0)" ::: "memory");
  { const int ln = opaque(lane), r32e = ln & 31, hie = ln >> 5;
    const bf16_t* Gl = Gb + (long)(wid * QBLK + 4 * hie) * LDU + r32e; bf16_t* Yl = Yb + (long)(wid * QBLK + 4 * hie) * DM + r32e;
#pragma unroll
  for (int r = 0; r < 16; ++r) { const int ro = (r & 3) + 8 * (r >> 2); const float rl = __builtin_amdgcn_rcpf(li_l[ro + 4 * hie]);
    asm volatile("" ::: "memory");
#pragma unroll
    for (int d0 = 0; d0 < 4; ++d0) { const float gv = bf2f(Gl[ro * LDU + d0 * 32]);
      Yl[ro * DM + d0 * 32] = f2bf(o[d0][r] * rl * silu(gv)); } } }
  __syncthreads();
#undef SLOAD
#undef SWRITE
#undef SWAIT
#undef RESC
}
}

__device__ __forceinline__ void attn_phase(const PV& p, int L, unsigned char* lds) {
    const bf16_t* U = (const bf16_t*)(p.ws + WS_UT); bf16_t* Y = (bf16_t*)(p.ws + WS_Y);
    const int nqb = L / 256, NB = TG / L;
    const int nitem = NB * 8 * nqb;
    const int ipp = 4 * nqb;
    for (int k = 0; k * (int)gridDim.x < nitem; ++k) {
        int it;
        if (gridDim.x == 256) { const int xcd = blockIdx.x & 7, slot = blockIdx.x >> 3; const int sub = ipp / 32;
            const int pair = (k / sub) * 8 + xcd; it = pair * ipp + (k % sub) * 32 + slot; }
        else { it = blockIdx.x + k * gridDim.x; if (it >= nitem) break; }
        const int qb = it % nqb; const int hq = (it / nqb) & 7; const int b = it / (nqb * 8); const int kvh = hq >> 2;
        const size_t row0 = (size_t)b * L + (size_t)qb * 256;
        att::attn_dense_body(U + row0 * LDU + hq * 128, U + (size_t)b * L * LDU + 1024 + kvh * 128, U + (size_t)b * L * LDU + 1280 + kvh * 128,
                             U + row0 * LDU + 1536 + hq * 128, Y + row0 * DM + hq * 128, L, (char*)lds);
    }
}

__device__ __forceinline__ void run_phase(const Params& pin, int ph, unsigned char* lds) {
    const PV p(pin, opaque_zero());
    if (ph == 0) { if (PHMASK & 1) prologue_phase(p, lds); return; }
    const int q = ph - 1, g = q / 21, r = q % 21;
    const int L = g == 0 ? 2048 : 4096;
    if (r == 0) { if (PHMASK & 2) cvt_phase(p, g); return; }
    const int layer = (r - 1) / 5, sub = (r - 1) % 5, j = layer >> 1;
    bf16_t* XB = (bf16_t*)(p.ws + WS_XB); bf16_t* UT = (bf16_t*)(p.ws + WS_UT); bf16_t* Y = (bf16_t*)(p.ws + WS_Y);
    if (sub == 4) {
#if PROBE_WHAT == 2
        if (layer != 3) ln_phase(p, g, layer, (bf16_t*)(p.ws + WS_GATE));
#endif
        if (PHMASK & 4) ln_phase(p, g, layer, XB); return; }
    if (sub == 3) {
        const bf16_t* WT = (const bf16_t*)(p.ws + ((layer & 1) ? WS_AWOUT : WS_HWOUT)) + (size_t)j * 1024 * 1024;
        EpiRes E; E.out = p.out + (size_t)g * TG * DM; E.xb = XB; E.last = layer == 3; E.bias = ((layer & 1) ? p.in(21) : p.in(15)) + j * 1024;
        E.dst = XB;
#if PROBE_WHAT == 1
        if (layer != 3) { EpiRes E0 = E; E0.dst = (bf16_t*)(p.ws + WS_GATE); run_gemm(lds, Y, WT, TG, 1024, E0); }
#endif
        if (PHMASK & 8) run_gemm(lds, Y, WT, TG, 1024, E); return;
    }
    if ((layer & 1) == 0) {
        if (sub == 0) {
            const bf16_t* WT = (const bf16_t*)(p.ws + WS_HWIN) + (size_t)j * 4096 * 1024;
            EpiUT E1; E1.O = UT; E1.bias = p.in(3) + j * 4096; E1.L = L;
            if (PHMASK & 16) run_gemm(lds, WT, XB, 3072, TG, E1);
            EpiBf16B E2; E2.O = (bf16_t*)(p.ws + WS_GATE); E2.ldc = 1024; E2.bias = p.in(3) + j * 4096 + 3072;
            if (PHMASK & 32) run_gemm(lds, XB, WT + (size_t)3072 * 1024, TG, 1024, E2);
            if (PHMASK & 2048) { if (g == 0) filter_phase<2048>(p, j, g * 2 + j, lds); else filter_phase<4096>(p, j, g * 2 + j, lds); }
        } else if (sub == 1) {
#if PROBE_WHAT == 4
            if (g == 0) conv_phase<16>(p, j, g * 2 + j, lds, Y, 1024); else conv_phase<8>(p, j, g * 2 + j, lds, Y, 1024);
#endif
            if (g == 0) { if (PHMASK & 64) conv_phase<16>(p, j, g * 2 + j, lds, UT, 3072); } else { if (PHMASK & 128) conv_phase<8>(p, j, g * 2 + j, lds, UT, 3072); } }
        else if (sub == 2) { if (PHMASK & 256) ygate_phase(p, L, lds); }
    } else {
        if (sub == 0) {
            const bf16_t* WT = (const bf16_t*)(p.ws + WS_AWIN) + (size_t)j * 2560 * 1024;
            EpiBf16B E; E.O = UT; E.ldc = LDU; E.bias = p.in(17) + j * 2560;
            if (PHMASK & 32) run_gemm(lds, XB, WT, TG, 2560, E);
        } else if (sub == 1) {
#if PROBE_WHAT == 3
            rope_phase(p, j, L, (bf16_t*)(p.ws + WS_GATE), 1280);
#endif
            if (PHMASK & 512) rope_phase(p, j, L, UT, LDU); }
        else if (sub == 2) { if (PHMASK & 1024) attn_phase(p, L, lds); }
    }
}

#ifndef DUPMASK
#define DUPMASK 0
#endif
__device__ __forceinline__ bool dup_phase(int ph) {
    if (ph == 0) return (DUPMASK >> 5) & 1;
    const int r = (ph - 1) % 21; if (r == 0) return (DUPMASK >> 5) & 1;
    const int layer = (r - 1) / 5, sub = (r - 1) % 5;
    if (sub > 2) return false;
    if ((layer & 1) == 0) return (DUPMASK >> sub) & 1;
    if (sub == 0) return (DUPMASK >> 3) & 1;
    if (sub == 2) return (DUPMASK >> 4) & 1;
    return false;
}
#define XB_XCNT(j)  (256  + 64 * (j))
#define XB_XSUB(j)  (1280 + 64 * (j))
#define XB_XGEN(j)  (2304 + 64 * (j))
#define XB_TOP      3328
#define XB_TOPGEN   3392
#define XCD_BAR_WORDS 3456
__device__ __forceinline__ unsigned xb_ld(unsigned* p)              { return __hip_atomic_load(p, __ATOMIC_RELAXED, __HIP_MEMORY_SCOPE_AGENT); }
__device__ __forceinline__ unsigned xb_add(unsigned* p, unsigned v) { return __hip_atomic_fetch_add(p, v, __ATOMIC_RELAXED, __HIP_MEMORY_SCOPE_AGENT); }
__device__ __forceinline__ unsigned xb_xcc_id() { return (unsigned)__builtin_amdgcn_s_getreg((3 << 11) | 20) & 0xFu; }
__device__ __forceinline__ void xcd_barrier(unsigned* bar, unsigned x, unsigned& nloc, unsigned& nx) {
    asm volatile("s_waitcnt vmcnt(0)" ::: "memory");
    __syncthreads();
    if (tidx() == 0) {
        __builtin_amdgcn_s_waitcnt(0);
        if (nloc == 0u) {
            const unsigned G = gridDim.x; unsigned sum, cnt, mine;
            for (;;) { sum = 0u; cnt = 0u; mine = 0u;
#pragma unroll
                for (unsigned j = 0; j < 16; ++j) { const unsigned c = xb_ld(&bar[XB_XCNT(j)]); sum += c; cnt += (c > 0u) ? 1u : 0u; mine = (j == x) ? c : mine; }
                if (sum == G) break;
                __builtin_amdgcn_s_sleep(1); }
            nloc = mine > 0u ? mine : 1u; nx = cnt > 0u ? cnt : 1u; }
        const unsigned old = xb_add(&bar[XB_XSUB(x)], 1u);
        const unsigned gen = old / nloc;
        if (old + 1u == (gen + 1u) * nloc) {
            __builtin_amdgcn_fence(__ATOMIC_RELEASE, "agent");
            asm volatile("s_waitcnt vmcnt(0)" ::: "memory");
            const unsigned og = xb_add(&bar[XB_TOP], 1u);
            const unsigned tg = og / nx;
            if (og + 1u == (tg + 1u) * nx) xb_add(&bar[XB_TOPGEN], 1u);
            else while (xb_ld(&bar[XB_TOPGEN]) == tg) __builtin_amdgcn_s_sleep(1);
            __builtin_amdgcn_fence(__ATOMIC_ACQUIRE, "agent");
            xb_add(&bar[XB_XGEN(x)], 1u);
            asm volatile("s_waitcnt vmcnt(0)" ::: "memory");
        } else {
            while (xb_ld(&bar[XB_XGEN(x)]) == gen) __builtin_amdgcn_s_sleep(1);
            __builtin_amdgcn_fence(__ATOMIC_ACQUIRE, "agent");
            asm volatile("s_waitcnt vmcnt(0)" ::: "memory");
        }
    }
    __syncthreads();
}

__global__ __launch_bounds__(512, 2) void mk_forward(Params p) {
    extern __shared__ __attribute__((aligned(16))) unsigned char smem[];
    cg::grid_group grid = cg::this_grid();
    unsigned* bar = (unsigned*)(p.ws + WS_BAR);
    unsigned xcc = 0, nloc = 0, nx = 0;
    for (int ph = p.ph_lo; ph < p.ph_hi; ++ph) {
        if (ph == 0 && blockIdx.x == 0) for (int i = threadIdx.x; i < XCD_BAR_WORDS; i += 512) __hip_atomic_store(bar + i, 0u, __ATOMIC_RELAXED, __HIP_MEMORY_SCOPE_AGENT);
        run_phase(p, ph, smem);
        if (ph + 1 < p.ph_hi) {
            if (ph == p.ph_lo) { grid.sync();
                xcc = xb_xcc_id(); if (threadIdx.x == 0) (void)xb_add(&bar[XB_XCNT(xcc)], 1u); }
            else xcd_barrier(bar, xcc, nloc, nx);
        }
    }
}

extern "C" void kernel_launch(void* const* d_in, const int* in_sizes, int n_in, void* d_out, int out_size, void* d_ws, size_t ws_size, hipStream_t stream) {
    static int grid = 0;
    if (grid == 0) {
        if (n_in != 24 || ws_size < WS_END) { fprintf(stderr, "kernel_launch: unexpected n_in %d / ws %zu\n", n_in, ws_size); grid = -1; return; }
        int dev = 0, cus = 0, per_cu = 0;
        hipGetDevice(&dev); hipDeviceGetAttribute(&cus, hipDeviceAttributeMultiprocessorCount, dev);
        if (hipFuncSetAttribute((const void*)mk_forward, hipFuncAttributeMaxDynamicSharedMemorySize, LDS_BYTES) != hipSuccess) { fprintf(stderr, "kernel_launch: hipFuncSetAttribute failed\n"); grid = -1; return; }
        if (hipOccupancyMaxActiveBlocksPerMultiprocessor(&per_cu, (const void*)mk_forward, 512, LDS_BYTES) != hipSuccess || per_cu < 1) { fprintf(stderr, "kernel_launch: occupancy query gives %d\n", per_cu); per_cu = 1; }
        (void)hipGetLastError();
        grid = cus * per_cu;
    }
    if (grid < 0) return;
    Params p{};
    for (int i = 0; i < 24; ++i) p.in[i] = (const float*)d_in[i];
    p.out = (float*)d_out; p.ws = (unsigned char*)d_ws;
#if MK_LAUNCHES == 1
    p.ph_lo = 0; p.ph_hi = NPHASE;
    void* args[] = {&p};
    hipError_t e = hipLaunchCooperativeKernel((const void*)mk_forward, dim3(grid), dim3(512), args, LDS_BYTES, stream);
    if (e != hipSuccess) fprintf(stderr, "cooperative launch failed: %s (grid %d)\n", hipGetErrorString(e), grid);
#else
    for (int ph = 0; ph < NPHASE; ++ph) { p.ph_lo = ph; p.ph_hi = ph + 1;
        hipLaunchKernelGGL(mk_forward, dim3(grid), dim3(512), LDS_BYTES, stream, p); }
#endif
}
```

```cpp
#include <hip/hip_runtime.h>
#include <hip/hip_cooperative_groups.h>
#include <cstdio>
#include <cstdint>
namespace cg = cooperative_groups;

#ifndef MK_LAUNCHES
#define MK_LAUNCHES 1
#endif

__device__ __forceinline__ int tidx() { int t = threadIdx.x; asm volatile("" : "+v"(t)); return t; }

namespace pg8 {
#define PG8_LAS __attribute__((address_space(3)))
typedef unsigned short bf16_t;
typedef short bf16x8 __attribute__((ext_vector_type(8)));
typedef float f32x4 __attribute__((ext_vector_type(4)));
typedef unsigned u32x4 __attribute__((ext_vector_type(4)));
constexpr int BM = 256, BK = 64, HALF = 128, HTB = HALF * BK * 2  , STAGE_BYTES = 8 * HTB, NXCD = 8, WGM = 8;

__host__ __device__ __forceinline__ int lds_byte(int r, int c) { const int st = (r >> 4) * 2 + (c >> 5), rr = r & 15, cc = c & 31, ob = rr * 64 + cc * 2; return st * 1024 + (ob ^ (((ob >> 9) & 1) << 5)); }
__host__ __device__ __forceinline__ void stage_rc(int b, int& R, int& C) { const int st = b / 1024, sb = b % 1024, swz = sb ^ (((sb >> 9) & 1) << 5); R = (st >> 1) * 16 + swz / 64; C = (st & 1) * 32 + (swz % 64) / 2; }
__host__ __device__ __forceinline__ int perm32(int rho) { const int n = rho >> 4, i = rho & 15; return 8 * (i >> 2) + 4 * n + (i & 3); }

struct Unit { int pm, pn; };
struct Gemm { const bf16_t* A; const bf16_t* Bt; int M, N, K; };
struct StaticOrder {
    int nM, nN, nwg, G, c;
    __host__ __device__ void init(int M, int N, int G_, int c_) { nM = M / BM; nN = N / BM; nwg = nM * nN; G = G_; c = c_; }
    __host__ __device__ bool next(int i, Unit& u) const {
        const long L = (long)i * G + c; if (L >= nwg) return false;
        int wgid = (int)L; { const int q = nwg / NXCD, r = nwg % NXCD, xcd = wgid % NXCD, off = wgid / NXCD; wgid = (xcd < r ? xcd * (q + 1) : r * (q + 1) + (xcd - r) * q) + off; }
        const int nig = WGM * nN, gid = wgid / nig, fm = gid * WGM, gsz = (nM - fm) < WGM ? (nM - fm) : WGM;
        u.pm = fm + ((wgid % nig) % gsz); u.pn = (wgid % nig) / gsz; return true;
    }
    __device__ __forceinline__ void a_ready(const Unit&) const {}
    __device__ __forceinline__ void done(const Unit&) const {}
};
__device__ __forceinline__ unsigned cvt_pk_bf16(float lo, float hi) { unsigned r; asm volatile("v_cvt_pk_bf16_f32 %0, %1, %2" : "=v"(r) : "v"(lo), "v"(hi)); return r; }
template <class Epi, class Sched, bool STAMP = false>
__device__ __forceinline__ void gemm_phase(PG8_LAS unsigned char* lds, const Gemm g, const Sched& S, const Epi& E, unsigned long long* stamps) {
    const int tid = tidx(), wid = __builtin_amdgcn_readfirstlane(tid >> 6), lane = tid & 63, wr = wid >> 2, wc = wid & 3, fr = lane & 15, fq = lane >> 4;
    const int K = g.K, nt = K / BK;
    unsigned voffA[2], voffB[2];
#pragma unroll
    for (int i = 0; i < 2; ++i) { int R, C; stage_rc(tid * 16 + i * 8192, R, C); const int Rb = Epi::PERM ? ((R & ~31) + perm32(R & 31)) : R;
        voffA[i] = (unsigned)(R * K + C) * 2u; voffB[i] = (unsigned)(Rb * K + C) * 2u; }
    const size_t kstep = (size_t)(BK * 2);
    const size_t hstep = (size_t)HALF * K * 2;
    const size_t tstep = 2 * hstep;
    const unsigned ldsw = (unsigned)wid * 1024u;
    const int aoff = lds_byte(wr * 64 + fr, fq * 8), boff = lds_byte(wc * 32 + fr, fq * 8);
#define PG8_SA(b, h) (((b) * 2 + (h)) * HTB)
#define PG8_SB(b, h) ((4 + (b) * 2 + (h)) * HTB)
#define PG8_STAGE(bufoff, gbase, voff) do { _Pragma("unroll") for (int _i = 0; _i < 2; ++_i) \
        __builtin_amdgcn_global_load_lds((const unsigned*)((const char*)(gbase) + (voff)[_i]), (PG8_LAS unsigned*)(lds + (bufoff) + ldsw + _i * 8192), 16, 0, 0); } while (0)
#define PG8_LDA(dst, b, h) do { _Pragma("unroll") for (int m = 0; m < 4; ++m) _Pragma("unroll") for (int k = 0; k < 2; ++k) dst[m][k] = *(const PG8_LAS bf16x8*)(lds + PG8_SA(b, h) + aoff + m * 2048 + k * 1024); } while (0)
#define PG8_LDB(dst, b, h) do { _Pragma("unroll") for (int n = 0; n < 2; ++n) _Pragma("unroll") for (int k = 0; k < 2; ++k) dst[n][k] = *(const PG8_LAS bf16x8*)(lds + PG8_SB(b, h) + boff + n * 2048 + k * 1024); } while (0)
#define PG8_MMA(ai, bj, At, Bt) do { __builtin_amdgcn_s_setprio(1); _Pragma("unroll") for (int m = 0; m < 4; ++m) _Pragma("unroll") for (int n = 0; n < 2; ++n) _Pragma("unroll") for (int k = 0; k < 2; ++k) \
        acc[ai][bj][m][n] = __builtin_amdgcn_mfma_f32_16x16x32_bf16(Bt[n][k], At[m][k], acc[ai][bj][m][n], 0, 0, 0); __builtin_amdgcn_s_setprio(0); } while (0)
#define PG8_WAIT_V(n) asm volatile("s_waitcnt vmcnt(" #n ")" ::: "memory")
#define PG8_WAIT_L(n) asm volatile("s_waitcnt lgkmcnt(" #n ")" ::: "memory")
#define PG8_BAR __builtin_amdgcn_s_barrier()
#define PG8_SCHED __builtin_amdgcn_sched_barrier(0)
    Unit cur, nxt; int ui = 0;
    if (!S.next(0, cur)) return;
    f32x4 acc[2][2][4][2];
#pragma unroll
    for (int a = 0; a < 2; ++a)
#pragma unroll
        for (int b = 0; b < 2; ++b)
#pragma unroll
            for (int m = 0; m < 4; ++m)
#pragma unroll
                for (int n = 0; n < 2; ++n) acc[a][b][m][n] = (f32x4){0.f, 0.f, 0.f, 0.f};
    bf16x8 At[4][2], B0[2][2], B1[2][2];
    const char* cA = (const char*)g.A + (size_t)cur.pm * tstep; const char* cB = (const char*)g.Bt + (size_t)cur.pn * tstep;
    S.a_ready(cur);
    PG8_STAGE(PG8_SB(0, 0), cB, voffB); PG8_STAGE(PG8_SA(0, 0), cA, voffA); PG8_STAGE(PG8_SB(0, 1), cB + hstep, voffB); PG8_STAGE(PG8_SA(0, 1), cA + hstep, voffA);
    if (wr == 1) PG8_BAR;
    PG8_WAIT_V(4); PG8_BAR;
    PG8_STAGE(PG8_SB(1, 0), cB + kstep, voffB); PG8_STAGE(PG8_SA(1, 0), cA + kstep, voffA); PG8_STAGE(PG8_SB(1, 1), cB + hstep + kstep, voffB);
    PG8_WAIT_V(6); PG8_BAR;
    for (;;) {
        const bool has_next = S.next(ui + 1, nxt);
        const char* nA = has_next ? (const char*)g.A + (size_t)nxt.pm * tstep : cA; const char* nB = has_next ? (const char*)g.Bt + (size_t)nxt.pn * tstep : cB;
        for (int t = 0; t < nt; t += 2) {
            const bool last = (t == nt - 2);
            const char* a1 = cA + (size_t)(t + 1) * kstep;
            const char* a2 = last ? nA : cA + (size_t)(t + 2) * kstep; const char* b2 = last ? nB : cB + (size_t)(t + 2) * kstep;
            const char* a3 = a2 + kstep; const char* b3 = b2 + kstep;
            if (last && has_next) S.a_ready(nxt);
            PG8_LDB(B0, 0, 0); PG8_SCHED; PG8_LDA(At, 0, 0); PG8_STAGE(PG8_SA(1, 1), a1 + hstep, voffA);
            PG8_WAIT_L(8); PG8_BAR; PG8_WAIT_L(0); PG8_MMA(0, 0, At, B0); PG8_BAR; PG8_SCHED;
            PG8_LDB(B1, 0, 1); PG8_STAGE(PG8_SB(0, 0), b2, voffB);
            PG8_BAR; PG8_WAIT_L(0); PG8_MMA(0, 1, At, B1); PG8_BAR;
            PG8_LDA(At, 0, 1); PG8_STAGE(PG8_SA(0, 0), a2, voffA);
            PG8_BAR; PG8_WAIT_L(0); PG8_MMA(1, 0, At, B0); PG8_BAR; PG8_SCHED;
            PG8_STAGE(PG8_SB(0, 1), b2 + hstep, voffB);
            PG8_WAIT_V(6); PG8_BAR; PG8_MMA(1, 1, At, B1); PG8_BAR;
            PG8_LDB(B0, 1, 0); PG8_SCHED; PG8_LDA(At, 1, 0); PG8_STAGE(PG8_SA(0, 1), a2 + hstep, voffA);
            PG8_WAIT_L(8); PG8_BAR; PG8_WAIT_L(0); PG8_MMA(0, 0, At, B0); PG8_BAR; PG8_SCHED;
            PG8_LDB(B1, 1, 1); PG8_STAGE(PG8_SB(1, 0), b3, voffB);
            PG8_BAR; PG8_WAIT_L(0); PG8_MMA(0, 1, At, B1); PG8_BAR;
            PG8_LDA(At, 1, 1); PG8_STAGE(PG8_SA(1, 0), a3, voffA);
            PG8_BAR; PG8_WAIT_L(0); PG8_MMA(1, 0, At, B0); PG8_BAR; PG8_SCHED;
            PG8_STAGE(PG8_SB(1, 1), b3 + hstep, voffB);
            PG8_WAIT_V(6); PG8_BAR; PG8_MMA(1, 1, At, B1); PG8_BAR;
        }
        if constexpr (!Epi::AFTER_DRAIN) { E(acc, cur, wr, wc, fr, fq); S.done(cur); }
        if (!has_next) break;
#pragma unroll
        for (int a = 0; a < 2; ++a)
#pragma unroll
            for (int b = 0; b < 2; ++b)
#pragma unroll
                for (int m = 0; m < 4; ++m)
#pragma unroll
                    for (int n = 0; n < 2; ++n) acc[a][b][m][n] = (f32x4){0.f, 0.f, 0.f, 0.f};
        cur = nxt; cA = nA; cB = nB; ++ui;
    }
    PG8_WAIT_V(0);
    if (wr == 0) PG8_BAR;
    PG8_BAR;
    if constexpr (Epi::AFTER_DRAIN) { E.fused(acc, cur, wr, wc, fr, fq, lds, wid, lane); S.done(cur); }
#undef PG8_SA
#undef PG8_SB
#undef PG8_STAGE
#undef PG8_LDA
#undef PG8_LDB
#undef PG8_MMA
#undef PG8_WAIT_V
#undef PG8_WAIT_L
#undef PG8_BAR
#undef PG8_SCHED
}
}

using pg8::bf16_t; using pg8::bf16x8; using pg8::f32x4; using pg8::u32x4; using pg8::cvt_pk_bf16;
typedef short s16x4 __attribute__((ext_vector_type(4)));
typedef float f32x8 __attribute__((ext_vector_type(8)));
typedef float f32x16 __attribute__((ext_vector_type(16)));
typedef unsigned u32x2 __attribute__((ext_vector_type(2)));

constexpr int DM = 1024, TG = 32768;
constexpr size_t MiB = 1u << 20;
constexpr size_t WS_HWIN = 0, WS_HWOUT = 16 * MiB, WS_AWIN = 20 * MiB, WS_AWOUT = 30 * MiB, WS_H2 = 34 * MiB, WS_XB = 38 * MiB,
                 WS_UT = 102 * MiB, WS_GATE = 294 * MiB, WS_Y = 358 * MiB, WS_FILT = 422 * MiB, WS_SUMSQ = 454 * MiB, WS_BAR = 456 * MiB, WS_END = 457 * MiB;
constexpr int LDS_BYTES = 136 * 1024;
constexpr float ALPHA = 1.681792830507429f;
constexpr int NPHASE = 1 + 2 * 20;
#ifndef PHMASK
#define PHMASK 0xFFFF
#endif
#ifndef PROBE_WHAT
#define PROBE_WHAT 0
#endif

struct Params { const float* in[24]; float* out; unsigned char* ws; int ph_lo, ph_hi; };
struct PV { const Params& q; int z; float* out; unsigned char* ws;
    __device__ __forceinline__ PV(const Params& q_, int z_) : q(q_), z(z_), out(q_.out + z_), ws(q_.ws + z_) {}
    __device__ __forceinline__ const float* in(int k) const { return q.in[k + z]; } };

__device__ __forceinline__ float bf2f(unsigned short x) { return __uint_as_float(((unsigned)x) << 16); }
__device__ __forceinline__ float bf2f_s(short x) { return __uint_as_float(((unsigned)(unsigned short)x) << 16); }
__device__ __forceinline__ unsigned short f2bf(float x) { return (unsigned short)(cvt_pk_bf16(x, 0.f) & 0xffffu); }
__device__ __forceinline__ float wave_sum(float v) {
#pragma unroll
    for (int o = 32; o >= 1; o >>= 1) v += __shfl_xor(v, o, 64);
    return v;
}
template <class T> __device__ __forceinline__ T* launder(T* q) {
    unsigned long long w = (unsigned long long)q; unsigned lo = (unsigned)w, hi = (unsigned)(w >> 32);
    asm volatile("" : "+v"(lo), "+v"(hi));
    lo = __builtin_amdgcn_readfirstlane(lo); hi = __builtin_amdgcn_readfirstlane(hi);
    return (T*)(((unsigned long long)hi << 32) | lo);
}
__device__ __forceinline__ int opaque_zero() { int z = 0; asm volatile("" : "+v"(z)); return __builtin_amdgcn_readfirstlane(z); }
__device__ __forceinline__ int opaque(int x) { asm volatile("" : "+v"(x)); return x; }
__device__ __forceinline__ float silu(float x) { return x / (1.f + __expf(-x)); }

struct EpiBf16B {
    static constexpr bool PERM = true, AFTER_DRAIN = false;
    bf16_t* O; int ldc; const float* bias;
    __device__ __forceinline__ void operator()(const f32x4 (&acc)[2][2][4][2], const pg8::Unit& u, int wr, int wc, int fr, int fq) const {
        const int row0 = u.pm * 256 + wr * 64 + fr, col0 = u.pn * 256 + wc * 32 + 8 * fq;
        f32x4 bv[2][2];
#pragma unroll
        for (int bj = 0; bj < 2; ++bj)
#pragma unroll
            for (int n = 0; n < 2; ++n) bv[bj][n] = *(const f32x4*)(bias + col0 + bj * 128 + 4 * n);
#pragma unroll
        for (int ai = 0; ai < 2; ++ai)
#pragma unroll
            for (int m = 0; m < 4; ++m) { bf16_t* rowp = O + (size_t)(row0 + ai * 128 + m * 16) * ldc + col0;
#pragma unroll
                for (int bj = 0; bj < 2; ++bj) { f32x4 v0 = acc[ai][bj][m][0] + bv[bj][0], v1 = acc[ai][bj][m][1] + bv[bj][1];
                    u32x4 w; w.x = cvt_pk_bf16(v0[0], v0[1]); w.y = cvt_pk_bf16(v0[2], v0[3]); w.z = cvt_pk_bf16(v1[0], v1[1]); w.w = cvt_pk_bf16(v1[2], v1[3]);
                    *(u32x4*)(rowp + bj * 128) = w; } }
    }
};
struct EpiUT {
    static constexpr bool PERM = true, AFTER_DRAIN = false;
    bf16_t* O; const float* bias; int L;
    __device__ __forceinline__ void operator()(const f32x4 (&acc)[2][2][4][2], const pg8::Unit& u, int wr, int wc, int fr, int fq) const {
        const int row0 = u.pm * 256 + wr * 64 + fr; const int tokt = u.pn * 256; const int b = tokt / L; const int t0 = tokt - b * L + wc * 32 + 8 * fq;
#pragma unroll
        for (int ai = 0; ai < 2; ++ai)
#pragma unroll
            for (int m = 0; m < 4; ++m) { const int ch = row0 + ai * 128 + m * 16; const float bs = bias[ch];
                bf16_t* rowp = O + ((size_t)b * 3072 + ch) * L + t0;
#pragma unroll
                for (int bj = 0; bj < 2; ++bj) { f32x4 v0 = acc[ai][bj][m][0] + bs, v1 = acc[ai][bj][m][1] + bs;
                    u32x4 w; w.x = cvt_pk_bf16(v0[0], v0[1]); w.y = cvt_pk_bf16(v0[2], v0[3]); w.z = cvt_pk_bf16(v1[0], v1[1]); w.w = cvt_pk_bf16(v1[2], v1[3]);
                    *(u32x4*)(rowp + bj * 128) = w; } }
    }
};
struct EpiRes {
    static constexpr bool PERM = true, AFTER_DRAIN = false;
    float* out; bf16_t* xb; const float* bias; int last; bf16_t* dst;
    __device__ __forceinline__ void operator()(const f32x4 (&acc)[2][2][4][2], const pg8::Unit& u, int wr, int wc, int fr, int fq) const {
        const int row0 = u.pm * 256 + wr * 64 + fr, col0 = u.pn * 256 + wc * 32 + 8 * fq;
        f32x4 bv[2][2];
#pragma unroll
        for (int bj = 0; bj < 2; ++bj)
#pragma unroll
            for (int n = 0; n < 2; ++n) bv[bj][n] = *(const f32x4*)(bias + col0 + bj * 128 + 4 * n);
#pragma unroll
        for (int ai = 0; ai < 2; ++ai)
#pragma unroll
            for (int m = 0; m < 4; ++m) { const size_t ro = (size_t)(row0 + ai * 128 + m * 16) * DM + col0;
#pragma unroll
                for (int bj = 0; bj < 2; ++bj) { const bf16x8 xv = *(const bf16x8*)(xb + ro + bj * 128);
                    f32x4 v0, v1;
#pragma unroll
                    for (int e = 0; e < 4; ++e) { v0[e] = bf2f_s(xv[e]) * ALPHA + acc[ai][bj][m][0][e] + bv[bj][0][e]; v1[e] = bf2f_s(xv[4 + e]) * ALPHA + acc[ai][bj][m][1][e] + bv[bj][1][e]; }
                    if (last) { *(f32x4*)(out + ro + bj * 128) = v0; *(f32x4*)(out + ro + bj * 128 + 4) = v1; }
                    else { u32x4 w; w.x = cvt_pk_bf16(v0[0], v0[1]); w.y = cvt_pk_bf16(v0[2], v0[3]); w.z = cvt_pk_bf16(v1[0], v1[1]); w.w = cvt_pk_bf16(v1[2], v1[3]);
                        *(u32x4*)(dst + ro + bj * 128) = w; } } }
    }
};

template <class Epi> __device__ __forceinline__ void run_gemm(unsigned char* lds, const bf16_t* A, const bf16_t* Bt, int M, int N, const Epi& E) {
    pg8::Gemm g; g.A = A; g.Bt = Bt; g.M = M; g.N = N; g.K = DM;
    pg8::StaticOrder S; S.init(M, N, (int)gridDim.x, (int)blockIdx.x);
    pg8::gemm_phase<Epi, pg8::StaticOrder, false>((PG8_LAS unsigned char*)lds, g, S, E, nullptr);
    __syncthreads();
}

struct TileRef { const float* W; bf16_t* WT; int N, tk, tn; };
__device__ __forceinline__ TileRef tile_ref(const PV& p, int it) {
    const int j = it / 2176; int r = it - j * 2176; int kind;
    if (r < 1024) kind = 0; else if (r < 1280) { kind = 1; r -= 1024; } else if (r < 1920) { kind = 2; r -= 1280; } else { kind = 3; r -= 1920; }
    TileRef t; t.N = kind == 0 ? 4096 : (kind == 2 ? 2560 : 1024);
    const int nN = t.N / 64; t.tk = r / nN; t.tn = r % nN;
    t.W = (kind == 0 ? p.in(2) : kind == 1 ? p.in(14) : kind == 2 ? p.in(16) : p.in(20)) + (size_t)j * 1024 * t.N;
    t.WT = (bf16_t*)(p.ws + (kind == 0 ? WS_HWIN : kind == 1 ? WS_HWOUT : kind == 2 ? WS_AWIN : WS_AWOUT)) + (size_t)j * 1024 * t.N;
    return t;
}
__device__ __forceinline__ void prologue_phase(const PV& p, unsigned char* lds) {
    const int tid = tidx();
    { const int wid = __builtin_amdgcn_readfirstlane(tid >> 6), lane = tid & 63;
        for (int j = 0; j < 2; ++j) {
            const float* w1 = p.in(6) + j * 33 * 64; const float* w2 = p.in(9) + j * 64 * 64;
            float w1r[33], w2r[64];
#pragma unroll
            for (int i = 0; i < 33; ++i) w1r[i] = w1[i * 64 + lane];
#pragma unroll
            for (int i = 0; i < 64; ++i) w2r[i] = w2[i * 64 + lane];
            const float b1v = p.in(7)[j * 64 + lane], b2v = p.in(10)[j * 64 + lane], fr = p.in(8)[j * 64 + lane];
            for (int row = blockIdx.x * 8 + wid; row < 6144; row += gridDim.x * 8) {
                int t = row; const int sel = t >= 2048 ? 1 : 0; if (sel) t -= 2048; const int L = sel ? 4096 : 2048;
                float feat = 0.f;
                if (lane == 0) feat = (float)t / (float)(L - 1);
                else if (lane <= 32) { const int i = (lane - 1) & 15; const double f = 1e-4 + (double)i * ((15.0 - 1e-4) / 15.0);
                    double ph = f * (double)t / (double)L; ph -= (double)(long long)ph;
                    const float a = (float)(ph * 6.283185307179586);
                    feat = lane <= 16 ? cosf(a) : -sinf(a); }
                float s = b1v;
#pragma unroll
                for (int i = 0; i < 33; ++i) s += __shfl(feat, i, 64) * w1r[i];
                const float h1 = sinf(fr * s);
                float s2 = b2v;
#pragma unroll
                for (int i = 0; i < 64; ++i) s2 += __shfl(h1, i, 64) * w2r[i];
                ((float*)(p.ws + WS_H2))[((size_t)(j * 2 + sel) * 4096 + t) * 64 + lane] = sinf(fr * s2);
            }
        }
    }
    { float* tile = (float*)lds;
        const int total = 2 * 2176;
        f32x4 v[2];
        int it = blockIdx.x;
        if (it < total) { const TileRef t = tile_ref(p, it);
#pragma unroll
            for (int i = 0; i < 2; ++i) { const int q = tid + i * 512; v[i] = *(const f32x4*)(t.W + (size_t)(t.tk * 64 + (q >> 4)) * t.N + t.tn * 64 + (q & 15) * 4); } }
        for (; it < total; it += gridDim.x) {
            const TileRef t = tile_ref(p, it);
#pragma unroll
            for (int i = 0; i < 2; ++i) { const int q = tid + i * 512, k = q >> 4, n4 = (q & 15) * 4;
                tile[k * 65 + n4 + 0] = v[i][0]; tile[k * 65 + n4 + 1] = v[i][1]; tile[k * 65 + n4 + 2] = v[i][2]; tile[k * 65 + n4 + 3] = v[i][3]; }
            __syncthreads();
            if (it + (int)gridDim.x < total) { const TileRef t2 = tile_ref(p, it + gridDim.x);
#pragma unroll
                for (int i = 0; i < 2; ++i) { const int q = tid + i * 512; v[i] = *(const f32x4*)(t2.W + (size_t)(t2.tk * 64 + (q >> 4)) * t2.N + t2.tn * 64 + (q & 15) * 4); } }
            { const int n = tid >> 3, k8 = (tid & 7) * 8; float x[8];
#pragma unroll
                for (int e = 0; e < 8; ++e) x[e] = tile[(k8 + e) * 65 + n];
                u32x4 w; w.x = cvt_pk_bf16(x[0], x[1]); w.y = cvt_pk_bf16(x[2], x[3]); w.z = cvt_pk_bf16(x[4], x[5]); w.w = cvt_pk_bf16(x[6], x[7]);
                *(u32x4*)(t.WT + (size_t)(t.tn * 64 + n) * 1024 + t.tk * 64 + k8) = w; }
            __syncthreads();
        }
    }
}

__device__ __forceinline__ void cvt_phase(const PV& p, int g) {
    const float* x = p.in(g); bf16_t* xb = (bf16_t*)(p.ws + WS_XB);
    const size_t n8 = (size_t)TG * DM / 8;
    for (size_t i = (size_t)blockIdx.x * 512 + tidx(); i < n8; i += (size_t)gridDim.x * 512) {
        const f32x4 a = *(const f32x4*)(x + i * 8), b = *(const f32x4*)(x + i * 8 + 4);
        u32x4 w; w.x = cvt_pk_bf16(a[0], a[1]); w.y = cvt_pk_bf16(a[2], a[3]); w.z = cvt_pk_bf16(b[0], b[1]); w.w = cvt_pk_bf16(b[2], b[3]);
        *(u32x4*)(xb + i * 8) = w;
    }
}

__device__ __forceinline__ void ln_phase(const PV& p, int g, int layer, bf16_t* xdst) {
    float* x = p.out + (size_t)g * TG * DM; bf16_t* xb = (bf16_t*)(p.ws + WS_XB);
    const float* gam = p.in(22) + layer * DM; const float* bet = p.in(23) + layer * DM;
    const int tid_ = tidx(); const int wid = __builtin_amdgcn_readfirstlane(tid_ >> 6), lane = tid_ & 63;
    const bool last = layer == 3;
    f32x4 gv[4], bv[4];
#pragma unroll
    for (int k = 0; k < 4; ++k) { const int c = (k >> 1) * 512 + lane * 8 + (k & 1) * 4; gv[k] = *(const f32x4*)(gam + c); bv[k] = *(const f32x4*)(bet + c); }
    constexpr int NR = 2;
    for (int row0 = (blockIdx.x * 8 + wid) * NR; row0 < TG; row0 += gridDim.x * 8 * NR) {
        f32x4 v[NR][4];
#pragma unroll
        for (int rr = 0; rr < NR; ++rr) { const size_t ro = (size_t)(row0 + rr) * DM;
            if (last) {
#pragma unroll
                for (int k = 0; k < 4; ++k) v[rr][k] = *(const f32x4*)(x + ro + (k >> 1) * 512 + lane * 8 + (k & 1) * 4);
            } else {
#pragma unroll
                for (int hh = 0; hh < 2; ++hh) { const bf16x8 t = *(const bf16x8*)(xb + ro + hh * 512 + lane * 8);
#pragma unroll
                    for (int e = 0; e < 4; ++e) { v[rr][hh * 2][e] = bf2f_s(t[e]); v[rr][hh * 2 + 1][e] = bf2f_s(t[4 + e]); } }
            } }
        float s[NR], q[NR];
#pragma unroll
        for (int rr = 0; rr < NR; ++rr) { s[rr] = 0.f;
#pragma unroll
            for (int k = 0; k < 4; ++k) s[rr] += v[rr][k][0] + v[rr][k][1] + v[rr][k][2] + v[rr][k][3]; }
#pragma unroll
        for (int o = 32; o >= 1; o >>= 1) {
#pragma unroll
            for (int rr = 0; rr < NR; ++rr) s[rr] += __shfl_xor(s[rr], o, 64); }
#pragma unroll
        for (int rr = 0; rr < NR; ++rr) { const float mu = s[rr] * (1.f / DM); q[rr] = 0.f;
#pragma unroll
            for (int k = 0; k < 4; ++k) { v[rr][k] = v[rr][k] - mu; q[rr] += v[rr][k][0] * v[rr][k][0] + v[rr][k][1] * v[rr][k][1] + v[rr][k][2] * v[rr][k][2] + v[rr][k][3] * v[rr][k][3]; } }
#pragma unroll
        for (int o = 32; o >= 1; o >>= 1) {
#pragma unroll
            for (int rr = 0; rr < NR; ++rr) q[rr] += __shfl_xor(q[rr], o, 64); }
#pragma unroll
        for (int rr = 0; rr < NR; ++rr) { const size_t ro = (size_t)(row0 + rr) * DM; const float rstd = rsqrtf(q[rr] * (1.f / DM) + 1e-5f);
#pragma unroll
            for (int k = 0; k < 4; ++k) v[rr][k] = v[rr][k] * rstd * gv[k] + bv[k];
            if (last) {
#pragma unroll
                for (int k = 0; k < 4; ++k) *(f32x4*)(x + ro + (k >> 1) * 512 + lane * 8 + (k & 1) * 4) = v[rr][k];
            } else {
#pragma unroll
                for (int hh = 0; hh < 2; ++hh) { u32x4 w; w.x = cvt_pk_bf16(v[rr][hh * 2][0], v[rr][hh * 2][1]); w.y = cvt_pk_bf16(v[rr][hh * 2][2], v[rr][hh * 2][3]);
                    w.z = cvt_pk_bf16(v[rr][hh * 2 + 1][0], v[rr][hh * 2 + 1][1]); w.w = cvt_pk_bf16(v[rr][hh * 2 + 1][2], v[rr][hh * 2 + 1][3]);
                    *(u32x4*)(xdst + ro + hh * 512 + lane * 8) = w; }
            } }
    }
}

template <int L> __device__ __forceinline__ void filter_phase(const PV& p, int hj, int slot, unsigned char* lds) {
    const int tid = tidx(), wid = __builtin_amdgcn_readfirstlane(tid >> 6), lane = tid & 63, n16 = lane & 15, kq = lane >> 4;
    const float* h2 = (const float*)(p.ws + WS_H2) + (size_t)(hj * 2 + (L == 2048 ? 0 : 1)) * 4096 * 64;
    const float* w3 = p.in(11) + (size_t)hj * 64 * 4096; const float* decay = p.in(12) + hj * 4096;
    bf16_t* FILT = (bf16_t*)(p.ws + WS_FILT); float* PART = (float*)(p.ws + WS_SUMSQ);
    constexpr int HS = 72;
    bf16_t* stg = (bf16_t*)lds;
    unsigned* tile = (unsigned*)(lds + 36864);
    constexpr int NCH = L / 256;
    for (int it = blockIdx.x; it < 64 * NCH; it += gridDim.x) {
        const int cb = it / NCH, chunk = it - cb * NCH, t0 = chunk * 256;
        const int od = cb >> 4, dir = od & 1, o = od >> 1;
        const int tb = t0 + dir;
        __syncthreads();
#pragma unroll
        for (int i = 0; i < 8; ++i) { const int q = tid + 512 * i, rr = q >> 4, c4 = (q & 15) * 4; int tr = tb + rr; tr = tr < L ? tr : L - 1;
            const f32x4 x = *(const f32x4*)(h2 + (size_t)tr * 64 + c4);
            u32x2 w; w.x = cvt_pk_bf16(x[0], x[1]); w.y = cvt_pk_bf16(x[2], x[3]); *(u32x2*)(stg + rr * HS + c4) = w; }
        bf16x8 bfr[4][2]; float dec[4];
#pragma unroll
        for (int ct = 0; ct < 4; ++ct) { const int col = cb * 64 + ct * 16 + n16; dec[ct] = fabsf(decay[col]);
#pragma unroll
            for (int ks = 0; ks < 2; ++ks) { float x[8];
#pragma unroll
                for (int e = 0; e < 8; ++e) x[e] = w3[(size_t)(ks * 32 + kq * 8 + e) * 4096 + col];
                u32x4 w; w.x = cvt_pk_bf16(x[0], x[1]); w.y = cvt_pk_bf16(x[2], x[3]); w.z = cvt_pk_bf16(x[4], x[5]); w.w = cvt_pk_bf16(x[6], x[7]);
                bfr[ct][ks] = *reinterpret_cast<bf16x8*>(&w); } }
        float ss[4] = {0.f, 0.f, 0.f, 0.f};
        if (dir == 1 && t0 == 0 && wid == 0) {
#pragma unroll
            for (int ct = 0; ct < 4; ++ct) { const int col = cb * 64 + ct * 16 + n16; float d = 0.f;
                for (int j = 0; j < 64; ++j) d += h2[j] * w3[(size_t)j * 4096 + col];
                ss[ct] = kq == 0 ? d * d : 0.f; } }
        __syncthreads();
#pragma unroll
        for (int tt = 0; tt < 2; ++tt) {
            const int trow = wid * 32 + tt * 16;
            const bf16x8 a0 = *(const bf16x8*)(stg + (trow + n16) * HS + kq * 8), a1 = *(const bf16x8*)(stg + (trow + n16) * HS + 32 + kq * 8);
#pragma unroll
            for (int ct = 0; ct < 4; ++ct) {
                f32x4 acc = {0.f, 0.f, 0.f, 0.f};
                acc = __builtin_amdgcn_mfma_f32_16x16x32_bf16(a0, bfr[ct][0], acc, 0, 0, 0);
                acc = __builtin_amdgcn_mfma_f32_16x16x32_bf16(a1, bfr[ct][1], acc, 0, 0, 0);
                unsigned short* trw = (unsigned short*)(tile + (ct * 16 + n16) * 129);
#pragma unroll
                for (int i = 0; i < 4; ++i) { const int tl = trow + kq * 4 + i, t = tb + tl;
                    float d = acc[i] * expf(-(float)t * (1.0f / (float)(L - 1)) * dec[ct]);
                    if (t >= L) d = 0.f;
                    ss[ct] += d * d;
                    trw[dir ? tl : 255 - tl] = f2bf(d); }
            }
        }
#pragma unroll
        for (int ct = 0; ct < 4; ++ct) { float v = ss[ct]; v += __shfl_xor(v, 16, 64); v += __shfl_xor(v, 32, 64);
            if (kq == 0) PART[(size_t)(cb * 64 + ct * 16 + n16) * (NCH * 8) + chunk * 8 + wid] = v; }
        __syncthreads();
        { const int cc = tid >> 3, part = tid & 7; const unsigned* src = tile + cc * 129 + part * 16;
            const int ccol = cb * 64 + cc, c2 = ccol & 1023;
            bf16_t* dst = FILT + ((size_t)(o * 1024 + c2)) * (2 * L) + (dir ? L + t0 : L - 256 - t0) + part * 32;
#pragma unroll
            for (int k = 0; k < 4; ++k) { u32x4 v; v.x = src[k * 4]; v.y = src[k * 4 + 1]; v.z = src[k * 4 + 2]; v.w = src[k * 4 + 3]; *(u32x4*)(dst + k * 8) = v; } }
    }
    __syncthreads();
}

__device__ __forceinline__ bf16x8 lds_a4(const unsigned char* lds, unsigned addr) {
    const unsigned* q = (const unsigned*)(lds + addr); u32x4 w; w.x = q[0]; w.y = q[1]; w.z = q[2]; w.w = q[3]; return *reinterpret_cast<bf16x8*>(&w);
}
template <int NB> struct ConvCfg {
    static constexpr int L = NB == 16 ? 2048 : 4096, ROWE = L + 8, SB = NB == 16 ? 0 : -2048, NT = NB == 16 ? 64 : 192;
    static constexpr int ZOFF = 0, FOFF = 66560, FCOPY = 2 * L * 2, W3OFF = FOFF + 4 * FCOPY, REDOFF = W3OFF + 1024;
};
template <int NB> __device__ __forceinline__ void conv_main(const unsigned char* lds, int o, f32x4 (&acc)[16]) {
    using C = ConvCfg<NB>;
    const int tid_ = tidx(); const int lane = tid_ & 63, wid = __builtin_amdgcn_readfirstlane(tid_ >> 6), r = lane & 15, gq = lane >> 4;
    const int b = NB == 16 ? r : (r & 7), h = NB == 16 ? 0 : (r >> 3);
    const int E0 = (C::L - 1) + C::SB - 256 * wid + 8 * gq - r;
    const int P = E0 & 1;
    unsigned aPtr = (unsigned)(C::FOFF + (o * 2 + P) * C::FCOPY + 2 * (E0 - P));
    const int bBase = C::ZOFF + b * C::ROWE * 2 + 2 * (C::SB + 2048 * h + 8 * gq);
    const int s_lane0 = C::SB + 2048 * h;
    bf16x8 A[16];
#pragma unroll
    for (int i = 0; i < 16; ++i) { A[i] = lds_a4(lds, aPtr - 32 * i); acc[i] = (f32x4){0.f, 0.f, 0.f, 0.f}; }
    auto ldb = [&](int j) -> bf16x8 {
        if (NB == 16) return *(const bf16x8*)(lds + bBase + 64 * j);
        const bool valid = (unsigned)(s_lane0 + 32 * j) < (unsigned)C::L;
        const bf16x8 t = *(const bf16x8*)(lds + (valid ? bBase + 64 * j : C::ZOFF));
        const bf16x8 z = {0, 0, 0, 0, 0, 0, 0, 0}; return valid ? t : z; };
    bf16x8 bnext = ldb(0);
    for (int jo = 0; jo < C::NT / 8; ++jo) {
#pragma unroll
        for (int jj = 0; jj < 8; ++jj) {
            const int j = jo * 8 + jj;
            const bf16x8 bf = bnext;
            bnext = ldb(j + 1 < C::NT ? j + 1 : j);
            acc[15] = __builtin_amdgcn_mfma_f32_16x16x32_bf16(A[(15 - 2 * jj) & 15], bf, acc[15], 0, 0, 0);
            acc[14] = __builtin_amdgcn_mfma_f32_16x16x32_bf16(A[(14 - 2 * jj) & 15], bf, acc[14], 0, 0, 0);
            A[(14 - 2 * jj) & 15] = lds_a4(lds, aPtr + 64 * (jj + 1));
            A[(15 - 2 * jj) & 15] = lds_a4(lds, aPtr + 64 * (jj + 1) - 32);
#pragma unroll
            for (int i = 13; i >= 0; --i) acc[i] = __builtin_amdgcn_mfma_f32_16x16x32_bf16(A[(i - 2 * jj) & 15], bf, acc[i], 0, 0, 0);
            __builtin_amdgcn_sched_barrier(0);
        }
        aPtr += 512;
    }
}
template <int NB, int I0, int I1> __device__ __forceinline__ void conv_gload(const bf16_t* UT, int gch, s16x4 (&gu)[16], unsigned (&gh)[16]) {
    using C = ConvCfg<NB>;
    const int tid_ = tidx(); const int lane = tid_ & 63, wid = __builtin_amdgcn_readfirstlane(tid_ >> 6), r = lane & 15, gq = lane >> 4;
    const int b = NB == 16 ? r : (r & 7), h = NB == 16 ? 0 : (r >> 3);
    const bf16_t* grow = UT + ((size_t)b * 3072 + gch) * C::L;
#pragma unroll
    for (int i = I0; i < I1; ++i) {
        const int t = 256 * wid + 16 * i + 4 * gq + 2048 * h;
        gu[i] = *(const s16x4*)(grow + t);
        const unsigned lo = grow[t > 0 ? t - 1 : 0], hi = grow[(t + 4 < C::L) ? t + 4 : C::L - 1];
        gh[i] = lo | (hi << 16);
    }
}
template <int NB> __device__ __forceinline__ void conv_epi(const unsigned char* lds, const f32x4 (&acc)[16], u32x2 (&zp)[16], const s16x4 (&gu_)[16], const unsigned (&gh)[16],
                                                          float gw0, float gw1, float gw2, float gcb, float fb, float nrm) {
    using C = ConvCfg<NB>;
    const int tid_ = tidx(); const int lane = tid_ & 63, wid = __builtin_amdgcn_readfirstlane(tid_ >> 6), r = lane & 15, gq = lane >> 4;
    const int b = NB == 16 ? r : (r & 7), h = NB == 16 ? 0 : (r >> 3);
#pragma unroll
    for (int i = 0; i < 16; ++i) {
        const int t = 256 * wid + 16 * i + 4 * gq + 2048 * h;
        const s16x4 gu = gu_[i];
        const float gl = t > 0 ? bf2f((unsigned short)(gh[i] & 0xffffu)) : 0.f, gr = (t + 4 < C::L) ? bf2f((unsigned short)(gh[i] >> 16)) : 0.f;
        const float u0 = bf2f_s(gu[0]), u1 = bf2f_s(gu[1]), u2 = bf2f_s(gu[2]), u3 = bf2f_s(gu[3]);
        const float g0 = gw0 * gl + gw1 * u0 + gw2 * u1 + gcb, g1 = gw0 * u0 + gw1 * u1 + gw2 * u2 + gcb;
        const float g2 = gw0 * u1 + gw1 * u2 + gw2 * u3 + gcb, g3 = gw0 * u2 + gw1 * u3 + gw2 * gr + gcb;
        const s16x4 vz = *(const s16x4*)(lds + C::ZOFF + (b * C::ROWE + t) * 2);
        const float z0 = g0 * (acc[i][0] * nrm + bf2f_s(vz[0]) * fb), z1 = g1 * (acc[i][1] * nrm + bf2f_s(vz[1]) * fb);
        const float z2 = g2 * (acc[i][2] * nrm + bf2f_s(vz[2]) * fb), z3 = g3 * (acc[i][3] * nrm + bf2f_s(vz[3]) * fb);
        zp[i].x = cvt_pk_bf16(z0, z1); zp[i].y = cvt_pk_bf16(z2, z3);
    }
}
template <int NB> __device__ __forceinline__ void conv_store_z(unsigned char* lds, const u32x2 (&zp)[16]) {
    using C = ConvCfg<NB>;
    const int tid_ = tidx(); const int lane = tid_ & 63, wid = __builtin_amdgcn_readfirstlane(tid_ >> 6), r = lane & 15, gq = lane >> 4;
    const int b = NB == 16 ? r : (r & 7), h = NB == 16 ? 0 : (r >> 3);
#pragma unroll
    for (int i = 0; i < 16; ++i) { const int t = 256 * wid + 16 * i + 4 * gq + 2048 * h; *(u32x2*)(lds + C::ZOFF + (b * C::ROWE + t) * 2) = zp[i]; }
}

template <int NB> __device__ __forceinline__ void conv_phase(const PV& p, int hj, int slot, unsigned char* lds, bf16_t* zdst, int zstride) {
    using C = ConvCfg<NB>;
    constexpr int L = C::L;
    const int tid_wg = tidx(), wid = __builtin_amdgcn_readfirstlane(tid_wg >> 6), lane = tid_wg & 63;
    bf16_t* UT = (bf16_t*)(p.ws + WS_UT);
    const float* w3 = p.in(11) + (size_t)hj * 64 * 4096; const float* decay = p.in(12) + hj * 4096;
    const float* fbias = p.in(13) + hj * 2048; const float* cw = p.in(4) + hj * 3 * 3072; const float* cb = p.in(5) + hj * 3072;
    float* w3s = (float*)(lds + C::W3OFF); float* red = (float*)(lds + C::REDOFF);
    for (int c = blockIdx.x; c < 1024; c += gridDim.x) {
        __syncthreads();
        const int tid = opaque(tid_wg);
        constexpr int NF = (2 * (2 * L / 8)) / 512;
        u32x4 fr[NF]; bf16x8 vx[8]; float hl[8], hr[8];
        { const bf16_t* FILT = (const bf16_t*)(p.ws + WS_FILT);
#pragma unroll
            for (int i = 0; i < NF; ++i) { const int q = tid + 512 * i, o = q / (2 * L / 8), i8 = (q - o * (2 * L / 8)) * 8;
                fr[i] = *(const u32x4*)(FILT + ((size_t)(o * 1024 + c)) * (2 * L) + i8); } }
#pragma unroll
        for (int i = 0; i < 8; ++i) { const int chunk = tid + 512 * i, b = chunk / (L / 8), s8 = (chunk % (L / 8)) * 8;
            const bf16_t* src = UT + ((size_t)b * 3072 + c) * L + s8;
            vx[i] = *(const bf16x8*)src; const float a_ = bf2f(src[s8 > 0 ? -1 : 0]), b_ = bf2f(src[(s8 + 8 < L) ? 8 : 7]);
            hl[i] = s8 > 0 ? a_ : 0.f; hr[i] = (s8 + 8 < L) ? b_ : 0.f; }
        { constexpr int NP = (L / 256) * 8; const float* PART = (const float*)(p.ws + WS_SUMSQ);
            const int o = tid >> 8, idx = tid & 255, dir = idx / NP, k = idx - dir * NP;
            float v = (idx < 2 * NP) ? PART[(size_t)((o * 2 + dir) * 1024 + c) * NP + k] : 0.f;
            v = wave_sum(v); if (lane == 0) red[wid] = v; }
#pragma unroll
        for (int i = 0; i < NF; ++i) { const int q = tid + 512 * i, o = q / (2 * L / 8), i8 = (q - o * (2 * L / 8)) * 8;
            *(u32x4*)(lds + C::FOFF + (o * 2) * C::FCOPY + i8 * 2) = fr[i]; }
        { const float w0 = cw[c], w1 = cw[3072 + c], w2 = cw[2 * 3072 + c], cbv = cb[c];
#pragma unroll
            for (int i = 0; i < 8; ++i) { const int chunk = tid + 512 * i, b = chunk / (L / 8), s8 = (chunk % (L / 8)) * 8;
                float xe[10]; xe[0] = hl[i]; xe[9] = hr[i];
#pragma unroll
                for (int e = 0; e < 8; ++e) xe[e + 1] = bf2f_s(vx[i][e]);
                float y[8];
#pragma unroll
                for (int e = 0; e < 8; ++e) y[e] = w0 * xe[e] + w1 * xe[e + 1] + w2 * xe[e + 2] + cbv;
                u32x4 w; w.x = cvt_pk_bf16(y[0], y[1]); w.y = cvt_pk_bf16(y[2], y[3]); w.z = cvt_pk_bf16(y[4], y[5]); w.w = cvt_pk_bf16(y[6], y[7]);
                *(u32x4*)(lds + C::ZOFF + (b * C::ROWE + s8) * 2) = w;
                __builtin_amdgcn_sched_barrier(0); } }
        __syncthreads();
        const float nrm0 = rsqrtf(red[0] + red[1] + red[2] + red[3] + 1e-6f), nrm1 = rsqrtf(red[4] + red[5] + red[6] + red[7] + 1e-6f);
#pragma unroll
        for (int i = 0; i < NF; ++i) { const int q = tid + 512 * i, o = q / (2 * L / 8), m4 = (q - o * (2 * L / 8)) * 4;
            const unsigned* s0 = (const unsigned*)(lds + C::FOFF + (o * 2) * C::FCOPY) + m4; unsigned* d1 = (unsigned*)(lds + C::FOFF + (o * 2 + 1) * C::FCOPY) + m4;
            const u32x4 a = *(const u32x4*)s0; const unsigned nx = (m4 + 4 < L) ? s0[4] : 0u;
            u32x4 r; r.x = __builtin_amdgcn_alignbit(a.y, a.x, 16); r.y = __builtin_amdgcn_alignbit(a.z, a.y, 16); r.z = __builtin_amdgcn_alignbit(a.w, a.z, 16); r.w = __builtin_amdgcn_alignbit(nx, a.w, 16);
            *(u32x4*)d1 = r; }
        __syncthreads();
        f32x4 acc[16]; u32x2 zp[16]; s16x4 gu[16]; unsigned gh[16];
        conv_gload<NB, 0, 8>(UT, 1024 + c, gu, gh);
        conv_main<NB>(lds, 0, acc);
        conv_gload<NB, 8, 16>(UT, 1024 + c, gu, gh);
        conv_epi<NB>(lds, acc, zp, gu, gh, cw[1024 + c], cw[3072 + 1024 + c], cw[2 * 3072 + 1024 + c], cb[1024 + c], fbias[c], nrm0);
        __syncthreads();
        conv_store_z<NB>(lds, zp);
        __syncthreads();
        conv_gload<NB, 0, 8>(UT, 2048 + c, gu, gh);
        conv_main<NB>(lds, 1, acc);
        conv_gload<NB, 8, 16>(UT, 2048 + c, gu, gh);
        conv_epi<NB>(lds, acc, zp, gu, gh, cw[2048 + c], cw[3072 + 2048 + c], cw[2 * 3072 + 2048 + c], cb[2048 + c], fbias[1024 + c], nrm1);
        __syncthreads();
        conv_store_z<NB>(lds, zp);
        __syncthreads();
#pragma unroll
        for (int i = 0; i < 8; ++i) { const int chunk = tid + 512 * i, b = chunk / (L / 8), s8 = (chunk % (L / 8)) * 8;
            *(u32x4*)(zdst + ((size_t)b * zstride + c) * L + s8) = *(const u32x4*)(lds + C::ZOFF + (b * C::ROWE + s8) * 2); }
        __syncthreads();
    }
}

__device__ __forceinline__ void ygate_phase(const PV& p, int L, unsigned char* lds) {
    const bf16_t* UT = (const bf16_t*)(p.ws + WS_UT); const bf16_t* G = (const bf16_t*)(p.ws + WS_GATE); bf16_t* Y = (bf16_t*)(p.ws + WS_Y);
    const int tid = tidx(); constexpr int RS = 136;
    bf16_t* tile = (bf16_t*)lds;
    const int nit = (TG / 128) * 16;
    u32x4 zr[2]; bf16x8 gr[2];
    auto issue = [&](int it) {
        const int tc = it & 15, tt = it >> 4; const int tok0 = tt * 128, b = tok0 / L, t0 = tok0 - b * L, c0 = tc * 64;
#pragma unroll
        for (int i = 0; i < 2; ++i) { const int q = tid + i * 512;
            zr[i] = *(const u32x4*)(UT + ((size_t)b * 3072 + c0 + (q >> 4)) * L + t0 + (q & 15) * 8);
            gr[i] = *(const bf16x8*)(G + (size_t)(tok0 + (q >> 3)) * DM + c0 + (q & 7) * 8); } };
    int it = blockIdx.x;
    if (it < nit) issue(it);
    for (; it < nit; it += gridDim.x) {
        const int tc = it & 15, tt = it >> 4; const int tok0 = tt * 128, c0 = tc * 64;
#pragma unroll
        for (int i = 0; i < 2; ++i) { const int q = tid + i * 512; *(u32x4*)(tile + (q >> 4) * RS + (q & 15) * 8) = zr[i]; }
        const bf16x8 g0 = gr[0], g1 = gr[1];
        __syncthreads();
        if (it + (int)gridDim.x < nit) issue(it + gridDim.x);
#pragma unroll
        for (int i = 0; i < 2; ++i) { const int q = tid + i * 512, t = q >> 3, cch = (q & 7) * 8; const bf16x8 gv = i ? g1 : g0; float y[8];
#pragma unroll
            for (int e = 0; e < 8; ++e) y[e] = bf2f(tile[(cch + e) * RS + t]) * silu(bf2f_s(gv[e]));
            u32x4 w; w.x = cvt_pk_bf16(y[0], y[1]); w.y = cvt_pk_bf16(y[2], y[3]); w.z = cvt_pk_bf16(y[4], y[5]); w.w = cvt_pk_bf16(y[6], y[7]);
            *(u32x4*)(Y + (size_t)(tok0 + t) * DM + c0 + cch) = w; }
        __syncthreads();
    }
}

constexpr int LDU = 2560;
__device__ __forceinline__ void rope_phase(const PV& p, int aj, int L, bf16_t* D, int ldd) {
    bf16_t* U = (bf16_t*)(p.ws + WS_UT);
    const float* qn = p.in(18) + aj * 128; const float* kn = p.in(19) + aj * 128;
    const int tid = tidx(), sub = tid & 7;
    float inv[8], q1[8], q2[8], k1[8], k2[8];
#pragma unroll
    for (int e = 0; e < 8; ++e) { inv[e] = exp2f(-(float)((8 * sub + e) & 31) * (13.287712379549449f / 32.f));
        q1[e] = qn[8 * sub + e]; q2[e] = qn[64 + 8 * sub + e]; k1[e] = kn[8 * sub + e]; k2[e] = kn[64 + 8 * sub + e]; }
    for (int tok = blockIdx.x * 64 + (tid >> 3); tok < TG; tok += gridDim.x * 64) {
        const int t = tok & (L - 1); const float pos = (float)(sub < 4 ? (t >> 6) : (t & 63));
        float cs[8], sn[8];
#pragma unroll
        for (int e = 0; e < 8; ++e) { const float ang = pos * inv[e]; cs[e] = __cosf(ang); sn[e] = __sinf(ang); }
        bf16_t* u = U + (size_t)tok * LDU + 8 * sub;
#pragma unroll
        for (int hd = 0; hd < 10; ++hd) {
            const bf16x8 a = *(const bf16x8*)(u + hd * 128), bq = *(const bf16x8*)(u + hd * 128 + 64);
            float x1[8], x2[8]; float ss = 0.f;
#pragma unroll
            for (int e = 0; e < 8; ++e) { x1[e] = bf2f_s(a[e]); x2[e] = bf2f_s(bq[e]); ss += x1[e] * x1[e] + x2[e] * x2[e]; }
            ss += __shfl_xor(ss, 1, 64); ss += __shfl_xor(ss, 2, 64); ss += __shfl_xor(ss, 4, 64);
            const float rs = rsqrtf(ss * (1.f / 128.f) + 1e-6f);
            float o1[8], o2[8];
#pragma unroll
            for (int e = 0; e < 8; ++e) { const float xa = x1[e] * rs * (hd < 8 ? q1[e] : k1[e]), xb2 = x2[e] * rs * (hd < 8 ? q2[e] : k2[e]);
                o1[e] = xa * cs[e] - xb2 * sn[e]; o2[e] = xb2 * cs[e] + xa * sn[e]; }
            u32x4 w1, w2; w1.x = cvt_pk_bf16(o1[0], o1[1]); w1.y = cvt_pk_bf16(o1[2], o1[3]); w1.z = cvt_pk_bf16(o1[4], o1[5]); w1.w = cvt_pk_bf16(o1[6], o1[7]);
            w2.x = cvt_pk_bf16(o2[0], o2[1]); w2.y = cvt_pk_bf16(o2[2], o2[3]); w2.z = cvt_pk_bf16(o2[4], o2[5]); w2.w = cvt_pk_bf16(o2[6], o2[7]);
            bf16_t* d = D + (size_t)tok * ldd + 8 * sub; *(u32x4*)(d + hd * 128) = w1; *(u32x4*)(d + hd * 128 + 64) = w2;
        }
    }
}

namespace att {
constexpr int D = 128, NW = 8, QBLK = 32, KVBLK = 64;
constexpr float SCALE = 0.088388347648318440f;
constexpr float THR = 8.f;
constexpr int LDQ = LDU, LDK = LDU;
constexpr size_t SHM_V = KVBLK * D * 2, SHM_K = KVBLK * D * 2, SHM_ATTN = 2 * SHM_V + 2 * SHM_K + NW * 64 * 4;
#define KSWZ(row, colB) ((row) * 256 + ((colB) ^ (((row) & 7) << 4)))
#define SBAR() __builtin_amdgcn_sched_barrier(0)
__device__ __forceinline__ int crow(int r, int hi) { return (r & 3) + 8 * (r >> 2) + 4 * hi; }
__device__ __forceinline__ unsigned cvtpk(float lo, float hi) { unsigned r; asm volatile("v_cvt_pk_bf16_f32 %0, %1, %2" : "=v"(r) : "v"(lo), "v"(hi)); return r; }
__device__ __forceinline__ bf16x8 ld8(const bf16_t* p) { return *reinterpret_cast<const bf16x8*>(p); }
__device__ __forceinline__ void partialSM(f32x16& p0, f32x16& p1, float& m_reg, float& mn, float& alpha) {
  constexpr float C = SCALE * 1.4426950408889634f;
  float pmax = p0[0]; for (int r = 1; r < 16; ++r) pmax = fmaxf(pmax, p0[r]); for (int r = 0; r < 16; ++r) pmax = fmaxf(pmax, p1[r]);
  { auto rr = __builtin_amdgcn_permlane32_swap(__float_as_uint(pmax), __float_as_uint(pmax), false, false);
    pmax = fmaxf(__uint_as_float(rr[0]), __uint_as_float(rr[1])); }
  if (__builtin_expect(__all(pmax - m_reg <= THR / SCALE), 1)) { mn = m_reg; alpha = 1.f; }
  else { mn = fmaxf(m_reg, pmax); alpha = __builtin_amdgcn_exp2f((m_reg - mn) * C); m_reg = mn; }
  float mnC = -mn * C;
  for (int r = 0; r < 16; ++r) p0[r] = fmaf(p0[r], C, mnC); for (int r = 0; r < 16; ++r) p1[r] = fmaf(p1[r], C, mnC);
  for (int r = 0; r < 16; ++r) p0[r] = __builtin_amdgcn_exp2f(p0[r]);
}
__device__ __forceinline__ void finishSM(f32x16& p0, f32x16& p1, float alpha, float& l_reg, bf16x8& pa0, bf16x8& pa1, bf16x8& pa2, bf16x8& pa3) {
  for (int r = 0; r < 16; ++r) p1[r] = __builtin_amdgcn_exp2f(p1[r]);
  float ps = 0; for (int r = 0; r < 16; ++r) ps += p0[r]; for (int r = 0; r < 16; ++r) ps += p1[r];
  { auto rr = __builtin_amdgcn_permlane32_swap(__float_as_uint(ps), __float_as_uint(ps), false, false);
    ps = __uint_as_float(rr[0]) + __uint_as_float(rr[1]); }
  l_reg = l_reg * alpha + ps;
#define PK4(P, BASE, OUT) do { unsigned a0 = cvtpk(P[BASE + 0], P[BASE + 1]), a1 = cvtpk(P[BASE + 2], P[BASE + 3]);   \
    unsigned b0 = cvtpk(P[BASE + 4], P[BASE + 5]), b1 = cvtpk(P[BASE + 6], P[BASE + 7]);                              \
    auto r0 = __builtin_amdgcn_permlane32_swap(a0, b0, false, false); auto r1 = __builtin_amdgcn_permlane32_swap(a1, b1, false, false); \
    u32x4 w = {r0[0], r1[0], r0[1], r1[1]}; OUT = *reinterpret_cast<bf16x8*>(&w); } while (0)
  PK4(p0, 0, pa0); PK4(p0, 8, pa1); PK4(p1, 0, pa2); PK4(p1, 8, pa3);
#undef PK4
}
__device__ __forceinline__ void qkt(f32x16& p0, f32x16& p1, const bf16_t* Ks, const bf16x8* qr, int r32, int hi) {
  p0 = f32x16{}; p1 = f32x16{};
  for (int d0 = 0; d0 < 8; ++d0) { int cb = (d0 * 16 + hi * 8) * 2;
    bf16x8 b0 = *reinterpret_cast<const bf16x8*>((const char*)Ks + KSWZ(r32, cb));
    bf16x8 b1 = *reinterpret_cast<const bf16x8*>((const char*)Ks + KSWZ(32 + r32, cb));
    p0 = __builtin_amdgcn_mfma_f32_32x32x16_bf16(b0, qr[d0], p0, 0, 0, 0);
    p1 = __builtin_amdgcn_mfma_f32_32x32x16_bf16(b1, qr[d0], p1, 0, 0, 0); }
}
__device__ __forceinline__ int v_st(int k, int c) { const int kk = (k & ~0xC) | ((k & 4) << 1) | ((k & 8) >> 1); return ((kk >> 3) * 4 + (c >> 5)) * 512 + ((kk & 7) * 32 + (c & 31)) * 2; }
__device__ __forceinline__ int v_rd_base(int lane) { return ((lane & 3) << 3) | (((lane >> 2) & 3) << 6) | (((lane >> 4) & 1) << 5) | (((lane >> 5) & 1) << 8); }
constexpr int v_rd_off(int d0, int ks, int half) { return d0 * 512 + ks * 4096 + half * 2048; }
template <int OFF> __device__ __forceinline__ s16x4 tr_read(int vb) {
  s16x4 r; asm volatile("ds_read_b64_tr_b16 %0, %1 offset:%2" : "=&v"(r) : "v"(vb), "i"(OFF) : "memory"); return r;
}
template <int D0> __device__ __forceinline__ void pv_one(f32x16& od, int vb, bf16x8 pa0, bf16x8 pa1, bf16x8 pa2, bf16x8 pa3) {
  const s16x4 l0 = tr_read<v_rd_off(D0, 0, 0)>(vb), h0 = tr_read<v_rd_off(D0, 0, 1)>(vb), l1 = tr_read<v_rd_off(D0, 1, 0)>(vb), h1 = tr_read<v_rd_off(D0, 1, 1)>(vb);
  const s16x4 l2 = tr_read<v_rd_off(D0, 2, 0)>(vb), h2 = tr_read<v_rd_off(D0, 2, 1)>(vb), l3 = tr_read<v_rd_off(D0, 3, 0)>(vb), h3 = tr_read<v_rd_off(D0, 3, 1)>(vb);
  asm volatile("s_waitcnt lgkmcnt(0)" ::: "memory"); SBAR();
#define PK(L, H) (bf16x8){L[0], L[1], L[2], L[3], H[0], H[1], H[2], H[3]}
  od = __builtin_amdgcn_mfma_f32_32x32x16_bf16(pa0, PK(l0, h0), od, 0, 0, 0);
  od = __builtin_amdgcn_mfma_f32_32x32x16_bf16(pa1, PK(l1, h1), od, 0, 0, 0);
  od = __builtin_amdgcn_mfma_f32_32x32x16_bf16(pa2, PK(l2, h2), od, 0, 0, 0);
  od = __builtin_amdgcn_mfma_f32_32x32x16_bf16(pa3, PK(l3, h3), od, 0, 0, 0);
#undef PK
}
__device__ __forceinline__ void pv_d0(f32x16* o, int vb, bf16x8 pa0, bf16x8 pa1, bf16x8 pa2, bf16x8 pa3) {
  pv_one<0>(o[0], vb, pa0, pa1, pa2, pa3); pv_one<1>(o[1], vb, pa0, pa1, pa2, pa3); pv_one<2>(o[2], vb, pa0, pa1, pa2, pa3); pv_one<3>(o[3], vb, pa0, pa1, pa2, pa3);
}
__device__ __forceinline__ void attn_dense_body(const bf16_t* __restrict__ Qb, const bf16_t* __restrict__ Kh, const bf16_t* __restrict__ Vh,
                                                const bf16_t* __restrict__ Gb, bf16_t* __restrict__ Yb, int seq, char* lds) {
  constexpr int SDEPTH = 1;
  const int tid = tidx(), wid = __builtin_amdgcn_readfirstlane(tid >> 6), lane = tid & 63, r32 = lane & 31, hi = lane >> 5;
  bf16_t* V_lds = (bf16_t*)lds; bf16_t* K_lds = (bf16_t*)(lds + 2 * SHM_V);
  float* ws = (float*)(lds + 2 * SHM_V + 2 * SHM_K) + wid * 64; float* li_l = ws; float* al_l = ws + 32;
  float m_reg = -1e30f, l_reg = 0; f32x16 o[4] = {}; bf16x8 qr[8];
  const bf16_t* Qw = Qb + (long)(wid * QBLK + r32) * LDQ + hi * 8;
#pragma unroll
  for (int d0 = 0; d0 < 8; ++d0) qr[d0] = ld8(Qw + d0 * 16);
  const int sr = tid >> 4, sc = (tid & 15) * 8, vst0 = v_st(sr, sc), vst1 = v_st(32 + sr, sc);
  const int vb0 = (int)(uintptr_t)V_lds + v_rd_base(lane);
  struct { bf16x8 vs0, vs1, ks0, ks1; } sr_[SDEPTH];
#define SLOAD(i, k0) do { sr_[i].vs0 = ld8(&Vh[(long)((k0) + sr) * LDK + sc]); sr_[i].vs1 = ld8(&Vh[(long)((k0) + 32 + sr) * LDK + sc]); \
    sr_[i].ks0 = ld8(&Kh[(long)((k0) + sr) * LDK + sc]); sr_[i].ks1 = ld8(&Kh[(long)((k0) + 32 + sr) * LDK + sc]); } while (0)
#define SWRITE(b, i) do { *(bf16x8*)((char*)V_lds + (b) * SHM_V + vst0) = sr_[i].vs0;          \
    *(bf16x8*)((char*)V_lds + (b) * SHM_V + vst1) = sr_[i].vs1; int kc = sc * 2;               \
    *(bf16x8*)((char*)K_lds + (b) * SHM_K + KSWZ(sr, kc)) = sr_[i].ks0;                       \
    *(bf16x8*)((char*)K_lds + (b) * SHM_K + KSWZ(32 + sr, kc)) = sr_[i].ks1; } while (0)
#define SWAIT() do { asm volatile("s_waitcnt vmcnt(0)" ::: "memory"); } while (0)
#define RESC(a) do { if (__any((a) < 1.f)) { if (hi == 0) al_l[r32] = (a); asm volatile("s_waitcnt lgkmcnt(0)" ::: "memory"); \
    for (int d = 0; d < 4; ++d) for (int r = 0; r < 16; ++r) o[d][r] *= al_l[crow(r, hi)]; } } while (0)
  f32x16 pA0, pA1, pB0, pB1; float mnA, mnB, alA, alB; bf16x8 pa0, pa1, pa2, pa3; const int NT = seq / KVBLK;
  constexpr int SE = 0, SO = SDEPTH - 1;
  SLOAD(SE, 0); asm volatile("s_waitcnt vmcnt(0)" ::: "memory"); SWRITE(0, SE); __syncthreads();
  qkt(pA0, pA1, K_lds, qr, r32, hi); partialSM(pA0, pA1, m_reg, mnA, alA);
  SLOAD(SO, KVBLK);
  SWAIT(); SWRITE(1, SO); __syncthreads();
  for (int j = 1; j + 1 < NT; j += 2) {
    SBAR(); qkt(pB0, pB1, (bf16_t*)((char*)K_lds + SHM_K), qr, r32, hi);
    finishSM(pA0, pA1, alA, l_reg, pa0, pa1, pa2, pa3); SBAR();
    SLOAD(SO, (j + SDEPTH) * KVBLK); SBAR();
    pv_d0(o, vb0, pa0, pa1, pa2, pa3); partialSM(pB0, pB1, m_reg, mnB, alB);
    __syncthreads(); SWAIT(); SWRITE(0, SE);
    RESC(alB); __syncthreads();
    SBAR(); qkt(pA0, pA1, K_lds, qr, r32, hi);
    finishSM(pB0, pB1, alB, l_reg, pa0, pa1, pa2, pa3); SBAR();
    SLOAD(SE, (j + 1 + SDEPTH) * KVBLK); SBAR();
    pv_d0(o, vb0 + (int)SHM_V, pa0, pa1, pa2, pa3); partialSM(pA0, pA1, m_reg, mnA, alA);
    __syncthreads(); SWAIT(); SWRITE(1, SO);
    RESC(alA); __syncthreads();
  }
  SBAR(); qkt(pB0, pB1, (bf16_t*)((char*)K_lds + SHM_K), qr, r32, hi);
  finishSM(pA0, pA1, alA, l_reg, pa0, pa1, pa2, pa3); SBAR();
  pv_d0(o, vb0, pa0, pa1, pa2, pa3); partialSM(pB0, pB1, m_reg, mnB, alB);
  __syncthreads(); RESC(alB);
  finishSM(pB0, pB1, alB, l_reg, pa0, pa1, pa2, pa3); SBAR();
  pv_d0(o, vb0 + (int)SHM_V, pa0, pa1, pa2, pa3);
  if (hi == 0) li_l[r32] = l_reg; asm volatile("s_waitcnt lgkmcnt(0)" ::: "memory");
  { const int ln = opaque(lane), r32e = ln & 31, hie = ln >> 5;
    const bf16_t* Gl = Gb + (long)(wid * QBLK + 4 * hie) * LDU + r32e; bf16_t* Yl = Yb + (long)(wid * QBLK + 4 * hie) * DM + r32e;
#pragma unroll
  for (int r = 0; r < 16; ++r) { const int ro = (r & 3) + 8 * (r >> 2); const float rl = __builtin_amdgcn_rcpf(li_l[ro + 4 * hie]);
    asm volatile("" ::: "memory");
#pragma unroll
    for (int d0 = 0; d0 < 4; ++d0) { const float gv = bf2f(Gl[ro * LDU + d0 * 32]);
      Yl[ro * DM + d0 * 32] = f2bf(o[d0][r] * rl * silu(gv)); } } }
  __syncthreads();
#undef SLOAD
#undef SWRITE
#undef SWAIT
#undef RESC
}
}

__device__ __forceinline__ void attn_phase(const PV& p, int L, unsigned char* lds) {
    const bf16_t* U = (const bf16_t*)(p.ws + WS_UT); bf16_t* Y = (bf16_t*)(p.ws + WS_Y);
    const int nqb = L / 256, NB = TG / L;
    const int nitem = NB * 8 * nqb;
    const int ipp = 4 * nqb;
    for (int k = 0; k * (int)gridDim.x < nitem; ++k) {
        int it;
        if (gridDim.x == 256) { const int xcd = blockIdx.x & 7, slot = blockIdx.x >> 3; const int sub = ipp / 32;
            const int pair = (k / sub) * 8 + xcd; it = pair * ipp + (k % sub) * 32 + slot; }
        else { it = blockIdx.x + k * gridDim.x; if (it >= nitem) break; }
        const int qb = it % nqb; const int hq = (it / nqb) & 7; const int b = it / (nqb * 8); const int kvh = hq >> 2;
        const size_t row0 = (size_t)b * L + (size_t)qb * 256;
        att::attn_dense_body(U + row0 * LDU + hq * 128, U + (size_t)b * L * LDU + 1024 + kvh * 128, U + (size_t)b * L * LDU + 1280 + kvh * 128,
                             U + row0 * LDU + 1536 + hq * 128, Y + row0 * DM + hq * 128, L, (char*)lds);
    }
}

__device__ __forceinline__ void run_phase(const Params& pin, int ph, unsigned char* lds) {
    const PV p(pin, opaque_zero());
    if (ph == 0) { if (PHMASK & 1) prologue_phase(p, lds); if (PHMASK & 2) cvt_phase(p, 0); return; }
    const int q = ph - 1, g = q / 20, r = q % 20 + 1;
    const int L = g == 0 ? 2048 : 4096;
    const int layer = (r - 1) / 5, sub = (r - 1) % 5, j = layer >> 1;
    bf16_t* XB = (bf16_t*)(p.ws + WS_XB); bf16_t* UT = (bf16_t*)(p.ws + WS_UT); bf16_t* Y = (bf16_t*)(p.ws + WS_Y);
    if (sub == 4) {
#if PROBE_WHAT == 2
        if (layer != 3) ln_phase(p, g, layer, (bf16_t*)(p.ws + WS_GATE));
#endif
        if (PHMASK & 4) ln_phase(p, g, layer, XB);
        if (g == 0 && layer == 3 && (PHMASK & 2)) cvt_phase(p, 1);
        return; }
    if (sub == 3) {
        const bf16_t* WT = (const bf16_t*)(p.ws + ((layer & 1) ? WS_AWOUT : WS_HWOUT)) + (size_t)j * 1024 * 1024;
        EpiRes E; E.out = p.out + (size_t)g * TG * DM; E.xb = XB; E.last = layer == 3; E.bias = ((layer & 1) ? p.in(21) : p.in(15)) + j * 1024;
        E.dst = XB;
#if PROBE_WHAT == 1
        if (layer != 3) { EpiRes E0 = E; E0.dst = (bf16_t*)(p.ws + WS_GATE); run_gemm(lds, Y, WT, TG, 1024, E0); }
#endif
        if (PHMASK & 8) run_gemm(lds, Y, WT, TG, 1024, E); return;
    }
    if ((layer & 1) == 0) {
        if (sub == 0) {
            const bf16_t* WT = (const bf16_t*)(p.ws + WS_HWIN) + (size_t)j * 4096 * 1024;
            EpiUT E1; E1.O = UT; E1.bias = p.in(3) + j * 4096; E1.L = L;
            if (PHMASK & 16) run_gemm(lds, WT, XB, 3072, TG, E1);
            EpiBf16B E2; E2.O = (bf16_t*)(p.ws + WS_GATE); E2.ldc = 1024; E2.bias = p.in(3) + j * 4096 + 3072;
            if (PHMASK & 32) run_gemm(lds, XB, WT + (size_t)3072 * 1024, TG, 1024, E2);
            if (PHMASK & 2048) { if (g == 0) filter_phase<2048>(p, j, g * 2 + j, lds); else filter_phase<4096>(p, j, g * 2 + j, lds); }
        } else if (sub == 1) {
#if PROBE_WHAT == 4
            if (g == 0) conv_phase<16>(p, j, g * 2 + j, lds, Y, 1024); else conv_phase<8>(p, j, g * 2 + j, lds, Y, 1024);
#endif
            if (g == 0) { if (PHMASK & 64) conv_phase<16>(p, j, g * 2 + j, lds, UT, 3072); } else { if (PHMASK & 128) conv_phase<8>(p, j, g * 2 + j, lds, UT, 3072); } }
        else if (sub == 2) { if (PHMASK & 256) ygate_phase(p, L, lds); }
    } else {
        if (sub == 0) {
            const bf16_t* WT = (const bf16_t*)(p.ws + WS_AWIN) + (size_t)j * 2560 * 1024;
            EpiBf16B E; E.O = UT; E.ldc = LDU; E.bias = p.in(17) + j * 2560;
            if (PHMASK & 32) run_gemm(lds, XB, WT, TG, 2560, E);
        } else if (sub == 1) {
#if PROBE_WHAT == 3
            rope_phase(p, j, L, (bf16_t*)(p.ws + WS_GATE), 1280);
#endif
            if (PHMASK & 512) rope_phase(p, j, L, UT, LDU); }
        else if (sub == 2) { if (PHMASK & 1024) attn_phase(p, L, lds); }
    }
}

#ifndef DUPMASK
#define DUPMASK 0
#endif
__device__ __forceinline__ bool dup_phase(int ph) {
    if (ph == 0) return (DUPMASK >> 5) & 1;
    const int r = (ph - 1) % 21; if (r == 0) return (DUPMASK >> 5) & 1;
    const int layer = (r - 1) / 5, sub = (r - 1) % 5;
    if (sub > 2) return false;
    if ((layer & 1) == 0) return (DUPMASK >> sub) & 1;
    if (sub == 0) return (DUPMASK >> 3) & 1;
    if (sub == 2) return (DUPMASK >> 4) & 1;
    return false;
}
#define XB_XCNT(j)  (256  + 64 * (j))
#define XB_XSUB(j)  (1280 + 64 * (j))
#define XB_XGEN(j)  (2304 + 64 * (j))
#define XB_TOP      3328
#define XB_TOPGEN   3392
#define XCD_BAR_WORDS 3456
__device__ __forceinline__ unsigned xb_ld(unsigned* p)              { return __hip_atomic_load(p, __ATOMIC_RELAXED, __HIP_MEMORY_SCOPE_AGENT); }
__device__ __forceinline__ unsigned xb_add(unsigned* p, unsigned v) { return __hip_atomic_fetch_add(p, v, __ATOMIC_RELAXED, __HIP_MEMORY_SCOPE_AGENT); }
__device__ __forceinline__ unsigned xb_xcc_id() { return (unsigned)__builtin_amdgcn_s_getreg((3 << 11) | 20) & 0xFu; }
__device__ __forceinline__ void xcd_barrier(unsigned* bar, unsigned x, unsigned& nloc, unsigned& nx) {
    asm volatile("s_waitcnt vmcnt(0)" ::: "memory");
    __syncthreads();
    if (tidx() == 0) {
        __builtin_amdgcn_s_waitcnt(0);
        if (nloc == 0u) {
            const unsigned G = gridDim.x; unsigned sum, cnt, mine;
            for (;;) { sum = 0u; cnt = 0u; mine = 0u;
#pragma unroll
                for (unsigned j = 0; j < 16; ++j) { const unsigned c = xb_ld(&bar[XB_XCNT(j)]); sum += c; cnt += (c > 0u) ? 1u : 0u; mine = (j == x) ? c : mine; }
                if (sum == G) break;
                __builtin_amdgcn_s_sleep(1); }
            nloc = mine > 0u ? mine : 1u; nx = cnt > 0u ? cnt : 1u; }
        const unsigned old = xb_add(&bar[XB_XSUB(x)], 1u);
        const unsigned gen = old / nloc;
        if (old + 1u == (gen + 1u) * nloc) {
            __builtin_amdgcn_fence(__ATOMIC_RELEASE, "agent");
            asm volatile("s_waitcnt vmcnt(0)" ::: "memory");
            const unsigned og = xb_add(&bar[XB_TOP], 1u);
            const unsigned tg = og / nx;
            if (og + 1u == (tg + 1u) * nx) xb_add(&bar[XB_TOPGEN], 1u);
            else while (xb_ld(&bar[XB_TOPGEN]) == tg) __builtin_amdgcn_s_sleep(1);
            __builtin_amdgcn_fence(__ATOMIC_ACQUIRE, "agent");
            xb_add(&bar[XB_XGEN(x)], 1u);
            asm volatile("s_waitcnt vmcnt(0)" ::: "memory");
        } else {
            while (xb_ld(&bar[XB_XGEN(x)]) == gen) __builtin_amdgcn_s_sleep(1);
            __builtin_amdgcn_fence(__ATOMIC_ACQUIRE, "agent");
            asm volatile("s_waitcnt vmcnt(0)" ::: "memory");
        }
    }
    __syncthreads();
}

__global__ __launch_bounds__(512, 2) void mk_forward(Params p) {
    extern __shared__ __attribute__((aligned(16))) unsigned char smem[];
    cg::grid_group grid = cg::this_grid();
    unsigned* bar = (unsigned*)(p.ws + WS_BAR);
    unsigned xcc = 0, nloc = 0, nx = 0;
    for (int ph = p.ph_lo; ph < p.ph_hi; ++ph) {
        if (ph == 0 && blockIdx.x == 0) for (int i = threadIdx.x; i < XCD_BAR_WORDS; i += 512) __hip_atomic_store(bar + i, 0u, __ATOMIC_RELAXED, __HIP_MEMORY_SCOPE_AGENT);
        run_phase(p, ph, smem);
        if (ph + 1 < p.ph_hi) {
            if (ph == p.ph_lo) { grid.sync();
                xcc = xb_xcc_id(); if (threadIdx.x == 0) (void)xb_add(&bar[XB_XCNT(xcc)], 1u); }
            else xcd_barrier(bar, xcc, nloc, nx);
        }
    }
}

extern "C" void kernel_launch(void* const* d_in, const int* in_sizes, int n_in, void* d_out, int out_size, void* d_ws, size_t ws_size, hipStream_t stream) {
    static int grid = 0;
    if (grid == 0) {
        if (n_in != 24 || ws_size < WS_END) { fprintf(stderr, "kernel_launch: unexpected n_in %d / ws %zu\n", n_in, ws_size); grid = -1; return; }
        int dev = 0, cus = 0, per_cu = 0;
        hipGetDevice(&dev); hipDeviceGetAttribute(&cus, hipDeviceAttributeMultiprocessorCount, dev);
        if (hipFuncSetAttribute((const void*)mk_forward, hipFuncAttributeMaxDynamicSharedMemorySize, LDS_BYTES) != hipSuccess) { fprintf(stderr, "kernel_launch: hipFuncSetAttribute failed\n"); grid = -1; return; }
        if (hipOccupancyMaxActiveBlocksPerMultiprocessor(&per_cu, (const void*)mk_forward, 512, LDS_BYTES) != hipSuccess || per_cu < 1) { fprintf(stderr, "kernel_launch: occupancy query gives %d\n", per_cu); per_cu = 1; }
        (void)hipGetLastError();
        grid = cus * per_cu;
    }
    if (grid < 0) return;
    Params p{};
    for (int i = 0; i < 24; ++i) p.in[i] = (const float*)d_in[i];
    p.out = (float*)d_out; p.ws = (unsigned char*)d_ws;
#if MK_LAUNCHES == 1
    p.ph_lo = 0; p.ph_hi = NPHASE;
    void* args[] = {&p};
    hipError_t e = hipLaunchCooperativeKernel((const void*)mk_forward, dim3(grid), dim3(512), args, LDS_BYTES, stream);
    if (e != hipSuccess) fprintf(stderr, "cooperative launch failed: %s (grid %d)\n", hipGetErrorString(e), grid);
#else
    for (int ph = 0; ph < NPHASE; ++ph) { p.ph_lo = ph; p.ph_hi = ph + 1;
        hipLaunchKernelGGL(mk_forward, dim3(grid), dim3(512), LDS_BYTES, stream, p); }
#endif
}
```

```cpp
#include <hip/hip_runtime.h>
#include <hip/hip_cooperative_groups.h>
#include <cstdio>
#include <cstdint>
namespace cg = cooperative_groups;

#ifndef MK_LAUNCHES
#define MK_LAUNCHES 1
#endif

__device__ __forceinline__ int tidx() { int t = threadIdx.x; asm volatile("" : "+v"(t)); return t; }

namespace pg8 {
#define PG8_LAS __attribute__((address_space(3)))
typedef unsigned short bf16_t;
typedef short bf16x8 __attribute__((ext_vector_type(8)));
typedef float f32x4 __attribute__((ext_vector_type(4)));
typedef unsigned u32x4 __attribute__((ext_vector_type(4)));
constexpr int BM = 256, BK = 64, HALF = 128, HTB = HALF * BK * 2  , STAGE_BYTES = 8 * HTB, NXCD = 8, WGM = 8;

__host__ __device__ __forceinline__ int lds_byte(int r, int c) { const int st = (r >> 4) * 2 + (c >> 5), rr = r & 15, cc = c & 31, ob = rr * 64 + cc * 2; return st * 1024 + (ob ^ (((ob >> 9) & 1) << 5)); }
__host__ __device__ __forceinline__ void stage_rc(int b, int& R, int& C) { const int st = b / 1024, sb = b % 1024, swz = sb ^ (((sb >> 9) & 1) << 5); R = (st >> 1) * 16 + swz / 64; C = (st & 1) * 32 + (swz % 64) / 2; }
__host__ __device__ __forceinline__ int perm32(int rho) { const int n = rho >> 4, i = rho & 15; return 8 * (i >> 2) + 4 * n + (i & 3); }

struct Unit { int pm, pn; };
struct Gemm { const bf16_t* A; const bf16_t* Bt; int M, N, K; };
struct StaticOrder {
    int nM, nN, nwg, G, c;
    __host__ __device__ void init(int M, int N, int G_, int c_) { nM = M / BM; nN = N / BM; nwg = nM * nN; G = G_; c = c_; }
    __host__ __device__ bool next(int i, Unit& u) const {
        const long L = (long)i * G + c; if (L >= nwg) return false;
        int wgid = (int)L; { const int q = nwg / NXCD, r = nwg % NXCD, xcd = wgid % NXCD, off = wgid / NXCD; wgid = (xcd < r ? xcd * (q + 1) : r * (q + 1) + (xcd - r) * q) + off; }
        const int nig = WGM * nN, gid = wgid / nig, fm = gid * WGM, gsz = (nM - fm) < WGM ? (nM - fm) : WGM;
        u.pm = fm + ((wgid % nig) % gsz); u.pn = (wgid % nig) / gsz; return true;
    }
    __device__ __forceinline__ void a_ready(const Unit&) const {}
    __device__ __forceinline__ void done(const Unit&) const {}
};
__device__ __forceinline__ unsigned cvt_pk_bf16(float lo, float hi) { unsigned r; asm volatile("v_cvt_pk_bf16_f32 %0, %1, %2" : "=v"(r) : "v"(lo), "v"(hi)); return r; }
template <class Epi, class Sched, bool STAMP = false>
__device__ __forceinline__ void gemm_phase(PG8_LAS unsigned char* lds, const Gemm g, const Sched& S, const Epi& E, unsigned long long* stamps) {
    const int tid = tidx(), wid = __builtin_amdgcn_readfirstlane(tid >> 6), lane = tid & 63, wr = wid >> 2, wc = wid & 3, fr = lane & 15, fq = lane >> 4;
    const int K = g.K, nt = K / BK;
    unsigned voffA[2], voffB[2];
#pragma unroll
    for (int i = 0; i < 2; ++i) { int R, C; stage_rc(tid * 16 + i * 8192, R, C); const int Rb = Epi::PERM ? ((R & ~31) + perm32(R & 31)) : R;
        voffA[i] = (unsigned)(R * K + C) * 2u; voffB[i] = (unsigned)(Rb * K + C) * 2u; }
    const size_t kstep = (size_t)(BK * 2);
    const size_t hstep = (size_t)HALF * K * 2;
    const size_t tstep = 2 * hstep;
    const unsigned ldsw = (unsigned)wid * 1024u;
    const int aoff = lds_byte(wr * 64 + fr, fq * 8), boff = lds_byte(wc * 32 + fr, fq * 8);
#define PG8_SA(b, h) (((b) * 2 + (h)) * HTB)
#define PG8_SB(b, h) ((4 + (b) * 2 + (h)) * HTB)
#define PG8_STAGE(bufoff, gbase, voff) do { _Pragma("unroll") for (int _i = 0; _i < 2; ++_i) \
        __builtin_amdgcn_global_load_lds((const unsigned*)((const char*)(gbase) + (voff)[_i]), (PG8_LAS unsigned*)(lds + (bufoff) + ldsw + _i * 8192), 16, 0, 0); } while (0)
#define PG8_LDA(dst, b, h) do { _Pragma("unroll") for (int m = 0; m < 4; ++m) _Pragma("unroll") for (int k = 0; k < 2; ++k) dst[m][k] = *(const PG8_LAS bf16x8*)(lds + PG8_SA(b, h) + aoff + m * 2048 + k * 1024); } while (0)
#define PG8_LDB(dst, b, h) do { _Pragma("unroll") for (int n = 0; n < 2; ++n) _Pragma("unroll") for (int k = 0; k < 2; ++k) dst[n][k] = *(const PG8_LAS bf16x8*)(lds + PG8_SB(b, h) + boff + n * 2048 + k * 1024); } while (0)
#define PG8_MMA(ai, bj, At, Bt) do { __builtin_amdgcn_s_setprio(1); _Pragma("unroll") for (int m = 0; m < 4; ++m) _Pragma("unroll") for (int n = 0; n < 2; ++n) _Pragma("unroll") for (int k = 0; k < 2; ++k) \
        acc[ai][bj][m][n] = __builtin_amdgcn_mfma_f32_16x16x32_bf16(Bt[n][k], At[m][k], acc[ai][bj][m][n], 0, 0, 0); __builtin_amdgcn_s_setprio(0); } while (0)
#define PG8_WAIT_V(n) asm volatile("s_waitcnt vmcnt(" #n ")" ::: "memory")
#define PG8_WAIT_L(n) asm volatile("s_waitcnt lgkmcnt(" #n ")" ::: "memory")
#define PG8_BAR __builtin_amdgcn_s_barrier()
#define PG8_SCHED __builtin_amdgcn_sched_barrier(0)
    Unit cur, nxt; int ui = 0;
    if (!S.next(0, cur)) return;
    f32x4 acc[2][2][4][2];
#pragma unroll
    for (int a = 0; a < 2; ++a)
#pragma unroll
        for (int b = 0; b < 2; ++b)
#pragma unroll
            for (int m = 0; m < 4; ++m)
#pragma unroll
                for (int n = 0; n < 2; ++n) acc[a][b][m][n] = (f32x4){0.f, 0.f, 0.f, 0.f};
    bf16x8 At[4][2], B0[2][2], B1[2][2];
    const char* cA = (const char*)g.A + (size_t)cur.pm * tstep; const char* cB = (const char*)g.Bt + (size_t)cur.pn * tstep;
    S.a_ready(cur);
    PG8_STAGE(PG8_SB(0, 0), cB, voffB); PG8_STAGE(PG8_SA(0, 0), cA, voffA); PG8_STAGE(PG8_SB(0, 1), cB + hstep, voffB); PG8_STAGE(PG8_SA(0, 1), cA + hstep, voffA);
    if (wr == 1) PG8_BAR;
    PG8_WAIT_V(4); PG8_BAR;
    PG8_STAGE(PG8_SB(1, 0), cB + kstep, voffB); PG8_STAGE(PG8_SA(1, 0), cA + kstep, voffA); PG8_STAGE(PG8_SB(1, 1), cB + hstep + kstep, voffB);
    PG8_WAIT_V(6); PG8_BAR;
    for (;;) {
        const bool has_next = S.next(ui + 1, nxt);
        const char* nA = has_next ? (const char*)g.A + (size_t)nxt.pm * tstep : cA; const char* nB = has_next ? (const char*)g.Bt + (size_t)nxt.pn * tstep : cB;
        for (int t = 0; t < nt; t += 2) {
            const bool last = (t == nt - 2);
            const char* a1 = cA + (size_t)(t + 1) * kstep;
            const char* a2 = last ? nA : cA + (size_t)(t + 2) * kstep; const char* b2 = last ? nB : cB + (size_t)(t + 2) * kstep;
            const char* a3 = a2 + kstep; const char* b3 = b2 + kstep;
            if (last && has_next) S.a_ready(nxt);
            PG8_LDB(B0, 0, 0); PG8_SCHED; PG8_LDA(At, 0, 0); PG8_STAGE(PG8_SA(1, 1), a1 + hstep, voffA);
            PG8_WAIT_L(8); PG8_BAR; PG8_WAIT_L(0); PG8_MMA(0, 0, At, B0); PG8_BAR; PG8_SCHED;
            PG8_LDB(B1, 0, 1); PG8_STAGE(PG8_SB(0, 0), b2, voffB);
            PG8_BAR; PG8_WAIT_L(0); PG8_MMA(0, 1, At, B1); PG8_BAR;
            PG8_LDA(At, 0, 1); PG8_STAGE(PG8_SA(0, 0), a2, voffA);
            PG8_BAR; PG8_WAIT_L(0); PG8_MMA(1, 0, At, B0); PG8_BAR; PG8_SCHED;
            PG8_STAGE(PG8_SB(0, 1), b2 + hstep, voffB);
            PG8_WAIT_V(6); PG8_BAR; PG8_MMA(1, 1, At, B1); PG8_BAR;
            PG8_LDB(B0, 1, 0); PG8_SCHED; PG8_LDA(At, 1, 0); PG8_STAGE(PG8_SA(0, 1), a2 + hstep, voffA);
            PG8_WAIT_L(8); PG8_BAR; PG8_WAIT_L(0); PG8_MMA(0, 0, At, B0); PG8_BAR; PG8_SCHED;
            PG8_LDB(B1, 1, 1); PG8_STAGE(PG8_SB(1, 0), b3, voffB);
            PG8_BAR; PG8_WAIT_L(0); PG8_MMA(0, 1, At, B1); PG8_BAR;
            PG8_LDA(At, 1, 1); PG8_STAGE(PG8_SA(1, 0), a3, voffA);
            PG8_BAR; PG8_WAIT_L(0); PG8_MMA(1, 0, At, B0); PG8_BAR; PG8_SCHED;
            PG8_STAGE(PG8_SB(1, 1), b3 + hstep, voffB);
            PG8_WAIT_V(6); PG8_BAR; PG8_MMA(1, 1, At, B1); PG8_BAR;
        }
        if constexpr (!Epi::AFTER_DRAIN) { E(acc, cur, wr, wc, fr, fq); S.done(cur); }
        if (!has_next) break;
#pragma unroll
        for (int a = 0; a < 2; ++a)
#pragma unroll
            for (int b = 0; b < 2; ++b)
#pragma unroll
                for (int m = 0; m < 4; ++m)
#pragma unroll
                    for (int n = 0; n < 2; ++n) acc[a][b][m][n] = (f32x4){0.f, 0.f, 0.f, 0.f};
        cur = nxt; cA = nA; cB = nB; ++ui;
    }
    PG8_WAIT_V(0);
    if (wr == 0) PG8_BAR;
    PG8_BAR;
    if constexpr (Epi::AFTER_DRAIN) { E.fused(acc, cur, wr, wc, fr, fq, lds, wid, lane); S.done(cur); }
#undef PG8_SA
#undef PG8_SB
#undef PG8_STAGE
#undef PG8_LDA
#undef PG8_LDB
#undef PG8_MMA
#undef PG8_WAIT_V
#undef PG8_WAIT_L
#undef PG8_BAR
#undef PG8_SCHED
}
}

using pg8::bf16_t; using pg8::bf16x8; using pg8::f32x4; using pg8::u32x4; using pg8::cvt_pk_bf16;
typedef short s16x4 __attribute__((ext_vector_type(4)));
typedef float f32x8 __attribute__((ext_vector_type(8)));
typedef float f32x16 __attribute__((ext_vector_type(16)));
typedef unsigned u32x2 __attribute__((ext_vector_type(2)));

constexpr int DM = 1024, TG = 32768;
constexpr size_t MiB = 1u << 20;
constexpr size_t WS_HWIN = 0, WS_HWOUT = 16 * MiB, WS_AWIN = 20 * MiB, WS_AWOUT = 30 * MiB, WS_H2 = 34 * MiB, WS_XB = 38 * MiB,
                 WS_UT = 102 * MiB, WS_GATE = 294 * MiB, WS_Y = 358 * MiB, WS_FILT = 422 * MiB, WS_SUMSQ = 454 * MiB, WS_BAR = 456 * MiB, WS_END = 457 * MiB;
constexpr int LDS_BYTES = 136 * 1024;
constexpr float ALPHA = 1.681792830507429f;
constexpr int NPHASE = 1 + 2 * 20;
#ifndef PHMASK
#define PHMASK 0xFFFF
#endif
#ifndef PROBE_WHAT
#define PROBE_WHAT 0
#endif

struct Params { const float* in[24]; float* out; unsigned char* ws; int ph_lo, ph_hi; };
struct PV { const Params& q; int z; float* out; unsigned char* ws;
    __device__ __forceinline__ PV(const Params& q_, int z_) : q(q_), z(z_), out(q_.out + z_), ws(q_.ws + z_) {}
    __device__ __forceinline__ const float* in(int k) const { return q.in[k + z]; } };

__device__ __forceinline__ float bf2f(unsigned short x) { return __uint_as_float(((unsigned)x) << 16); }
__device__ __forceinline__ float bf2f_s(short x) { return __uint_as_float(((unsigned)(unsigned short)x) << 16); }
__device__ __forceinline__ unsigned short f2bf(float x) { return (unsigned short)(cvt_pk_bf16(x, 0.f) & 0xffffu); }
__device__ __forceinline__ float wave_sum(float v) {
#pragma unroll
    for (int o = 32; o >= 1; o >>= 1) v += __shfl_xor(v, o, 64);
    return v;
}
template <class T> __device__ __forceinline__ T* launder(T* q) {
    unsigned long long w = (unsigned long long)q; unsigned lo = (unsigned)w, hi = (unsigned)(w >> 32);
    asm volatile("" : "+v"(lo), "+v"(hi));
    lo = __builtin_amdgcn_readfirstlane(lo); hi = __builtin_amdgcn_readfirstlane(hi);
    return (T*)(((unsigned long long)hi << 32) | lo);
}
__device__ __forceinline__ int opaque_zero() { int z = 0; asm volatile("" : "+v"(z)); return __builtin_amdgcn_readfirstlane(z); }
__device__ __forceinline__ int opaque(int x) { asm volatile("" : "+v"(x)); return x; }
__device__ __forceinline__ float silu(float x) { return x / (1.f + __expf(-x)); }

struct EpiBf16B {
    static constexpr bool PERM = true, AFTER_DRAIN = false;
    bf16_t* O; int ldc; const float* bias;
    __device__ __forceinline__ void operator()(const f32x4 (&acc)[2][2][4][2], const pg8::Unit& u, int wr, int wc, int fr, int fq) const {
        const int row0 = u.pm * 256 + wr * 64 + fr, col0 = u.pn * 256 + wc * 32 + 8 * fq;
        f32x4 bv[2][2];
#pragma unroll
        for (int bj = 0; bj < 2; ++bj)
#pragma unroll
            for (int n = 0; n < 2; ++n) bv[bj][n] = *(const f32x4*)(bias + col0 + bj * 128 + 4 * n);
#pragma unroll
        for (int ai = 0; ai < 2; ++ai)
#pragma unroll
            for (int m = 0; m < 4; ++m) { bf16_t* rowp = O + (size_t)(row0 + ai * 128 + m * 16) * ldc + col0;
#pragma unroll
                for (int bj = 0; bj < 2; ++bj) { f32x4 v0 = acc[ai][bj][m][0] + bv[bj][0], v1 = acc[ai][bj][m][1] + bv[bj][1];
                    u32x4 w; w.x = cvt_pk_bf16(v0[0], v0[1]); w.y = cvt_pk_bf16(v0[2], v0[3]); w.z = cvt_pk_bf16(v1[0], v1[1]); w.w = cvt_pk_bf16(v1[2], v1[3]);
                    *(u32x4*)(rowp + bj * 128) = w; } }
    }
};
struct EpiUT {
    static constexpr bool PERM = true, AFTER_DRAIN = false;
    bf16_t* O; const float* bias; int L;
    __device__ __forceinline__ void operator()(const f32x4 (&acc)[2][2][4][2], const pg8::Unit& u, int wr, int wc, int fr, int fq) const {
        const int row0 = u.pm * 256 + wr * 64 + fr; const int tokt = u.pn * 256; const int b = tokt / L; const int t0 = tokt - b * L + wc * 32 + 8 * fq;
#pragma unroll
        for (int ai = 0; ai < 2; ++ai)
#pragma unroll
            for (int m = 0; m < 4; ++m) { const int ch = row0 + ai * 128 + m * 16; const float bs = bias[ch];
                bf16_t* rowp = O + ((size_t)b * 3072 + ch) * L + t0;
#pragma unroll
                for (int bj = 0; bj < 2; ++bj) { f32x4 v0 = acc[ai][bj][m][0] + bs, v1 = acc[ai][bj][m][1] + bs;
                    u32x4 w; w.x = cvt_pk_bf16(v0[0], v0[1]); w.y = cvt_pk_bf16(v0[2], v0[3]); w.z = cvt_pk_bf16(v1[0], v1[1]); w.w = cvt_pk_bf16(v1[2], v1[3]);
                    *(u32x4*)(rowp + bj * 128) = w; } }
    }
};
struct EpiRes {
    static constexpr bool PERM = true, AFTER_DRAIN = false;
    float* out; bf16_t* xb; const float* bias; int last; bf16_t* dst;
    __device__ __forceinline__ void operator()(const f32x4 (&acc)[2][2][4][2], const pg8::Unit& u, int wr, int wc, int fr, int fq) const {
        const int row0 = u.pm * 256 + wr * 64 + fr, col0 = u.pn * 256 + wc * 32 + 8 * fq;
        f32x4 bv[2][2];
#pragma unroll
        for (int bj = 0; bj < 2; ++bj)
#pragma unroll
            for (int n = 0; n < 2; ++n) bv[bj][n] = *(const f32x4*)(bias + col0 + bj * 128 + 4 * n);
#pragma unroll
        for (int ai = 0; ai < 2; ++ai)
#pragma unroll
            for (int m = 0; m < 4; ++m) { const size_t ro = (size_t)(row0 + ai * 128 + m * 16) * DM + col0;
#pragma unroll
                for (int bj = 0; bj < 2; ++bj) { const bf16x8 xv = *(const bf16x8*)(xb + ro + bj * 128);
                    f32x4 v0, v1;
#pragma unroll
                    for (int e = 0; e < 4; ++e) { v0[e] = bf2f_s(xv[e]) * ALPHA + acc[ai][bj][m][0][e] + bv[bj][0][e]; v1[e] = bf2f_s(xv[4 + e]) * ALPHA + acc[ai][bj][m][1][e] + bv[bj][1][e]; }
                    if (last) { *(f32x4*)(out + ro + bj * 128) = v0; *(f32x4*)(out + ro + bj * 128 + 4) = v1; }
                    else { u32x4 w; w.x = cvt_pk_bf16(v0[0], v0[1]); w.y = cvt_pk_bf16(v0[2], v0[3]); w.z = cvt_pk_bf16(v1[0], v1[1]); w.w = cvt_pk_bf16(v1[2], v1[3]);
                        *(u32x4*)(dst + ro + bj * 128) = w; } } }
    }
};

template <class Epi> __device__ __forceinline__ void run_gemm(unsigned char* lds, const bf16_t* A, const bf16_t* Bt, int M, int N, const Epi& E) {
    pg8::Gemm g; g.A = A; g.Bt = Bt; g.M = M; g.N = N; g.K = DM;
    pg8::StaticOrder S; S.init(M, N, (int)gridDim.x, (int)blockIdx.x);
    pg8::gemm_phase<Epi, pg8::StaticOrder, false>((PG8_LAS unsigned char*)lds, g, S, E, nullptr);
    __syncthreads();
}

struct TileRef { const float* W; bf16_t* WT; int N, tk, tn; };
__device__ __forceinline__ TileRef tile_ref(const PV& p, int it) {
    const int j = it / 2176; int r = it - j * 2176; int kind;
    if (r < 1024) kind = 0; else if (r < 1280) { kind = 1; r -= 1024; } else if (r < 1920) { kind = 2; r -= 1280; } else { kind = 3; r -= 1920; }
    TileRef t; t.N = kind == 0 ? 4096 : (kind == 2 ? 2560 : 1024);
    const int nN = t.N / 64; t.tk = r / nN; t.tn = r % nN;
    t.W = (kind == 0 ? p.in(2) : kind == 1 ? p.in(14) : kind == 2 ? p.in(16) : p.in(20)) + (size_t)j * 1024 * t.N;
    t.WT = (bf16_t*)(p.ws + (kind == 0 ? WS_HWIN : kind == 1 ? WS_HWOUT : kind == 2 ? WS_AWIN : WS_AWOUT)) + (size_t)j * 1024 * t.N;
    return t;
}
__device__ __forceinline__ void prologue_phase(const PV& p, unsigned char* lds) {
    const int tid = tidx();
    { const int wid = __builtin_amdgcn_readfirstlane(tid >> 6), lane = tid & 63;
        for (int j = 0; j < 2; ++j) {
            const float* w1 = p.in(6) + j * 33 * 64; const float* w2 = p.in(9) + j * 64 * 64;
            float w1r[33], w2r[64];
#pragma unroll
            for (int i = 0; i < 33; ++i) w1r[i] = w1[i * 64 + lane];
#pragma unroll
            for (int i = 0; i < 64; ++i) w2r[i] = w2[i * 64 + lane];
            const float b1v = p.in(7)[j * 64 + lane], b2v = p.in(10)[j * 64 + lane], fr = p.in(8)[j * 64 + lane];
            for (int row = blockIdx.x * 8 + wid; row < 6144; row += gridDim.x * 8) {
                int t = row; const int sel = t >= 2048 ? 1 : 0; if (sel) t -= 2048; const int L = sel ? 4096 : 2048;
                float feat = 0.f;
                if (lane == 0) feat = (float)t / (float)(L - 1);
                else if (lane <= 32) { const int i = (lane - 1) & 15; const double f = 1e-4 + (double)i * ((15.0 - 1e-4) / 15.0);
                    double ph = f * (double)t / (double)L; ph -= (double)(long long)ph;
                    const float a = (float)(ph * 6.283185307179586);
                    feat = lane <= 16 ? cosf(a) : -sinf(a); }
                float s = b1v;
#pragma unroll
                for (int i = 0; i < 33; ++i) s += __shfl(feat, i, 64) * w1r[i];
                const float h1 = sinf(fr * s);
                float s2 = b2v;
#pragma unroll
                for (int i = 0; i < 64; ++i) s2 += __shfl(h1, i, 64) * w2r[i];
                ((float*)(p.ws + WS_H2))[((size_t)(j * 2 + sel) * 4096 + t) * 64 + lane] = sinf(fr * s2);
            }
        }
    }
    { float* tile = (float*)lds;
        const int total = 2 * 2176;
        f32x4 v[2];
        int it = blockIdx.x;
        if (it < total) { const TileRef t = tile_ref(p, it);
#pragma unroll
            for (int i = 0; i < 2; ++i) { const int q = tid + i * 512; v[i] = *(const f32x4*)(t.W + (size_t)(t.tk * 64 + (q >> 4)) * t.N + t.tn * 64 + (q & 15) * 4); } }
        for (; it < total; it += gridDim.x) {
            const TileRef t = tile_ref(p, it);
#pragma unroll
            for (int i = 0; i < 2; ++i) { const int q = tid + i * 512, k = q >> 4, n4 = (q & 15) * 4;
                tile[k * 65 + n4 + 0] = v[i][0]; tile[k * 65 + n4 + 1] = v[i][1]; tile[k * 65 + n4 + 2] = v[i][2]; tile[k * 65 + n4 + 3] = v[i][3]; }
            __syncthreads();
            if (it + (int)gridDim.x < total) { const TileRef t2 = tile_ref(p, it + gridDim.x);
#pragma unroll
                for (int i = 0; i < 2; ++i) { const int q = tid + i * 512; v[i] = *(const f32x4*)(t2.W + (size_t)(t2.tk * 64 + (q >> 4)) * t2.N + t2.tn * 64 + (q & 15) * 4); } }
            { const int n = tid >> 3, k8 = (tid & 7) * 8; float x[8];
#pragma unroll
                for (int e = 0; e < 8; ++e) x[e] = tile[(k8 + e) * 65 + n];
                u32x4 w; w.x = cvt_pk_bf16(x[0], x[1]); w.y = cvt_pk_bf16(x[2], x[3]); w.z = cvt_pk_bf16(x[4], x[5]); w.w = cvt_pk_bf16(x[6], x[7]);
                *(u32x4*)(t.WT + (size_t)(t.tn * 64 + n) * 1024 + t.tk * 64 + k8) = w; }
            __syncthreads();
        }
    }
}

__device__ __forceinline__ void cvt_phase(const PV& p, int g) {
    const float* x = p.in(g); bf16_t* xb = (bf16_t*)(p.ws + WS_XB);
    const size_t n8 = (size_t)TG * DM / 8;
    for (size_t i = (size_t)blockIdx.x * 512 + tidx(); i < n8; i += (size_t)gridDim.x * 512) {
        const f32x4 a = *(const f32x4*)(x + i * 8), b = *(const f32x4*)(x + i * 8 + 4);
        u32x4 w; w.x = cvt_pk_bf16(a[0], a[1]); w.y = cvt_pk_bf16(a[2], a[3]); w.z = cvt_pk_bf16(b[0], b[1]); w.w = cvt_pk_bf16(b[2], b[3]);
        *(u32x4*)(xb + i * 8) = w;
    }
}

__device__ __forceinline__ void ln_phase(const PV& p, int g, int layer, bf16_t* xdst) {
    float* x = p.out + (size_t)g * TG * DM; bf16_t* xb = (bf16_t*)(p.ws + WS_XB);
    const float* gam = p.in(22) + layer * DM; const float* bet = p.in(23) + layer * DM;
    const int tid_ = tidx(); const int wid = __builtin_amdgcn_readfirstlane(tid_ >> 6), lane = tid_ & 63;
    const bool last = layer == 3;
    f32x4 gv[4], bv[4];
#pragma unroll
    for (int k = 0; k < 4; ++k) { const int c = (k >> 1) * 512 + lane * 8 + (k & 1) * 4; gv[k] = *(const f32x4*)(gam + c); bv[k] = *(const f32x4*)(bet + c); }
    constexpr int NR = 2;
    for (int row0 = (blockIdx.x * 8 + wid) * NR; row0 < TG; row0 += gridDim.x * 8 * NR) {
        f32x4 v[NR][4];
#pragma unroll
        for (int rr = 0; rr < NR; ++rr) { const size_t ro = (size_t)(row0 + rr) * DM;
            if (last) {
#pragma unroll
                for (int k = 0; k < 4; ++k) v[rr][k] = *(const f32x4*)(x + ro + (k >> 1) * 512 + lane * 8 + (k & 1) * 4);
            } else {
#pragma unroll
                for (int hh = 0; hh < 2; ++hh) { const bf16x8 t = *(const bf16x8*)(xb + ro + hh * 512 + lane * 8);
#pragma unroll
                    for (int e = 0; e < 4; ++e) { v[rr][hh * 2][e] = bf2f_s(t[e]); v[rr][hh * 2 + 1][e] = bf2f_s(t[4 + e]); } }
            } }
        float s[NR], q[NR];
#pragma unroll
        for (int rr = 0; rr < NR; ++rr) { s[rr] = 0.f;
#pragma unroll
            for (int k = 0; k < 4; ++k) s[rr] += v[rr][k][0] + v[rr][k][1] + v[rr][k][2] + v[rr][k][3]; }
#pragma unroll
        for (int o = 32; o >= 1; o >>= 1) {
#pragma unroll
            for (int rr = 0; rr < NR; ++rr) s[rr] += __shfl_xor(s[rr], o, 64); }
#pragma unroll
        for (int rr = 0; rr < NR; ++rr) { const float mu = s[rr] * (1.f / DM); q[rr] = 0.f;
#pragma unroll
            for (int k = 0; k < 4; ++k) { v[rr][k] = v[rr][k] - mu; q[rr] += v[rr][k][0] * v[rr][k][0] + v[rr][k][1] * v[rr][k][1] + v[rr][k][2] * v[rr][k][2] + v[rr][k][3] * v[rr][k][3]; } }
#pragma unroll
        for (int o = 32; o >= 1; o >>= 1) {
#pragma unroll
            for (int rr = 0; rr < NR; ++rr) q[rr] += __shfl_xor(q[rr], o, 64); }
#pragma unroll
        for (int rr = 0; rr < NR; ++rr) { const size_t ro = (size_t)(row0 + rr) * DM; const float rstd = rsqrtf(q[rr] * (1.f / DM) + 1e-5f);
#pragma unroll
            for (int k = 0; k < 4; ++k) v[rr][k] = v[rr][k] * rstd * gv[k] + bv[k];
            if (last) {
#pragma unroll
                for (int k = 0; k < 4; ++k) *(f32x4*)(x + ro + (k >> 1) * 512 + lane * 8 + (k & 1) * 4) = v[rr][k];
            } else {
#pragma unroll
                for (int hh = 0; hh < 2; ++hh) { u32x4 w; w.x = cvt_pk_bf16(v[rr][hh * 2][0], v[rr][hh * 2][1]); w.y = cvt_pk_bf16(v[rr][hh * 2][2], v[rr][hh * 2][3]);
                    w.z = cvt_pk_bf16(v[rr][hh * 2 + 1][0], v[rr][hh * 2 + 1][1]); w.w = cvt_pk_bf16(v[rr][hh * 2 + 1][2], v[rr][hh * 2 + 1][3]);
                    *(u32x4*)(xdst + ro + hh * 512 + lane * 8) = w; }
            } }
    }
}

template <int L> __device__ __forceinline__ void filter_phase(const PV& p, int hj, int slot, unsigned char* lds) {
    const int tid = tidx(), wid = __builtin_amdgcn_readfirstlane(tid >> 6), lane = tid & 63, n16 = lane & 15, kq = lane >> 4;
    const float* h2 = (const float*)(p.ws + WS_H2) + (size_t)(hj * 2 + (L == 2048 ? 0 : 1)) * 4096 * 64;
    const float* w3 = p.in(11) + (size_t)hj * 64 * 4096; const float* decay = p.in(12) + hj * 4096;
    bf16_t* FILT = (bf16_t*)(p.ws + WS_FILT); float* PART = (float*)(p.ws + WS_SUMSQ);
    constexpr int HS = 72;
    bf16_t* stg = (bf16_t*)lds;
    unsigned* tile = (unsigned*)(lds + 36864);
    constexpr int NCH = L / 256;
    for (int it = blockIdx.x; it < 64 * NCH; it += gridDim.x) {
        const int cb = it / NCH, chunk = it - cb * NCH, t0 = chunk * 256;
        const int od = cb >> 4, dir = od & 1, o = od >> 1;
        const int tb = t0 + dir;
        __syncthreads();
#pragma unroll
        for (int i = 0; i < 8; ++i) { const int q = tid + 512 * i, rr = q >> 4, c4 = (q & 15) * 4; int tr = tb + rr; tr = tr < L ? tr : L - 1;
            const f32x4 x = *(const f32x4*)(h2 + (size_t)tr * 64 + c4);
            u32x2 w; w.x = cvt_pk_bf16(x[0], x[1]); w.y = cvt_pk_bf16(x[2], x[3]); *(u32x2*)(stg + rr * HS + c4) = w; }
        bf16x8 bfr[4][2]; float dec[4];
#pragma unroll
        for (int ct = 0; ct < 4; ++ct) { const int col = cb * 64 + ct * 16 + n16; dec[ct] = fabsf(decay[col]);
#pragma unroll
            for (int ks = 0; ks < 2; ++ks) { float x[8];
#pragma unroll
                for (int e = 0; e < 8; ++e) x[e] = w3[(size_t)(ks * 32 + kq * 8 + e) * 4096 + col];
                u32x4 w; w.x = cvt_pk_bf16(x[0], x[1]); w.y = cvt_pk_bf16(x[2], x[3]); w.z = cvt_pk_bf16(x[4], x[5]); w.w = cvt_pk_bf16(x[6], x[7]);
                bfr[ct][ks] = *reinterpret_cast<bf16x8*>(&w); } }
        float ss[4] = {0.f, 0.f, 0.f, 0.f};
        if (dir == 1 && t0 == 0 && wid == 0) {
#pragma unroll
            for (int ct = 0; ct < 4; ++ct) { const int col = cb * 64 + ct * 16 + n16; float d = 0.f;
                for (int j = 0; j < 64; ++j) d += h2[j] * w3[(size_t)j * 4096 + col];
                ss[ct] = kq == 0 ? d * d : 0.f; } }
        __syncthreads();
#pragma unroll
        for (int tt = 0; tt < 2; ++tt) {
            const int trow = wid * 32 + tt * 16;
            const bf16x8 a0 = *(const bf16x8*)(stg + (trow + n16) * HS + kq * 8), a1 = *(const bf16x8*)(stg + (trow + n16) * HS + 32 + kq * 8);
#pragma unroll
            for (int ct = 0; ct < 4; ++ct) {
                f32x4 acc = {0.f, 0.f, 0.f, 0.f};
                acc = __builtin_amdgcn_mfma_f32_16x16x32_bf16(a0, bfr[ct][0], acc, 0, 0, 0);
                acc = __builtin_amdgcn_mfma_f32_16x16x32_bf16(a1, bfr[ct][1], acc, 0, 0, 0);
                unsigned short* trw = (unsigned short*)(tile + (ct * 16 + n16) * 129);
#pragma unroll
                for (int i = 0; i < 4; ++i) { const int tl = trow + kq * 4 + i, t = tb + tl;
                    float d = acc[i] * expf(-(float)t * (1.0f / (float)(L - 1)) * dec[ct]);
                    if (t >= L) d = 0.f;
                    ss[ct] += d * d;
                    trw[dir ? tl : 255 - tl] = f2bf(d); }
            }
        }
#pragma unroll
        for (int ct = 0; ct < 4; ++ct) { float v = ss[ct]; v += __shfl_xor(v, 16, 64); v += __shfl_xor(v, 32, 64);
            if (kq == 0) PART[(size_t)(cb * 64 + ct * 16 + n16) * (NCH * 8) + chunk * 8 + wid] = v; }
        __syncthreads();
        { const int cc = tid >> 3, part = tid & 7; const unsigned* src = tile + cc * 129 + part * 16;
            const int ccol = cb * 64 + cc, c2 = ccol & 1023;
            bf16_t* dst = FILT + ((size_t)(o * 1024 + c2)) * (2 * L) + (dir ? L + t0 : L - 256 - t0) + part * 32;
#pragma unroll
            for (int k = 0; k < 4; ++k) { u32x4 v; v.x = src[k * 4]; v.y = src[k * 4 + 1]; v.z = src[k * 4 + 2]; v.w = src[k * 4 + 3]; *(u32x4*)(dst + k * 8) = v; } }
    }
    __syncthreads();
}

__device__ __forceinline__ bf16x8 lds_a4(const unsigned char* lds, unsigned addr) {
    const unsigned* q = (const unsigned*)(lds + addr); u32x4 w; w.x = q[0]; w.y = q[1]; w.z = q[2]; w.w = q[3]; return *reinterpret_cast<bf16x8*>(&w);
}
template <int NB> struct ConvCfg {
    static constexpr int L = NB == 16 ? 2048 : 4096, ROWE = L + 8, SB = NB == 16 ? 0 : -2048, NT = NB == 16 ? 64 : 192;
    static constexpr int ZOFF = 0, FOFF = 66560, FCOPY = 2 * L * 2, W3OFF = FOFF + 4 * FCOPY, REDOFF = W3OFF + 1024;
};
template <int NB> __device__ __forceinline__ void conv_main(const unsigned char* lds, int o, f32x4 (&acc)[16]) {
    using C = ConvCfg<NB>;
    const int tid_ = tidx(); const int lane = tid_ & 63, wid = __builtin_amdgcn_readfirstlane(tid_ >> 6), r = lane & 15, gq = lane >> 4;
    const int b = NB == 16 ? r : (r & 7), h = NB == 16 ? 0 : (r >> 3);
    const int E0 = (C::L - 1) + C::SB - 256 * wid + 8 * gq - r;
    const int P = E0 & 1;
    unsigned aPtr = (unsigned)(C::FOFF + (o * 2 + P) * C::FCOPY + 2 * (E0 - P));
    const int bBase = C::ZOFF + b * C::ROWE * 2 + 2 * (C::SB + 2048 * h + 8 * gq);
    const int s_lane0 = C::SB + 2048 * h;
    bf16x8 A[16];
#pragma unroll
    for (int i = 0; i < 16; ++i) { A[i] = lds_a4(lds, aPtr - 32 * i); acc[i] = (f32x4){0.f, 0.f, 0.f, 0.f}; }
    auto ldb = [&](int j) -> bf16x8 {
        if (NB == 16) return *(const bf16x8*)(lds + bBase + 64 * j);
        const bool valid = (unsigned)(s_lane0 + 32 * j) < (unsigned)C::L;
        const bf16x8 t = *(const bf16x8*)(lds + (valid ? bBase + 64 * j : C::ZOFF));
        const bf16x8 z = {0, 0, 0, 0, 0, 0, 0, 0}; return valid ? t : z; };
    bf16x8 bnext = ldb(0);
    for (int jo = 0; jo < C::NT / 8; ++jo) {
#pragma unroll
        for (int jj = 0; jj < 8; ++jj) {
            const int j = jo * 8 + jj;
            const bf16x8 bf = bnext;
            bnext = ldb(j + 1 < C::NT ? j + 1 : j);
            acc[15] = __builtin_amdgcn_mfma_f32_16x16x32_bf16(A[(15 - 2 * jj) & 15], bf, acc[15], 0, 0, 0);
            acc[14] = __builtin_amdgcn_mfma_f32_16x16x32_bf16(A[(14 - 2 * jj) & 15], bf, acc[14], 0, 0, 0);
            A[(14 - 2 * jj) & 15] = lds_a4(lds, aPtr + 64 * (jj + 1));
            A[(15 - 2 * jj) & 15] = lds_a4(lds, aPtr + 64 * (jj + 1) - 32);
#pragma unroll
            for (int i = 13; i >= 0; --i) acc[i] = __builtin_amdgcn_mfma_f32_16x16x32_bf16(A[(i - 2 * jj) & 15], bf, acc[i], 0, 0, 0);
            __builtin_amdgcn_sched_barrier(0);
        }
        aPtr += 512;
    }
}
template <int NB, int I0, int I1> __device__ __forceinline__ void conv_gload(const bf16_t* UT, int gch, s16x4 (&gu)[16], unsigned (&gh)[16]) {
    using C = ConvCfg<NB>;
    const int tid_ = tidx(); const int lane = tid_ & 63, wid = __builtin_amdgcn_readfirstlane(tid_ >> 6), r = lane & 15, gq = lane >> 4;
    const int b = NB == 16 ? r : (r & 7), h = NB == 16 ? 0 : (r >> 3);
    const bf16_t* grow = UT + ((size_t)b * 3072 + gch) * C::L;
#pragma unroll
    for (int i = I0; i < I1; ++i) {
        const int t = 256 * wid + 16 * i + 4 * gq + 2048 * h;
        gu[i] = *(const s16x4*)(grow + t);
        const unsigned lo = grow[t > 0 ? t - 1 : 0], hi = grow[(t + 4 < C::L) ? t + 4 : C::L - 1];
        gh[i] = lo | (hi << 16);
    }
}
template <int NB> __device__ __forceinline__ void conv_epi(const unsigned char* lds, const f32x4 (&acc)[16], u32x2 (&zp)[16], const s16x4 (&gu_)[16], const unsigned (&gh)[16],
                                                          float gw0, float gw1, float gw2, float gcb, float fb, float nrm) {
    using C = ConvCfg<NB>;
    const int tid_ = tidx(); const int lane = tid_ & 63, wid = __builtin_amdgcn_readfirstlane(tid_ >> 6), r = lane & 15, gq = lane >> 4;
    const int b = NB == 16 ? r : (r & 7), h = NB == 16 ? 0 : (r >> 3);
#pragma unroll
    for (int i = 0; i < 16; ++i) {
        const int t = 256 * wid + 16 * i + 4 * gq + 2048 * h;
        const s16x4 gu = gu_[i];
        const float gl = t > 0 ? bf2f((unsigned short)(gh[i] & 0xffffu)) : 0.f, gr = (t + 4 < C::L) ? bf2f((unsigned short)(gh[i] >> 16)) : 0.f;
        const float u0 = bf2f_s(gu[0]), u1 = bf2f_s(gu[1]), u2 = bf2f_s(gu[2]), u3 = bf2f_s(gu[3]);
        const float g0 = gw0 * gl + gw1 * u0 + gw2 * u1 + gcb, g1 = gw0 * u0 + gw1 * u1 + gw2 * u2 + gcb;
        const float g2 = gw0 * u1 + gw1 * u2 + gw2 * u3 + gcb, g3 = gw0 * u2 + gw1 * u3 + gw2 * gr + gcb;
        const s16x4 vz = *(const s16x4*)(lds + C::ZOFF + (b * C::ROWE + t) * 2);
        const float z0 = g0 * (acc[i][0] * nrm + bf2f_s(vz[0]) * fb), z1 = g1 * (acc[i][1] * nrm + bf2f_s(vz[1]) * fb);
        const float z2 = g2 * (acc[i][2] * nrm + bf2f_s(vz[2]) * fb), z3 = g3 * (acc[i][3] * nrm + bf2f_s(vz[3]) * fb);
        zp[i].x = cvt_pk_bf16(z0, z1); zp[i].y = cvt_pk_bf16(z2, z3);
    }
}
template <int NB> __device__ __forceinline__ void conv_store_z(unsigned char* lds, const u32x2 (&zp)[16]) {
    using C = ConvCfg<NB>;
    const int tid_ = tidx(); const int lane = tid_ & 63, wid = __builtin_amdgcn_readfirstlane(tid_ >> 6), r = lane & 15, gq = lane >> 4;
    const int b = NB == 16 ? r : (r & 7), h = NB == 16 ? 0 : (r >> 3);
#pragma unroll
    for (int i = 0; i < 16; ++i) { const int t = 256 * wid + 16 * i + 4 * gq + 2048 * h; *(u32x2*)(lds + C::ZOFF + (b * C::ROWE + t) * 2) = zp[i]; }
}

template <int NB> __device__ __forceinline__ void conv_phase(const PV& p, int hj, int slot, unsigned char* lds, bf16_t* zdst, int zstride) {
    using C = ConvCfg<NB>;
    constexpr int L = C::L;
    const int tid_wg = tidx(), wid = __builtin_amdgcn_readfirstlane(tid_wg >> 6), lane = tid_wg & 63;
    bf16_t* UT = (bf16_t*)(p.ws + WS_UT);
    const float* w3 = p.in(11) + (size_t)hj * 64 * 4096; const float* decay = p.in(12) + hj * 4096;
    const float* fbias = p.in(13) + hj * 2048; const float* cw = p.in(4) + hj * 3 * 3072; const float* cb = p.in(5) + hj * 3072;
    float* w3s = (float*)(lds + C::W3OFF); float* red = (float*)(lds + C::REDOFF);
    for (int c = blockIdx.x; c < 1024; c += gridDim.x) {
        __syncthreads();
        const int tid = opaque(tid_wg);
        constexpr int NF = (2 * (2 * L / 8)) / 512;
        u32x4 fr[NF]; bf16x8 vx[8]; float hl[8], hr[8];
        { const bf16_t* FILT = (const bf16_t*)(p.ws + WS_FILT);
#pragma unroll
            for (int i = 0; i < NF; ++i) { const int q = tid + 512 * i, o = q / (2 * L / 8), i8 = (q - o * (2 * L / 8)) * 8;
                fr[i] = *(const u32x4*)(FILT + ((size_t)(o * 1024 + c)) * (2 * L) + i8); } }
#pragma unroll
        for (int i = 0; i < 8; ++i) { const int chunk = tid + 512 * i, b = chunk / (L / 8), s8 = (chunk % (L / 8)) * 8;
            const bf16_t* src = UT + ((size_t)b * 3072 + c) * L + s8;
            vx[i] = *(const bf16x8*)src; const float a_ = bf2f(src[s8 > 0 ? -1 : 0]), b_ = bf2f(src[(s8 + 8 < L) ? 8 : 7]);
            hl[i] = s8 > 0 ? a_ : 0.f; hr[i] = (s8 + 8 < L) ? b_ : 0.f; }
        { constexpr int NP = (L / 256) * 8; const float* PART = (const float*)(p.ws + WS_SUMSQ);
            const int o = tid >> 8, idx = tid & 255, dir = idx / NP, k = idx - dir * NP;
            float v = (idx < 2 * NP) ? PART[(size_t)((o * 2 + dir) * 1024 + c) * NP + k] : 0.f;
            v = wave_sum(v); if (lane == 0) red[wid] = v; }
#pragma unroll
        for (int i = 0; i < NF; ++i) { const int q = tid + 512 * i, o = q / (2 * L / 8), i8 = (q - o * (2 * L / 8)) * 8;
            *(u32x4*)(lds + C::FOFF + (o * 2) * C::FCOPY + i8 * 2) = fr[i]; }
        { const float w0 = cw[c], w1 = cw[3072 + c], w2 = cw[2 * 3072 + c], cbv = cb[c];
#pragma unroll
            for (int i = 0; i < 8; ++i) { const int chunk = tid + 512 * i, b = chunk / (L / 8), s8 = (chunk % (L / 8)) * 8;
                float xe[10]; xe[0] = hl[i]; xe[9] = hr[i];
#pragma unroll
                for (int e = 0; e < 8; ++e) xe[e + 1] = bf2f_s(vx[i][e]);
                float y[8];
#pragma unroll
                for (int e = 0; e < 8; ++e) y[e] = w0 * xe[e] + w1 * xe[e + 1] + w2 * xe[e + 2] + cbv;
                u32x4 w; w.x = cvt_pk_bf16(y[0], y[1]); w.y = cvt_pk_bf16(y[2], y[3]); w.z = cvt_pk_bf16(y[4], y[5]); w.w = cvt_pk_bf16(y[6], y[7]);
                *(u32x4*)(lds + C::ZOFF + (b * C::ROWE + s8) * 2) = w;
                __builtin_amdgcn_sched_barrier(0); } }
        __syncthreads();
        const float nrm0 = rsqrtf(red[0] + red[1] + red[2] + red[3] + 1e-6f), nrm1 = rsqrtf(red[4] + red[5] + red[6] + red[7] + 1e-6f);
#pragma unroll
        for (int i = 0; i < NF; ++i) { const int q = tid + 512 * i, o = q / (2 * L / 8), m4 = (q - o * (2 * L / 8)) * 4;
            const unsigned* s0 = (const unsigned*)(lds + C::FOFF + (o * 2) * C::FCOPY) + m4; unsigned* d1 = (unsigned*)(lds + C::FOFF + (o * 2 + 1) * C::FCOPY) + m4;
            const u32x4 a = *(const u32x4*)s0; const unsigned nx = (m4 + 4 < L) ? s0[4] : 0u;
            u32x4 r; r.x = __builtin_amdgcn_alignbit(a.y, a.x, 16); r.y = __builtin_amdgcn_alignbit(a.z, a.y, 16); r.z = __builtin_amdgcn_alignbit(a.w, a.z, 16); r.w = __builtin_amdgcn_alignbit(nx, a.w, 16);
            *(u32x4*)d1 = r; }
        __syncthreads();
        f32x4 acc[16]; u32x2 zp[16]; s16x4 gu[16]; unsigned gh[16];
        conv_gload<NB, 0, 8>(UT, 1024 + c, gu, gh);
        conv_main<NB>(lds, 0, acc);
        conv_gload<NB, 8, 16>(UT, 1024 + c, gu, gh);
        conv_epi<NB>(lds, acc, zp, gu, gh, cw[1024 + c], cw[3072 + 1024 + c], cw[2 * 3072 + 1024 + c], cb[1024 + c], fbias[c], nrm0);
        __syncthreads();
        conv_store_z<NB>(lds, zp);
        __syncthreads();
        conv_gload<NB, 0, 8>(UT, 2048 + c, gu, gh);
        conv_main<NB>(lds, 1, acc);
        conv_gload<NB, 8, 16>(UT, 2048 + c, gu, gh);
        conv_epi<NB>(lds, acc, zp, gu, gh, cw[2048 + c], cw[3072 + 2048 + c], cw[2 * 3072 + 2048 + c], cb[2048 + c], fbias[1024 + c], nrm1);
        __syncthreads();
        conv_store_z<NB>(lds, zp);
        __syncthreads();
#pragma unroll
        for (int i = 0; i < 8; ++i) { const int chunk = tid + 512 * i, b = chunk / (L / 8), s8 = (chunk % (L / 8)) * 8;
            *(u32x4*)(zdst + ((size_t)b * zstride + c) * L + s8) = *(const u32x4*)(lds + C::ZOFF + (b * C::ROWE + s8) * 2); }
        __syncthreads();
    }
}

__device__ __forceinline__ void ygate_phase(const PV& p, int L, unsigned char* lds) {
    const bf16_t* UT = (const bf16_t*)(p.ws + WS_UT); const bf16_t* G = (const bf16_t*)(p.ws + WS_GATE); bf16_t* Y = (bf16_t*)(p.ws + WS_Y);
    const int tid = tidx(); constexpr int RS = 136;
    bf16_t* tile = (bf16_t*)lds;
    const int nit = (TG / 128) * 16;
    u32x4 zr[2]; bf16x8 gr[2];
    auto issue = [&](int it) {
        const int tc = it & 15, tt = it >> 4; const int tok0 = tt * 128, b = tok0 / L, t0 = tok0 - b * L, c0 = tc * 64;
#pragma unroll
        for (int i = 0; i < 2; ++i) { const int q = tid + i * 512;
            zr[i] = *(const u32x4*)(UT + ((size_t)b * 3072 + c0 + (q >> 4)) * L + t0 + (q & 15) * 8);
            gr[i] = *(const bf16x8*)(G + (size_t)(tok0 + (q >> 3)) * DM + c0 + (q & 7) * 8); } };
    int it = blockIdx.x;
    if (it < nit) issue(it);
    for (; it < nit; it += gridDim.x) {
        const int tc = it & 15, tt = it >> 4; const int tok0 = tt * 128, c0 = tc * 64;
#pragma unroll
        for (int i = 0; i < 2; ++i) { const int q = tid + i * 512; *(u32x4*)(tile + (q >> 4) * RS + (q & 15) * 8) = zr[i]; }
        const bf16x8 g0 = gr[0], g1 = gr[1];
        __syncthreads();
        if (it + (int)gridDim.x < nit) issue(it + gridDim.x);
#pragma unroll
        for (int i = 0; i < 2; ++i) { const int q = tid + i * 512, t = q >> 3, cch = (q & 7) * 8; const bf16x8 gv = i ? g1 : g0; float y[8];
#pragma unroll
            for (int e = 0; e < 8; ++e) y[e] = bf2f(tile[(cch + e) * RS + t]) * silu(bf2f_s(gv[e]));
            u32x4 w; w.x = cvt_pk_bf16(y[0], y[1]); w.y = cvt_pk_bf16(y[2], y[3]); w.z = cvt_pk_bf16(y[4], y[5]); w.w = cvt_pk_bf16(y[6], y[7]);
            *(u32x4*)(Y + (size_t)(tok0 + t) * DM + c0 + cch) = w; }
        __syncthreads();
    }
}

constexpr int LDU = 2560;
__device__ __forceinline__ void rope_phase(const PV& p, int aj, int L, bf16_t* D, int ldd) {
    bf16_t* U = (bf16_t*)(p.ws + WS_UT);
    const float* qn = p.in(18) + aj * 128; const float* kn = p.in(19) + aj * 128;
    const int tid = tidx(), sub = tid & 7;
    float inv[8], q1[8], q2[8], k1[8], k2[8];
#pragma unroll
    for (int e = 0; e < 8; ++e) { inv[e] = exp2f(-(float)((8 * sub + e) & 31) * (13.287712379549449f / 32.f));
        q1[e] = qn[8 * sub + e]; q2[e] = qn[64 + 8 * sub + e]; k1[e] = kn[8 * sub + e]; k2[e] = kn[64 + 8 * sub + e]; }
    for (int tok = blockIdx.x * 64 + (tid >> 3); tok < TG; tok += gridDim.x * 64) {
        const int t = tok & (L - 1); const float pos = (float)(sub < 4 ? (t >> 6) : (t & 63));
        float cs[8], sn[8];
#pragma unroll
        for (int e = 0; e < 8; ++e) { const float ang = pos * inv[e]; cs[e] = __cosf(ang); sn[e] = __sinf(ang); }
        bf16_t* u = U + (size_t)tok * LDU + 8 * sub;
#pragma unroll
        for (int hd = 8; hd < 10; ++hd) {
            const bf16x8 a = *(const bf16x8*)(u + hd * 128), bq = *(const bf16x8*)(u + hd * 128 + 64);
            float x1[8], x2[8]; float ss = 0.f;
#pragma unroll
            for (int e = 0; e < 8; ++e) { x1[e] = bf2f_s(a[e]); x2[e] = bf2f_s(bq[e]); ss += x1[e] * x1[e] + x2[e] * x2[e]; }
            ss += __shfl_xor(ss, 1, 64); ss += __shfl_xor(ss, 2, 64); ss += __shfl_xor(ss, 4, 64);
            const float rs = rsqrtf(ss * (1.f / 128.f) + 1e-6f);
            float o1[8], o2[8];
#pragma unroll
            for (int e = 0; e < 8; ++e) { const float xa = x1[e] * rs * (hd < 8 ? q1[e] : k1[e]), xb2 = x2[e] * rs * (hd < 8 ? q2[e] : k2[e]);
                o1[e] = xa * cs[e] - xb2 * sn[e]; o2[e] = xb2 * cs[e] + xa * sn[e]; }
            u32x4 w1, w2; w1.x = cvt_pk_bf16(o1[0], o1[1]); w1.y = cvt_pk_bf16(o1[2], o1[3]); w1.z = cvt_pk_bf16(o1[4], o1[5]); w1.w = cvt_pk_bf16(o1[6], o1[7]);
            w2.x = cvt_pk_bf16(o2[0], o2[1]); w2.y = cvt_pk_bf16(o2[2], o2[3]); w2.z = cvt_pk_bf16(o2[4], o2[5]); w2.w = cvt_pk_bf16(o2[6], o2[7]);
            bf16_t* d = D + (size_t)tok * ldd + 8 * sub; *(u32x4*)(d + hd * 128) = w1; *(u32x4*)(d + hd * 128 + 64) = w2;
        }
    }
}

namespace att {
constexpr int D = 128, NW = 8, QBLK = 32, KVBLK = 64;
constexpr float SCALE = 0.088388347648318440f;
constexpr float THR = 8.f;
constexpr int LDQ = LDU, LDK = LDU;
constexpr size_t SHM_V = KVBLK * D * 2, SHM_K = KVBLK * D * 2, SHM_ATTN = 2 * SHM_V + 2 * SHM_K + NW * 64 * 4;
#define KSWZ(row, colB) ((row) * 256 + ((colB) ^ (((row) & 7) << 4)))
#define SBAR() __builtin_amdgcn_sched_barrier(0)
__device__ __forceinline__ int crow(int r, int hi) { return (r & 3) + 8 * (r >> 2) + 4 * hi; }
__device__ __forceinline__ unsigned cvtpk(float lo, float hi) { unsigned r; asm volatile("v_cvt_pk_bf16_f32 %0, %1, %2" : "=v"(r) : "v"(lo), "v"(hi)); return r; }
__device__ __forceinline__ bf16x8 ld8(const bf16_t* p) { return *reinterpret_cast<const bf16x8*>(p); }
__device__ __forceinline__ void partialSM(f32x16& p0, f32x16& p1, float& m_reg, float& mn, float& alpha) {
  constexpr float C = SCALE * 1.4426950408889634f;
  float pmax = p0[0]; for (int r = 1; r < 16; ++r) pmax = fmaxf(pmax, p0[r]); for (int r = 0; r < 16; ++r) pmax = fmaxf(pmax, p1[r]);
  { auto rr = __builtin_amdgcn_permlane32_swap(__float_as_uint(pmax), __float_as_uint(pmax), false, false);
    pmax = fmaxf(__uint_as_float(rr[0]), __uint_as_float(rr[1])); }
  if (__builtin_expect(__all(pmax - m_reg <= THR / SCALE), 1)) { mn = m_reg; alpha = 1.f; }
  else { mn = fmaxf(m_reg, pmax); alpha = __builtin_amdgcn_exp2f((m_reg - mn) * C); m_reg = mn; }
  float mnC = -mn * C;
  for (int r = 0; r < 16; ++r) p0[r] = fmaf(p0[r], C, mnC); for (int r = 0; r < 16; ++r) p1[r] = fmaf(p1[r], C, mnC);
  for (int r = 0; r < 16; ++r) p0[r] = __builtin_amdgcn_exp2f(p0[r]);
}
__device__ __forceinline__ void finishSM(f32x16& p0, f32x16& p1, float alpha, float& l_reg, bf16x8& pa0, bf16x8& pa1, bf16x8& pa2, bf16x8& pa3) {
  for (int r = 0; r < 16; ++r) p1[r] = __builtin_amdgcn_exp2f(p1[r]);
  float ps = 0; for (int r = 0; r < 16; ++r) ps += p0[r]; for (int r = 0; r < 16; ++r) ps += p1[r];
  { auto rr = __builtin_amdgcn_permlane32_swap(__float_as_uint(ps), __float_as_uint(ps), false, false);
    ps = __uint_as_float(rr[0]) + __uint_as_float(rr[1]); }
  l_reg = l_reg * alpha + ps;
#define PK4(P, BASE, OUT) do { unsigned a0 = cvtpk(P[BASE + 0], P[BASE + 1]), a1 = cvtpk(P[BASE + 2], P[BASE + 3]);   \
    unsigned b0 = cvtpk(P[BASE + 4], P[BASE + 5]), b1 = cvtpk(P[BASE + 6], P[BASE + 7]);                              \
    auto r0 = __builtin_amdgcn_permlane32_swap(a0, b0, false, false); auto r1 = __builtin_amdgcn_permlane32_swap(a1, b1, false, false); \
    u32x4 w = {r0[0], r1[0], r0[1], r1[1]}; OUT = *reinterpret_cast<bf16x8*>(&w); } while (0)
  PK4(p0, 0, pa0); PK4(p0, 8, pa1); PK4(p1, 0, pa2); PK4(p1, 8, pa3);
#undef PK4
}
__device__ __forceinline__ void qkt(f32x16& p0, f32x16& p1, const bf16_t* Ks, const bf16x8* qr, int r32, int hi) {
  p0 = f32x16{}; p1 = f32x16{};
  for (int d0 = 0; d0 < 8; ++d0) { int cb = (d0 * 16 + hi * 8) * 2;
    bf16x8 b0 = *reinterpret_cast<const bf16x8*>((const char*)Ks + KSWZ(r32, cb));
    bf16x8 b1 = *reinterpret_cast<const bf16x8*>((const char*)Ks + KSWZ(32 + r32, cb));
    p0 = __builtin_amdgcn_mfma_f32_32x32x16_bf16(b0, qr[d0], p0, 0, 0, 0);
    p1 = __builtin_amdgcn_mfma_f32_32x32x16_bf16(b1, qr[d0], p1, 0, 0, 0); }
}
__device__ __forceinline__ int v_st(int k, int c) { const int kk = (k & ~0xC) | ((k & 4) << 1) | ((k & 8) >> 1); return ((kk >> 3) * 4 + (c >> 5)) * 512 + ((kk & 7) * 32 + (c & 31)) * 2; }
__device__ __forceinline__ int v_rd_base(int lane) { return ((lane & 3) << 3) | (((lane >> 2) & 3) << 6) | (((lane >> 4) & 1) << 5) | (((lane >> 5) & 1) << 8); }
constexpr int v_rd_off(int d0, int ks, int half) { return d0 * 512 + ks * 4096 + half * 2048; }
template <int OFF> __device__ __forceinline__ s16x4 tr_read(int vb) {
  s16x4 r; asm volatile("ds_read_b64_tr_b16 %0, %1 offset:%2" : "=&v"(r) : "v"(vb), "i"(OFF) : "memory"); return r;
}
template <int D0> __device__ __forceinline__ void pv_one(f32x16& od, int vb, bf16x8 pa0, bf16x8 pa1, bf16x8 pa2, bf16x8 pa3) {
  const s16x4 l0 = tr_read<v_rd_off(D0, 0, 0)>(vb), h0 = tr_read<v_rd_off(D0, 0, 1)>(vb), l1 = tr_read<v_rd_off(D0, 1, 0)>(vb), h1 = tr_read<v_rd_off(D0, 1, 1)>(vb);
  const s16x4 l2 = tr_read<v_rd_off(D0, 2, 0)>(vb), h2 = tr_read<v_rd_off(D0, 2, 1)>(vb), l3 = tr_read<v_rd_off(D0, 3, 0)>(vb), h3 = tr_read<v_rd_off(D0, 3, 1)>(vb);
  asm volatile("s_waitcnt lgkmcnt(0)" ::: "memory"); SBAR();
#define PK(L, H) (bf16x8){L[0], L[1], L[2], L[3], H[0], H[1], H[2], H[3]}
  od = __builtin_amdgcn_mfma_f32_32x32x16_bf16(pa0, PK(l0, h0), od, 0, 0, 0);
  od = __builtin_amdgcn_mfma_f32_32x32x16_bf16(pa1, PK(l1, h1), od, 0, 0, 0);
  od = __builtin_amdgcn_mfma_f32_32x32x16_bf16(pa2, PK(l2, h2), od, 0, 0, 0);
  od = __builtin_amdgcn_mfma_f32_32x32x16_bf16(pa3, PK(l3, h3), od, 0, 0, 0);
#undef PK
}
__device__ __forceinline__ void pv_d0(f32x16* o, int vb, bf16x8 pa0, bf16x8 pa1, bf16x8 pa2, bf16x8 pa3) {
  pv_one<0>(o[0], vb, pa0, pa1, pa2, pa3); pv_one<1>(o[1], vb, pa0, pa1, pa2, pa3); pv_one<2>(o[2], vb, pa0, pa1, pa2, pa3); pv_one<3>(o[3], vb, pa0, pa1, pa2, pa3);
}
__device__ __forceinline__ void attn_dense_body(const bf16_t* __restrict__ Qb, const bf16_t* __restrict__ Kh, const bf16_t* __restrict__ Vh,
                                                const bf16_t* __restrict__ Gb, bf16_t* __restrict__ Yb, int seq, char* lds, const float* __restrict__ qnw, int tpos0) {
  constexpr int SDEPTH = 1;
  const int tid = tidx(), wid = __builtin_amdgcn_readfirstlane(tid >> 6), lane = tid & 63, r32 = lane & 31, hi = lane >> 5;
  bf16_t* V_lds = (bf16_t*)lds; bf16_t* K_lds = (bf16_t*)(lds + 2 * SHM_V);
  float* ws = (float*)(lds + 2 * SHM_V + 2 * SHM_K) + wid * 64; float* li_l = ws; float* al_l = ws + 32;
  float m_reg = -1e30f, l_reg = 0; f32x16 o[4] = {}; bf16x8 qr[8];
  const bf16_t* Qw = Qb + (long)(wid * QBLK + r32) * LDQ + hi * 8;
#pragma unroll
  for (int d0 = 0; d0 < 8; ++d0) qr[d0] = ld8(Qw + d0 * 16);
  {
    float ss = 0.f;
#pragma unroll
    for (int d0 = 0; d0 < 8; ++d0)
#pragma unroll
      for (int e = 0; e < 8; ++e) { const float x = bf2f_s(qr[d0][e]); ss += x * x; }
    ss += __shfl_xor(ss, 32, 64);
    const float rs = rsqrtf(ss * (1.f / 128.f) + 1e-6f);
    const int tq = tpos0 + wid * QBLK + r32;
    const float prow = (float)(tq >> 6), pcol = (float)(tq & 63);
#pragma unroll
    for (int d0 = 0; d0 < 4; ++d0) {
      const int c0 = d0 * 16 + hi * 8;
      const f32x4 ga = *(const f32x4*)(qnw + c0), gb = *(const f32x4*)(qnw + c0 + 4), gc = *(const f32x4*)(qnw + 64 + c0), gd = *(const f32x4*)(qnw + 64 + c0 + 4);
      float o1[8], o2[8];
#pragma unroll
      for (int e = 0; e < 8; ++e) {
        const float inv = exp2f(-(float)((c0 + e) & 31) * (13.287712379549449f / 32.f));
        const float ang = (d0 < 2 ? prow : pcol) * inv; const float cs = __cosf(ang), sn = __sinf(ang);
        const float x1 = bf2f_s(qr[d0][e]) * rs * (e < 4 ? ga[e & 3] : gb[e & 3]), x2 = bf2f_s(qr[d0 + 4][e]) * rs * (e < 4 ? gc[e & 3] : gd[e & 3]);
        o1[e] = x1 * cs - x2 * sn; o2[e] = x2 * cs + x1 * sn; }
      u32x4 w1, w2; w1.x = cvtpk(o1[0], o1[1]); w1.y = cvtpk(o1[2], o1[3]); w1.z = cvtpk(o1[4], o1[5]); w1.w = cvtpk(o1[6], o1[7]);
      w2.x = cvtpk(o2[0], o2[1]); w2.y = cvtpk(o2[2], o2[3]); w2.z = cvtpk(o2[4], o2[5]); w2.w = cvtpk(o2[6], o2[7]);
      qr[d0] = *reinterpret_cast<bf16x8*>(&w1); qr[d0 + 4] = *reinterpret_cast<bf16x8*>(&w2); }
  }
  const int sr = tid >> 4, sc = (tid & 15) * 8, vst0 = v_st(sr, sc), vst1 = v_st(32 + sr, sc);
  const int vb0 = (int)(uintptr_t)V_lds + v_rd_base(lane);
  struct { bf16x8 vs0, vs1, ks0, ks1; } sr_[SDEPTH];
#define SLOAD(i, k0) do { sr_[i].vs0 = ld8(&Vh[(long)((k0) + sr) * LDK + sc]); sr_[i].vs1 = ld8(&Vh[(long)((k0) + 32 + sr) * LDK + sc]); \
    sr_[i].ks0 = ld8(&Kh[(long)((k0) + sr) * LDK + sc]); sr_[i].ks1 = ld8(&Kh[(long)((k0) + 32 + sr) * LDK + sc]); } while (0)
#define SWRITE(b, i) do { *(bf16x8*)((char*)V_lds + (b) * SHM_V + vst0) = sr_[i].vs0;          \
    *(bf16x8*)((char*)V_lds + (b) * SHM_V + vst1) = sr_[i].vs1; int kc = sc * 2;               \
    *(bf16x8*)((char*)K_lds + (b) * SHM_K + KSWZ(sr, kc)) = sr_[i].ks0;                       \
    *(bf16x8*)((char*)K_lds + (b) * SHM_K + KSWZ(32 + sr, kc)) = sr_[i].ks1; } while (0)
#define SWAIT() do { asm volatile("s_waitcnt vmcnt(0)" ::: "memory"); } while (0)
#define RESC(a) do { if (__any((a) < 1.f)) { if (hi == 0) al_l[r32] = (a); asm volatile("s_waitcnt lgkmcnt(0)" ::: "memory"); \
    for (int d = 0; d < 4; ++d) for (int r = 0; r < 16; ++r) o[d][r] *= al_l[crow(r, hi)]; } } while (0)
  f32x16 pA0, pA1, pB0, pB1; float mnA, mnB, alA, alB; bf16x8 pa0, pa1, pa2, pa3; const int NT = seq / KVBLK;
  constexpr int SE = 0, SO = SDEPTH - 1;
  SLOAD(SE, 0); asm volatile("s_waitcnt vmcnt(0)" ::: "memory"); SWRITE(0, SE); __syncthreads();
  qkt(pA0, pA1, K_lds, qr, r32, hi); partialSM(pA0, pA1, m_reg, mnA, alA);
  SLOAD(SO, KVBLK);
  SWAIT(); SWRITE(1, SO); __syncthreads();
  for (int j = 1; j + 1 < NT; j += 2) {
    SBAR(); qkt(pB0, pB1, (bf16_t*)((char*)K_lds + SHM_K), qr, r32, hi);
    finishSM(pA0, pA1, alA, l_reg, pa0, pa1, pa2, pa3); SBAR();
    SLOAD(SO, (j + SDEPTH) * KVBLK); SBAR();
    pv_d0(o, vb0, pa0, pa1, pa2, pa3); partialSM(pB0, pB1, m_reg, mnB, alB);
    __syncthreads(); SWAIT(); SWRITE(0, SE);
    RESC(alB); __syncthreads();
    SBAR(); qkt(pA0, pA1, K_lds, qr, r32, hi);
    finishSM(pB0, pB1, alB, l_reg, pa0, pa1, pa2, pa3); SBAR();
    SLOAD(SE, (j + 1 + SDEPTH) * KVBLK); SBAR();
    pv_d0(o, vb0 + (int)SHM_V, pa0, pa1, pa2, pa3); partialSM(pA0, pA1, m_reg, mnA, alA);
    __syncthreads(); SWAIT(); SWRITE(1, SO);
    RESC(alA); __syncthreads();
  }
  SBAR(); qkt(pB0, pB1, (bf16_t*)((char*)K_lds + SHM_K), qr, r32, hi);
  finishSM(pA0, pA1, alA, l_reg, pa0, pa1, pa2, pa3); SBAR();
  pv_d0(o, vb0, pa0, pa1, pa2, pa3); partialSM(pB0, pB1, m_reg, mnB, alB);
  __syncthreads(); RESC(alB);
  finishSM(pB0, pB1, alB, l_reg, pa0, pa1, pa2, pa3); SBAR();
  pv_d0(o, vb0 + (int)SHM_V, pa0, pa1, pa2, pa3);
  if (hi == 0) li_l[r32] = l_reg; asm volatile("s_waitcnt lgkmcnt(0)" ::: "memory");
  { const int ln = opaque(lane), r32e = ln & 31, hie = ln >> 5;
    const bf16_t* Gl = Gb + (long)(wid * QBLK + 4 * hie) * LDU + r32e; bf16_t* Yl = Yb + (long)(wid * QBLK + 4 * hie) * DM + r32e;
#pragma unroll
  for (int r = 0; r < 16; ++r) { const int ro = (r & 3) + 8 * (r >> 2); const float rl = __builtin_amdgcn_rcpf(li_l[ro + 4 * hie]);
    asm volatile("" ::: "memory");
#pragma unroll
    for (int d0 = 0; d0 < 4; ++d0) { const float gv = bf2f(Gl[ro * LDU + d0 * 32]);
      Yl[ro * DM + d0 * 32] = f2bf(o[d0][r] * rl * silu(gv)); } } }
  __syncthreads();
#undef SLOAD
#undef SWRITE
#undef SWAIT
#undef RESC
}
}

__device__ __forceinline__ void attn_phase(const PV& p, int aj, int L, unsigned char* lds) {
    const float* qnw = p.in(18) + aj * 128;
    const bf16_t* U = (const bf16_t*)(p.ws + WS_UT); bf16_t* Y = (bf16_t*)(p.ws + WS_Y);
    const int nqb = L / 256, NB = TG / L;
    const int nitem = NB * 8 * nqb;
    const int ipp = 4 * nqb;
    for (int k = 0; k * (int)gridDim.x < nitem; ++k) {
        int it;
        if (gridDim.x == 256) { const int xcd = blockIdx.x & 7, slot = blockIdx.x >> 3; const int sub = ipp / 32;
            const int pair = (k / sub) * 8 + xcd; it = pair * ipp + (k % sub) * 32 + slot; }
        else { it = blockIdx.x + k * gridDim.x; if (it >= nitem) break; }
        const int qb = it % nqb; const int hq = (it / nqb) & 7; const int b = it / (nqb * 8); const int kvh = hq >> 2;
        const size_t row0 = (size_t)b * L + (size_t)qb * 256;
        att::attn_dense_body(U + row0 * LDU + hq * 128, U + (size_t)b * L * LDU + 1024 + kvh * 128, U + (size_t)b * L * LDU + 1280 + kvh * 128,
                             U + row0 * LDU + 1536 + hq * 128, Y + row0 * DM + hq * 128, L, (char*)lds, qnw, qb * 256);
    }
}

__device__ __forceinline__ void run_phase(const Params& pin, int ph, unsigned char* lds) {
    const PV p(pin, opaque_zero());
    if (ph == 0) { if (PHMASK & 1) prologue_phase(p, lds); if (PHMASK & 2) cvt_phase(p, 0); return; }
    const int q = ph - 1, g = q / 20, r = q % 20 + 1;
    const int L = g == 0 ? 2048 : 4096;
    const int layer = (r - 1) / 5, sub = (r - 1) % 5, j = layer >> 1;
    bf16_t* XB = (bf16_t*)(p.ws + WS_XB); bf16_t* UT = (bf16_t*)(p.ws + WS_UT); bf16_t* Y = (bf16_t*)(p.ws + WS_Y);
    if (sub == 4) {
#if PROBE_WHAT == 2
        if (layer != 3) ln_phase(p, g, layer, (bf16_t*)(p.ws + WS_GATE));
#endif
        if (PHMASK & 4) ln_phase(p, g, layer, XB);
        if (g == 0 && layer == 3 && (PHMASK & 2)) cvt_phase(p, 1);
        return; }
    if (sub == 3) {
        const bf16_t* WT = (const bf16_t*)(p.ws + ((layer & 1) ? WS_AWOUT : WS_HWOUT)) + (size_t)j * 1024 * 1024;
        EpiRes E; E.out = p.out + (size_t)g * TG * DM; E.xb = XB; E.last = layer == 3; E.bias = ((layer & 1) ? p.in(21) : p.in(15)) + j * 1024;
        E.dst = XB;
#if PROBE_WHAT == 1
        if (layer != 3) { EpiRes E0 = E; E0.dst = (bf16_t*)(p.ws + WS_GATE); run_gemm(lds, Y, WT, TG, 1024, E0); }
#endif
        if (PHMASK & 8) run_gemm(lds, Y, WT, TG, 1024, E); return;
    }
    if ((layer & 1) == 0) {
        if (sub == 0) {
            const bf16_t* WT = (const bf16_t*)(p.ws + WS_HWIN) + (size_t)j * 4096 * 1024;
            EpiUT E1; E1.O = UT; E1.bias = p.in(3) + j * 4096; E1.L = L;
            if (PHMASK & 16) run_gemm(lds, WT, XB, 3072, TG, E1);
            EpiBf16B E2; E2.O = (bf16_t*)(p.ws + WS_GATE); E2.ldc = 1024; E2.bias = p.in(3) + j * 4096 + 3072;
            if (PHMASK & 32) run_gemm(lds, XB, WT + (size_t)3072 * 1024, TG, 1024, E2);
            if (PHMASK & 2048) { if (g == 0) filter_phase<2048>(p, j, g * 2 + j, lds); else filter_phase<4096>(p, j, g * 2 + j, lds); }
        } else if (sub == 1) {
#if PROBE_WHAT == 4
            if (g == 0) conv_phase<16>(p, j, g * 2 + j, lds, Y, 1024); else conv_phase<8>(p, j, g * 2 + j, lds, Y, 1024);
#endif
            if (g == 0) { if (PHMASK & 64) conv_phase<16>(p, j, g * 2 + j, lds, UT, 3072); } else { if (PHMASK & 128) conv_phase<8>(p, j, g * 2 + j, lds, UT, 3072); } }
        else if (sub == 2) { if (PHMASK & 256) ygate_phase(p, L, lds); }
    } else {
        if (sub == 0) {
            const bf16_t* WT = (const bf16_t*)(p.ws + WS_AWIN) + (size_t)j * 2560 * 1024;
            EpiBf16B E; E.O = UT; E.ldc = LDU; E.bias = p.in(17) + j * 2560;
            if (PHMASK & 32) run_gemm(lds, XB, WT, TG, 2560, E);
        } else if (sub == 1) {
#if PROBE_WHAT == 3
            rope_phase(p, j, L, (bf16_t*)(p.ws + WS_GATE), 1280);
#endif
            if (PHMASK & 512) rope_phase(p, j, L, UT, LDU); }
        else if (sub == 2) { if (PHMASK & 1024) attn_phase(p, j, L, lds); }
    }
}

#ifndef DUPMASK
#define DUPMASK 0
#endif
__device__ __forceinline__ bool dup_phase(int ph) {
    if (ph == 0) return (DUPMASK >> 5) & 1;
    const int r = (ph - 1) % 21; if (r == 0) return (DUPMASK >> 5) & 1;
    const int layer = (r - 1) / 5, sub = (r - 1) % 5;
    if (sub > 2) return false;
    if ((layer & 1) == 0) return (DUPMASK >> sub) & 1;
    if (sub == 0) return (DUPMASK >> 3) & 1;
    if (sub == 2) return (DUPMASK >> 4) & 1;
    return false;
}
#define XB_XCNT(j)  (256  + 64 * (j))
#define XB_XSUB(j)  (1280 + 64 * (j))
#define XB_XGEN(j)  (2304 + 64 * (j))
#define XB_TOP      3328
#define XB_TOPGEN   3392
#define XCD_BAR_WORDS 3456
__device__ __forceinline__ unsigned xb_ld(unsigned* p)              { return __hip_atomic_load(p, __ATOMIC_RELAXED, __HIP_MEMORY_SCOPE_AGENT); }
__device__ __forceinline__ unsigned xb_add(unsigned* p, unsigned v) { return __hip_atomic_fetch_add(p, v, __ATOMIC_RELAXED, __HIP_MEMORY_SCOPE_AGENT); }
__device__ __forceinline__ unsigned xb_xcc_id() { return (unsigned)__builtin_amdgcn_s_getreg((3 << 11) | 20) & 0xFu; }
__device__ __forceinline__ void xcd_barrier(unsigned* bar, unsigned x, unsigned& nloc, unsigned& nx) {
    asm volatile("s_waitcnt vmcnt(0)" ::: "memory");
    __syncthreads();
    if (tidx() == 0) {
        __builtin_amdgcn_s_waitcnt(0);
        if (nloc == 0u) {
            const unsigned G = gridDim.x; unsigned sum, cnt, mine;
            for (;;) { sum = 0u; cnt = 0u; mine = 0u;
#pragma unroll
                for (unsigned j = 0; j < 16; ++j) { const unsigned c = xb_ld(&bar[XB_XCNT(j)]); sum += c; cnt += (c > 0u) ? 1u : 0u; mine = (j == x) ? c : mine; }
                if (sum == G) break;
                __builtin_amdgcn_s_sleep(1); }
            nloc = mine > 0u ? mine : 1u; nx = cnt > 0u ? cnt : 1u; }
        const unsigned old = xb_add(&bar[XB_XSUB(x)], 1u);
        const unsigned gen = old / nloc;
        if (old + 1u == (gen + 1u) * nloc) {
            __builtin_amdgcn_fence(__ATOMIC_RELEASE, "agent");
            asm volatile("s_waitcnt vmcnt(0)" ::: "memory");
            const unsigned og = xb_add(&bar[XB_TOP], 1u);
            const unsigned tg = og / nx;
            if (og + 1u == (tg + 1u) * nx) xb_add(&bar[XB_TOPGEN], 1u);
            else while (xb_ld(&bar[XB_TOPGEN]) == tg) __builtin_amdgcn_s_sleep(1);
            __builtin_amdgcn_fence(__ATOMIC_ACQUIRE, "agent");
            xb_add(&bar[XB_XGEN(x)], 1u);
            asm volatile("s_waitcnt vmcnt(0)" ::: "memory");
        } else {
            while (xb_ld(&bar[XB_XGEN(x)]) == gen) __builtin_amdgcn_s_sleep(1);
            __builtin_amdgcn_fence(__ATOMIC_ACQUIRE, "agent");
            asm volatile("s_waitcnt vmcnt(0)" ::: "memory");
        }
    }
    __syncthreads();
}

__global__ __launch_bounds__(512, 2) void mk_forward(Params p) {
    extern __shared__ __attribute__((aligned(16))) unsigned char smem[];
    cg::grid_group grid = cg::this_grid();
    unsigned* bar = (unsigned*)(p.ws + WS_BAR);
    unsigned xcc = 0, nloc = 0, nx = 0;
    for (int ph = p.ph_lo; ph < p.ph_hi; ++ph) {
        if (ph == 0 && blockIdx.x == 0) for (int i = threadIdx.x; i < XCD_BAR_WORDS; i += 512) __hip_atomic_store(bar + i, 0u, __ATOMIC_RELAXED, __HIP_MEMORY_SCOPE_AGENT);
        run_phase(p, ph, smem);
        if (ph + 1 < p.ph_hi) {
            if (ph == p.ph_lo) { grid.sync();
                xcc = xb_xcc_id(); if (threadIdx.x == 0) (void)xb_add(&bar[XB_XCNT(xcc)], 1u); }
            else xcd_barrier(bar, xcc, nloc, nx);
        }
    }
}

extern "C" void kernel_launch(void* const* d_in, const int* in_sizes, int n_in, void* d_out, int out_size, void* d_ws, size_t ws_size, hipStream_t stream) {
    static int grid = 0;
    if (grid == 0) {
        if (n_in != 24 || ws_size < WS_END) { fprintf(stderr, "kernel_launch: unexpected n_in %d / ws %zu\n", n_in, ws_size); grid = -1; return; }
        int dev = 0, cus = 0, per_cu = 0;
        hipGetDevice(&dev); hipDeviceGetAttribute(&cus, hipDeviceAttributeMultiprocessorCount, dev);
        if (hipFuncSetAttribute((const void*)mk_forward, hipFuncAttributeMaxDynamicSharedMemorySize, LDS_BYTES) != hipSuccess) { fprintf(stderr, "kernel_launch: hipFuncSetAttribute failed\n"); grid = -1; return; }
        if (hipOccupancyMaxActiveBlocksPerMultiprocessor(&per_cu, (const void*)mk_forward, 512, LDS_BYTES) != hipSuccess || per_cu < 1) { fprintf(stderr, "kernel_launch: occupancy query gives %d\n", per_cu); per_cu = 1; }
        (void)hipGetLastError();
        grid = cus * per_cu;
    }
    if (grid < 0) return;
    Params p{};
    for (int i = 0; i < 24; ++i) p.in[i] = (const float*)d_in[i];
    p.out = (float*)d_out; p.ws = (unsigned char*)d_ws;
#if MK_LAUNCHES == 1
    p.ph_lo = 0; p.ph_hi = NPHASE;
    void* args[] = {&p};
    hipError_t e = hipLaunchCooperativeKernel((const void*)mk_forward, dim3(grid), dim3(512), args, LDS_BYTES, stream);
    if (e != hipSuccess) fprintf(stderr, "cooperative launch failed: %s (grid %d)\n", hipGetErrorString(e), grid);
#else
    for (int ph = 0; ph < NPHASE; ++ph) { p.ph_lo = ph; p.ph_hi = ph + 1;
        hipLaunchKernelGGL(mk_forward, dim3(grid), dim3(512), LDS_BYTES, stream, p); }
#endif
}
```

```cpp
#include <hip/hip_runtime.h>
#include <hip/hip_cooperative_groups.h>
#include <cstdio>
#include <cstdint>
namespace cg = cooperative_groups;

#ifndef MK_LAUNCHES
#define MK_LAUNCHES 1
#endif

__device__ __forceinline__ int tidx() { int t = threadIdx.x; asm volatile("" : "+v"(t)); return t; }

namespace pg8 {
#define PG8_LAS __attribute__((address_space(3)))
typedef unsigned short bf16_t;
typedef short bf16x8 __attribute__((ext_vector_type(8)));
typedef float f32x4 __attribute__((ext_vector_type(4)));
typedef unsigned u32x4 __attribute__((ext_vector_type(4)));
constexpr int BM = 256, BK = 64, HALF = 128, HTB = HALF * BK * 2  , STAGE_BYTES = 8 * HTB, NXCD = 8, WGM = 8;

__host__ __device__ __forceinline__ int lds_byte(int r, int c) { const int st = (r >> 4) * 2 + (c >> 5), rr = r & 15, cc = c & 31, ob = rr * 64 + cc * 2; return st * 1024 + (ob ^ (((ob >> 9) & 1) << 5)); }
__host__ __device__ __forceinline__ void stage_rc(int b, int& R, int& C) { const int st = b / 1024, sb = b % 1024, swz = sb ^ (((sb >> 9) & 1) << 5); R = (st >> 1) * 16 + swz / 64; C = (st & 1) * 32 + (swz % 64) / 2; }
__host__ __device__ __forceinline__ int perm32(int rho) { const int n = rho >> 4, i = rho & 15; return 8 * (i >> 2) + 4 * n + (i & 3); }

struct Unit { int pm, pn; };
struct Gemm { const bf16_t* A; const bf16_t* Bt; int M, N, K; };
struct StaticOrder {
    int nM, nN, nwg, G, c;
    __host__ __device__ void init(int M, int N, int G_, int c_) { nM = M / BM; nN = N / BM; nwg = nM * nN; G = G_; c = c_; }
    __host__ __device__ bool next(int i, Unit& u) const {
        const long L = (long)i * G + c; if (L >= nwg) return false;
        int wgid = (int)L; { const int q = nwg / NXCD, r = nwg % NXCD, xcd = wgid % NXCD, off = wgid / NXCD; wgid = (xcd < r ? xcd * (q + 1) : r * (q + 1) + (xcd - r) * q) + off; }
        const int nig = WGM * nN, gid = wgid / nig, fm = gid * WGM, gsz = (nM - fm) < WGM ? (nM - fm) : WGM;
        u.pm = fm + ((wgid % nig) % gsz); u.pn = (wgid % nig) / gsz; return true;
    }
    __device__ __forceinline__ void a_ready(const Unit&) const {}
    __device__ __forceinline__ void done(const Unit&) const {}
};
__device__ __forceinline__ unsigned cvt_pk_bf16(float lo, float hi) { unsigned r; asm volatile("v_cvt_pk_bf16_f32 %0, %1, %2" : "=v"(r) : "v"(lo), "v"(hi)); return r; }
template <class Epi, class Sched, bool STAMP = false>
__device__ __forceinline__ void gemm_phase(PG8_LAS unsigned char* lds, const Gemm g, const Sched& S, const Epi& E, unsigned long long* stamps) {
    const int tid = tidx(), wid = __builtin_amdgcn_readfirstlane(tid >> 6), lane = tid & 63, wr = wid >> 2, wc = wid & 3, fr = lane & 15, fq = lane >> 4;
    const int K = g.K, nt = K / BK;
    unsigned voffA[2], voffB[2];
#pragma unroll
    for (int i = 0; i < 2; ++i) { int R, C; stage_rc(tid * 16 + i * 8192, R, C); const int Rb = Epi::PERM ? ((R & ~31) + perm32(R & 31)) : R;
        voffA[i] = (unsigned)(R * K + C) * 2u; voffB[i] = (unsigned)(Rb * K + C) * 2u; }
    const size_t kstep = (size_t)(BK * 2);
    const size_t hstep = (size_t)HALF * K * 2;
    const size_t tstep = 2 * hstep;
    const unsigned ldsw = (unsigned)wid * 1024u;
    const int aoff = lds_byte(wr * 64 + fr, fq * 8), boff = lds_byte(wc * 32 + fr, fq * 8);
#define PG8_SA(b, h) (((b) * 2 + (h)) * HTB)
#define PG8_SB(b, h) ((4 + (b) * 2 + (h)) * HTB)
#define PG8_STAGE(bufoff, gbase, voff) do { _Pragma("unroll") for (int _i = 0; _i < 2; ++_i) \
        __builtin_amdgcn_global_load_lds((const unsigned*)((const char*)(gbase) + (voff)[_i]), (PG8_LAS unsigned*)(lds + (bufoff) + ldsw + _i * 8192), 16, 0, 0); } while (0)
#define PG8_LDA(dst, b, h) do { _Pragma("unroll") for (int m = 0; m < 4; ++m) _Pragma("unroll") for (int k = 0; k < 2; ++k) dst[m][k] = *(const PG8_LAS bf16x8*)(lds + PG8_SA(b, h) + aoff + m * 2048 + k * 1024); } while (0)
#define PG8_LDB(dst, b, h) do { _Pragma("unroll") for (int n = 0; n < 2; ++n) _Pragma("unroll") for (int k = 0; k < 2; ++k) dst[n][k] = *(const PG8_LAS bf16x8*)(lds + PG8_SB(b, h) + boff + n * 2048 + k * 1024); } while (0)
#define PG8_MMA(ai, bj, At, Bt) do { __builtin_amdgcn_s_setprio(1); _Pragma("unroll") for (int m = 0; m < 4; ++m) _Pragma("unroll") for (int n = 0; n < 2; ++n) _Pragma("unroll") for (int k = 0; k < 2; ++k) \
        acc[ai][bj][m][n] = __builtin_amdgcn_mfma_f32_16x16x32_bf16(Bt[n][k], At[m][k], acc[ai][bj][m][n], 0, 0, 0); __builtin_amdgcn_s_setprio(0); } while (0)
#define PG8_WAIT_V(n) asm volatile("s_waitcnt vmcnt(" #n ")" ::: "memory")
#define PG8_WAIT_L(n) asm volatile("s_waitcnt lgkmcnt(" #n ")" ::: "memory")
#define PG8_BAR __builtin_amdgcn_s_barrier()
#define PG8_SCHED __builtin_amdgcn_sched_barrier(0)
    Unit cur, nxt; int ui = 0;
    if (!S.next(0, cur)) return;
    f32x4 acc[2][2][4][2];
#pragma unroll
    for (int a = 0; a < 2; ++a)
#pragma unroll
        for (int b = 0; b < 2; ++b)
#pragma unroll
            for (int m = 0; m < 4; ++m)
#pragma unroll
                for (int n = 0; n < 2; ++n) acc[a][b][m][n] = (f32x4){0.f, 0.f, 0.f, 0.f};
    bf16x8 At[4][2], B0[2][2], B1[2][2];
    const char* cA = (const char*)g.A + (size_t)cur.pm * tstep; const char* cB = (const char*)g.Bt + (size_t)cur.pn * tstep;
    S.a_ready(cur);
    PG8_STAGE(PG8_SB(0, 0), cB, voffB); PG8_STAGE(PG8_SA(0, 0), cA, voffA); PG8_STAGE(PG8_SB(0, 1), cB + hstep, voffB); PG8_STAGE(PG8_SA(0, 1), cA + hstep, voffA);
    if (wr == 1) PG8_BAR;
    PG8_WAIT_V(4); PG8_BAR;
    PG8_STAGE(PG8_SB(1, 0), cB + kstep, voffB); PG8_STAGE(PG8_SA(1, 0), cA + kstep, voffA); PG8_STAGE(PG8_SB(1, 1), cB + hstep + kstep, voffB);
    PG8_WAIT_V(6); PG8_BAR;
    for (;;) {
        const bool has_next = S.next(ui + 1, nxt);
        const char* nA = has_next ? (const char*)g.A + (size_t)nxt.pm * tstep : cA; const char* nB = has_next ? (const char*)g.Bt + (size_t)nxt.pn * tstep : cB;
        for (int t = 0; t < nt; t += 2) {
            const bool last = (t == nt - 2);
            const char* a1 = cA + (size_t)(t + 1) * kstep;
            const char* a2 = last ? nA : cA + (size_t)(t + 2) * kstep; const char* b2 = last ? nB : cB + (size_t)(t + 2) * kstep;
            const char* a3 = a2 + kstep; const char* b3 = b2 + kstep;
            if (last && has_next) S.a_ready(nxt);
            PG8_LDB(B0, 0, 0); PG8_SCHED; PG8_LDA(At, 0, 0); PG8_STAGE(PG8_SA(1, 1), a1 + hstep, voffA);
            PG8_WAIT_L(8); PG8_BAR; PG8_WAIT_L(0); PG8_MMA(0, 0, At, B0); PG8_BAR; PG8_SCHED;
            PG8_LDB(B1, 0, 1); PG8_STAGE(PG8_SB(0, 0), b2, voffB);
            PG8_BAR; PG8_WAIT_L(0); PG8_MMA(0, 1, At, B1); PG8_BAR;
            PG8_LDA(At, 0, 1); PG8_STAGE(PG8_SA(0, 0), a2, voffA);
            PG8_BAR; PG8_WAIT_L(0); PG8_MMA(1, 0, At, B0); PG8_BAR; PG8_SCHED;
            PG8_STAGE(PG8_SB(0, 1), b2 + hstep, voffB);
            PG8_WAIT_V(6); PG8_BAR; PG8_MMA(1, 1, At, B1); PG8_BAR;
            PG8_LDB(B0, 1, 0); PG8_SCHED; PG8_LDA(At, 1, 0); PG8_STAGE(PG8_SA(0, 1), a2 + hstep, voffA);
            PG8_WAIT_L(8); PG8_BAR; PG8_WAIT_L(0); PG8_MMA(0, 0, At, B0); PG8_BAR; PG8_SCHED;
            PG8_LDB(B1, 1, 1); PG8_STAGE(PG8_SB(1, 0), b3, voffB);
            PG8_BAR; PG8_WAIT_L(0); PG8_MMA(0, 1, At, B1); PG8_BAR;
            PG8_LDA(At, 1, 1); PG8_STAGE(PG8_SA(1, 0), a3, voffA);
            PG8_BAR; PG8_WAIT_L(0); PG8_MMA(1, 0, At, B0); PG8_BAR; PG8_SCHED;
            PG8_STAGE(PG8_SB(1, 1), b3 + hstep, voffB);
            PG8_WAIT_V(6); PG8_BAR; PG8_MMA(1, 1, At, B1); PG8_BAR;
        }
        if constexpr (!Epi::AFTER_DRAIN) { E(acc, cur, wr, wc, fr, fq); S.done(cur); }
        if (!has_next) break;
#pragma unroll
        for (int a = 0; a < 2; ++a)
#pragma unroll
            for (int b = 0; b < 2; ++b)
#pragma unroll
                for (int m = 0; m < 4; ++m)
#pragma unroll
                    for (int n = 0; n < 2; ++n) acc[a][b][m][n] = (f32x4){0.f, 0.f, 0.f, 0.f};
        cur = nxt; cA = nA; cB = nB; ++ui;
    }
    PG8_WAIT_V(0);
    if (wr == 0) PG8_BAR;
    PG8_BAR;
    if constexpr (Epi::AFTER_DRAIN) { E.fused(acc, cur, wr, wc, fr, fq, lds, wid, lane); S.done(cur); }
#undef PG8_SA
#undef PG8_SB
#undef PG8_STAGE
#undef PG8_LDA
#undef PG8_LDB
#undef PG8_MMA
#undef PG8_WAIT_V
#undef PG8_WAIT_L
#undef PG8_BAR
#undef PG8_SCHED
}
}

using pg8::bf16_t; using pg8::bf16x8; using pg8::f32x4; using pg8::u32x4; using pg8::cvt_pk_bf16;
typedef short s16x4 __attribute__((ext_vector_type(4)));
typedef float f32x8 __attribute__((ext_vector_type(8)));
typedef float f32x16 __attribute__((ext_vector_type(16)));
typedef unsigned u32x2 __attribute__((ext_vector_type(2)));

constexpr int DM = 1024, TG = 32768;
constexpr size_t MiB = 1u << 20;
constexpr size_t WS_HWIN = 0, WS_HWOUT = 16 * MiB, WS_AWIN = 20 * MiB, WS_AWOUT = 30 * MiB, WS_H2 = 34 * MiB, WS_XB = 38 * MiB,
                 WS_UT = 102 * MiB, WS_GATE = 294 * MiB, WS_Y = 358 * MiB, WS_FILT = 422 * MiB, WS_SUMSQ = 454 * MiB, WS_BAR = 456 * MiB, WS_END = 457 * MiB;
constexpr int LDS_BYTES = 136 * 1024;
constexpr float ALPHA = 1.681792830507429f;
constexpr int NPHASE = 1 + 2 * 20;
#ifndef PHMASK
#define PHMASK 0xFFFF
#endif
#ifndef PROBE_WHAT
#define PROBE_WHAT 0
#endif

struct Params { const float* in[24]; float* out; unsigned char* ws; int ph_lo, ph_hi; };
struct PV { const Params& q; int z; float* out; unsigned char* ws;
    __device__ __forceinline__ PV(const Params& q_, int z_) : q(q_), z(z_), out(q_.out + z_), ws(q_.ws + z_) {}
    __device__ __forceinline__ const float* in(int k) const { return q.in[k + z]; } };

__device__ __forceinline__ float bf2f(unsigned short x) { return __uint_as_float(((unsigned)x) << 16); }
__device__ __forceinline__ float bf2f_s(short x) { return __uint_as_float(((unsigned)(unsigned short)x) << 16); }
__device__ __forceinline__ unsigned short f2bf(float x) { return (unsigned short)(cvt_pk_bf16(x, 0.f) & 0xffffu); }
__device__ __forceinline__ float wave_sum(float v) {
#pragma unroll
    for (int o = 32; o >= 1; o >>= 1) v += __shfl_xor(v, o, 64);
    return v;
}
template <class T> __device__ __forceinline__ T* launder(T* q) {
    unsigned long long w = (unsigned long long)q; unsigned lo = (unsigned)w, hi = (unsigned)(w >> 32);
    asm volatile("" : "+v"(lo), "+v"(hi));
    lo = __builtin_amdgcn_readfirstlane(lo); hi = __builtin_amdgcn_readfirstlane(hi);
    return (T*)(((unsigned long long)hi << 32) | lo);
}
__device__ __forceinline__ int opaque_zero() { int z = 0; asm volatile("" : "+v"(z)); return __builtin_amdgcn_readfirstlane(z); }
__device__ __forceinline__ int opaque(int x) { asm volatile("" : "+v"(x)); return x; }
__device__ __forceinline__ float silu(float x) { return x / (1.f + __expf(-x)); }

struct EpiBf16B {
    static constexpr bool PERM = true, AFTER_DRAIN = false;
    bf16_t* O; int ldc; const float* bias;
    __device__ __forceinline__ void operator()(const f32x4 (&acc)[2][2][4][2], const pg8::Unit& u, int wr, int wc, int fr, int fq) const {
        const int row0 = u.pm * 256 + wr * 64 + fr, col0 = u.pn * 256 + wc * 32 + 8 * fq;
        f32x4 bv[2][2];
#pragma unroll
        for (int bj = 0; bj < 2; ++bj)
#pragma unroll
            for (int n = 0; n < 2; ++n) bv[bj][n] = *(const f32x4*)(bias + col0 + bj * 128 + 4 * n);
#pragma unroll
        for (int ai = 0; ai < 2; ++ai)
#pragma unroll
            for (int m = 0; m < 4; ++m) { bf16_t* rowp = O + (size_t)(row0 + ai * 128 + m * 16) * ldc + col0;
#pragma unroll
                for (int bj = 0; bj < 2; ++bj) { f32x4 v0 = acc[ai][bj][m][0] + bv[bj][0], v1 = acc[ai][bj][m][1] + bv[bj][1];
                    u32x4 w; w.x = cvt_pk_bf16(v0[0], v0[1]); w.y = cvt_pk_bf16(v0[2], v0[3]); w.z = cvt_pk_bf16(v1[0], v1[1]); w.w = cvt_pk_bf16(v1[2], v1[3]);
                    *(u32x4*)(rowp + bj * 128) = w; } }
    }
};
struct EpiUT {
    static constexpr bool PERM = true, AFTER_DRAIN = false;
    bf16_t* O; const float* bias; int L;
    __device__ __forceinline__ void operator()(const f32x4 (&acc)[2][2][4][2], const pg8::Unit& u, int wr, int wc, int fr, int fq) const {
        const int row0 = u.pm * 256 + wr * 64 + fr; const int tokt = u.pn * 256; const int b = tokt / L; const int t0 = tokt - b * L + wc * 32 + 8 * fq;
#pragma unroll
        for (int ai = 0; ai < 2; ++ai)
#pragma unroll
            for (int m = 0; m < 4; ++m) { const int ch = row0 + ai * 128 + m * 16; const float bs = bias[ch];
                bf16_t* rowp = O + ((size_t)b * 3072 + ch) * L + t0;
#pragma unroll
                for (int bj = 0; bj < 2; ++bj) { f32x4 v0 = acc[ai][bj][m][0] + bs, v1 = acc[ai][bj][m][1] + bs;
                    u32x4 w; w.x = cvt_pk_bf16(v0[0], v0[1]); w.y = cvt_pk_bf16(v0[2], v0[3]); w.z = cvt_pk_bf16(v1[0], v1[1]); w.w = cvt_pk_bf16(v1[2], v1[3]);
                    *(u32x4*)(rowp + bj * 128) = w; } }
    }
};
struct EpiRes {
    static constexpr bool PERM = true, AFTER_DRAIN = false;
    float* out; bf16_t* xb; const float* bias; int last; bf16_t* dst;
    __device__ __forceinline__ void operator()(const f32x4 (&acc)[2][2][4][2], const pg8::Unit& u, int wr, int wc, int fr, int fq) const {
        const int row0 = u.pm * 256 + wr * 64 + fr, col0 = u.pn * 256 + wc * 32 + 8 * fq;
        f32x4 bv[2][2];
#pragma unroll
        for (int bj = 0; bj < 2; ++bj)
#pragma unroll
            for (int n = 0; n < 2; ++n) bv[bj][n] = *(const f32x4*)(bias + col0 + bj * 128 + 4 * n);
#pragma unroll
        for (int ai = 0; ai < 2; ++ai)
#pragma unroll
            for (int m = 0; m < 4; ++m) { const size_t ro = (size_t)(row0 + ai * 128 + m * 16) * DM + col0;
#pragma unroll
                for (int bj = 0; bj < 2; ++bj) { const bf16x8 xv = *(const bf16x8*)(xb + ro + bj * 128);
                    f32x4 v0, v1;
#pragma unroll
                    for (int e = 0; e < 4; ++e) { v0[e] = bf2f_s(xv[e]) * ALPHA + acc[ai][bj][m][0][e] + bv[bj][0][e]; v1[e] = bf2f_s(xv[4 + e]) * ALPHA + acc[ai][bj][m][1][e] + bv[bj][1][e]; }
                    if (last) { *(f32x4*)(out + ro + bj * 128) = v0; *(f32x4*)(out + ro + bj * 128 + 4) = v1; }
                    else { u32x4 w; w.x = cvt_pk_bf16(v0[0], v0[1]); w.y = cvt_pk_bf16(v0[2], v0[3]); w.z = cvt_pk_bf16(v1[0], v1[1]); w.w = cvt_pk_bf16(v1[2], v1[3]);
                        *(u32x4*)(dst + ro + bj * 128) = w; } } }
    }
};

template <class Epi> __device__ __forceinline__ void run_gemm(unsigned char* lds, const bf16_t* A, const bf16_t* Bt, int M, int N, const Epi& E) {
    pg8::Gemm g; g.A = A; g.Bt = Bt; g.M = M; g.N = N; g.K = DM;
    pg8::StaticOrder S; S.init(M, N, (int)gridDim.x, (int)blockIdx.x);
    pg8::gemm_phase<Epi, pg8::StaticOrder, false>((PG8_LAS unsigned char*)lds, g, S, E, nullptr);
    __syncthreads();
}

struct TileRef { const float* W; bf16_t* WT; int N, tk, tn; };
__device__ __forceinline__ TileRef tile_ref(const PV& p, int it) {
    const int j = it / 2176; int r = it - j * 2176; int kind;
    if (r < 1024) kind = 0; else if (r < 1280) { kind = 1; r -= 1024; } else if (r < 1920) { kind = 2; r -= 1280; } else { kind = 3; r -= 1920; }
    TileRef t; t.N = kind == 0 ? 4096 : (kind == 2 ? 2560 : 1024);
    const int nN = t.N / 64; t.tk = r / nN; t.tn = r % nN;
    t.W = (kind == 0 ? p.in(2) : kind == 1 ? p.in(14) : kind == 2 ? p.in(16) : p.in(20)) + (size_t)j * 1024 * t.N;
    t.WT = (bf16_t*)(p.ws + (kind == 0 ? WS_HWIN : kind == 1 ? WS_HWOUT : kind == 2 ? WS_AWIN : WS_AWOUT)) + (size_t)j * 1024 * t.N;
    return t;
}
__device__ __forceinline__ void prologue_phase(const PV& p, unsigned char* lds) {
    const int tid = tidx();
    { const int wid = __builtin_amdgcn_readfirstlane(tid >> 6), lane = tid & 63;
        for (int j = 0; j < 2; ++j) {
            const float* w1 = p.in(6) + j * 33 * 64; const float* w2 = p.in(9) + j * 64 * 64;
            float w1r[33], w2r[64];
#pragma unroll
            for (int i = 0; i < 33; ++i) w1r[i] = w1[i * 64 + lane];
#pragma unroll
            for (int i = 0; i < 64; ++i) w2r[i] = w2[i * 64 + lane];
            const float b1v = p.in(7)[j * 64 + lane], b2v = p.in(10)[j * 64 + lane], fr = p.in(8)[j * 64 + lane];
            for (int row = blockIdx.x * 8 + wid; row < 6144; row += gridDim.x * 8) {
                int t = row; const int sel = t >= 2048 ? 1 : 0; if (sel) t -= 2048; const int L = sel ? 4096 : 2048;
                float feat = 0.f;
                if (lane == 0) feat = (float)t / (float)(L - 1);
                else if (lane <= 32) { const int i = (lane - 1) & 15; const double f = 1e-4 + (double)i * ((15.0 - 1e-4) / 15.0);
                    double ph = f * (double)t / (double)L; ph -= (double)(long long)ph;
                    const float a = (float)(ph * 6.283185307179586);
                    feat = lane <= 16 ? cosf(a) : -sinf(a); }
                float s = b1v;
#pragma unroll
                for (int i = 0; i < 33; ++i) s += __shfl(feat, i, 64) * w1r[i];
                const float h1 = sinf(fr * s);
                float s2 = b2v;
#pragma unroll
                for (int i = 0; i < 64; ++i) s2 += __shfl(h1, i, 64) * w2r[i];
                ((float*)(p.ws + WS_H2))[((size_t)(j * 2 + sel) * 4096 + t) * 64 + lane] = sinf(fr * s2);
            }
        }
    }
    { float* tile = (float*)lds;
        const int total = 2 * 2176;
        f32x4 v[2];
        int it = blockIdx.x;
        if (it < total) { const TileRef t = tile_ref(p, it);
#pragma unroll
            for (int i = 0; i < 2; ++i) { const int q = tid + i * 512; v[i] = *(const f32x4*)(t.W + (size_t)(t.tk * 64 + (q >> 4)) * t.N + t.tn * 64 + (q & 15) * 4); } }
        for (; it < total; it += gridDim.x) {
            const TileRef t = tile_ref(p, it);
#pragma unroll
            for (int i = 0; i < 2; ++i) { const int q = tid + i * 512, k = q >> 4, n4 = (q & 15) * 4;
                tile[k * 65 + n4 + 0] = v[i][0]; tile[k * 65 + n4 + 1] = v[i][1]; tile[k * 65 + n4 + 2] = v[i][2]; tile[k * 65 + n4 + 3] = v[i][3]; }
            __syncthreads();
            if (it + (int)gridDim.x < total) { const TileRef t2 = tile_ref(p, it + gridDim.x);
#pragma unroll
                for (int i = 0; i < 2; ++i) { const int q = tid + i * 512; v[i] = *(const f32x4*)(t2.W + (size_t)(t2.tk * 64 + (q >> 4)) * t2.N + t2.tn * 64 + (q & 15) * 4); } }
            { const int n = tid >> 3, k8 = (tid & 7) * 8; float x[8];
#pragma unroll
                for (int e = 0; e < 8; ++e) x[e] = tile[(k8 + e) * 65 + n];
                u32x4 w; w.x = cvt_pk_bf16(x[0], x[1]); w.y = cvt_pk_bf16(x[2], x[3]); w.z = cvt_pk_bf16(x[4], x[5]); w.w = cvt_pk_bf16(x[6], x[7]);
                *(u32x4*)(t.WT + (size_t)(t.tn * 64 + n) * 1024 + t.tk * 64 + k8) = w; }
            __syncthreads();
        }
    }
}

__device__ __forceinline__ void cvt_phase(const PV& p, int g) {
    const float* x = p.in(g); bf16_t* xb = (bf16_t*)(p.ws + WS_XB);
    const size_t n8 = (size_t)TG * DM / 8;
    for (size_t i = (size_t)blockIdx.x * 512 + tidx(); i < n8; i += (size_t)gridDim.x * 512) {
        const f32x4 a = *(const f32x4*)(x + i * 8), b = *(const f32x4*)(x + i * 8 + 4);
        u32x4 w; w.x = cvt_pk_bf16(a[0], a[1]); w.y = cvt_pk_bf16(a[2], a[3]); w.z = cvt_pk_bf16(b[0], b[1]); w.w = cvt_pk_bf16(b[2], b[3]);
        *(u32x4*)(xb + i * 8) = w;
    }
}

__device__ __forceinline__ void ln_phase(const PV& p, int g, int layer, bf16_t* xdst) {
    float* x = p.out + (size_t)g * TG * DM; bf16_t* xb = (bf16_t*)(p.ws + WS_XB);
    const float* gam = p.in(22) + layer * DM; const float* bet = p.in(23) + layer * DM;
    const int tid_ = tidx(); const int wid = __builtin_amdgcn_readfirstlane(tid_ >> 6), lane = tid_ & 63;
    const bool last = layer == 3;
    f32x4 gv[4], bv[4];
#pragma unroll
    for (int k = 0; k < 4; ++k) { const int c = (k >> 1) * 512 + lane * 8 + (k & 1) * 4; gv[k] = *(const f32x4*)(gam + c); bv[k] = *(const f32x4*)(bet + c); }
    constexpr int NR = 2;
    for (int row0 = (blockIdx.x * 8 + wid) * NR; row0 < TG; row0 += gridDim.x * 8 * NR) {
        f32x4 v[NR][4];
#pragma unroll
        for (int rr = 0; rr < NR; ++rr) { const size_t ro = (size_t)(row0 + rr) * DM;
            if (last) {
#pragma unroll
                for (int k = 0; k < 4; ++k) v[rr][k] = *(const f32x4*)(x + ro + (k >> 1) * 512 + lane * 8 + (k & 1) * 4);
            } else {
#pragma unroll
                for (int hh = 0; hh < 2; ++hh) { const bf16x8 t = *(const bf16x8*)(xb + ro + hh * 512 + lane * 8);
#pragma unroll
                    for (int e = 0; e < 4; ++e) { v[rr][hh * 2][e] = bf2f_s(t[e]); v[rr][hh * 2 + 1][e] = bf2f_s(t[4 + e]); } }
            } }
        float s[NR], q[NR];
#pragma unroll
        for (int rr = 0; rr < NR; ++rr) { s[rr] = 0.f;
#pragma unroll
            for (int k = 0; k < 4; ++k) s[rr] += v[rr][k][0] + v[rr][k][1] + v[rr][k][2] + v[rr][k][3]; }
#pragma unroll
        for (int o = 32; o >= 1; o >>= 1) {
#pragma unroll
            for (int rr = 0; rr < NR; ++rr) s[rr] += __shfl_xor(s[rr], o, 64); }
#pragma unroll
        for (int rr = 0; rr < NR; ++rr) { const float mu = s[rr] * (1.f / DM); q[rr] = 0.f;
#pragma unroll
            for (int k = 0; k < 4; ++k) { v[rr][k] = v[rr][k] - mu; q[rr] += v[rr][k][0] * v[rr][k][0] + v[rr][k][1] * v[rr][k][1] + v[rr][k][2] * v[rr][k][2] + v[rr][k][3] * v[rr][k][3]; } }
#pragma unroll
        for (int o = 32; o >= 1; o >>= 1) {
#pragma unroll
            for (int rr = 0; rr < NR; ++rr) q[rr] += __shfl_xor(q[rr], o, 64); }
#pragma unroll
        for (int rr = 0; rr < NR; ++rr) { const size_t ro = (size_t)(row0 + rr) * DM; const float rstd = rsqrtf(q[rr] * (1.f / DM) + 1e-5f);
#pragma unroll
            for (int k = 0; k < 4; ++k) v[rr][k] = v[rr][k] * rstd * gv[k] + bv[k];
            if (last) {
#pragma unroll
                for (int k = 0; k < 4; ++k) *(f32x4*)(x + ro + (k >> 1) * 512 + lane * 8 + (k & 1) * 4) = v[rr][k];
            } else {
#pragma unroll
                for (int hh = 0; hh < 2; ++hh) { u32x4 w; w.x = cvt_pk_bf16(v[rr][hh * 2][0], v[rr][hh * 2][1]); w.y = cvt_pk_bf16(v[rr][hh * 2][2], v[rr][hh * 2][3]);
                    w.z = cvt_pk_bf16(v[rr][hh * 2 + 1][0], v[rr][hh * 2 + 1][1]); w.w = cvt_pk_bf16(v[rr][hh * 2 + 1][2], v[rr][hh * 2 + 1][3]);
                    *(u32x4*)(xdst + ro + hh * 512 + lane * 8) = w; }
            } }
    }
}

template <int L> __device__ __forceinline__ void filter_phase(const PV& p, int hj, int slot, unsigned char* lds) {
    const int tid = tidx(), wid = __builtin_amdgcn_readfirstlane(tid >> 6), lane = tid & 63, n16 = lane & 15, kq = lane >> 4;
    const float* h2 = (const float*)(p.ws + WS_H2) + (size_t)(hj * 2 + (L == 2048 ? 0 : 1)) * 4096 * 64;
    const float* w3 = p.in(11) + (size_t)hj * 64 * 4096; const float* decay = p.in(12) + hj * 4096;
    bf16_t* FILT = (bf16_t*)(p.ws + WS_FILT); float* PART = (float*)(p.ws + WS_SUMSQ);
    constexpr int HS = 72;
    bf16_t* stg = (bf16_t*)lds;
    unsigned* tile = (unsigned*)(lds + 36864);
    constexpr int NCH = L / 256;
    for (int it = blockIdx.x; it < 64 * NCH; it += gridDim.x) {
        const int cb = it / NCH, chunk = it - cb * NCH, t0 = chunk * 256;
        const int od = cb >> 4, dir = od & 1, o = od >> 1;
        const int tb = t0 + dir;
        __syncthreads();
#pragma unroll
        for (int i = 0; i < 8; ++i) { const int q = tid + 512 * i, rr = q >> 4, c4 = (q & 15) * 4; int tr = tb + rr; tr = tr < L ? tr : L - 1;
            const f32x4 x = *(const f32x4*)(h2 + (size_t)tr * 64 + c4);
            u32x2 w; w.x = cvt_pk_bf16(x[0], x[1]); w.y = cvt_pk_bf16(x[2], x[3]); *(u32x2*)(stg + rr * HS + c4) = w; }
        bf16x8 bfr[4][2]; float dec[4];
#pragma unroll
        for (int ct = 0; ct < 4; ++ct) { const int col = cb * 64 + ct * 16 + n16; dec[ct] = fabsf(decay[col]);
#pragma unroll
            for (int ks = 0; ks < 2; ++ks) { float x[8];
#pragma unroll
                for (int e = 0; e < 8; ++e) x[e] = w3[(size_t)(ks * 32 + kq * 8 + e) * 4096 + col];
                u32x4 w; w.x = cvt_pk_bf16(x[0], x[1]); w.y = cvt_pk_bf16(x[2], x[3]); w.z = cvt_pk_bf16(x[4], x[5]); w.w = cvt_pk_bf16(x[6], x[7]);
                bfr[ct][ks] = *reinterpret_cast<bf16x8*>(&w); } }
        float ss[4] = {0.f, 0.f, 0.f, 0.f};
        if (dir == 1 && t0 == 0 && wid == 0) {
#pragma unroll
            for (int ct = 0; ct < 4; ++ct) { const int col = cb * 64 + ct * 16 + n16; float d = 0.f;
                for (int j = 0; j < 64; ++j) d += h2[j] * w3[(size_t)j * 4096 + col];
                ss[ct] = kq == 0 ? d * d : 0.f; } }
        __syncthreads();
#pragma unroll
        for (int tt = 0; tt < 2; ++tt) {
            const int trow = wid * 32 + tt * 16;
            const bf16x8 a0 = *(const bf16x8*)(stg + (trow + n16) * HS + kq * 8), a1 = *(const bf16x8*)(stg + (trow + n16) * HS + 32 + kq * 8);
#pragma unroll
            for (int ct = 0; ct < 4; ++ct) {
                f32x4 acc = {0.f, 0.f, 0.f, 0.f};
                acc = __builtin_amdgcn_mfma_f32_16x16x32_bf16(a0, bfr[ct][0], acc, 0, 0, 0);
                acc = __builtin_amdgcn_mfma_f32_16x16x32_bf16(a1, bfr[ct][1], acc, 0, 0, 0);
                unsigned short* trw = (unsigned short*)(tile + (ct * 16 + n16) * 129);
#pragma unroll
                for (int i = 0; i < 4; ++i) { const int tl = trow + kq * 4 + i, t = tb + tl;
                    float d = acc[i] * expf(-(float)t * (1.0f / (float)(L - 1)) * dec[ct]);
                    if (t >= L) d = 0.f;
                    ss[ct] += d * d;
                    trw[dir ? tl : 255 - tl] = f2bf(d); }
            }
        }
#pragma unroll
        for (int ct = 0; ct < 4; ++ct) { float v = ss[ct]; v += __shfl_xor(v, 16, 64); v += __shfl_xor(v, 32, 64);
            if (kq == 0) PART[(size_t)(cb * 64 + ct * 16 + n16) * (NCH * 8) + chunk * 8 + wid] = v; }
        __syncthreads();
        { const int cc = tid >> 3, part = tid & 7; const unsigned* src = tile + cc * 129 + part * 16;
            const int ccol = cb * 64 + cc, c2 = ccol & 1023;
            bf16_t* dst = FILT + ((size_t)(o * 1024 + c2)) * (2 * L) + (dir ? L + t0 : L - 256 - t0) + part * 32;
#pragma unroll
            for (int k = 0; k < 4; ++k) { u32x4 v; v.x = src[k * 4]; v.y = src[k * 4 + 1]; v.z = src[k * 4 + 2]; v.w = src[k * 4 + 3]; *(u32x4*)(dst + k * 8) = v; } }
    }
    __syncthreads();
}

__device__ __forceinline__ bf16x8 lds_a4(const unsigned char* lds, unsigned addr) {
    const unsigned* q = (const unsigned*)(lds + addr); u32x4 w; w.x = q[0]; w.y = q[1]; w.z = q[2]; w.w = q[3]; return *reinterpret_cast<bf16x8*>(&w);
}
template <int NB> struct ConvCfg {
    static constexpr int L = NB == 16 ? 2048 : 4096, ROWE = L + 8, WROWS = NB == 16 ? 256 : 512, HSH = NB == 16 ? 0 : 256, SB = -HSH, NT = (L + HSH) / 32;
    static constexpr int ZOFF = 0, FOFF = 66560, FCOPY = 2 * L * 2, W3OFF = FOFF + 4 * FCOPY, REDOFF = W3OFF + 1024;
};
template <int NB> __device__ __forceinline__ void conv_main(const unsigned char* lds, int o, f32x4 (&acc)[16]) {
    using C = ConvCfg<NB>;
    const int tid_ = tidx(); const int lane = tid_ & 63, wid = __builtin_amdgcn_readfirstlane(tid_ >> 6), r = lane & 15, gq = lane >> 4;
    const int b = NB == 16 ? r : (r & 7), h = NB == 16 ? 0 : (r >> 3);
    const int E0 = (C::L - 1) + C::SB - C::WROWS * wid + 8 * gq - r;
    const int P = E0 & 1;
    unsigned aPtr = (unsigned)(C::FOFF + (o * 2 + P) * C::FCOPY + 2 * (E0 - P));
    const int bBase = C::ZOFF + b * C::ROWE * 2 + 2 * (C::SB + C::HSH * h + 8 * gq);
    const int s_lane0 = C::SB + C::HSH * h;
    bf16x8 A[16];
#pragma unroll
    for (int i = 0; i < 16; ++i) { A[i] = lds_a4(lds, aPtr - 32 * i); acc[i] = (f32x4){0.f, 0.f, 0.f, 0.f}; }
    auto ldb = [&](int j) -> bf16x8 {
        if (NB == 16) return *(const bf16x8*)(lds + bBase + 64 * j);
        const bool valid = (unsigned)(s_lane0 + 32 * j) < (unsigned)C::L;
        const bf16x8 t = *(const bf16x8*)(lds + (valid ? bBase + 64 * j : C::ZOFF));
        const bf16x8 z = {0, 0, 0, 0, 0, 0, 0, 0}; return valid ? t : z; };
    bf16x8 bnext = ldb(0);
    for (int jo = 0; jo < C::NT / 8; ++jo) {
#pragma unroll
        for (int jj = 0; jj < 8; ++jj) {
            const int j = jo * 8 + jj;
            const bf16x8 bf = bnext;
            bnext = ldb(j + 1 < C::NT ? j + 1 : j);
            acc[15] = __builtin_amdgcn_mfma_f32_16x16x32_bf16(A[(15 - 2 * jj) & 15], bf, acc[15], 0, 0, 0);
            acc[14] = __builtin_amdgcn_mfma_f32_16x16x32_bf16(A[(14 - 2 * jj) & 15], bf, acc[14], 0, 0, 0);
            A[(14 - 2 * jj) & 15] = lds_a4(lds, aPtr + 64 * (jj + 1));
            A[(15 - 2 * jj) & 15] = lds_a4(lds, aPtr + 64 * (jj + 1) - 32);
#pragma unroll
            for (int i = 13; i >= 0; --i) acc[i] = __builtin_amdgcn_mfma_f32_16x16x32_bf16(A[(i - 2 * jj) & 15], bf, acc[i], 0, 0, 0);
            __builtin_amdgcn_sched_barrier(0);
        }
        aPtr += 512;
    }
}
template <int NB, int I0, int I1> __device__ __forceinline__ void conv_gload(const bf16_t* UT, int gch, s16x4 (&gu)[16], unsigned (&gh)[16]) {
    using C = ConvCfg<NB>;
    const int tid_ = tidx(); const int lane = tid_ & 63, wid = __builtin_amdgcn_readfirstlane(tid_ >> 6), r = lane & 15, gq = lane >> 4;
    const int b = NB == 16 ? r : (r & 7), h = NB == 16 ? 0 : (r >> 3);
    const bf16_t* grow = UT + ((size_t)b * 3072 + gch) * C::L;
#pragma unroll
    for (int i = I0; i < I1; ++i) {
        const int t = C::WROWS * wid + 16 * i + 4 * gq + C::HSH * h;
        gu[i] = *(const s16x4*)(grow + t);
        const unsigned lo = grow[t > 0 ? t - 1 : 0], hi = grow[(t + 4 < C::L) ? t + 4 : C::L - 1];
        gh[i] = lo | (hi << 16);
    }
}
template <int NB> __device__ __forceinline__ void conv_epi(const unsigned char* lds, const f32x4 (&acc)[16], u32x2 (&zp)[16], const s16x4 (&gu_)[16], const unsigned (&gh)[16],
                                                          float gw0, float gw1, float gw2, float gcb, float fb, float nrm) {
    using C = ConvCfg<NB>;
    const int tid_ = tidx(); const int lane = tid_ & 63, wid = __builtin_amdgcn_readfirstlane(tid_ >> 6), r = lane & 15, gq = lane >> 4;
    const int b = NB == 16 ? r : (r & 7), h = NB == 16 ? 0 : (r >> 3);
#pragma unroll
    for (int i = 0; i < 16; ++i) {
        const int t = C::WROWS * wid + 16 * i + 4 * gq + C::HSH * h;
        const s16x4 gu = gu_[i];
        const float gl = t > 0 ? bf2f((unsigned short)(gh[i] & 0xffffu)) : 0.f, gr = (t + 4 < C::L) ? bf2f((unsigned short)(gh[i] >> 16)) : 0.f;
        const float u0 = bf2f_s(gu[0]), u1 = bf2f_s(gu[1]), u2 = bf2f_s(gu[2]), u3 = bf2f_s(gu[3]);
        const float g0 = gw0 * gl + gw1 * u0 + gw2 * u1 + gcb, g1 = gw0 * u0 + gw1 * u1 + gw2 * u2 + gcb;
        const float g2 = gw0 * u1 + gw1 * u2 + gw2 * u3 + gcb, g3 = gw0 * u2 + gw1 * u3 + gw2 * gr + gcb;
        const s16x4 vz = *(const s16x4*)(lds + C::ZOFF + (b * C::ROWE + t) * 2);
        const float z0 = g0 * (acc[i][0] * nrm + bf2f_s(vz[0]) * fb), z1 = g1 * (acc[i][1] * nrm + bf2f_s(vz[1]) * fb);
        const float z2 = g2 * (acc[i][2] * nrm + bf2f_s(vz[2]) * fb), z3 = g3 * (acc[i][3] * nrm + bf2f_s(vz[3]) * fb);
        zp[i].x = cvt_pk_bf16(z0, z1); zp[i].y = cvt_pk_bf16(z2, z3);
    }
}
template <int NB> __device__ __forceinline__ void conv_store_z(unsigned char* lds, const u32x2 (&zp)[16]) {
    using C = ConvCfg<NB>;
    const int tid_ = tidx(); const int lane = tid_ & 63, wid = __builtin_amdgcn_readfirstlane(tid_ >> 6), r = lane & 15, gq = lane >> 4;
    const int b = NB == 16 ? r : (r & 7), h = NB == 16 ? 0 : (r >> 3);
#pragma unroll
    for (int i = 0; i < 16; ++i) { const int t = C::WROWS * wid + 16 * i + 4 * gq + C::HSH * h; *(u32x2*)(lds + C::ZOFF + (b * C::ROWE + t) * 2) = zp[i]; }
}

template <int NB> __device__ __forceinline__ void conv_phase(const PV& p, int hj, int slot, unsigned char* lds, bf16_t* zdst, int zstride) {
    using C = ConvCfg<NB>;
    constexpr int L = C::L;
    const int tid_wg = tidx(), wid = __builtin_amdgcn_readfirstlane(tid_wg >> 6), lane = tid_wg & 63;
    bf16_t* UT = (bf16_t*)(p.ws + WS_UT);
    const float* w3 = p.in(11) + (size_t)hj * 64 * 4096; const float* decay = p.in(12) + hj * 4096;
    const float* fbias = p.in(13) + hj * 2048; const float* cw = p.in(4) + hj * 3 * 3072; const float* cb = p.in(5) + hj * 3072;
    float* w3s = (float*)(lds + C::W3OFF); float* red = (float*)(lds + C::REDOFF);
    for (int c = blockIdx.x; c < 1024; c += gridDim.x) {
        __syncthreads();
        const int tid = opaque(tid_wg);
        constexpr int NF = (2 * (2 * L / 8)) / 512;
        u32x4 fr[NF]; bf16x8 vx[8]; float hl[8], hr[8];
        { const bf16_t* FILT = (const bf16_t*)(p.ws + WS_FILT);
#pragma unroll
            for (int i = 0; i < NF; ++i) { const int q = tid + 512 * i, o = q / (2 * L / 8), i8 = (q - o * (2 * L / 8)) * 8;
                fr[i] = *(const u32x4*)(FILT + ((size_t)(o * 1024 + c)) * (2 * L) + i8); } }
#pragma unroll
        for (int i = 0; i < 8; ++i) { const int chunk = tid + 512 * i, b = chunk / (L / 8), s8 = (chunk % (L / 8)) * 8;
            const bf16_t* src = UT + ((size_t)b * 3072 + c) * L + s8;
            vx[i] = *(const bf16x8*)src; const float a_ = bf2f(src[s8 > 0 ? -1 : 0]), b_ = bf2f(src[(s8 + 8 < L) ? 8 : 7]);
            hl[i] = s8 > 0 ? a_ : 0.f; hr[i] = (s8 + 8 < L) ? b_ : 0.f; }
        { constexpr int NP = (L / 256) * 8; const float* PART = (const float*)(p.ws + WS_SUMSQ);
            const int o = tid >> 8, idx = tid & 255, dir = idx / NP, k = idx - dir * NP;
            float v = (idx < 2 * NP) ? PART[(size_t)((o * 2 + dir) * 1024 + c) * NP + k] : 0.f;
            v = wave_sum(v); if (lane == 0) red[wid] = v; }
#pragma unroll
        for (int i = 0; i < NF; ++i) { const int q = tid + 512 * i, o = q / (2 * L / 8), i8 = (q - o * (2 * L / 8)) * 8;
            *(u32x4*)(lds + C::FOFF + (o * 2) * C::FCOPY + i8 * 2) = fr[i]; }
        { const float w0 = cw[c], w1 = cw[3072 + c], w2 = cw[2 * 3072 + c], cbv = cb[c];
#pragma unroll
            for (int i = 0; i < 8; ++i) { const int chunk = tid + 512 * i, b = chunk / (L / 8), s8 = (chunk % (L / 8)) * 8;
                float xe[10]; xe[0] = hl[i]; xe[9] = hr[i];
#pragma unroll
                for (int e = 0; e < 8; ++e) xe[e + 1] = bf2f_s(vx[i][e]);
                float y[8];
#pragma unroll
                for (int e = 0; e < 8; ++e) y[e] = w0 * xe[e] + w1 * xe[e + 1] + w2 * xe[e + 2] + cbv;
                u32x4 w; w.x = cvt_pk_bf16(y[0], y[1]); w.y = cvt_pk_bf16(y[2], y[3]); w.z = cvt_pk_bf16(y[4], y[5]); w.w = cvt_pk_bf16(y[6], y[7]);
                *(u32x4*)(lds + C::ZOFF + (b * C::ROWE + s8) * 2) = w;
                __builtin_amdgcn_sched_barrier(0); } }
        __syncthreads();
        const float nrm0 = rsqrtf(red[0] + red[1] + red[2] + red[3] + 1e-6f), nrm1 = rsqrtf(red[4] + red[5] + red[6] + red[7] + 1e-6f);
#pragma unroll
        for (int i = 0; i < NF; ++i) { const int q = tid + 512 * i, o = q / (2 * L / 8), m4 = (q - o * (2 * L / 8)) * 4;
            const unsigned* s0 = (const unsigned*)(lds + C::FOFF + (o * 2) * C::FCOPY) + m4; unsigned* d1 = (unsigned*)(lds + C::FOFF + (o * 2 + 1) * C::FCOPY) + m4;
            const u32x4 a = *(const u32x4*)s0; const unsigned nx = (m4 + 4 < L) ? s0[4] : 0u;
            u32x4 r; r.x = __builtin_amdgcn_alignbit(a.y, a.x, 16); r.y = __builtin_amdgcn_alignbit(a.z, a.y, 16); r.z = __builtin_amdgcn_alignbit(a.w, a.z, 16); r.w = __builtin_amdgcn_alignbit(nx, a.w, 16);
            *(u32x4*)d1 = r; }
        __syncthreads();
        f32x4 acc[16]; u32x2 zp[16]; s16x4 gu[16]; unsigned gh[16];
        conv_gload<NB, 0, 8>(UT, 1024 + c, gu, gh);
        conv_main<NB>(lds, 0, acc);
        conv_gload<NB, 8, 16>(UT, 1024 + c, gu, gh);
        conv_epi<NB>(lds, acc, zp, gu, gh, cw[1024 + c], cw[3072 + 1024 + c], cw[2 * 3072 + 1024 + c], cb[1024 + c], fbias[c], nrm0);
        __syncthreads();
        conv_store_z<NB>(lds, zp);
        __syncthreads();
        conv_gload<NB, 0, 8>(UT, 2048 + c, gu, gh);
        conv_main<NB>(lds, 1, acc);
        conv_gload<NB, 8, 16>(UT, 2048 + c, gu, gh);
        conv_epi<NB>(lds, acc, zp, gu, gh, cw[2048 + c], cw[3072 + 2048 + c], cw[2 * 3072 + 2048 + c], cb[2048 + c], fbias[1024 + c], nrm1);
        __syncthreads();
        conv_store_z<NB>(lds, zp);
        __syncthreads();
#pragma unroll
        for (int i = 0; i < 8; ++i) { const int chunk = tid + 512 * i, b = chunk / (L / 8), s8 = (chunk % (L / 8)) * 8;
            *(u32x4*)(zdst + ((size_t)b * zstride + c) * L + s8) = *(const u32x4*)(lds + C::ZOFF + (b * C::ROWE + s8) * 2); }
        __syncthreads();
    }
}

__device__ __forceinline__ void ygate_phase(const PV& p, int L, unsigned char* lds) {
    const bf16_t* UT = (const bf16_t*)(p.ws + WS_UT); const bf16_t* G = (const bf16_t*)(p.ws + WS_GATE); bf16_t* Y = (bf16_t*)(p.ws + WS_Y);
    const int tid = tidx(); constexpr int RS = 136;
    bf16_t* tile = (bf16_t*)lds;
    const int nit = (TG / 128) * 16;
    u32x4 zr[2]; bf16x8 gr[2];
    auto issue = [&](int it) {
        const int tc = it & 15, tt = it >> 4; const int tok0 = tt * 128, b = tok0 / L, t0 = tok0 - b * L, c0 = tc * 64;
#pragma unroll
        for (int i = 0; i < 2; ++i) { const int q = tid + i * 512;
            zr[i] = *(const u32x4*)(UT + ((size_t)b * 3072 + c0 + (q >> 4)) * L + t0 + (q & 15) * 8);
            gr[i] = *(const bf16x8*)(G + (size_t)(tok0 + (q >> 3)) * DM + c0 + (q & 7) * 8); } };
    int it = blockIdx.x;
    if (it < nit) issue(it);
    for (; it < nit; it += gridDim.x) {
        const int tc = it & 15, tt = it >> 4; const int tok0 = tt * 128, c0 = tc * 64;
#pragma unroll
        for (int i = 0; i < 2; ++i) { const int q = tid + i * 512; *(u32x4*)(tile + (q >> 4) * RS + (q & 15) * 8) = zr[i]; }
        const bf16x8 g0 = gr[0], g1 = gr[1];
        __syncthreads();
        if (it + (int)gridDim.x < nit) issue(it + gridDim.x);
#pragma unroll
        for (int i = 0; i < 2; ++i) { const int q = tid + i * 512, t = q >> 3, cch = (q & 7) * 8; const bf16x8 gv = i ? g1 : g0; float y[8];
#pragma unroll
            for (int e = 0; e < 8; ++e) y[e] = bf2f(tile[(cch + e) * RS + t]) * silu(bf2f_s(gv[e]));
            u32x4 w; w.x = cvt_pk_bf16(y[0], y[1]); w.y = cvt_pk_bf16(y[2], y[3]); w.z = cvt_pk_bf16(y[4], y[5]); w.w = cvt_pk_bf16(y[6], y[7]);
            *(u32x4*)(Y + (size_t)(tok0 + t) * DM + c0 + cch) = w; }
        __syncthreads();
    }
}

constexpr int LDU = 2560;
__device__ __forceinline__ void rope_phase(const PV& p, int aj, int L, bf16_t* D, int ldd, int tok_lo, int tok_hi) {
    bf16_t* U = (bf16_t*)(p.ws + WS_UT);
    const float* qn = p.in(18) + aj * 128; const float* kn = p.in(19) + aj * 128;
    const int tid = tidx(), sub = tid & 7;
    float inv[8], q1[8], q2[8], k1[8], k2[8];
#pragma unroll
    for (int e = 0; e < 8; ++e) { inv[e] = exp2f(-(float)((8 * sub + e) & 31) * (13.287712379549449f / 32.f));
        q1[e] = qn[8 * sub + e]; q2[e] = qn[64 + 8 * sub + e]; k1[e] = kn[8 * sub + e]; k2[e] = kn[64 + 8 * sub + e]; }
    for (int tok = tok_lo + (tid >> 3); tok < tok_hi; tok += 64) {
        const int t = tok & (L - 1); const float pos = (float)(sub < 4 ? (t >> 6) : (t & 63));
        float cs[8], sn[8];
#pragma unroll
        for (int e = 0; e < 8; ++e) { const float ang = pos * inv[e]; cs[e] = __cosf(ang); sn[e] = __sinf(ang); }
        bf16_t* u = U + (size_t)tok * LDU + 8 * sub;
#pragma unroll
        for (int hd = 8; hd < 10; ++hd) {
            const bf16x8 a = *(const bf16x8*)(u + hd * 128), bq = *(const bf16x8*)(u + hd * 128 + 64);
            float x1[8], x2[8]; float ss = 0.f;
#pragma unroll
            for (int e = 0; e < 8; ++e) { x1[e] = bf2f_s(a[e]); x2[e] = bf2f_s(bq[e]); ss += x1[e] * x1[e] + x2[e] * x2[e]; }
            ss += __shfl_xor(ss, 1, 64); ss += __shfl_xor(ss, 2, 64); ss += __shfl_xor(ss, 4, 64);
            const float rs = rsqrtf(ss * (1.f / 128.f) + 1e-6f);
            float o1[8], o2[8];
#pragma unroll
            for (int e = 0; e < 8; ++e) { const float xa = x1[e] * rs * (hd < 8 ? q1[e] : k1[e]), xb2 = x2[e] * rs * (hd < 8 ? q2[e] : k2[e]);
                o1[e] = xa * cs[e] - xb2 * sn[e]; o2[e] = xb2 * cs[e] + xa * sn[e]; }
            u32x4 w1, w2; w1.x = cvt_pk_bf16(o1[0], o1[1]); w1.y = cvt_pk_bf16(o1[2], o1[3]); w1.z = cvt_pk_bf16(o1[4], o1[5]); w1.w = cvt_pk_bf16(o1[6], o1[7]);
            w2.x = cvt_pk_bf16(o2[0], o2[1]); w2.y = cvt_pk_bf16(o2[2], o2[3]); w2.z = cvt_pk_bf16(o2[4], o2[5]); w2.w = cvt_pk_bf16(o2[6], o2[7]);
            bf16_t* d = D + (size_t)tok * ldd + 8 * sub; *(u32x4*)(d + hd * 128) = w1; *(u32x4*)(d + hd * 128 + 64) = w2;
        }
    }
}

namespace att {
constexpr int D = 128, NW = 8, QBLK = 32, KVBLK = 64;
constexpr float SCALE = 0.088388347648318440f;
constexpr float THR = 8.f;
constexpr int LDQ = LDU, LDK = LDU;
constexpr size_t SHM_V = KVBLK * D * 2, SHM_K = KVBLK * D * 2, SHM_ATTN = 2 * SHM_V + 2 * SHM_K + NW * 64 * 4;
#define KSWZ(row, colB) ((row) * 256 + ((colB) ^ (((row) & 7) << 4)))
#define SBAR() __builtin_amdgcn_sched_barrier(0)
__device__ __forceinline__ int crow(int r, int hi) { return (r & 3) + 8 * (r >> 2) + 4 * hi; }
__device__ __forceinline__ unsigned cvtpk(float lo, float hi) { unsigned r; asm volatile("v_cvt_pk_bf16_f32 %0, %1, %2" : "=v"(r) : "v"(lo), "v"(hi)); return r; }
__device__ __forceinline__ bf16x8 ld8(const bf16_t* p) { return *reinterpret_cast<const bf16x8*>(p); }
__device__ __forceinline__ void partialSM(f32x16& p0, f32x16& p1, float& m_reg, float& mn, float& alpha) {
  constexpr float C = SCALE * 1.4426950408889634f;
  float pmax = p0[0]; for (int r = 1; r < 16; ++r) pmax = fmaxf(pmax, p0[r]); for (int r = 0; r < 16; ++r) pmax = fmaxf(pmax, p1[r]);
  { auto rr = __builtin_amdgcn_permlane32_swap(__float_as_uint(pmax), __float_as_uint(pmax), false, false);
    pmax = fmaxf(__uint_as_float(rr[0]), __uint_as_float(rr[1])); }
  if (__builtin_expect(__all(pmax - m_reg <= THR / SCALE), 1)) { mn = m_reg; alpha = 1.f; }
  else { mn = fmaxf(m_reg, pmax); alpha = __builtin_amdgcn_exp2f((m_reg - mn) * C); m_reg = mn; }
  float mnC = -mn * C;
  for (int r = 0; r < 16; ++r) p0[r] = fmaf(p0[r], C, mnC); for (int r = 0; r < 16; ++r) p1[r] = fmaf(p1[r], C, mnC);
  for (int r = 0; r < 16; ++r) p0[r] = __builtin_amdgcn_exp2f(p0[r]);
}
__device__ __forceinline__ void finishSM(f32x16& p0, f32x16& p1, float alpha, float& l_reg, bf16x8& pa0, bf16x8& pa1, bf16x8& pa2, bf16x8& pa3) {
  for (int r = 0; r < 16; ++r) p1[r] = __builtin_amdgcn_exp2f(p1[r]);
  float ps = 0; for (int r = 0; r < 16; ++r) ps += p0[r]; for (int r = 0; r < 16; ++r) ps += p1[r];
  { auto rr = __builtin_amdgcn_permlane32_swap(__float_as_uint(ps), __float_as_uint(ps), false, false);
    ps = __uint_as_float(rr[0]) + __uint_as_float(rr[1]); }
  l_reg = l_reg * alpha + ps;
#define PK4(P, BASE, OUT) do { unsigned a0 = cvtpk(P[BASE + 0], P[BASE + 1]), a1 = cvtpk(P[BASE + 2], P[BASE + 3]);   \
    unsigned b0 = cvtpk(P[BASE + 4], P[BASE + 5]), b1 = cvtpk(P[BASE + 6], P[BASE + 7]);                              \
    auto r0 = __builtin_amdgcn_permlane32_swap(a0, b0, false, false); auto r1 = __builtin_amdgcn_permlane32_swap(a1, b1, false, false); \
    u32x4 w = {r0[0], r1[0], r0[1], r1[1]}; OUT = *reinterpret_cast<bf16x8*>(&w); } while (0)
  PK4(p0, 0, pa0); PK4(p0, 8, pa1); PK4(p1, 0, pa2); PK4(p1, 8, pa3);
#undef PK4
}
__device__ __forceinline__ void qkt(f32x16& p0, f32x16& p1, const bf16_t* Ks, const bf16x8* qr, int r32, int hi) {
  p0 = f32x16{}; p1 = f32x16{};
  for (int d0 = 0; d0 < 8; ++d0) { int cb = (d0 * 16 + hi * 8) * 2;
    bf16x8 b0 = *reinterpret_cast<const bf16x8*>((const char*)Ks + KSWZ(r32, cb));
    bf16x8 b1 = *reinterpret_cast<const bf16x8*>((const char*)Ks + KSWZ(32 + r32, cb));
    p0 = __builtin_amdgcn_mfma_f32_32x32x16_bf16(b0, qr[d0], p0, 0, 0, 0);
    p1 = __builtin_amdgcn_mfma_f32_32x32x16_bf16(b1, qr[d0], p1, 0, 0, 0); }
}
__device__ __forceinline__ int v_st(int k, int c) { const int kk = (k & ~0xC) | ((k & 4) << 1) | ((k & 8) >> 1); return ((kk >> 3) * 4 + (c >> 5)) * 512 + ((kk & 7) * 32 + (c & 31)) * 2; }
__device__ __forceinline__ int v_rd_base(int lane) { return ((lane & 3) << 3) | (((lane >> 2) & 3) << 6) | (((lane >> 4) & 1) << 5) | (((lane >> 5) & 1) << 8); }
constexpr int v_rd_off(int d0, int ks, int half) { return d0 * 512 + ks * 4096 + half * 2048; }
template <int OFF> __device__ __forceinline__ s16x4 tr_read(int vb) {
  s16x4 r; asm volatile("ds_read_b64_tr_b16 %0, %1 offset:%2" : "=&v"(r) : "v"(vb), "i"(OFF) : "memory"); return r;
}
template <int D0> __device__ __forceinline__ void pv_one(f32x16& od, int vb, bf16x8 pa0, bf16x8 pa1, bf16x8 pa2, bf16x8 pa3) {
  const s16x4 l0 = tr_read<v_rd_off(D0, 0, 0)>(vb), h0 = tr_read<v_rd_off(D0, 0, 1)>(vb), l1 = tr_read<v_rd_off(D0, 1, 0)>(vb), h1 = tr_read<v_rd_off(D0, 1, 1)>(vb);
  const s16x4 l2 = tr_read<v_rd_off(D0, 2, 0)>(vb), h2 = tr_read<v_rd_off(D0, 2, 1)>(vb), l3 = tr_read<v_rd_off(D0, 3, 0)>(vb), h3 = tr_read<v_rd_off(D0, 3, 1)>(vb);
  asm volatile("s_waitcnt lgkmcnt(0)" ::: "memory"); SBAR();
#define PK(L, H) (bf16x8){L[0], L[1], L[2], L[3], H[0], H[1], H[2], H[3]}
  od = __builtin_amdgcn_mfma_f32_32x32x16_bf16(pa0, PK(l0, h0), od, 0, 0, 0);
  od = __builtin_amdgcn_mfma_f32_32x32x16_bf16(pa1, PK(l1, h1), od, 0, 0, 0);
  od = __builtin_amdgcn_mfma_f32_32x32x16_bf16(pa2, PK(l2, h2), od, 0, 0, 0);
  od = __builtin_amdgcn_mfma_f32_32x32x16_bf16(pa3, PK(l3, h3), od, 0, 0, 0);
#undef PK
}
__device__ __forceinline__ void pv_d0(f32x16* o, int vb, bf16x8 pa0, bf16x8 pa1, bf16x8 pa2, bf16x8 pa3) {
  pv_one<0>(o[0], vb, pa0, pa1, pa2, pa3); pv_one<1>(o[1], vb, pa0, pa1, pa2, pa3); pv_one<2>(o[2], vb, pa0, pa1, pa2, pa3); pv_one<3>(o[3], vb, pa0, pa1, pa2, pa3);
}
__device__ __forceinline__ void attn_dense_body(const bf16_t* __restrict__ Qb, const bf16_t* __restrict__ Kh, const bf16_t* __restrict__ Vh,
                                                const bf16_t* __restrict__ Gb, bf16_t* __restrict__ Yb, int seq, char* lds, const float* __restrict__ qnw, int tpos0) {
  constexpr int SDEPTH = 1;
  const int tid = tidx(), wid = __builtin_amdgcn_readfirstlane(tid >> 6), lane = tid & 63, r32 = lane & 31, hi = lane >> 5;
  bf16_t* V_lds = (bf16_t*)lds; bf16_t* K_lds = (bf16_t*)(lds + 2 * SHM_V);
  float* ws = (float*)(lds + 2 * SHM_V + 2 * SHM_K) + wid * 64; float* li_l = ws; float* al_l = ws + 32;
  float m_reg = -1e30f, l_reg = 0; f32x16 o[4] = {}; bf16x8 qr[8];
  const bf16_t* Qw = Qb + (long)(wid * QBLK + r32) * LDQ + hi * 8;
#pragma unroll
  for (int d0 = 0; d0 < 8; ++d0) qr[d0] = ld8(Qw + d0 * 16);
  {
    float ss = 0.f;
#pragma unroll
    for (int d0 = 0; d0 < 8; ++d0)
#pragma unroll
      for (int e = 0; e < 8; ++e) { const float x = bf2f_s(qr[d0][e]); ss += x * x; }
    ss += __shfl_xor(ss, 32, 64);
    const float rs = rsqrtf(ss * (1.f / 128.f) + 1e-6f);
    const int tq = tpos0 + wid * QBLK + r32;
    const float prow = (float)(tq >> 6), pcol = (float)(tq & 63);
#pragma unroll
    for (int d0 = 0; d0 < 4; ++d0) {
      const int c0 = d0 * 16 + hi * 8;
      const f32x4 ga = *(const f32x4*)(qnw + c0), gb = *(const f32x4*)(qnw + c0 + 4), gc = *(const f32x4*)(qnw + 64 + c0), gd = *(const f32x4*)(qnw + 64 + c0 + 4);
      float o1[8], o2[8];
#pragma unroll
      for (int e = 0; e < 8; ++e) {
        const float inv = exp2f(-(float)((c0 + e) & 31) * (13.287712379549449f / 32.f));
        const float ang = (d0 < 2 ? prow : pcol) * inv; const float cs = __cosf(ang), sn = __sinf(ang);
        const float x1 = bf2f_s(qr[d0][e]) * rs * (e < 4 ? ga[e & 3] : gb[e & 3]), x2 = bf2f_s(qr[d0 + 4][e]) * rs * (e < 4 ? gc[e & 3] : gd[e & 3]);
        o1[e] = x1 * cs - x2 * sn; o2[e] = x2 * cs + x1 * sn; }
      u32x4 w1, w2; w1.x = cvtpk(o1[0], o1[1]); w1.y = cvtpk(o1[2], o1[3]); w1.z = cvtpk(o1[4], o1[5]); w1.w = cvtpk(o1[6], o1[7]);
      w2.x = cvtpk(o2[0], o2[1]); w2.y = cvtpk(o2[2], o2[3]); w2.z = cvtpk(o2[4], o2[5]); w2.w = cvtpk(o2[6], o2[7]);
      qr[d0] = *reinterpret_cast<bf16x8*>(&w1); qr[d0 + 4] = *reinterpret_cast<bf16x8*>(&w2); }
  }
  const int sr = tid >> 4, sc = (tid & 15) * 8, vst0 = v_st(sr, sc), vst1 = v_st(32 + sr, sc);
  const int vb0 = (int)(uintptr_t)V_lds + v_rd_base(lane);
  struct { bf16x8 vs0, vs1, ks0, ks1; } sr_[SDEPTH];
#define SLOAD(i, k0) do { sr_[i].vs0 = ld8(&Vh[(long)((k0) + sr) * LDK + sc]); sr_[i].vs1 = ld8(&Vh[(long)((k0) + 32 + sr) * LDK + sc]); \
    sr_[i].ks0 = ld8(&Kh[(long)((k0) + sr) * LDK + sc]); sr_[i].ks1 = ld8(&Kh[(long)((k0) + 32 + sr) * LDK + sc]); } while (0)
#define SWRITE(b, i) do { *(bf16x8*)((char*)V_lds + (b) * SHM_V + vst0) = sr_[i].vs0;          \
    *(bf16x8*)((char*)V_lds + (b) * SHM_V + vst1) = sr_[i].vs1; int kc = sc * 2;               \
    *(bf16x8*)((char*)K_lds + (b) * SHM_K + KSWZ(sr, kc)) = sr_[i].ks0;                       \
    *(bf16x8*)((char*)K_lds + (b) * SHM_K + KSWZ(32 + sr, kc)) = sr_[i].ks1; } while (0)
#define SWAIT() do { asm volatile("s_waitcnt vmcnt(0)" ::: "memory"); } while (0)
#define RESC(a) do { if (__any((a) < 1.f)) { if (hi == 0) al_l[r32] = (a); asm volatile("s_waitcnt lgkmcnt(0)" ::: "memory"); \
    for (int d = 0; d < 4; ++d) for (int r = 0; r < 16; ++r) o[d][r] *= al_l[crow(r, hi)]; } } while (0)
  f32x16 pA0, pA1, pB0, pB1; float mnA, mnB, alA, alB; bf16x8 pa0, pa1, pa2, pa3; const int NT = seq / KVBLK;
  constexpr int SE = 0, SO = SDEPTH - 1;
  SLOAD(SE, 0); asm volatile("s_waitcnt vmcnt(0)" ::: "memory"); SWRITE(0, SE); __syncthreads();
  qkt(pA0, pA1, K_lds, qr, r32, hi); partialSM(pA0, pA1, m_reg, mnA, alA);
  SLOAD(SO, KVBLK);
  SWAIT(); SWRITE(1, SO); __syncthreads();
  for (int j = 1; j + 1 < NT; j += 2) {
    SBAR(); qkt(pB0, pB1, (bf16_t*)((char*)K_lds + SHM_K), qr, r32, hi);
    finishSM(pA0, pA1, alA, l_reg, pa0, pa1, pa2, pa3); SBAR();
    SLOAD(SO, (j + SDEPTH) * KVBLK); SBAR();
    pv_d0(o, vb0, pa0, pa1, pa2, pa3); partialSM(pB0, pB1, m_reg, mnB, alB);
    __syncthreads(); SWAIT(); SWRITE(0, SE);
    RESC(alB); __syncthreads();
    SBAR(); qkt(pA0, pA1, K_lds, qr, r32, hi);
    finishSM(pB0, pB1, alB, l_reg, pa0, pa1, pa2, pa3); SBAR();
    SLOAD(SE, (j + 1 + SDEPTH) * KVBLK); SBAR();
    pv_d0(o, vb0 + (int)SHM_V, pa0, pa1, pa2, pa3); partialSM(pA0, pA1, m_reg, mnA, alA);
    __syncthreads(); SWAIT(); SWRITE(1, SO);
    RESC(alA); __syncthreads();
  }
  SBAR(); qkt(pB0, pB1, (bf16_t*)((char*)K_lds + SHM_K), qr, r32, hi);
  finishSM(pA0, pA1, alA, l_reg, pa0, pa1, pa2, pa3); SBAR();
  pv_d0(o, vb0, pa0, pa1, pa2, pa3); partialSM(pB0, pB1, m_reg, mnB, alB);
  __syncthreads(); RESC(alB);
  finishSM(pB0, pB1, alB, l_reg, pa0, pa1, pa2, pa3); SBAR();
  pv_d0(o, vb0 + (int)SHM_V, pa0, pa1, pa2, pa3);
  if (hi == 0) li_l[r32] = l_reg; asm volatile("s_waitcnt lgkmcnt(0)" ::: "memory");
  { const int ln = opaque(lane), r32e = ln & 31, hie = ln >> 5;
    const bf16_t* Gl = Gb + (long)(wid * QBLK + 4 * hie) * LDU + r32e; bf16_t* Yl = Yb + (long)(wid * QBLK + 4 * hie) * DM + r32e;
#pragma unroll
  for (int r = 0; r < 16; ++r) { const int ro = (r & 3) + 8 * (r >> 2); const float rl = __builtin_amdgcn_rcpf(li_l[ro + 4 * hie]);
    asm volatile("" ::: "memory");
#pragma unroll
    for (int d0 = 0; d0 < 4; ++d0) { const float gv = bf2f(Gl[ro * LDU + d0 * 32]);
      Yl[ro * DM + d0 * 32] = f2bf(o[d0][r] * rl * silu(gv)); } } }
  __syncthreads();
#undef SLOAD
#undef SWRITE
#undef SWAIT
#undef RESC
}
}

__device__ __forceinline__ void attn_phase(const PV& p, int aj, int L, unsigned char* lds) {
    const float* qnw = p.in(18) + aj * 128;
    const bf16_t* U = (const bf16_t*)(p.ws + WS_UT); bf16_t* Y = (bf16_t*)(p.ws + WS_Y);
    const int nqb = L / 256, NB = TG / L;
    const int nitem = NB * 8 * nqb;
    const int ipp = 4 * nqb;
    for (int k = 0; k * (int)gridDim.x < nitem; ++k) {
        int it;
        if (gridDim.x == 256) { const int xcd = blockIdx.x & 7, slot = blockIdx.x >> 3; const int sub = ipp / 32;
            const int pair = (k / sub) * 8 + xcd; it = pair * ipp + (k % sub) * 32 + slot; }
        else { it = blockIdx.x + k * gridDim.x; if (it >= nitem) break; }
        const int qb = it % nqb; const int hq = (it / nqb) & 7; const int b = it / (nqb * 8); const int kvh = hq >> 2;
        const size_t row0 = (size_t)b * L + (size_t)qb * 256;
        att::attn_dense_body(U + row0 * LDU + hq * 128, U + (size_t)b * L * LDU + 1024 + kvh * 128, U + (size_t)b * L * LDU + 1280 + kvh * 128,
                             U + row0 * LDU + 1536 + hq * 128, Y + row0 * DM + hq * 128, L, (char*)lds, qnw, qb * 256);
    }
}

__device__ __forceinline__ void run_phase(const Params& pin, int ph, unsigned char* lds) {
    const PV p(pin, opaque_zero());
    if (ph == 0) { if (PHMASK & 1) prologue_phase(p, lds); if (PHMASK & 2) cvt_phase(p, 0); return; }
    const int q = ph - 1, g = q / 20, r = q % 20 + 1;
    const int L = g == 0 ? 2048 : 4096;
    const int layer = (r - 1) / 5, sub = (r - 1) % 5, j = layer >> 1;
    bf16_t* XB = (bf16_t*)(p.ws + WS_XB); bf16_t* UT = (bf16_t*)(p.ws + WS_UT); bf16_t* Y = (bf16_t*)(p.ws + WS_Y);
    if (sub == 4) {
#if PROBE_WHAT == 2
        if (layer != 3) ln_phase(p, g, layer, (bf16_t*)(p.ws + WS_GATE));
#endif
        if (PHMASK & 4) ln_phase(p, g, layer, XB);
        if (g == 0 && layer == 3 && (PHMASK & 2)) cvt_phase(p, 1);
        return; }
    if (sub == 3) {
        const bf16_t* WT = (const bf16_t*)(p.ws + ((layer & 1) ? WS_AWOUT : WS_HWOUT)) + (size_t)j * 1024 * 1024;
        EpiRes E; E.out = p.out + (size_t)g * TG * DM; E.xb = XB; E.last = layer == 3; E.bias = ((layer & 1) ? p.in(21) : p.in(15)) + j * 1024;
        E.dst = XB;
#if PROBE_WHAT == 1
        if (layer != 3) { EpiRes E0 = E; E0.dst = (bf16_t*)(p.ws + WS_GATE); run_gemm(lds, Y, WT, TG, 1024, E0); }
#endif
        if (PHMASK & 8) run_gemm(lds, Y, WT, TG, 1024, E); return;
    }
    if ((layer & 1) == 0) {
        if (sub == 0) {
            const bf16_t* WT = (const bf16_t*)(p.ws + WS_HWIN) + (size_t)j * 4096 * 1024;
            EpiUT E1; E1.O = UT; E1.bias = p.in(3) + j * 4096; E1.L = L;
            if (PHMASK & 16) run_gemm(lds, WT, XB, 3072, TG, E1);
            EpiBf16B E2; E2.O = (bf16_t*)(p.ws + WS_GATE); E2.ldc = 1024; E2.bias = p.in(3) + j * 4096 + 3072;
            if (PHMASK & 32) run_gemm(lds, XB, WT + (size_t)3072 * 1024, TG, 1024, E2);
            if (PHMASK & 2048) { if (g == 0) filter_phase<2048>(p, j, g * 2 + j, lds); else filter_phase<4096>(p, j, g * 2 + j, lds); }
        } else if (sub == 1) {
#if PROBE_WHAT == 4
            if (g == 0) conv_phase<16>(p, j, g * 2 + j, lds, Y, 1024); else conv_phase<8>(p, j, g * 2 + j, lds, Y, 1024);
#endif
            if (g == 0) { if (PHMASK & 64) conv_phase<16>(p, j, g * 2 + j, lds, UT, 3072); } else { if (PHMASK & 128) conv_phase<8>(p, j, g * 2 + j, lds, UT, 3072); } }
        else if (sub == 2) { if (PHMASK & 256) ygate_phase(p, L, lds); }
    } else {
        if (sub == 0) {
            const bf16_t* WT = (const bf16_t*)(p.ws + WS_AWIN) + (size_t)j * 2560 * 1024;
            EpiBf16B E; E.O = UT; E.ldc = LDU; E.bias = p.in(17) + j * 2560;
            if (PHMASK & 32) run_gemm(lds, XB, WT, TG, 2560, E);
            asm volatile("s_waitcnt vmcnt(0)" ::: "memory"); __syncthreads();
            { pg8::StaticOrder S; S.init(TG, 2560, (int)gridDim.x, (int)blockIdx.x); pg8::Unit u;
                for (int i = 0; S.next(i, u); ++i) if (u.pn == 4) rope_phase(p, j, L, UT, LDU, u.pm * 256, u.pm * 256 + 256); }
        }
        else if (sub == 2) { if (PHMASK & 1024) attn_phase(p, j, L, lds); }
    }
}

#ifndef DUPMASK
#define DUPMASK 0
#endif
__device__ __forceinline__ bool dup_phase(int ph) {
    if (ph == 0) return (DUPMASK >> 5) & 1;
    const int r = (ph - 1) % 21; if (r == 0) return (DUPMASK >> 5) & 1;
    const int layer = (r - 1) / 5, sub = (r - 1) % 5;
    if (sub > 2) return false;
    if ((layer & 1) == 0) return (DUPMASK >> sub) & 1;
    if (sub == 0) return (DUPMASK >> 3) & 1;
    if (sub == 2) return (DUPMASK >> 4) & 1;
    return false;
}
#define XB_XCNT(j)  (256  + 64 * (j))
#define XB_XSUB(j)  (1280 + 64 * (j))
#define XB_XGEN(j)  (2304 + 64 * (j))
#define XB_TOP      3328
#define XB_TOPGEN   3392
#define XCD_BAR_WORDS 3456
__device__ __forceinline__ unsigned xb_ld(unsigned* p)              { return __hip_atomic_load(p, __ATOMIC_RELAXED, __HIP_MEMORY_SCOPE_AGENT); }
__device__ __forceinline__ unsigned xb_add(unsigned* p, unsigned v) { return __hip_atomic_fetch_add(p, v, __ATOMIC_RELAXED, __HIP_MEMORY_SCOPE_AGENT); }
__device__ __forceinline__ unsigned xb_xcc_id() { return (unsigned)__builtin_amdgcn_s_getreg((3 << 11) | 20) & 0xFu; }
__device__ __forceinline__ void xcd_barrier(unsigned* bar, unsigned x, unsigned& nloc, unsigned& nx) {
    asm volatile("s_waitcnt vmcnt(0)" ::: "memory");
    __syncthreads();
    if (tidx() == 0) {
        __builtin_amdgcn_s_waitcnt(0);
        if (nloc == 0u) {
            const unsigned G = gridDim.x; unsigned sum, cnt, mine;
            for (;;) { sum = 0u; cnt = 0u; mine = 0u;
#pragma unroll
                for (unsigned j = 0; j < 16; ++j) { const unsigned c = xb_ld(&bar[XB_XCNT(j)]); sum += c; cnt += (c > 0u) ? 1u : 0u; mine = (j == x) ? c : mine; }
                if (sum == G) break;
                __builtin_amdgcn_s_sleep(1); }
            nloc = mine > 0u ? mine : 1u; nx = cnt > 0u ? cnt : 1u; }
        const unsigned old = xb_add(&bar[XB_XSUB(x)], 1u);
        const unsigned gen = old / nloc;
        if (old + 1u == (gen + 1u) * nloc) {
            __builtin_amdgcn_fence(__ATOMIC_RELEASE, "agent");
            asm volatile("s_waitcnt vmcnt(0)" ::: "memory");
            const unsigned og = xb_add(&bar[XB_TOP], 1u);
            const unsigned tg = og / nx;
            if (og + 1u == (tg + 1u) * nx) xb_add(&bar[XB_TOPGEN], 1u);
            else while (xb_ld(&bar[XB_TOPGEN]) == tg) __builtin_amdgcn_s_sleep(1);
            __builtin_amdgcn_fence(__ATOMIC_ACQUIRE, "agent");
            xb_add(&bar[XB_XGEN(x)], 1u);
            asm volatile("s_waitcnt vmcnt(0)" ::: "memory");
        } else {
            while (xb_ld(&bar[XB_XGEN(x)]) == gen) __builtin_amdgcn_s_sleep(1);
            __builtin_amdgcn_fence(__ATOMIC_ACQUIRE, "agent");
            asm volatile("s_waitcnt vmcnt(0)" ::: "memory");
        }
    }
    __syncthreads();
}

__global__ __launch_bounds__(512, 2) void mk_forward(Params p) {
    extern __shared__ __attribute__((aligned(16))) unsigned char smem[];
    cg::grid_group grid = cg::this_grid();
    unsigned* bar = (unsigned*)(p.ws + WS_BAR);
    unsigned xcc = 0, nloc = 0, nx = 0;
    for (int ph = p.ph_lo; ph < p.ph_hi; ++ph) {
        if (ph == 0 && blockIdx.x == 0) for (int i = threadIdx.x; i < XCD_BAR_WORDS; i += 512) __hip_atomic_store(bar + i, 0u, __ATOMIC_RELAXED, __HIP_MEMORY_SCOPE_AGENT);
        if (ph > 0 && (((ph - 1) % 20) / 5 & 1) && ((ph - 1) % 5) == 1) continue;
        run_phase(p, ph, smem);
        if (ph + 1 < p.ph_hi) {
            if (ph == p.ph_lo) { grid.sync();
                xcc = xb_xcc_id(); if (threadIdx.x == 0) (void)xb_add(&bar[XB_XCNT(xcc)], 1u); }
            else xcd_barrier(bar, xcc, nloc, nx);
        }
    }
}

extern "C" void kernel_launch(void* const* d_in, const int* in_sizes, int n_in, void* d_out, int out_size, void* d_ws, size_t ws_size, hipStream_t stream) {
    static int grid = 0;
    if (grid == 0) {
        if (n_in != 24 || ws_size < WS_END) { fprintf(stderr, "kernel_launch: unexpected n_in %d / ws %zu\n", n_in, ws_size); grid = -1; return; }
        int dev = 0, cus = 0, per_cu = 0;
        hipGetDevice(&dev); hipDeviceGetAttribute(&cus, hipDeviceAttributeMultiprocessorCount, dev);
        if (hipFuncSetAttribute((const void*)mk_forward, hipFuncAttributeMaxDynamicSharedMemorySize, LDS_BYTES) != hipSuccess) { fprintf(stderr, "kernel_launch: hipFuncSetAttribute failed\n"); grid = -1; return; }
        if (hipOccupancyMaxActiveBlocksPerMultiprocessor(&per_cu, (const void*)mk_forward, 512, LDS_BYTES) != hipSuccess || per_cu < 1) { fprintf(stderr, "kernel_launch: occupancy query gives %d\n", per_cu); per_cu = 1; }
        (void)hipGetLastError();
        grid = cus * per_cu;
    }
    if (grid < 0) return;
    Params p{};
    for (int i = 0; i < 24; ++i) p.in[i] = (const float*)d_in[i];
    p.out = (float*)d_out; p.ws = (unsigned char*)d_ws;
#if MK_LAUNCHES == 1
    p.ph_lo = 0; p.ph_hi = NPHASE;
    void* args[] = {&p};
    hipError_t e = hipLaunchCooperativeKernel((const void*)mk_forward, dim3(grid), dim3(512), args, LDS_BYTES, stream);
    if (e != hipSuccess) fprintf(stderr, "cooperative launch failed: %s (grid %d)\n", hipGetErrorString(e), grid);
#else
    for (int ph = 0; ph < NPHASE; ++ph) { p.ph_lo = ph; p.ph_hi = ph + 1;
        hipLaunchKernelGGL(mk_forward, dim3(grid), dim3(512), LDS_BYTES, stream, p); }
#endif
}
```
